# Optimizing an MI355X kernel written in HIP

```python
import math
import jax, jax.numpy as jnp
from jax import lax
import numpy as np

D_MODEL = 2048
BATCH = 1
SEQ = 8192
DEPTH = 4

CHUNK = 64
Q_BLOCK = 128

N_HEADS = 16
Q_LORA = 512
KV_LORA = 512
QK_NOPE = 128
QK_ROPE = 64
V_HEAD = 128
MLA_WIDTH = N_HEADS * V_HEAD
ROPE_THETA = 10000.0

LRU_WIDTH = D_MODEL
LRU_BLOCKS = 16
LRU_BLOCK_DIM = LRU_WIDTH // LRU_BLOCKS
CONV_K = 4
LRU_C = 8.0

PLE_DIM = 256

EPS = 1e-6

IN_SIZES = (Q_LORA, KV_LORA, QK_ROPE, MLA_WIDTH, LRU_WIDTH, LRU_WIDTH, D_MODEL, D_MODEL)
IN_TOTAL = sum(IN_SIZES)
IN_SPLITS = tuple(int(s) for s in np.cumsum(IN_SIZES)[:-1])

kernel_name = "hybrid_mla_rglru_gated_merge"


def rms_norm(x, g):
    xf = x.astype(jnp.float32)
    y = xf * lax.rsqrt(jnp.mean(xf * xf, axis=-1, keepdims=True) + EPS)
    return (y * g.astype(jnp.float32)).astype(x.dtype)


def rope_tables(positions):
    inv_freq = ROPE_THETA ** (-jnp.arange(0, QK_ROPE, 2, dtype=jnp.float32) / QK_ROPE)
    ang = positions.astype(jnp.float32)[..., None] * inv_freq
    return jnp.cos(ang), jnp.sin(ang)


def apply_rope(x, cos, sin):
    x1, x2 = jnp.split(x, 2, axis=-1)
    c = cos.astype(x.dtype)
    s = sin.astype(x.dtype)
    return jnp.concatenate([x1 * c - x2 * s, x2 * c + x1 * s], axis=-1)


def mla_branch(q_lat, kv_lat, k_rope_raw, gate, cos, sin, q_a_norm, w_q_b, kv_a_norm, w_kv_b, w_o):
    B, S, _ = q_lat.shape
    q = (rms_norm(q_lat, q_a_norm) @ w_q_b).reshape(B, S, N_HEADS, QK_NOPE + QK_ROPE)
    q_nope, q_rope = q[..., :QK_NOPE], q[..., QK_NOPE:]
    q_rope = apply_rope(q_rope, cos[:, :, None, :], sin[:, :, None, :])
    kv = (rms_norm(kv_lat, kv_a_norm) @ w_kv_b).reshape(B, S, N_HEADS, QK_NOPE + V_HEAD)
    k_nope, v = kv[..., :QK_NOPE], kv[..., QK_NOPE:]
    k_rope = apply_rope(k_rope_raw, cos, sin)
    scale = 1.0 / math.sqrt(QK_NOPE + QK_ROPE)
    n_blk = S // Q_BLOCK
    k_chunk = jnp.arange(S) // CHUNK

    qn_b = q_nope.reshape(B, n_blk, Q_BLOCK, N_HEADS, QK_NOPE).transpose(1, 0, 2, 3, 4)
    qr_b = q_rope.reshape(B, n_blk, Q_BLOCK, N_HEADS, QK_ROPE).transpose(1, 0, 2, 3, 4)

    def attend(args):
        qn, qr, blk = args
        s = (jnp.einsum('bqhd,bkhd->bhqk', qn, k_nope)
             + jnp.einsum('bqhr,bkr->bhqk', qr, k_rope)).astype(jnp.float32) * scale
        q_chunk = (blk * Q_BLOCK + jnp.arange(Q_BLOCK)) // CHUNK
        mask = k_chunk[None, :] <= q_chunk[:, None]
        s = jnp.where(mask[None, None], s, -jnp.inf)
        pr = jax.nn.softmax(s, axis=-1).astype(v.dtype)
        return jnp.einsum('bhqk,bkhd->bqhd', pr, v)

    o = lax.map(attend, (qn_b, qr_b, jnp.arange(n_blk)))
    o = o.transpose(1, 0, 2, 3, 4).reshape(B, S, MLA_WIDTH)
    return (o * jax.nn.silu(gate)) @ w_o


def causal_dwconv(x, w, b):
    S = x.shape[1]
    xp = jnp.pad(x, ((0, 0), (CONV_K - 1, 0), (0, 0)))
    y = xp[:, 0:S, :] * w[0]
    for k in range(1, CONV_K):
        y = y + xp[:, k:k + S, :] * w[k]
    return y + b


def rglru_branch(u, gate, conv_w, conv_b, w_rg, b_rg, w_ig, b_ig, lam, w_o):
    B, S, _ = u.shape
    xc = causal_dwconv(u, conv_w, conv_b)
    xh = xc.reshape(B, S, LRU_BLOCKS, LRU_BLOCK_DIM)
    r = jax.nn.sigmoid(jnp.einsum('bshi,hij->bshj', xh, w_rg).reshape(B, S, LRU_WIDTH) + b_rg)
    i = jax.nn.sigmoid(jnp.einsum('bshi,hij->bshj', xh, w_ig).reshape(B, S, LRU_WIDTH) + b_ig)
    log_a = (-LRU_C * r.astype(jnp.float32)) * jax.nn.softplus(-lam.astype(jnp.float32))
    a = jnp.exp(log_a)
    mult = jnp.sqrt(-jnp.expm1(2.0 * log_a))
    bterm = mult * (i * xc).astype(jnp.float32)

    def combine(lhs, rhs):
        a1, b1 = lhs
        a2, b2 = rhs
        return a1 * a2, a2 * b1 + b2

    _, h = lax.associative_scan(combine, (a, bterm), axis=1)
    h = h.astype(u.dtype)
    return (h * jax.nn.silu(gate)) @ w_o


def setup_inputs(seed: int = 0) -> dict:
    key = jax.random.key(seed)
    ks = jax.random.split(key, 32)
    f32 = jnp.float32

    def nrm(k, shape, fan_in):
        return jax.random.normal(k, shape, f32) * (fan_in ** -0.5)

    def gain(k, shape):
        return 1.0 + 0.02 * jax.random.normal(k, shape, f32)

    x = jax.random.normal(ks[0], (BATCH, SEQ, D_MODEL), f32)
    p = jax.random.normal(ks[1], (DEPTH, BATCH, SEQ, PLE_DIM), f32)
    offset = jax.random.randint(ks[2], (BATCH, 1), 0, 4096, dtype=jnp.int32)
    positions = offset + jnp.arange(SEQ, dtype=jnp.int32)[None, :]

    u = jax.random.uniform(ks[3], (DEPTH, LRU_WIDTH), f32, 0.9, 0.999)
    a0 = u ** (1.0 / LRU_C)
    lru_lambda = jnp.log(a0) - jnp.log1p(-a0)

    return {
        "x": x,
        "p": p,
        "positions": positions,
        "attn_norm": gain(ks[4], (DEPTH, D_MODEL)),
        "w_in": nrm(ks[5], (DEPTH, D_MODEL, IN_TOTAL), D_MODEL),
        "q_a_norm": gain(ks[6], (DEPTH, Q_LORA)),
        "w_q_b": nrm(ks[7], (DEPTH, Q_LORA, N_HEADS * (QK_NOPE + QK_ROPE)), Q_LORA),
        "kv_a_norm": gain(ks[8], (DEPTH, KV_LORA)),
        "w_kv_b": nrm(ks[9], (DEPTH, KV_LORA, N_HEADS * (QK_NOPE + V_HEAD)), KV_LORA),
        "conv_w": nrm(ks[10], (DEPTH, CONV_K, LRU_WIDTH), CONV_K),
        "conv_b": 0.01 * jax.random.normal(ks[11], (DEPTH, LRU_WIDTH), f32),
        "w_rg": nrm(ks[12], (DEPTH, LRU_BLOCKS, LRU_BLOCK_DIM, LRU_BLOCK_DIM), LRU_BLOCK_DIM),
        "b_rg": 0.01 * jax.random.normal(ks[13], (DEPTH, LRU_WIDTH), f32),
        "w_ig": nrm(ks[14], (DEPTH, LRU_BLOCKS, LRU_BLOCK_DIM, LRU_BLOCK_DIM), LRU_BLOCK_DIM),
        "b_ig": 0.01 * jax.random.normal(ks[15], (DEPTH, LRU_WIDTH), f32),
        "lru_lambda": lru_lambda,
        "w_o_mla": nrm(ks[16], (DEPTH, MLA_WIDTH, D_MODEL), MLA_WIDTH),
        "w_o_lru": nrm(ks[17], (DEPTH, LRU_WIDTH, D_MODEL), LRU_WIDTH),
        "w_out": nrm(ks[18], (DEPTH, D_MODEL, D_MODEL), D_MODEL),
        "ple_norm": gain(ks[19], (DEPTH, D_MODEL)),
        "w_ple_gate": nrm(ks[20], (DEPTH, D_MODEL, D_MODEL), D_MODEL),
        "w_ple": nrm(ks[21], (DEPTH, PLE_DIM, D_MODEL), PLE_DIM),
        "final_norm": gain(ks[22], (D_MODEL,)),
    }


def reference(x, p, positions, attn_norm, w_in, q_a_norm, w_q_b, kv_a_norm, w_kv_b,
              conv_w, conv_b, w_rg, b_rg, w_ig, b_ig, lru_lambda,
              w_o_mla, w_o_lru, w_out, ple_norm, w_ple_gate, w_ple, final_norm):
    cos, sin = rope_tables(positions)
    for l in range(DEPTH):
        h = rms_norm(x, attn_norm[l])
        z = h @ w_in[l]
        q_lat, kv_lat, k_rope_raw, g_mla, u_lru, g_lru, m_mla, m_lru = jnp.split(z, IN_SPLITS, axis=-1)
        y_mla = mla_branch(q_lat, kv_lat, k_rope_raw, g_mla, cos, sin,
                           q_a_norm[l], w_q_b[l], kv_a_norm[l], w_kv_b[l], w_o_mla[l])
        y_lru = rglru_branch(u_lru, g_lru, conv_w[l], conv_b[l], w_rg[l], b_rg[l],
                             w_ig[l], b_ig[l], lru_lambda[l], w_o_lru[l])
        merged = jax.nn.sigmoid(m_mla) * y_mla + jax.nn.sigmoid(m_lru) * y_lru
        x = x + merged @ w_out[l]
        ple_gate = jax.nn.sigmoid(rms_norm(x, ple_norm[l]) @ w_ple_gate[l])
        x = x + (p[l] @ w_ple[l]) * ple_gate
    return rms_norm(x, final_norm)
```

```cpp
#include <hip/hip_runtime.h>
#include <hip/hip_bf16.h>
#include <cstdio>
#include <cstdint>

constexpr int S = 8192, DM = 2048, DEPTH = 4, NH = 16, QL = 512, KVL = 512, NOPE = 128, ROPE = 64, VH = 128;
constexpr int INT = 11328, PLE = 256, LRUB = 16, LBD = 128, CHUNK = 64;
constexpr int QD = NOPE + ROPE;
constexpr int O_QLAT = 0, O_KVLAT = 512, O_KR = 1024, O_GMLA = 1088, O_U = 3136, O_GLRU = 5184, O_MMLA = 7232, O_MLRU = 9280;

typedef short bf16x8 __attribute__((ext_vector_type(8)));
typedef float f32x4 __attribute__((ext_vector_type(4)));

__device__ __forceinline__ unsigned short f2bf(float f) { unsigned u = __float_as_uint(f); u += 0x7FFFu + ((u >> 16) & 1u); return (unsigned short)(u >> 16); }
__device__ __forceinline__ float sigmoidf_(float x) { return 1.f / (1.f + __expf(-x)); }
__device__ __forceinline__ float siluf_(float x) { return x / (1.f + __expf(-x)); }

template <int BT>
__global__ __launch_bounds__(256) void ngemm(const float* __restrict__ A, long lda, long sA, const float* __restrict__ B, long ldb, long sB,
                                             float* __restrict__ C, long ldc, long sC, int M, int N, int K, int causal) {
    __shared__ __attribute__((aligned(16))) unsigned short sa[128][40];
    __shared__ __attribute__((aligned(16))) unsigned short sb[128][40];
    A += (long)blockIdx.z * sA; B += (long)blockIdx.z * sB; C += (long)blockIdx.z * sC;
    const int bm = blockIdx.y * 128, bn = blockIdx.x * 128;
    if (causal == 1 && bn >= bm + 128) return;
    if (causal == 2 && K > bm + 128) K = bm + 128;
    const int tid = threadIdx.x, wid = tid >> 6, lane = tid & 63, wr = wid >> 1, wc = wid & 1, row = lane & 15, quad = lane >> 4;
    f32x4 acc[4][4];
#pragma unroll
    for (int i = 0; i < 4; ++i)
#pragma unroll
        for (int j = 0; j < 4; ++j) acc[i][j] = (f32x4){0.f, 0.f, 0.f, 0.f};
    for (int k0 = 0; k0 < K; k0 += 32) {
        {
            const int r = tid >> 1, c0 = (tid & 1) * 16;
            const float* p = A + (long)(bm + r) * lda + k0 + c0;
#pragma unroll
            for (int j = 0; j < 4; ++j) { const f32x4 v = *(const f32x4*)(p + 4 * j);
                sa[r][c0 + 4 * j + 0] = f2bf(v[0]); sa[r][c0 + 4 * j + 1] = f2bf(v[1]); sa[r][c0 + 4 * j + 2] = f2bf(v[2]); sa[r][c0 + 4 * j + 3] = f2bf(v[3]); }
        }
        if (BT) {
            const int r = tid >> 1, c0 = (tid & 1) * 16;
            const bool ok = (bn + r) < N;
            const float* p = B + (long)(bn + r) * ldb + k0 + c0;
#pragma unroll
            for (int j = 0; j < 4; ++j) { f32x4 v = (f32x4){0.f, 0.f, 0.f, 0.f}; if (ok) v = *(const f32x4*)(p + 4 * j);
                sb[r][c0 + 4 * j + 0] = f2bf(v[0]); sb[r][c0 + 4 * j + 1] = f2bf(v[1]); sb[r][c0 + 4 * j + 2] = f2bf(v[2]); sb[r][c0 + 4 * j + 3] = f2bf(v[3]); }
        } else {
            const int k = tid >> 3, n0 = (tid & 7) * 16;
            const bool ok = (bn + n0) < N;
            const float* p = B + (long)(k0 + k) * ldb + bn + n0;
#pragma unroll
            for (int j = 0; j < 4; ++j) { f32x4 v = (f32x4){0.f, 0.f, 0.f, 0.f}; if (ok) v = *(const f32x4*)(p + 4 * j);
                sb[n0 + 4 * j + 0][k] = f2bf(v[0]); sb[n0 + 4 * j + 1][k] = f2bf(v[1]); sb[n0 + 4 * j + 2][k] = f2bf(v[2]); sb[n0 + 4 * j + 3][k] = f2bf(v[3]); }
        }
        __syncthreads();
        bf16x8 af[4], bfr[4];
#pragma unroll
        for (int i = 0; i < 4; ++i) af[i] = *(const bf16x8*)&sa[wr * 64 + i * 16 + row][quad * 8];
#pragma unroll
        for (int j = 0; j < 4; ++j) bfr[j] = *(const bf16x8*)&sb[wc * 64 + j * 16 + row][quad * 8];
#pragma unroll
        for (int i = 0; i < 4; ++i)
#pragma unroll
            for (int j = 0; j < 4; ++j) acc[i][j] = __builtin_amdgcn_mfma_f32_16x16x32_bf16(af[i], bfr[j], acc[i][j], 0, 0, 0);
        __syncthreads();
    }
#pragma unroll
    for (int i = 0; i < 4; ++i)
#pragma unroll
        for (int j = 0; j < 4; ++j) {
            const int c = bn + wc * 64 + j * 16 + row;
            if (c < N) {
#pragma unroll
                for (int e = 0; e < 4; ++e) C[(long)(bm + wr * 64 + i * 16 + quad * 4 + e) * ldc + c] = acc[i][j][e];
            }
        }
}

template <int BT>
static void gemm(hipStream_t st, const float* A, long lda, const float* B, long ldb, float* C, long ldc, int M, int N, int K,
                 int batch = 1, long sA = 0, long sB = 0, long sC = 0, int causal = 0) {
    dim3 g((N + 127) / 128, M / 128, batch);
    ngemm<BT><<<g, 256, 0, st>>>(A, lda, sA, B, ldb, sB, C, ldc, sC, M, N, K, causal);
}

template <class F> __global__ void ew_kernel(long n, F f) { long i = (long)blockIdx.x * blockDim.x + threadIdx.x; if (i < n) f(i); }
template <class F> static void ew(hipStream_t st, long n, F f) { ew_kernel<<<(unsigned)((n + 255) / 256), 256, 0, st>>>(n, f); }

__global__ __launch_bounds__(256) void rmsnorm_k(const float* __restrict__ in, long ldi, const float* __restrict__ g, float* __restrict__ out, long ldo, int n) {
    __shared__ float red[4];
    const float* p = in + (long)blockIdx.x * ldi; float* o = out + (long)blockIdx.x * ldo;
    float s = 0.f;
    for (int c = threadIdx.x; c < n; c += 256) { const float v = p[c]; s += v * v; }
    for (int off = 32; off; off >>= 1) s += __shfl_xor(s, off);
    if ((threadIdx.x & 63) == 0) red[threadIdx.x >> 6] = s;
    __syncthreads();
    s = red[0] + red[1] + red[2] + red[3];
    const float rinv = rsqrtf(s / (float)n + 1e-6f);
    for (int c = threadIdx.x; c < n; c += 256) o[c] = p[c] * rinv * g[c];
}

__global__ __launch_bounds__(256) void softmax_k(float* __restrict__ sc, float scale) {
    __shared__ float red[4];
    const int row = blockIdx.x; float* p = sc + (long)row * S;
    const int nv = 64 * (row / 64 + 1), nz = 128 * (row / 128 + 1);
    float m = -1e30f;
    for (int c = threadIdx.x; c < nv; c += 256) m = fmaxf(m, p[c]);
    for (int off = 32; off; off >>= 1) m = fmaxf(m, __shfl_xor(m, off));
    if ((threadIdx.x & 63) == 0) red[threadIdx.x >> 6] = m;
    __syncthreads();
    m = fmaxf(fmaxf(red[0], red[1]), fmaxf(red[2], red[3]));
    __syncthreads();
    float s = 0.f;
    for (int c = threadIdx.x; c < nv; c += 256) { const float e = __expf((p[c] - m) * scale); p[c] = e; s += e; }
    for (int off = 32; off; off >>= 1) s += __shfl_xor(s, off);
    if ((threadIdx.x & 63) == 0) red[threadIdx.x >> 6] = s;
    __syncthreads();
    s = red[0] + red[1] + red[2] + red[3];
    const float inv = 1.f / s;
    for (int c = threadIdx.x; c < nz; c += 256) p[c] = (c < nv) ? p[c] * inv : 0.f;
}

extern "C" void kernel_launch(void* const* d_in, const int* in_sizes, int n_in, void* d_out, int out_size, void* d_ws, size_t ws_size, hipStream_t st) {
    const float* x_in = (const float*)d_in[0];
    const float* p_in = (const float*)d_in[1];
    const int* pos = (const int*)d_in[2];
    const float* attn_norm = (const float*)d_in[3];
    const float* w_in = (const float*)d_in[4];
    const float* q_a_norm = (const float*)d_in[5];
    const float* w_q_b = (const float*)d_in[6];
    const float* kv_a_norm = (const float*)d_in[7];
    const float* w_kv_b = (const float*)d_in[8];
    const float* conv_w = (const float*)d_in[9];
    const float* conv_b = (const float*)d_in[10];
    const float* w_rg = (const float*)d_in[11];
    const float* b_rg = (const float*)d_in[12];
    const float* w_ig = (const float*)d_in[13];
    const float* b_ig = (const float*)d_in[14];
    const float* lam = (const float*)d_in[15];
    const float* w_o_mla = (const float*)d_in[16];
    const float* w_o_lru = (const float*)d_in[17];
    const float* w_out = (const float*)d_in[18];
    const float* ple_norm = (const float*)d_in[19];
    const float* w_ple_gate = (const float*)d_in[20];
    const float* w_ple = (const float*)d_in[21];
    const float* final_norm = (const float*)d_in[22];
    float* out = (float*)d_out;

    float* w = (float*)d_ws; size_t off = 0;
    auto take = [&](size_t n) { float* r = w + off; off += (n + 63) & ~(size_t)63; return r; };
    float* xr = take((size_t)S * DM);
    float* h = take((size_t)S * DM);
    float* z = take((size_t)S * INT);
    float* qn = take((size_t)S * QL);
    float* kvn = take((size_t)S * KVL);
    float* q = take((size_t)S * NH * QD);
    float* kv = take((size_t)S * NH * 256);
    float* kf = take((size_t)NH * S * QD);
    float* cs = take((size_t)S * 64);
    float* big = take((size_t)S * S);
    float* xc = take((size_t)S * DM);
    float* ga = take((size_t)S * DM);
    float* gb = take((size_t)S * DM);
    float* carry = take((size_t)3 * 128 * DM);
    if (off * 4 > ws_size) { fprintf(stderr, "workspace too small: need %zu have %zu\n", off * 4, ws_size); return; }
    float* y_mla = big; float* y_lru = big + (size_t)S * DM; float* merged = big + (size_t)2 * S * DM; float* pp = big + (size_t)3 * S * DM;
    float* o = h;

    hipMemcpyAsync(xr, x_in, (size_t)S * DM * 4, hipMemcpyDeviceToDevice, st);
    ew(st, (long)S * 32, [=] __device__(long i) {
        const int s = (int)(i >> 5), f = (int)(i & 31);
        const float inv = powf(10000.f, -(float)(2 * f) / 64.f);
        const float ang = (float)pos[s] * inv;
        cs[(long)s * 64 + f] = (float)cos((double)ang); cs[(long)s * 64 + 32 + f] = (float)sin((double)ang);
    });

    for (int l = 0; l < DEPTH; ++l) {
        const float* Win = w_in + (size_t)l * DM * INT;
        rmsnorm_k<<<S, 256, 0, st>>>(xr, DM, attn_norm + l * DM, h, DM, DM);
        gemm<0>(st, h, DM, Win, INT, z, INT, S, INT, DM);
        rmsnorm_k<<<S, 256, 0, st>>>(z + O_QLAT, INT, q_a_norm + l * QL, qn, QL, QL);
        rmsnorm_k<<<S, 256, 0, st>>>(z + O_KVLAT, INT, kv_a_norm + l * KVL, kvn, KVL, KVL);
        gemm<0>(st, qn, QL, w_q_b + (size_t)l * QL * NH * QD, NH * QD, q, NH * QD, S, NH * QD, QL);
        gemm<0>(st, kvn, KVL, w_kv_b + (size_t)l * KVL * NH * 256, NH * 256, kv, NH * 256, S, NH * 256, KVL);
        ew(st, (long)S * NH * 32, [=] __device__(long i) {
            const int f = (int)(i & 31), hh = (int)((i >> 5) & 15), s = (int)(i >> 9);
            float* p = q + (long)s * NH * QD + hh * QD + NOPE;
            const float c = cs[(long)s * 64 + f], sn = cs[(long)s * 64 + 32 + f], x1 = p[f], x2 = p[32 + f];
            p[f] = x1 * c - x2 * sn; p[32 + f] = x2 * c + x1 * sn;
        });
        ew(st, (long)NH * S * QD, [=] __device__(long i) {
            const int d = (int)(i % QD); const long t = i / QD; const int s = (int)(t % S), hh = (int)(t / S);
            float v;
            if (d < NOPE) v = kv[(long)s * NH * 256 + hh * 256 + d];
            else { const int f = (d - NOPE) & 31; const float* kr = z + (long)s * INT + O_KR;
                   const float c = cs[(long)s * 64 + f], sn = cs[(long)s * 64 + 32 + f], x1 = kr[f], x2 = kr[32 + f];
                   v = (d - NOPE) < 32 ? x1 * c - x2 * sn : x2 * c + x1 * sn; }
            kf[i] = v;
        });
        for (int hh = 0; hh < NH; ++hh) {
            gemm<1>(st, q + hh * QD, NH * QD, kf + (size_t)hh * S * QD, QD, big, S, S, S, QD, 1, 0, 0, 0, 1);
            softmax_k<<<S, 256, 0, st>>>(big, 0.07216878364870322f);
            gemm<0>(st, big, S, kv + hh * 256 + NOPE, NH * 256, o + hh * VH, DM, S, VH, S, 1, 0, 0, 0, 2);
        }
        ew(st, (long)S * DM, [=] __device__(long i) { const long s = i / DM; const int c = (int)(i % DM); o[i] *= siluf_(z[s * INT + O_GMLA + c]); });
        gemm<0>(st, o, DM, w_o_mla + (size_t)l * DM * DM, DM, y_mla, DM, S, DM, DM);
        {
            const float* cw = conv_w + (size_t)l * 4 * DM; const float* cb = conv_b + (size_t)l * DM;
            ew(st, (long)S * DM, [=] __device__(long i) {
                const int s = (int)(i / DM), c = (int)(i % DM); float y = cb[c];
#pragma unroll
                for (int k = 0; k < 4; ++k) { const int sp = s - 3 + k; if (sp >= 0) y += z[(long)sp * INT + O_U + c] * cw[k * DM + c]; }
                xc[i] = y;
            });
            gemm<0>(st, xc, DM, w_rg + (size_t)l * LRUB * LBD * LBD, LBD, ga, DM, S, LBD, LBD, LRUB, LBD, (long)LBD * LBD, LBD);
            gemm<0>(st, xc, DM, w_ig + (size_t)l * LRUB * LBD * LBD, LBD, gb, DM, S, LBD, LBD, LRUB, LBD, (long)LBD * LBD, LBD);
            const float* brg = b_rg + l * DM; const float* big_ = b_ig + l * DM; const float* lm = lam + l * DM;
            ew(st, (long)S * DM, [=] __device__(long i) {
                const int c = (int)(i % DM);
                const float r = sigmoidf_(ga[i] + brg[c]), ii = sigmoidf_(gb[i] + big_[c]);
                const float sp = log1pf(expf(-lm[c]));
                const float la = -8.f * r * sp;
                ga[i] = expf(la); gb[i] = sqrtf(-expm1f(2.f * la)) * (ii * xc[i]);
            });
            float* Pc = carry; float* Hc = carry + 128 * DM; float* Cin = carry + 2 * 128 * DM;
            ew(st, (long)128 * DM, [=] __device__(long i) {
                const int c = (int)(i % DM), ch = (int)(i / DM); float P = 1.f, H = 0.f;
                for (int t = 0; t < 64; ++t) { const long idx = (long)(ch * 64 + t) * DM + c; const float a = ga[idx]; H = a * H + gb[idx]; P *= a; }
                Pc[i] = P; Hc[i] = H;
            });
            ew(st, (long)DM, [=] __device__(long c) {
                float cr = 0.f;
                for (int ch = 0; ch < 128; ++ch) { Cin[(long)ch * DM + c] = cr; cr = Pc[(long)ch * DM + c] * cr + Hc[(long)ch * DM + c]; }
            });
            ew(st, (long)128 * DM, [=] __device__(long i) {
                const int c = (int)(i % DM), ch = (int)(i / DM); float H = Cin[i];
                for (int t = 0; t < 64; ++t) { const long idx = (long)(ch * 64 + t) * DM + c; H = ga[idx] * H + gb[idx];
                    gb[idx] = H * siluf_(z[(long)(ch * 64 + t) * INT + O_GLRU + c]); }
            });
            gemm<0>(st, gb, DM, w_o_lru + (size_t)l * DM * DM, DM, y_lru, DM, S, DM, DM);
        }
        ew(st, (long)S * DM, [=] __device__(long i) { const long s = i / DM; const int c = (int)(i % DM);
            merged[i] = sigmoidf_(z[s * INT + O_MMLA + c]) * y_mla[i] + sigmoidf_(z[s * INT + O_MLRU + c]) * y_lru[i]; });
        gemm<0>(st, merged, DM, w_out + (size_t)l * DM * DM, DM, y_mla, DM, S, DM, DM);
        ew(st, (long)S * DM, [=] __device__(long i) { xr[i] += y_mla[i]; });
        rmsnorm_k<<<S, 256, 0, st>>>(xr, DM, ple_norm + l * DM, h, DM, DM);
        gemm<0>(st, h, DM, w_ple_gate + (size_t)l * DM * DM, DM, y_lru, DM, S, DM, DM);
        gemm<0>(st, p_in + (size_t)l * S * PLE, PLE, w_ple + (size_t)l * PLE * DM, DM, pp, DM, S, DM, PLE);
        ew(st, (long)S * DM, [=] __device__(long i) { xr[i] += pp[i] * sigmoidf_(y_lru[i]); });
    }
    rmsnorm_k<<<S, 256, 0, st>>>(xr, DM, final_norm, out, DM, DM);
}
```

```cpp
#include <hip/hip_runtime.h>
#include <hip/hip_cooperative_groups.h>
#include <cstdio>
#include <cstdint>
namespace cg = cooperative_groups;

constexpr int S = 8192, DM = 2048, DEPTH = 4, NH = 16, QL = 512, KVL = 512, NOPE = 128, ROPE = 64, VH = 128;
constexpr int INT = 11328, PLE = 256, LRUB = 16, LBD = 128;
constexpr int QD = 192, NQ = NH * QD  , NKV = NH * 256  ;
constexpr int NIN = 11520;
constexpr int ZB = 10240, ZA = 1280;
constexpr int NTHR = 512;
constexpr float QSCALE = 0.07216878364870322f * 1.4426950408889634f;

typedef unsigned short u16;
typedef short bf16x8 __attribute__((ext_vector_type(8)));
typedef float f32x4 __attribute__((ext_vector_type(4)));
typedef float f32x2 __attribute__((ext_vector_type(2)));
typedef unsigned u32x2 __attribute__((ext_vector_type(2)));
typedef unsigned u32x4 __attribute__((ext_vector_type(4)));

__device__ __forceinline__ u16 f2bf(float f) { unsigned u = __float_as_uint(f); u += 0x7FFFu + ((u >> 16) & 1u); return (u16)(u >> 16); }
__device__ __forceinline__ float bf2f(u16 b) { return __uint_as_float(((unsigned)b) << 16); }
__device__ __forceinline__ unsigned pk2(float lo, float hi) { return (unsigned)f2bf(lo) | ((unsigned)f2bf(hi) << 16); }
__device__ __forceinline__ float sigmoidf_(float x) { return 1.f / (1.f + __expf(-x)); }
__device__ __forceinline__ float siluf_(float x) { return x / (1.f + __expf(-x)); }
__device__ __forceinline__ int opaque_zero() { int z; asm volatile("s_mov_b32 %0, 0" : "=s"(z)); return z; }
#define TID() ((int)threadIdx.x + opaque_zero())
__device__ __forceinline__ float wsum(float s) { for (int off = 32; off; off >>= 1) s += __shfl_xor(s, off); return s; }
__device__ __forceinline__ float wmax(float s) { for (int off = 32; off; off >>= 1) s = fmaxf(s, __shfl_xor(s, off)); return s; }

struct Params {
    const float *x_in, *p_in; const int* pos;
    const float *attn_norm, *w_in, *q_a_norm, *w_q_b, *kv_a_norm, *w_kv_b, *conv_w, *conv_b, *w_rg, *b_rg, *w_ig, *b_ig, *lam, *w_o_mla, *w_o_lru, *w_out, *ple_norm, *w_ple_gate, *w_ple, *final_norm;
    float* xr;
    u16 *Wt_in, *Wt_q, *Wt_kv, *Wt_lru, *Wt_o, *Wt_out, *Wt_pg, *Wt_ple;
    u16 *hb, *zB, *qn, *kvn, *Q, *Kf, *Vf, *xc, *OH, *mg, *pb, *Pm;
    float *zA, *la, *lb, *pp, *cs, *carry, *sc;
};

struct Unit { const u16* a; const u16* b; int pm, pn, aux; };

struct TileSched {
    const u16* A; long lda; const u16* B; long ldb; int nM, nN, G, c;
    __device__ __forceinline__ bool tile(int i, int& pm, int& pn) const {
        const int nwg = nM * nN; const long L = (long)i * G + c; if (L >= nwg) return false;
        int wgid = (int)L; { const int q = nwg / 8, r = nwg % 8, xcd = wgid % 8, off = wgid / 8; wgid = (xcd < r ? xcd * (q + 1) : r * (q + 1) + (xcd - r) * q) + off; }
        const int nig = 8 * nN, gid = wgid / nig, fm = gid * 8, gsz = (nM - fm) < 8 ? (nM - fm) : 8;
        pm = fm + ((wgid % nig) % gsz); pn = (wgid % nig) / gsz; return true;
    }
    __device__ __forceinline__ bool next(int i, Unit& u) const {
        if (!tile(i, u.pm, u.pn)) return false;
        u.a = A + (long)u.pm * 256 * lda; u.b = B + (long)u.pn * 256 * ldb; u.aux = 0; return true;
    }
};
struct LruSched : TileSched {
    __device__ __forceinline__ bool next(int i, Unit& u) const {
        if (!tile(i, u.pm, u.pn)) return false;
        u.a = A + (long)u.pm * 256 * lda + (u.pn >> 1) * 256; u.b = B + (long)u.pn * 65536; u.aux = 0; return true;
    }
};
struct MergeSched : TileSched {
    __device__ __forceinline__ bool next(int i, Unit& u) const {
        if (!tile(i >> 1, u.pm, u.pn)) return false;
        u.aux = i & 1; u.a = A + (long)u.pm * 256 * lda + u.aux * 2048; u.b = B + (long)u.pn * 256 * ldb + u.aux * 2048; return true;
    }
};
struct TriSched {
    const u16* A; long lda; const u16* B; long ldb; int G, c;
    __device__ __forceinline__ bool next(int i, Unit& u) const {
        int t = i * G + c; if (t >= 528) return false;
        int pm = 0; while (t >= pm + 1) { t -= pm + 1; ++pm; }
        u.pm = pm; u.pn = t; u.a = A + (long)pm * 256 * lda; u.b = B + (long)t * 256 * ldb; u.aux = 0; return true;
    }
};
struct RowSched {
    const u16* A; long lda; const u16* B; int G, c;
    __device__ __forceinline__ bool next(int i, Unit& u) const {
        const int t = i * G + c; if (t >= 32) return false;
        u.pm = 31 - t; u.pn = 0; u.a = A + (long)u.pm * 256 * lda; u.b = B; u.aux = 0; return true;
    }
};

template <class F>
__device__ __forceinline__ void epi_foreach(f32x4 (&acc)[2][2][4][2], const Unit& u, int wr, int wc, int fr, int fq, F f) {
    const int row0 = u.pm * 256 + wr * 64 + fr, col0 = u.pn * 256 + wc * 32 + 4 * fq;
#pragma unroll
    for (int ai = 0; ai < 2; ++ai)
#pragma unroll
        for (int m = 0; m < 4; ++m) {
#pragma unroll
            for (int bj = 0; bj < 2; ++bj)
#pragma unroll
                for (int n = 0; n < 2; ++n) f(row0 + ai * 128 + m * 16, col0 + bj * 128 + n * 16, acc[ai][bj][m][n]);
            __builtin_amdgcn_sched_barrier(0);
        }
}
#define EPI_COMMON  __device__ __forceinline__ bool keep(const Unit&) const { return false; } __device__ __forceinline__ int klimit(const Unit&, int K) const { return K; }
#define EPI_SIG     __device__ __forceinline__ void operator()(f32x4 (&acc)[2][2][4][2], const Unit& u, int wr, int wc, int fr, int fq) const

struct EpiIn { EPI_COMMON u16* zB; float* zA;
    EPI_SIG { const int seg = u.pn >> 3;
        epi_foreach(acc, u, wr, wc, fr, fq, [&](int row, int col, f32x4& v) {
            if (seg >= 5) { if (col < ZB + 1088) *(f32x4*)(zA + (long)row * ZA + (col - ZB)) = v; }
            else { f32x4 o;
#pragma unroll
                for (int e = 0; e < 4; ++e) o[e] = (seg == 1) ? v[e] : ((seg == 0 || seg == 2) ? siluf_(v[e]) : sigmoidf_(v[e]));
                *(u32x2*)(zB + (long)row * ZB + col) = (u32x2){pk2(o[0], o[1]), pk2(o[2], o[3])}; }
        }); } };
struct EpiQ { EPI_COMMON u16* Q; const float* cs;
    EPI_SIG { epi_foreach(acc, u, wr, wc, fr, fq, [&](int row, int col, f32x4& v) {
            const int d = col % QD; f32x4 o;
            if (d < NOPE) { o = v * QSCALE; }
            else { const int i0 = (d - NOPE) >> 1; const float* t = cs + (long)row * 64;
                   const float c0 = t[i0], s0 = t[32 + i0], c1 = t[i0 + 1], s1 = t[32 + i0 + 1];
                   o[0] = (v[0] * c0 - v[1] * s0) * QSCALE; o[1] = (v[1] * c0 + v[0] * s0) * QSCALE;
                   o[2] = (v[2] * c1 - v[3] * s1) * QSCALE; o[3] = (v[3] * c1 + v[2] * s1) * QSCALE; }
            *(u32x2*)(Q + (long)row * NQ + col) = (u32x2){pk2(o[0], o[1]), pk2(o[2], o[3])};
        }); } };
struct EpiKV { EPI_COMMON u16* Kf; u16* Vf;
    EPI_SIG { epi_foreach(acc, u, wr, wc, fr, fq, [&](int row, int col, f32x4& v) {
            const int hh = col >> 8, j = col & 255;
            u16* dst = (j < 128) ? Kf + ((long)hh * S + row) * QD + j : Vf + ((long)hh * S + row) * VH + (j - 128);
            *(u32x2*)dst = (u32x2){pk2(v[0], v[1]), pk2(v[2], v[3])};
        }); } };
struct EpiLru { EPI_COMMON const u16* xc; const float *brg, *big, *lam; float *la, *lb;
    EPI_SIG { epi_foreach(acc, u, wr, wc, fr, fq, [&](int row, int col, f32x4& v) {
            const int ch = (col >> 1);
            const unsigned xw = *(const unsigned*)(xc + (long)row * DM + ch);
            f32x2 av, bv;
#pragma unroll
            for (int e = 0; e < 2; ++e) { const int c = ch + e;
                const float r = sigmoidf_(v[2 * e] + brg[c]), ii = sigmoidf_(v[2 * e + 1] + big[c]);
                const float sp = log1pf(__expf(-lam[c])), lg = -8.f * r * sp;
                const float x = bf2f((u16)(e ? (xw >> 16) : (xw & 0xffffu)));
                av[e] = __expf(lg); bv[e] = sqrtf(-expm1f(2.f * lg)) * (ii * x); }
            *(f32x2*)(la + (long)row * DM + ch) = av; *(f32x2*)(lb + (long)row * DM + ch) = bv;
        }); } };
struct EpiMerge { const u16* zB; u16* mg;
    __device__ __forceinline__ bool keep(const Unit& u) const { return u.aux == 0; }
    __device__ __forceinline__ int klimit(const Unit&, int K) const { return K; }
    EPI_SIG { const int part = u.aux;
        epi_foreach(acc, u, wr, wc, fr, fq, [&](int row, int col, f32x4& v) {
            const u32x2 sm = *(const u32x2*)(zB + (long)row * ZB + 6144 + col), sl = *(const u32x2*)(zB + (long)row * ZB + 8192 + col);
            f32x4 fm = {__uint_as_float(sm[0] << 16), __uint_as_float(sm[0] & 0xffff0000u), __uint_as_float(sm[1] << 16), __uint_as_float(sm[1] & 0xffff0000u)};
            f32x4 fl = {__uint_as_float(sl[0] << 16), __uint_as_float(sl[0] & 0xffff0000u), __uint_as_float(sl[1] << 16), __uint_as_float(sl[1] & 0xffff0000u)};
#pragma unroll
            for (int e = 0; e < 4; ++e) fl[e] = fmaxf(fl[e], 1e-12f);
            if (part == 0) {
#pragma unroll
                for (int e = 0; e < 4; ++e) v[e] = v[e] * fm[e] / fl[e];
            } else { f32x4 o = v * fl; *(u32x2*)(mg + (long)row * DM + col) = (u32x2){pk2(o[0], o[1]), pk2(o[2], o[3])}; }
        }); } };
struct EpiOut { EPI_COMMON const float* xold; float* xnew;
    EPI_SIG { epi_foreach(acc, u, wr, wc, fr, fq, [&](int row, int col, f32x4& v) {
            const long idx = (long)row * DM + col; *(f32x4*)(xnew + idx) = *(const f32x4*)(xold + idx) + v; }); } };
struct EpiF32 { EPI_COMMON float* C; long ldc;
    EPI_SIG { epi_foreach(acc, u, wr, wc, fr, fq, [&](int row, int col, f32x4& v) { *(f32x4*)(C + (long)row * ldc + col) = v; }); } };
struct EpiPle { EPI_COMMON float* x; const float* pp;
    EPI_SIG { epi_foreach(acc, u, wr, wc, fr, fq, [&](int row, int col, f32x4& v) {
            const long idx = (long)row * DM + col; const f32x4 pv = *(const f32x4*)(pp + idx); f32x4 xv = *(const f32x4*)(x + idx);
#pragma unroll
            for (int e = 0; e < 4; ++e) xv[e] += pv[e] * sigmoidf_(v[e]);
            *(f32x4*)(x + idx) = xv; }); } };
struct EpiPV { const u16* zB; u16* OH; int head;
    __device__ __forceinline__ bool keep(const Unit&) const { return false; }
    __device__ __forceinline__ int klimit(const Unit& u, int K) const { return 256 * (u.pm + 1); }
    EPI_SIG { epi_foreach(acc, u, wr, wc, fr, fq, [&](int row, int col, f32x4& v) {
            if (col < VH) { const int c = head * VH + col; const u32x2 g = *(const u32x2*)(zB + (long)row * ZB + c);
                f32x4 o = {v[0] * __uint_as_float(g[0] << 16), v[1] * __uint_as_float(g[0] & 0xffff0000u), v[2] * __uint_as_float(g[1] << 16), v[3] * __uint_as_float(g[1] & 0xffff0000u)};
                *(u32x2*)(OH + (long)row * 4096 + c) = (u32x2){pk2(o[0], o[1]), pk2(o[2], o[3])}; }
        }); } };

template <int BMODE, class Epi, class Sched>
__device__ __forceinline__ void gemm_simple(char* lds, int K, long lda, long ldb, const Sched& Sc, const Epi& E) {
    u16 (*sa)[40] = (u16(*)[40])lds; u16 (*sb)[40] = (u16(*)[40])(lds + 256 * 40 * 2);
    const int tid = TID(), wid = tid >> 6, lane = tid & 63, wr = wid >> 2, wc = wid & 3, fr = lane & 15, fq = lane >> 4;
    f32x4 acc[2][2][4][2];
#pragma unroll
    for (int a = 0; a < 2; ++a)
#pragma unroll
        for (int b = 0; b < 2; ++b)
#pragma unroll
            for (int m = 0; m < 4; ++m)
#pragma unroll
                for (int n = 0; n < 2; ++n) acc[a][b][m][n] = (f32x4){0.f, 0.f, 0.f, 0.f};
    Unit u;
    for (int i = 0; Sc.next(i, u); ++i) {
        const int Ku = E.klimit(u, K);
        if (BMODE == 1) { for (int e = tid; e < 128 * 40; e += NTHR) sb[128 + e / 40][e % 40] = 0; }
        for (int k0 = 0; k0 < Ku; k0 += 32) {
#pragma unroll
            for (int j = 0; j < 2; ++j) { const int c = tid + j * NTHR, r = c >> 2, cc = (c & 3) * 8;
                *(u32x4*)&sa[r][cc] = *(const u32x4*)(u.a + (long)r * lda + k0 + cc);
                if (BMODE == 0) *(u32x4*)&sb[r][cc] = *(const u32x4*)(u.b + (long)r * ldb + k0 + cc); }
            if (BMODE == 1) { const int k = tid >> 4, n0 = (tid & 15) * 8; const u32x4 v = *(const u32x4*)(u.b + (long)(k0 + k) * ldb + n0);
#pragma unroll
                for (int e = 0; e < 4; ++e) { sb[n0 + 2 * e][k] = (u16)(v[e] & 0xffffu); sb[n0 + 2 * e + 1][k] = (u16)(v[e] >> 16); } }
            __syncthreads();
            bf16x8 bf[2][2];
#pragma unroll
            for (int bj = 0; bj < 2; ++bj)
#pragma unroll
                for (int n = 0; n < 2; ++n) bf[bj][n] = *(const bf16x8*)&sb[128 * bj + 32 * wc + 16 * n + fr][fq * 8];
#pragma unroll
            for (int ai = 0; ai < 2; ++ai) {
                bf16x8 af[4];
#pragma unroll
                for (int m = 0; m < 4; ++m) af[m] = *(const bf16x8*)&sa[128 * ai + 64 * wr + 16 * m + fr][fq * 8];
#pragma unroll
                for (int bj = 0; bj < 2; ++bj)
#pragma unroll
                    for (int m = 0; m < 4; ++m)
#pragma unroll
                        for (int n = 0; n < 2; ++n) acc[ai][bj][m][n] = __builtin_amdgcn_mfma_f32_16x16x32_bf16(bf[bj][n], af[m], acc[ai][bj][m][n], 0, 0, 0);
                __builtin_amdgcn_sched_barrier(0);
            }
            __syncthreads();
        }
        E(acc, u, wr, wc, fr, fq);
        if (!E.keep(u)) {
#pragma unroll
            for (int a = 0; a < 2; ++a)
#pragma unroll
                for (int b = 0; b < 2; ++b)
#pragma unroll
                    for (int m = 0; m < 4; ++m)
#pragma unroll
                        for (int n = 0; n < 2; ++n) acc[a][b][m][n] = (f32x4){0.f, 0.f, 0.f, 0.f};
        }
    }
}

template <class RM>
__device__ __forceinline__ void transpose_cvt(char* lds, const float* __restrict__ src, int K, int N, u16* __restrict__ dst, long ldd, int coff, RM rowmap) {
    u16 (*t)[72] = (u16(*)[72])lds;
    const int tk = K / 64, tn = N / 64, tid = TID();
    for (int tix = blockIdx.x; tix < tk * tn; tix += gridDim.x) {
        const int k0 = (tix / tn) * 64, n0 = (tix % tn) * 64;
        { const int k = tid >> 3, nn = (tid & 7) * 8; const float* p = src + (long)(k0 + k) * N + n0 + nn;
          const f32x4 v0 = *(const f32x4*)p, v1 = *(const f32x4*)(p + 4);
          *(u32x4*)&t[k][nn] = (u32x4){pk2(v0[0], v0[1]), pk2(v0[2], v0[3]), pk2(v1[0], v1[1]), pk2(v1[2], v1[3])}; }
        __syncthreads();
        { const int n = tid >> 3, kk = (tid & 7) * 8; u32x4 o;
#pragma unroll
          for (int e = 0; e < 4; ++e) o[e] = (unsigned)t[kk + 2 * e][n] | ((unsigned)t[kk + 2 * e + 1][n] << 16);
          *(u32x4*)(dst + (long)rowmap(n0 + n) * ldd + coff + k0 + kk) = o; }
        __syncthreads();
    }
}

__device__ __forceinline__ void phase_prologue(const Params& p, char* lds) {
    const long gtid = (long)blockIdx.x * NTHR + TID(), gsz = (long)gridDim.x * NTHR;
    for (int l = 0; l < DEPTH; ++l) {
        transpose_cvt(lds, p.w_in + (size_t)l * DM * INT, DM, INT, p.Wt_in + (size_t)l * NIN * DM, DM, 0, [](int n) { return n >= 1088 ? n - 1088 : n + ZB; });
        transpose_cvt(lds, p.w_q_b + (size_t)l * QL * NQ, QL, NQ, p.Wt_q + (size_t)l * NQ * QL, QL, 0, [](int n) {
            const int hh = n / QD, d = n % QD; if (d < NOPE) return n; const int e = d - NOPE; return hh * QD + NOPE + ((e & 31) << 1) + (e >> 5); });
        transpose_cvt(lds, p.w_kv_b + (size_t)l * KVL * NKV, KVL, NKV, p.Wt_kv + (size_t)l * NKV * KVL, KVL, 0, [](int n) { return n; });
        transpose_cvt(lds, p.w_o_mla + (size_t)l * DM * DM, DM, DM, p.Wt_o + (size_t)l * DM * 4096, 4096, 0, [](int n) { return n; });
        transpose_cvt(lds, p.w_o_lru + (size_t)l * DM * DM, DM, DM, p.Wt_o + (size_t)l * DM * 4096, 4096, 2048, [](int n) { return n; });
        transpose_cvt(lds, p.w_out + (size_t)l * DM * DM, DM, DM, p.Wt_out + (size_t)l * DM * DM, DM, 0, [](int n) { return n; });
        transpose_cvt(lds, p.w_ple_gate + (size_t)l * DM * DM, DM, DM, p.Wt_pg + (size_t)l * DM * DM, DM, 0, [](int n) { return n; });
        transpose_cvt(lds, p.w_ple + (size_t)l * PLE * DM, PLE, DM, p.Wt_ple + (size_t)l * DM * PLE, PLE, 0, [](int n) { return n; });
    }
    for (long i = gtid; i < (long)DEPTH * (NIN - INT) * DM / 8; i += gsz) { const long per = (long)(NIN - INT) * DM / 8; const int l = (int)(i / per); const long r = i % per;
        *(u32x4*)(p.Wt_in + ((size_t)l * NIN + INT) * DM + r * 8) = (u32x4){0u, 0u, 0u, 0u}; }
    for (long i = gtid; i < (long)DEPTH * LRUB * 256 * 256; i += gsz) {
        const int k = (int)(i & 255), o = (int)((i >> 8) & 255), blk = (int)((i >> 16) & 15), l = (int)(i >> 20);
        const int kk = k - 128 * (blk & 1), cl = o >> 1; float v = 0.f;
        if (kk >= 0 && kk < 128) v = ((o & 1) ? p.w_ig : p.w_rg)[(((size_t)l * LRUB + blk) * LBD + kk) * LBD + cl];
        p.Wt_lru[i] = f2bf(v); }
    for (long i = gtid; i < (long)DEPTH * S * PLE / 8; i += gsz) { const float* s = p.p_in + i * 8; const f32x4 v0 = *(const f32x4*)s, v1 = *(const f32x4*)(s + 4);
        *(u32x4*)(p.pb + i * 8) = (u32x4){pk2(v0[0], v0[1]), pk2(v0[2], v0[3]), pk2(v1[0], v1[1]), pk2(v1[2], v1[3])}; }
    for (long i = gtid; i < (long)S * 32; i += gsz) { const int s = (int)(i >> 5), f = (int)(i & 31);
        const float inv = powf(10000.f, -(float)(2 * f) / 64.f), ang = (float)p.pos[s] * inv;
        p.cs[(long)s * 64 + f] = (float)cos((double)ang); p.cs[(long)s * 64 + 32 + f] = (float)sin((double)ang); }
}

__device__ __forceinline__ void phase_rmsnorm_bf16(const float* __restrict__ x, const float* __restrict__ g, u16* __restrict__ out) {
    const int tid = TID(), lane = tid & 63, gw = blockIdx.x * (NTHR / 64) + (tid >> 6), nw = gridDim.x * (NTHR / 64);
    for (int row = gw; row < S; row += nw) {
        const float* p = x + (long)row * DM; f32x4 v[8]; float s = 0.f;
#pragma unroll
        for (int j = 0; j < 8; ++j) { v[j] = *(const f32x4*)(p + j * 256 + lane * 4); s += v[j][0] * v[j][0] + v[j][1] * v[j][1] + v[j][2] * v[j][2] + v[j][3] * v[j][3]; }
        s = wsum(s); const float rinv = rsqrtf(s * (1.f / DM) + 1e-6f);
#pragma unroll
        for (int j = 0; j < 8; ++j) { const f32x4 gg = *(const f32x4*)(g + j * 256 + lane * 4);
            *(u32x2*)(out + (long)row * DM + j * 256 + lane * 4) = (u32x2){pk2(v[j][0] * rinv * gg[0], v[j][1] * rinv * gg[1]), pk2(v[j][2] * rinv * gg[2], v[j][3] * rinv * gg[3])}; }
    }
}
__device__ __forceinline__ void phase_final_norm(float* __restrict__ x, const float* __restrict__ g) {
    const int tid = TID(), lane = tid & 63, gw = blockIdx.x * (NTHR / 64) + (tid >> 6), nw = gridDim.x * (NTHR / 64);
    for (int row = gw; row < S; row += nw) {
        float* p = x + (long)row * DM; f32x4 v[8]; float s = 0.f;
#pragma unroll
        for (int j = 0; j < 8; ++j) { v[j] = *(const f32x4*)(p + j * 256 + lane * 4); s += v[j][0] * v[j][0] + v[j][1] * v[j][1] + v[j][2] * v[j][2] + v[j][3] * v[j][3]; }
        s = wsum(s); const float rinv = rsqrtf(s * (1.f / DM) + 1e-6f);
#pragma unroll
        for (int j = 0; j < 8; ++j) { const f32x4 gg = *(const f32x4*)(g + j * 256 + lane * 4); *(f32x4*)(p + j * 256 + lane * 4) = v[j] * rinv * gg; }
    }
}
__device__ __forceinline__ void phase_t2(const Params& p, int l) {
    const int tid = TID(), lane = tid & 63, gw = blockIdx.x * (NTHR / 64) + (tid >> 6), nw = gridDim.x * (NTHR / 64);
    const float* cw = p.conv_w + (size_t)l * 4 * DM; const float* cb = p.conv_b + (size_t)l * DM;
    for (int row = gw; row < S; row += nw) {
        const float* zr = p.zA + (long)row * ZA;
#pragma unroll
        for (int part = 0; part < 2; ++part) {
            const float* src = zr + part * 512; const float* g = (part ? p.kv_a_norm : p.q_a_norm) + l * 512; u16* dst = (part ? p.kvn : p.qn) + (long)row * 512;
            const f32x4 v0 = *(const f32x4*)(src + lane * 4), v1 = *(const f32x4*)(src + 256 + lane * 4);
            float s = v0[0] * v0[0] + v0[1] * v0[1] + v0[2] * v0[2] + v0[3] * v0[3] + v1[0] * v1[0] + v1[1] * v1[1] + v1[2] * v1[2] + v1[3] * v1[3];
            s = wsum(s); const float rinv = rsqrtf(s * (1.f / 512.f) + 1e-6f);
            const f32x4 g0 = *(const f32x4*)(g + lane * 4), g1 = *(const f32x4*)(g + 256 + lane * 4);
            *(u32x2*)(dst + lane * 4) = (u32x2){pk2(v0[0] * rinv * g0[0], v0[1] * rinv * g0[1]), pk2(v0[2] * rinv * g0[2], v0[3] * rinv * g0[3])};
            *(u32x2*)(dst + 256 + lane * 4) = (u32x2){pk2(v1[0] * rinv * g1[0], v1[1] * rinv * g1[1]), pk2(v1[2] * rinv * g1[2], v1[3] * rinv * g1[3])};
        }
        if (lane < 32) { const float x1 = zr[1024 + lane], x2 = zr[1056 + lane], c = p.cs[(long)row * 64 + lane], sn = p.cs[(long)row * 64 + 32 + lane];
            const unsigned w = pk2(x1 * c - x2 * sn, x2 * c + x1 * sn);
#pragma unroll
            for (int hh = 0; hh < NH; ++hh) *(unsigned*)(p.Kf + ((long)hh * S + row) * QD + NOPE + 2 * lane) = w; }
#pragma unroll
        for (int j = 0; j < 8; ++j) { const int c = j * 256 + lane * 4; f32x4 y = *(const f32x4*)(cb + c);
#pragma unroll
            for (int k = 0; k < 4; ++k) { const int sp = row - 3 + k; if (sp >= 0) { const u32x2 uu = *(const u32x2*)(p.zB + (long)sp * ZB + 2048 + c); const f32x4 w = *(const f32x4*)(cw + k * DM + c);
                y[0] += __uint_as_float(uu[0] << 16) * w[0]; y[1] += __uint_as_float(uu[0] & 0xffff0000u) * w[1]; y[2] += __uint_as_float(uu[1] << 16) * w[2]; y[3] += __uint_as_float(uu[1] & 0xffff0000u) * w[3]; } }
            *(u32x2*)(p.xc + (long)row * DM + c) = (u32x2){pk2(y[0], y[1]), pk2(y[2], y[3])}; }
    }
}
__device__ __forceinline__ void phase_scan1(const Params& p) {
    float* Pc = p.carry; float* Hc = p.carry + 128 * DM;
    for (long i = (long)blockIdx.x * NTHR + TID(); i < 128L * DM; i += (long)gridDim.x * NTHR) {
        const int c = (int)(i % DM), ch = (int)(i / DM); float P = 1.f, H = 0.f;
        for (int t = 0; t < 64; ++t) { const long idx = (long)(ch * 64 + t) * DM + c; const float a = p.la[idx]; H = a * H + p.lb[idx]; P *= a; }
        Pc[i] = P; Hc[i] = H; }
}
__device__ __forceinline__ void phase_scan2(const Params& p) {
    float* Pc = p.carry; float* Hc = p.carry + 128 * DM; float* Cin = p.carry + 2 * 128 * DM;
    for (long c = (long)blockIdx.x * NTHR + TID(); c < DM; c += (long)gridDim.x * NTHR) {
        float cr = 0.f;
        for (int ch = 0; ch < 128; ++ch) { Cin[(long)ch * DM + c] = cr; cr = Pc[(long)ch * DM + c] * cr + Hc[(long)ch * DM + c]; } }
}
__device__ __forceinline__ void phase_scan3(const Params& p) {
    const float* Cin = p.carry + 2 * 128 * DM;
    for (long i = (long)blockIdx.x * NTHR + TID(); i < 128L * DM; i += (long)gridDim.x * NTHR) {
        const int c = (int)(i % DM), ch = (int)(i / DM); float H = Cin[i];
        for (int t = 0; t < 64; ++t) { const long r = ch * 64 + t, idx = r * DM + c; H = p.la[idx] * H + p.lb[idx];
            p.OH[r * 4096 + 2048 + c] = f2bf(H * bf2f(p.zB[r * ZB + 4096 + c])); } }
}
__device__ __forceinline__ void phase_softmax(const Params& p) {
    const int tid = TID(), lane = tid & 63, gw = blockIdx.x * (NTHR / 64) + (tid >> 6), nw = gridDim.x * (NTHR / 64);
    for (int row = gw; row < S; row += nw) {
        const float* s = p.sc + (long)row * S; u16* o = p.Pm + (long)row * S;
        const int nv = 64 * (row / 64 + 1), nz = 256 * (row / 256 + 1);
        float m = -1e30f; for (int c = lane; c < nv; c += 64) m = fmaxf(m, s[c]); m = wmax(m);
        float sum = 0.f; for (int c = lane; c < nv; c += 64) sum += exp2f(s[c] - m); sum = wsum(sum);
        const float inv = 1.f / sum;
        for (int c = lane; c < nz; c += 64) o[c] = (c < nv) ? f2bf(exp2f(s[c] - m) * inv) : (u16)0;
    }
}

__global__ __launch_bounds__(NTHR, 2) void mega(Params p) {
    extern __shared__ __attribute__((aligned(16))) char lds[];
    cg::grid_group grid = cg::this_grid();
    const int G = gridDim.x, c = blockIdx.x;
    phase_prologue(p, lds);
    grid.sync();
    for (int l = 0; l < DEPTH; ++l) {
        const float* xcur = l ? p.xr : p.x_in;
        phase_rmsnorm_bf16(xcur, p.attn_norm + l * DM, p.hb);
        grid.sync();
        { TileSched sc{p.hb, DM, p.Wt_in + (size_t)l * NIN * DM, DM, 32, NIN / 256, G, c}; EpiIn e{p.zB, p.zA}; gemm_simple<0>(lds, DM, DM, DM, sc, e); }
        grid.sync();
        phase_t2(p, l);
        grid.sync();
        { TileSched sc{p.qn, QL, p.Wt_q + (size_t)l * NQ * QL, QL, 32, NQ / 256, G, c}; EpiQ e{p.Q, p.cs}; gemm_simple<0>(lds, QL, QL, QL, sc, e); }
        { TileSched sc{p.kvn, KVL, p.Wt_kv + (size_t)l * NKV * KVL, KVL, 32, NKV / 256, G, (c + 128) % G}; EpiKV e{p.Kf, p.Vf}; gemm_simple<0>(lds, KVL, KVL, KVL, sc, e); }
        grid.sync();
        for (int hh = 0; hh < NH; ++hh) {
            { TriSched sc{p.Q + hh * QD, NQ, p.Kf + (size_t)hh * S * QD, QD, G, c}; EpiF32 e{p.sc, S}; gemm_simple<0>(lds, QD, NQ, QD, sc, e); }
            grid.sync();
            phase_softmax(p);
            grid.sync();
            { RowSched sc{p.Pm, S, p.Vf + (size_t)hh * S * VH, G, c}; EpiPV e{p.zB, p.OH, hh}; gemm_simple<1>(lds, S, S, VH, sc, e); }
            grid.sync();
        }
        { LruSched sc{{p.xc, DM, p.Wt_lru + (size_t)l * LRUB * 65536, 256, 32, LRUB, G, c}}; EpiLru e{p.xc, p.b_rg + l * DM, p.b_ig + l * DM, p.lam + l * DM, p.la, p.lb}; gemm_simple<0>(lds, 256, DM, 256, sc, e); }
        grid.sync();
        phase_scan1(p);
        grid.sync();
        phase_scan2(p);
        grid.sync();
        phase_scan3(p);
        grid.sync();
        { MergeSched sc{{p.OH, 4096, p.Wt_o + (size_t)l * DM * 4096, 4096, 32, 8, G, c}}; EpiMerge e{p.zB, p.mg}; gemm_simple<0>(lds, DM, 4096, 4096, sc, e); }
        grid.sync();
        { TileSched sc{p.mg, DM, p.Wt_out + (size_t)l * DM * DM, DM, 32, 8, G, c}; EpiOut e{xcur, p.xr}; gemm_simple<0>(lds, DM, DM, DM, sc, e); }
        { TileSched sc{p.pb + (size_t)l * S * PLE, PLE, p.Wt_ple + (size_t)l * DM * PLE, PLE, 32, 8, G, c}; EpiF32 e{p.pp, DM}; gemm_simple<0>(lds, PLE, PLE, PLE, sc, e); }
        grid.sync();
        phase_rmsnorm_bf16(p.xr, p.ple_norm + l * DM, p.hb);
        grid.sync();
        { TileSched sc{p.hb, DM, p.Wt_pg + (size_t)l * DM * DM, DM, 32, 8, G, c}; EpiPle e{p.xr, p.pp}; gemm_simple<0>(lds, DM, DM, DM, sc, e); }
        grid.sync();
    }
    phase_final_norm(p.xr, p.final_norm);
}

constexpr size_t LDS_BYTES = 2 * 256 * 40 * 2;

extern "C" void kernel_launch(void* const* d_in, const int* in_sizes, int n_in, void* d_out, int out_size, void* d_ws, size_t ws_size, hipStream_t st) {
    Params p{};
    p.x_in = (const float*)d_in[0]; p.p_in = (const float*)d_in[1]; p.pos = (const int*)d_in[2];
    p.attn_norm = (const float*)d_in[3]; p.w_in = (const float*)d_in[4]; p.q_a_norm = (const float*)d_in[5]; p.w_q_b = (const float*)d_in[6];
    p.kv_a_norm = (const float*)d_in[7]; p.w_kv_b = (const float*)d_in[8]; p.conv_w = (const float*)d_in[9]; p.conv_b = (const float*)d_in[10];
    p.w_rg = (const float*)d_in[11]; p.b_rg = (const float*)d_in[12]; p.w_ig = (const float*)d_in[13]; p.b_ig = (const float*)d_in[14]; p.lam = (const float*)d_in[15];
    p.w_o_mla = (const float*)d_in[16]; p.w_o_lru = (const float*)d_in[17]; p.w_out = (const float*)d_in[18]; p.ple_norm = (const float*)d_in[19];
    p.w_ple_gate = (const float*)d_in[20]; p.w_ple = (const float*)d_in[21]; p.final_norm = (const float*)d_in[22];
    p.xr = (float*)d_out;
    char* w = (char*)d_ws; size_t off = 0;
    auto take = [&](size_t bytes) { char* r = w + off; off += (bytes + 255) & ~(size_t)255; return r; };
    p.Wt_in = (u16*)take((size_t)DEPTH * NIN * DM * 2); p.Wt_q = (u16*)take((size_t)DEPTH * NQ * QL * 2); p.Wt_kv = (u16*)take((size_t)DEPTH * NKV * KVL * 2);
    p.Wt_lru = (u16*)take((size_t)DEPTH * LRUB * 65536 * 2); p.Wt_o = (u16*)take((size_t)DEPTH * DM * 4096 * 2); p.Wt_out = (u16*)take((size_t)DEPTH * DM * DM * 2);
    p.Wt_pg = (u16*)take((size_t)DEPTH * DM * DM * 2); p.Wt_ple = (u16*)take((size_t)DEPTH * DM * PLE * 2);
    p.hb = (u16*)take((size_t)S * DM * 2); p.zB = (u16*)take((size_t)S * ZB * 2); p.zA = (float*)take((size_t)S * ZA * 4);
    p.qn = (u16*)take((size_t)S * QL * 2); p.kvn = (u16*)take((size_t)S * KVL * 2); p.Q = (u16*)take((size_t)S * NQ * 2);
    p.Kf = (u16*)take((size_t)NH * S * QD * 2); p.Vf = (u16*)take((size_t)NH * S * VH * 2); p.xc = (u16*)take((size_t)S * DM * 2);
    p.OH = (u16*)take((size_t)S * 4096 * 2); p.pb = (u16*)take((size_t)DEPTH * S * PLE * 2); p.cs = (float*)take((size_t)S * 64 * 4); p.carry = (float*)take((size_t)3 * 128 * DM * 4);
    p.Pm = (u16*)take((size_t)S * S * 2);
    p.sc = (float*)take((size_t)S * S * 4);
    p.la = p.sc; p.lb = p.sc + (size_t)S * DM; p.pp = p.sc + (size_t)2 * S * DM; p.mg = (u16*)(p.sc + (size_t)3 * S * DM);
    if (off > ws_size) { fprintf(stderr, "workspace too small: need %zu have %zu\n", off, ws_size); return; }
    (void)hipFuncSetAttribute((const void*)mega, hipFuncAttributeMaxDynamicSharedMemorySize, (int)LDS_BYTES);
    int dev = 0, cus = 0; (void)hipGetDevice(&dev); (void)hipDeviceGetAttribute(&cus, hipDeviceAttributeMultiprocessorCount, dev);
    int per_cu = 0; (void)hipOccupancyMaxActiveBlocksPerMultiprocessor(&per_cu, mega, NTHR, LDS_BYTES);
    if (per_cu < 1 || cus < 1) { fprintf(stderr, "occupancy query failed\n"); return; }
    void* args[] = {&p};
    hipError_t e = hipLaunchCooperativeKernel((const void*)mega, dim3(cus), dim3(NTHR), args, LDS_BYTES, st);
    if (e != hipSuccess) fprintf(stderr, "cooperative launch failed: %s\n", hipGetErrorString(e));
}
```

```cpp
#include <hip/hip_runtime.h>
#include <hip/hip_cooperative_groups.h>
#include <cstdio>
#include <cstdint>
namespace cg = cooperative_groups;

constexpr int S = 8192, DM = 2048, DEPTH = 4, NH = 16, QL = 512, KVL = 512, NOPE = 128, ROPE = 64, VH = 128;
constexpr int INT = 11328, PLE = 256, LRUB = 16, LBD = 128;
constexpr int QD = 192, NQ = NH * QD  , NKV = NH * 256  ;
constexpr int NIN = 11520;
constexpr int ZB = 10240, ZA = 1280;
constexpr int NTHR = 512;
constexpr float QSCALE = 0.07216878364870322f * 1.4426950408889634f;

typedef unsigned short u16;
typedef short bf16x8 __attribute__((ext_vector_type(8)));
typedef float f32x4 __attribute__((ext_vector_type(4)));
typedef float f32x2 __attribute__((ext_vector_type(2)));
typedef unsigned u32x2 __attribute__((ext_vector_type(2)));
typedef unsigned u32x4 __attribute__((ext_vector_type(4)));

__device__ __forceinline__ u16 f2bf(float f) { unsigned u = __float_as_uint(f); u += 0x7FFFu + ((u >> 16) & 1u); return (u16)(u >> 16); }
__device__ __forceinline__ float bf2f(u16 b) { return __uint_as_float(((unsigned)b) << 16); }
__device__ __forceinline__ unsigned pk2(float lo, float hi) { return (unsigned)f2bf(lo) | ((unsigned)f2bf(hi) << 16); }
__device__ __forceinline__ float sigmoidf_(float x) { return 1.f / (1.f + __expf(-x)); }
__device__ __forceinline__ float siluf_(float x) { return x / (1.f + __expf(-x)); }
__device__ __forceinline__ int opaque_zero() { int z; asm volatile("s_mov_b32 %0, 0" : "=s"(z)); return z; }
#define TID() ((int)threadIdx.x + opaque_zero())
__device__ __forceinline__ float wsum(float s, int lane) { for (int off = 32; off; off >>= 1) s += __int_as_float(__builtin_amdgcn_ds_bpermute((lane ^ off) << 2, __float_as_int(s))); return s; }
__device__ __forceinline__ float wmax(float s, int lane) { for (int off = 32; off; off >>= 1) s = fmaxf(s, __int_as_float(__builtin_amdgcn_ds_bpermute((lane ^ off) << 2, __float_as_int(s)))); return s; }

struct Params {
    const float *x_in, *p_in; const int* pos;
    const float *attn_norm, *w_in, *q_a_norm, *w_q_b, *kv_a_norm, *w_kv_b, *conv_w, *conv_b, *w_rg, *b_rg, *w_ig, *b_ig, *lam, *w_o_mla, *w_o_lru, *w_out, *ple_norm, *w_ple_gate, *w_ple, *final_norm;
    float* xr;
    u16 *Wt_in, *Wt_q, *Wt_kv, *Wt_lru, *Wt_o, *Wt_out, *Wt_pg, *Wt_ple;
    u16 *hb, *zB, *qn, *kvn, *Q, *Kf, *Vf, *xc, *OH, *mg, *pb, *Pm;
    float *zA, *la, *lb, *pp, *cs, *carry, *sc, *nsp8;
};

struct Unit { const u16* a; const u16* b; int pm, pn, aux; };

struct TileSched {
    const u16* A; long lda; const u16* B; long ldb; int nM, nN, G, c;
    __device__ __forceinline__ bool tile(int i, int& pm, int& pn) const {
        const int nwg = nM * nN; const long L = (long)i * G + c; if (L >= nwg) return false;
        int wgid = (int)L; { const int q = nwg / 8, r = nwg % 8, xcd = wgid % 8, off = wgid / 8; wgid = (xcd < r ? xcd * (q + 1) : r * (q + 1) + (xcd - r) * q) + off; }
        const int nig = 8 * nN, gid = wgid / nig, fm = gid * 8, gsz = (nM - fm) < 8 ? (nM - fm) : 8;
        pm = fm + ((wgid % nig) % gsz); pn = (wgid % nig) / gsz; return true;
    }
    __device__ __forceinline__ bool next(int i, Unit& u) const {
        if (!tile(i, u.pm, u.pn)) return false;
        u.a = A + (long)u.pm * 256 * lda; u.b = B + (long)u.pn * 256 * ldb; u.aux = 0; return true;
    }
};
struct LruSched : TileSched {
    __device__ __forceinline__ bool next(int i, Unit& u) const {
        if (!tile(i, u.pm, u.pn)) return false;
        u.a = A + (long)u.pm * 256 * lda + (u.pn >> 1) * 256; u.b = B + (long)u.pn * 65536; u.aux = 0; return true;
    }
};
struct MergeSched : TileSched {
    __device__ __forceinline__ bool next(int i, Unit& u) const {
        if (!tile(i >> 1, u.pm, u.pn)) return false;
        u.aux = i & 1; u.a = A + (long)u.pm * 256 * lda + u.aux * 2048; u.b = B + (long)u.pn * 256 * ldb + u.aux * 2048; return true;
    }
};
struct TriSched {
    const u16* A; long lda; const u16* B; long ldb; int G, c;
    __device__ __forceinline__ bool next(int i, Unit& u) const {
        int t = i * G + c; if (t >= 528) return false;
        int pm = 0; while (t >= pm + 1) { t -= pm + 1; ++pm; }
        u.pm = pm; u.pn = t; u.a = A + (long)pm * 256 * lda; u.b = B + (long)t * 256 * ldb; u.aux = 0; return true;
    }
};
struct RowSched {
    const u16* A; long lda; const u16* B; int G, c;
    __device__ __forceinline__ bool next(int i, Unit& u) const {
        const int t = i * G + c; if (t >= 32) return false;
        u.pm = 31 - t; u.pn = 0; u.a = A + (long)u.pm * 256 * lda; u.b = B; u.aux = 0; return true;
    }
};

template <class F>
__device__ __forceinline__ void epi_foreach(f32x4 (&acc)[2][2][4][2], const Unit& u, int wr, int wc, int fr, int fq, F f) {
    const int row0 = u.pm * 256 + wr * 64 + fr, col0 = u.pn * 256 + wc * 32 + 4 * fq;
#pragma unroll
    for (int ai = 0; ai < 2; ++ai)
#pragma unroll
        for (int m = 0; m < 4; ++m) {
#pragma unroll
            for (int bj = 0; bj < 2; ++bj)
#pragma unroll
                for (int n = 0; n < 2; ++n) f(row0 + ai * 128 + m * 16, col0 + bj * 128 + n * 16, acc[ai][bj][m][n]);
            __builtin_amdgcn_sched_barrier(0);
        }
}
#define EPI_COMMON  __device__ __forceinline__ bool keep(const Unit&) const { return false; } __device__ __forceinline__ int klimit(const Unit&, int K) const { return K; }
#define EPI_SIG     __device__ __forceinline__ void operator()(f32x4 (&acc)[2][2][4][2], const Unit& u, int wr, int wc, int fr, int fq) const

struct EpiIn { EPI_COMMON u16* zB; float* zA;
    EPI_SIG { const int seg = u.pn >> 3;
        epi_foreach(acc, u, wr, wc, fr, fq, [&](int row, int col, f32x4& v) {
            if (seg >= 5) { if (col < ZB + 1088) *(f32x4*)(zA + (long)row * ZA + (col - ZB)) = v; }
            else { f32x4 o;
#pragma unroll
                for (int e = 0; e < 4; ++e) o[e] = (seg == 1) ? v[e] : ((seg == 0 || seg == 2) ? siluf_(v[e]) : sigmoidf_(v[e]));
                *(u32x2*)(zB + (long)row * ZB + col) = (u32x2){pk2(o[0], o[1]), pk2(o[2], o[3])}; }
        }); } };
struct EpiQ { EPI_COMMON u16* Q; const float* cs;
    EPI_SIG { epi_foreach(acc, u, wr, wc, fr, fq, [&](int row, int col, f32x4& v) {
            const int d = col % QD; f32x4 o;
            if (d < NOPE) { o = v * QSCALE; }
            else { const int i0 = (d - NOPE) >> 1; const float* t = cs + (long)row * 64;
                   const float c0 = t[i0], s0 = t[32 + i0], c1 = t[i0 + 1], s1 = t[32 + i0 + 1];
                   o[0] = (v[0] * c0 - v[1] * s0) * QSCALE; o[1] = (v[1] * c0 + v[0] * s0) * QSCALE;
                   o[2] = (v[2] * c1 - v[3] * s1) * QSCALE; o[3] = (v[3] * c1 + v[2] * s1) * QSCALE; }
            *(u32x2*)(Q + (long)row * NQ + col) = (u32x2){pk2(o[0], o[1]), pk2(o[2], o[3])};
        }); } };
struct EpiKV { EPI_COMMON u16* Kf; u16* Vf;
    EPI_SIG { epi_foreach(acc, u, wr, wc, fr, fq, [&](int row, int col, f32x4& v) {
            const int hh = col >> 8, j = col & 255;
            u16* dst = (j < 128) ? Kf + ((long)hh * S + row) * QD + j : Vf + ((long)hh * S + row) * VH + (j - 128);
            *(u32x2*)dst = (u32x2){pk2(v[0], v[1]), pk2(v[2], v[3])};
        }); } };
struct EpiLru { EPI_COMMON const u16* xc; const float *brg, *big, *nsp8; float *la, *lb;
    EPI_SIG { epi_foreach(acc, u, wr, wc, fr, fq, [&](int row, int col, f32x4& v) {
            const int ch = (col >> 1);
            const unsigned xw = *(const unsigned*)(xc + (long)row * DM + ch);
            const f32x2 b_r = *(const f32x2*)(brg + ch), b_i = *(const f32x2*)(big + ch), ns = *(const f32x2*)(nsp8 + ch);
            f32x2 av, bv;
#pragma unroll
            for (int e = 0; e < 2; ++e) {
                const float r = sigmoidf_(v[2 * e] + b_r[e]), ii = sigmoidf_(v[2 * e + 1] + b_i[e]);
                const float lg = r * ns[e], x2 = 2.f * lg;
                const float em = (x2 > -0.25f) ? x2 * (1.f + x2 * (0.5f + x2 * (0.16666667f + x2 * (0.041666668f + x2 * 0.0083333338f)))) : (__expf(x2) - 1.f);
                const float x = e ? __uint_as_float(xw & 0xffff0000u) : __uint_as_float(xw << 16);
                av[e] = __expf(lg); bv[e] = sqrtf(-em) * (ii * x); }
            *(f32x2*)(la + (long)row * DM + ch) = av; *(f32x2*)(lb + (long)row * DM + ch) = bv;
        }); } };
struct EpiMerge { const u16* zB; u16* mg;
    __device__ __forceinline__ bool keep(const Unit& u) const { return u.aux == 0; }
    __device__ __forceinline__ int klimit(const Unit&, int K) const { return K; }
    EPI_SIG { const int part = u.aux;
        epi_foreach(acc, u, wr, wc, fr, fq, [&](int row, int col, f32x4& v) {
            const u32x2 sm = *(const u32x2*)(zB + (long)row * ZB + 6144 + col), sl = *(const u32x2*)(zB + (long)row * ZB + 8192 + col);
            f32x4 fm = {__uint_as_float(sm[0] << 16), __uint_as_float(sm[0] & 0xffff0000u), __uint_as_float(sm[1] << 16), __uint_as_float(sm[1] & 0xffff0000u)};
            f32x4 fl = {__uint_as_float(sl[0] << 16), __uint_as_float(sl[0] & 0xffff0000u), __uint_as_float(sl[1] << 16), __uint_as_float(sl[1] & 0xffff0000u)};
#pragma unroll
            for (int e = 0; e < 4; ++e) fl[e] = fmaxf(fl[e], 1e-12f);
            if (part == 0) {
#pragma unroll
                for (int e = 0; e < 4; ++e) v[e] = v[e] * fm[e] / fl[e];
            } else { f32x4 o = v * fl; *(u32x2*)(mg + (long)row * DM + col) = (u32x2){pk2(o[0], o[1]), pk2(o[2], o[3])}; }
        }); } };
struct EpiOut { EPI_COMMON const float* xold; float* xnew;
    EPI_SIG { epi_foreach(acc, u, wr, wc, fr, fq, [&](int row, int col, f32x4& v) {
            const long idx = (long)row * DM + col; *(f32x4*)(xnew + idx) = *(const f32x4*)(xold + idx) + v; }); } };
struct EpiF32 { EPI_COMMON float* C; long ldc;
    EPI_SIG { epi_foreach(acc, u, wr, wc, fr, fq, [&](int row, int col, f32x4& v) { *(f32x4*)(C + (long)row * ldc + col) = v; }); } };
struct EpiPle { EPI_COMMON float* x; const float* pp;
    EPI_SIG { epi_foreach(acc, u, wr, wc, fr, fq, [&](int row, int col, f32x4& v) {
            const long idx = (long)row * DM + col; const f32x4 pv = *(const f32x4*)(pp + idx); f32x4 xv = *(const f32x4*)(x + idx);
#pragma unroll
            for (int e = 0; e < 4; ++e) xv[e] += pv[e] * sigmoidf_(v[e]);
            *(f32x4*)(x + idx) = xv; }); } };
struct EpiPV { const u16* zB; u16* OH; int head;
    __device__ __forceinline__ bool keep(const Unit&) const { return false; }
    __device__ __forceinline__ int klimit(const Unit& u, int K) const { return 256 * (u.pm + 1); }
    EPI_SIG { epi_foreach(acc, u, wr, wc, fr, fq, [&](int row, int col, f32x4& v) {
            if (col < VH) { const int c = head * VH + col; const u32x2 g = *(const u32x2*)(zB + (long)row * ZB + c);
                f32x4 o = {v[0] * __uint_as_float(g[0] << 16), v[1] * __uint_as_float(g[0] & 0xffff0000u), v[2] * __uint_as_float(g[1] << 16), v[3] * __uint_as_float(g[1] & 0xffff0000u)};
                *(u32x2*)(OH + (long)row * 4096 + c) = (u32x2){pk2(o[0], o[1]), pk2(o[2], o[3])}; }
        }); } };

template <int BMODE, class Epi, class Sched>
__device__ __forceinline__ void gemm_simple(char* lds, int K, long lda, long ldb, const Sched& Sc, const Epi& E) {
    u16 (*sa)[40] = (u16(*)[40])lds; u16 (*sb)[40] = (u16(*)[40])(lds + 256 * 40 * 2);
    const int tid = TID(), wid = tid >> 6, lane = tid & 63, wr = wid >> 2, wc = wid & 3, fr = lane & 15, fq = lane >> 4;
    f32x4 acc[2][2][4][2];
#pragma unroll
    for (int a = 0; a < 2; ++a)
#pragma unroll
        for (int b = 0; b < 2; ++b)
#pragma unroll
            for (int m = 0; m < 4; ++m)
#pragma unroll
                for (int n = 0; n < 2; ++n) acc[a][b][m][n] = (f32x4){0.f, 0.f, 0.f, 0.f};
    Unit u;
    for (int i = 0; Sc.next(i, u); ++i) {
        const int Ku = E.klimit(u, K);
        if (BMODE == 1) { for (int e = tid; e < 128 * 40; e += NTHR) sb[128 + e / 40][e % 40] = 0; }
        for (int k0 = 0; k0 < Ku; k0 += 32) {
#pragma unroll
            for (int j = 0; j < 2; ++j) { const int c = tid + j * NTHR, r = c >> 2, cc = (c & 3) * 8;
                *(u32x4*)&sa[r][cc] = *(const u32x4*)(u.a + (long)r * lda + k0 + cc);
                if (BMODE == 0) *(u32x4*)&sb[r][cc] = *(const u32x4*)(u.b + (long)r * ldb + k0 + cc); }
            if (BMODE == 1) { const int k = tid >> 4, n0 = (tid & 15) * 8; const u32x4 v = *(const u32x4*)(u.b + (long)(k0 + k) * ldb + n0);
#pragma unroll
                for (int e = 0; e < 4; ++e) { sb[n0 + 2 * e][k] = (u16)(v[e] & 0xffffu); sb[n0 + 2 * e + 1][k] = (u16)(v[e] >> 16); } }
            __syncthreads();
            bf16x8 bf[2][2];
#pragma unroll
            for (int bj = 0; bj < 2; ++bj)
#pragma unroll
                for (int n = 0; n < 2; ++n) bf[bj][n] = *(const bf16x8*)&sb[128 * bj + 32 * wc + 16 * n + fr][fq * 8];
#pragma unroll
            for (int ai = 0; ai < 2; ++ai) {
                bf16x8 af[4];
#pragma unroll
                for (int m = 0; m < 4; ++m) af[m] = *(const bf16x8*)&sa[128 * ai + 64 * wr + 16 * m + fr][fq * 8];
#pragma unroll
                for (int bj = 0; bj < 2; ++bj)
#pragma unroll
                    for (int m = 0; m < 4; ++m)
#pragma unroll
                        for (int n = 0; n < 2; ++n) acc[ai][bj][m][n] = __builtin_amdgcn_mfma_f32_16x16x32_bf16(bf[bj][n], af[m], acc[ai][bj][m][n], 0, 0, 0);
                __builtin_amdgcn_sched_barrier(0);
            }
            __syncthreads();
        }
        E(acc, u, wr, wc, fr, fq);
        if (!E.keep(u)) {
#pragma unroll
            for (int a = 0; a < 2; ++a)
#pragma unroll
                for (int b = 0; b < 2; ++b)
#pragma unroll
                    for (int m = 0; m < 4; ++m)
#pragma unroll
                        for (int n = 0; n < 2; ++n) acc[a][b][m][n] = (f32x4){0.f, 0.f, 0.f, 0.f};
        }
    }
}


#define LAS __attribute__((address_space(3)))
constexpr int HTB = 128 * 64 * 2;
__device__ __forceinline__ int lds_byte(int r, int c) { const int st = (r >> 4) * 2 + (c >> 5), rr = r & 15, cc = c & 31, ob = rr * 64 + cc * 2; return st * 1024 + (ob ^ (((ob >> 9) & 1) << 5)); }
__device__ __forceinline__ void stage_rc(int b, int& R, int& C) { const int st = b / 1024, sb = b % 1024, swz = sb ^ (((sb >> 9) & 1) << 5); R = (st >> 1) * 16 + swz / 64; C = (st & 1) * 32 + (swz % 64) / 2; }

template <class Epi, class Sched>
__device__ __forceinline__ void gemm_fast(char* lds_, int K, long lda, long ldb, const Sched& S_, const Epi& E) {
    LAS unsigned char* lds = (LAS unsigned char*)lds_;
    const int tid = TID(), wid = __builtin_amdgcn_readfirstlane(tid >> 6), lane = tid & 63, wr = wid >> 2, wc = wid & 3, fr = lane & 15, fq = lane >> 4;
    const int nt = K / 64;
    unsigned voffA[2], voffB[2];
#pragma unroll
    for (int i = 0; i < 2; ++i) { int R, C; stage_rc(tid * 16 + i * 8192, R, C); voffA[i] = (unsigned)(R * lda + C) * 2u; voffB[i] = (unsigned)(R * ldb + C) * 2u; }
    const size_t kstep = 128;
    const size_t hstepA = (size_t)128 * lda * 2, hstepB = (size_t)128 * ldb * 2;
    const unsigned ldsw = (unsigned)wid * 1024u;
    const int aoff = lds_byte(wr * 64 + fr, fq * 8), boff = lds_byte(wc * 32 + fr, fq * 8);
#define G_SA(b, h) (((b) * 2 + (h)) * HTB)
#define G_SB(b, h) ((4 + (b) * 2 + (h)) * HTB)
#define G_STAGE(bufoff, gbase, voff) do { _Pragma("unroll") for (int _i = 0; _i < 2; ++_i) \
        __builtin_amdgcn_global_load_lds((const unsigned*)((const char*)(gbase) + (voff)[_i]), (LAS unsigned*)(lds + (bufoff) + ldsw + _i * 8192), 16, 0, 0); } while (0)
#define G_LDA(dst, b, h) do { _Pragma("unroll") for (int m = 0; m < 4; ++m) _Pragma("unroll") for (int k = 0; k < 2; ++k) dst[m][k] = *(const LAS bf16x8*)(lds + G_SA(b, h) + aoff + m * 2048 + k * 1024); } while (0)
#define G_LDB(dst, b, h) do { _Pragma("unroll") for (int n = 0; n < 2; ++n) _Pragma("unroll") for (int k = 0; k < 2; ++k) dst[n][k] = *(const LAS bf16x8*)(lds + G_SB(b, h) + boff + n * 2048 + k * 1024); } while (0)
#define G_MMA(ai, bj, At, Bt) do { __builtin_amdgcn_s_setprio(1); _Pragma("unroll") for (int m = 0; m < 4; ++m) _Pragma("unroll") for (int n = 0; n < 2; ++n) _Pragma("unroll") for (int k = 0; k < 2; ++k) \
        acc[ai][bj][m][n] = __builtin_amdgcn_mfma_f32_16x16x32_bf16(Bt[n][k], At[m][k], acc[ai][bj][m][n], 0, 0, 0); __builtin_amdgcn_s_setprio(0); } while (0)
#define G_WAIT_V(n) asm volatile("s_waitcnt vmcnt(" #n ")" ::: "memory")
#define G_WAIT_L(n) asm volatile("s_waitcnt lgkmcnt(" #n ")" ::: "memory")
#define G_BAR __builtin_amdgcn_s_barrier()
#define G_SCHED __builtin_amdgcn_sched_barrier(0)
    Unit cur, nxt; int ui = 0;
    if (!S_.next(0, cur)) return;
    f32x4 acc[2][2][4][2];
#pragma unroll
    for (int a = 0; a < 2; ++a)
#pragma unroll
        for (int b = 0; b < 2; ++b)
#pragma unroll
            for (int m = 0; m < 4; ++m)
#pragma unroll
                for (int n = 0; n < 2; ++n) acc[a][b][m][n] = (f32x4){0.f, 0.f, 0.f, 0.f};
    bf16x8 At[4][2], B0[2][2], B1[2][2];
    const char* cA = (const char*)cur.a; const char* cB = (const char*)cur.b;
    G_STAGE(G_SB(0, 0), cB, voffB); G_STAGE(G_SA(0, 0), cA, voffA); G_STAGE(G_SB(0, 1), cB + hstepB, voffB); G_STAGE(G_SA(0, 1), cA + hstepA, voffA);
    if (wr == 1) G_BAR;
    G_WAIT_V(4); G_BAR;
    G_STAGE(G_SB(1, 0), cB + kstep, voffB); G_STAGE(G_SA(1, 0), cA + kstep, voffA); G_STAGE(G_SB(1, 1), cB + hstepB + kstep, voffB);
    G_WAIT_V(6); G_BAR;
    for (;;) {
        const bool has_next = S_.next(ui + 1, nxt);
        const char* nA = has_next ? (const char*)nxt.a : cA; const char* nB = has_next ? (const char*)nxt.b : cB;
#pragma unroll 1
        for (int t = 0; t < nt; t += 2) {
            const bool last = (t == nt - 2);
            const char* a1 = cA + (size_t)(t + 1) * kstep;
            const char* a2 = last ? nA : cA + (size_t)(t + 2) * kstep; const char* b2 = last ? nB : cB + (size_t)(t + 2) * kstep;
            const char* a3 = a2 + kstep; const char* b3 = b2 + kstep;
            G_LDB(B0, 0, 0); G_SCHED; G_LDA(At, 0, 0); G_STAGE(G_SA(1, 1), a1 + hstepA, voffA);
            G_WAIT_L(8); G_BAR; G_WAIT_L(0); G_MMA(0, 0, At, B0); G_BAR; G_SCHED;
            G_LDB(B1, 0, 1); G_STAGE(G_SB(0, 0), b2, voffB);
            G_BAR; G_WAIT_L(0); G_MMA(0, 1, At, B1); G_BAR;
            G_LDA(At, 0, 1); G_STAGE(G_SA(0, 0), a2, voffA);
            G_BAR; G_WAIT_L(0); G_MMA(1, 0, At, B0); G_BAR; G_SCHED;
            G_STAGE(G_SB(0, 1), b2 + hstepB, voffB);
            G_WAIT_V(6); G_BAR; G_MMA(1, 1, At, B1); G_BAR;
            G_LDB(B0, 1, 0); G_SCHED; G_LDA(At, 1, 0); G_STAGE(G_SA(0, 1), a2 + hstepA, voffA);
            G_WAIT_L(8); G_BAR; G_WAIT_L(0); G_MMA(0, 0, At, B0); G_BAR; G_SCHED;
            G_LDB(B1, 1, 1); G_STAGE(G_SB(1, 0), b3, voffB);
            G_BAR; G_WAIT_L(0); G_MMA(0, 1, At, B1); G_BAR;
            G_LDA(At, 1, 1); G_STAGE(G_SA(1, 0), a3, voffA);
            G_BAR; G_WAIT_L(0); G_MMA(1, 0, At, B0); G_BAR; G_SCHED;
            G_STAGE(G_SB(1, 1), b3 + hstepB, voffB);
            G_WAIT_V(6); G_BAR; G_MMA(1, 1, At, B1); G_BAR;
        }
        { const int t2 = TID(), w2 = t2 >> 6, l2 = t2 & 63;
          E(acc, cur, w2 >> 2, w2 & 3, l2 & 15, l2 >> 4); }
        if (!has_next) break;
        if (!E.keep(cur)) {
#pragma unroll
            for (int a = 0; a < 2; ++a)
#pragma unroll
                for (int b = 0; b < 2; ++b)
#pragma unroll
                    for (int m = 0; m < 4; ++m)
#pragma unroll
                        for (int n = 0; n < 2; ++n) acc[a][b][m][n] = (f32x4){0.f, 0.f, 0.f, 0.f};
        }
        cur = nxt; cA = nA; cB = nB; ++ui;
    }
    G_WAIT_V(0);
    if (wr == 0) G_BAR;
    G_BAR;
#undef G_SA
#undef G_SB
#undef G_STAGE
#undef G_LDA
#undef G_LDB
#undef G_MMA
#undef G_WAIT_V
#undef G_WAIT_L
#undef G_BAR
#undef G_SCHED
}

template <class RM>
__device__ __forceinline__ void transpose_cvt(char* lds, const float* __restrict__ src, int K, int N, u16* __restrict__ dst, long ldd, int coff, RM rowmap) {
    u16 (*t)[72] = (u16(*)[72])lds;
    const int tk = K / 64, tn = N / 64, tid = TID();
    for (int tix = blockIdx.x; tix < tk * tn; tix += gridDim.x) {
        const int k0 = (tix / tn) * 64, n0 = (tix % tn) * 64;
        { const int k = tid >> 3, nn = (tid & 7) * 8; const float* p = src + (long)(k0 + k) * N + n0 + nn;
          const f32x4 v0 = *(const f32x4*)p, v1 = *(const f32x4*)(p + 4);
          *(u32x4*)&t[k][nn] = (u32x4){pk2(v0[0], v0[1]), pk2(v0[2], v0[3]), pk2(v1[0], v1[1]), pk2(v1[2], v1[3])}; }
        __syncthreads();
        { const int n = tid >> 3, kk = (tid & 7) * 8; u32x4 o;
#pragma unroll
          for (int e = 0; e < 4; ++e) o[e] = (unsigned)t[kk + 2 * e][n] | ((unsigned)t[kk + 2 * e + 1][n] << 16);
          *(u32x4*)(dst + (long)rowmap(n0 + n) * ldd + coff + k0 + kk) = o; }
        __syncthreads();
    }
}

__device__ __forceinline__ void phase_prologue(const Params& p, char* lds) {
    const long gtid = (long)blockIdx.x * NTHR + TID(), gsz = (long)gridDim.x * NTHR;
    for (int l = 0; l < DEPTH; ++l) {
        transpose_cvt(lds, p.w_in + (size_t)l * DM * INT, DM, INT, p.Wt_in + (size_t)l * NIN * DM, DM, 0, [](int n) { return n >= 1088 ? n - 1088 : n + ZB; });
        transpose_cvt(lds, p.w_q_b + (size_t)l * QL * NQ, QL, NQ, p.Wt_q + (size_t)l * NQ * QL, QL, 0, [](int n) {
            const int hh = n / QD, d = n % QD; if (d < NOPE) return n; const int e = d - NOPE; return hh * QD + NOPE + ((e & 31) << 1) + (e >> 5); });
        transpose_cvt(lds, p.w_kv_b + (size_t)l * KVL * NKV, KVL, NKV, p.Wt_kv + (size_t)l * NKV * KVL, KVL, 0, [](int n) { return n; });
        transpose_cvt(lds, p.w_o_mla + (size_t)l * DM * DM, DM, DM, p.Wt_o + (size_t)l * DM * 4096, 4096, 0, [](int n) { return n; });
        transpose_cvt(lds, p.w_o_lru + (size_t)l * DM * DM, DM, DM, p.Wt_o + (size_t)l * DM * 4096, 4096, 2048, [](int n) { return n; });
        transpose_cvt(lds, p.w_out + (size_t)l * DM * DM, DM, DM, p.Wt_out + (size_t)l * DM * DM, DM, 0, [](int n) { return n; });
        transpose_cvt(lds, p.w_ple_gate + (size_t)l * DM * DM, DM, DM, p.Wt_pg + (size_t)l * DM * DM, DM, 0, [](int n) { return n; });
        transpose_cvt(lds, p.w_ple + (size_t)l * PLE * DM, PLE, DM, p.Wt_ple + (size_t)l * DM * PLE, PLE, 0, [](int n) { return n; });
    }
    for (long i = gtid; i < (long)DEPTH * (NIN - INT) * DM / 8; i += gsz) { const long per = (long)(NIN - INT) * DM / 8; const int l = (int)(i / per); const long r = i % per;
        *(u32x4*)(p.Wt_in + ((size_t)l * NIN + INT) * DM + r * 8) = (u32x4){0u, 0u, 0u, 0u}; }
    for (long i = gtid; i < (long)DEPTH * LRUB * 256 * 256; i += gsz) {
        const int k = (int)(i & 255), o = (int)((i >> 8) & 255), blk = (int)((i >> 16) & 15), l = (int)(i >> 20);
        const int kk = k - 128 * (blk & 1), cl = o >> 1; float v = 0.f;
        if (kk >= 0 && kk < 128) v = ((o & 1) ? p.w_ig : p.w_rg)[(((size_t)l * LRUB + blk) * LBD + kk) * LBD + cl];
        p.Wt_lru[i] = f2bf(v); }
    for (long i = gtid; i < (long)DEPTH * S * PLE / 8; i += gsz) { const float* s = p.p_in + i * 8; const f32x4 v0 = *(const f32x4*)s, v1 = *(const f32x4*)(s + 4);
        *(u32x4*)(p.pb + i * 8) = (u32x4){pk2(v0[0], v0[1]), pk2(v0[2], v0[3]), pk2(v1[0], v1[1]), pk2(v1[2], v1[3])}; }
    for (long i = gtid; i < (long)DEPTH * DM; i += gsz) p.nsp8[i] = -8.f * log1pf(expf(-p.lam[i]));
    for (long i = gtid; i < (long)S * 32; i += gsz) { const int s = (int)(i >> 5), f = (int)(i & 31);
        const float inv = powf(10000.f, -(float)(2 * f) / 64.f), ang = (float)p.pos[s] * inv;
        p.cs[(long)s * 64 + f] = (float)cos((double)ang); p.cs[(long)s * 64 + 32 + f] = (float)sin((double)ang); }
}

__device__ __forceinline__ void phase_rmsnorm_bf16(const float* __restrict__ x, const float* __restrict__ g, u16* __restrict__ out) {
    const int tid = TID(), lane = tid & 63, gw = blockIdx.x * (NTHR / 64) + (tid >> 6), nw = gridDim.x * (NTHR / 64);
    for (int row = gw; row < S; row += nw) {
        const float* p = x + (long)row * DM; f32x4 v[8]; float s = 0.f;
#pragma unroll
        for (int j = 0; j < 8; ++j) { v[j] = *(const f32x4*)(p + j * 256 + lane * 4); s += v[j][0] * v[j][0] + v[j][1] * v[j][1] + v[j][2] * v[j][2] + v[j][3] * v[j][3]; }
        s = wsum(s, lane); const float rinv = rsqrtf(s * (1.f / DM) + 1e-6f);
#pragma unroll
        for (int j = 0; j < 8; ++j) { const f32x4 gg = *(const f32x4*)(g + j * 256 + lane * 4);
            *(u32x2*)(out + (long)row * DM + j * 256 + lane * 4) = (u32x2){pk2(v[j][0] * rinv * gg[0], v[j][1] * rinv * gg[1]), pk2(v[j][2] * rinv * gg[2], v[j][3] * rinv * gg[3])}; }
    }
}
__device__ __forceinline__ void phase_final_norm(float* __restrict__ x, const float* __restrict__ g) {
    const int tid = TID(), lane = tid & 63, gw = blockIdx.x * (NTHR / 64) + (tid >> 6), nw = gridDim.x * (NTHR / 64);
    for (int row = gw; row < S; row += nw) {
        float* p = x + (long)row * DM; f32x4 v[8]; float s = 0.f;
#pragma unroll
        for (int j = 0; j < 8; ++j) { v[j] = *(const f32x4*)(p + j * 256 + lane * 4); s += v[j][0] * v[j][0] + v[j][1] * v[j][1] + v[j][2] * v[j][2] + v[j][3] * v[j][3]; }
        s = wsum(s, lane); const float rinv = rsqrtf(s * (1.f / DM) + 1e-6f);
#pragma unroll
        for (int j = 0; j < 8; ++j) { const f32x4 gg = *(const f32x4*)(g + j * 256 + lane * 4); *(f32x4*)(p + j * 256 + lane * 4) = v[j] * rinv * gg; }
    }
}
__device__ __forceinline__ void phase_t2(const Params& p, int l) {
    const int tid = TID(), lane = tid & 63, gw = blockIdx.x * (NTHR / 64) + (tid >> 6), nw = gridDim.x * (NTHR / 64);
    const float* cw = p.conv_w + (size_t)l * 4 * DM; const float* cb = p.conv_b + (size_t)l * DM;
    for (int row = gw; row < S; row += nw) {
        const float* zr = p.zA + (long)row * ZA;
#pragma unroll
        for (int part = 0; part < 2; ++part) {
            const float* src = zr + part * 512; const float* g = (part ? p.kv_a_norm : p.q_a_norm) + l * 512; u16* dst = (part ? p.kvn : p.qn) + (long)row * 512;
            const f32x4 v0 = *(const f32x4*)(src + lane * 4), v1 = *(const f32x4*)(src + 256 + lane * 4);
            float s = v0[0] * v0[0] + v0[1] * v0[1] + v0[2] * v0[2] + v0[3] * v0[3] + v1[0] * v1[0] + v1[1] * v1[1] + v1[2] * v1[2] + v1[3] * v1[3];
            s = wsum(s, lane); const float rinv = rsqrtf(s * (1.f / 512.f) + 1e-6f);
            const f32x4 g0 = *(const f32x4*)(g + lane * 4), g1 = *(const f32x4*)(g + 256 + lane * 4);
            *(u32x2*)(dst + lane * 4) = (u32x2){pk2(v0[0] * rinv * g0[0], v0[1] * rinv * g0[1]), pk2(v0[2] * rinv * g0[2], v0[3] * rinv * g0[3])};
            *(u32x2*)(dst + 256 + lane * 4) = (u32x2){pk2(v1[0] * rinv * g1[0], v1[1] * rinv * g1[1]), pk2(v1[2] * rinv * g1[2], v1[3] * rinv * g1[3])};
        }
        if (lane < 32) { const float x1 = zr[1024 + lane], x2 = zr[1056 + lane], c = p.cs[(long)row * 64 + lane], sn = p.cs[(long)row * 64 + 32 + lane];
            const unsigned w = pk2(x1 * c - x2 * sn, x2 * c + x1 * sn);
#pragma unroll
            for (int hh = 0; hh < NH; ++hh) *(unsigned*)(p.Kf + ((long)hh * S + row) * QD + NOPE + 2 * lane) = w; }
#pragma unroll
        for (int j = 0; j < 8; ++j) { const int c = j * 256 + lane * 4; f32x4 y = *(const f32x4*)(cb + c);
#pragma unroll
            for (int k = 0; k < 4; ++k) { const int sp = row - 3 + k; if (sp >= 0) { const u32x2 uu = *(const u32x2*)(p.zB + (long)sp * ZB + 2048 + c); const f32x4 w = *(const f32x4*)(cw + k * DM + c);
                y[0] += __uint_as_float(uu[0] << 16) * w[0]; y[1] += __uint_as_float(uu[0] & 0xffff0000u) * w[1]; y[2] += __uint_as_float(uu[1] << 16) * w[2]; y[3] += __uint_as_float(uu[1] & 0xffff0000u) * w[3]; } }
            *(u32x2*)(p.xc + (long)row * DM + c) = (u32x2){pk2(y[0], y[1]), pk2(y[2], y[3])}; }
    }
}
__device__ __forceinline__ void phase_scan1(const Params& p) {
    float* Pc = p.carry; float* Hc = p.carry + 128 * DM;
    for (long i = (long)blockIdx.x * NTHR + TID(); i < 128L * DM; i += (long)gridDim.x * NTHR) {
        const int c = (int)(i % DM), ch = (int)(i / DM); float P = 1.f, H = 0.f;
        for (int t = 0; t < 64; ++t) { const long idx = (long)(ch * 64 + t) * DM + c; const float a = p.la[idx]; H = a * H + p.lb[idx]; P *= a; }
        Pc[i] = P; Hc[i] = H; }
}
__device__ __forceinline__ void phase_scan2(const Params& p) {
    float* Pc = p.carry; float* Hc = p.carry + 128 * DM; float* Cin = p.carry + 2 * 128 * DM;
    for (long c = (long)blockIdx.x * NTHR + TID(); c < DM; c += (long)gridDim.x * NTHR) {
        float cr = 0.f;
        for (int ch = 0; ch < 128; ++ch) { Cin[(long)ch * DM + c] = cr; cr = Pc[(long)ch * DM + c] * cr + Hc[(long)ch * DM + c]; } }
}
__device__ __forceinline__ void phase_scan3(const Params& p) {
    const float* Cin = p.carry + 2 * 128 * DM;
    for (long i = (long)blockIdx.x * NTHR + TID(); i < 128L * DM; i += (long)gridDim.x * NTHR) {
        const int c = (int)(i % DM), ch = (int)(i / DM); float H = Cin[i];
        for (int t = 0; t < 64; ++t) { const long r = ch * 64 + t, idx = r * DM + c; H = p.la[idx] * H + p.lb[idx];
            p.OH[r * 4096 + 2048 + c] = f2bf(H * bf2f(p.zB[r * ZB + 4096 + c])); } }
}
__device__ __forceinline__ void phase_softmax(const Params& p) {
    const int tid = TID(), lane = tid & 63, gw = blockIdx.x * (NTHR / 64) + (tid >> 6), nw = gridDim.x * (NTHR / 64);
    for (int row = gw; row < S; row += nw) {
        const float* s = p.sc + (long)row * S; u16* o = p.Pm + (long)row * S;
        const int nv = 64 * (row / 64 + 1), nz = 256 * (row / 256 + 1);
        float m = -1e30f; for (int c = lane; c < nv; c += 64) m = fmaxf(m, s[c]); m = wmax(m, lane);
        float sum = 0.f; for (int c = lane; c < nv; c += 64) sum += exp2f(s[c] - m); sum = wsum(sum, lane);
        const float inv = 1.f / sum;
        for (int c = lane; c < nz; c += 64) o[c] = (c < nv) ? f2bf(exp2f(s[c] - m) * inv) : (u16)0;
    }
}

__global__ __launch_bounds__(NTHR, 2) void mega(Params p) {
    extern __shared__ __attribute__((aligned(16))) char lds[];
    cg::grid_group grid = cg::this_grid();
    const int G = gridDim.x, c = blockIdx.x;
    phase_prologue(p, lds);
    grid.sync();
    for (int l = 0; l < DEPTH; ++l) {
        const float* xcur = l ? p.xr : p.x_in;
        phase_rmsnorm_bf16(xcur, p.attn_norm + l * DM, p.hb);
        grid.sync();
        { TileSched sc{p.hb, DM, p.Wt_in + (size_t)l * NIN * DM, DM, 32, NIN / 256, G, c}; EpiIn e{p.zB, p.zA}; gemm_fast(lds, DM, DM, DM, sc, e); }
        grid.sync();
        phase_t2(p, l);
        grid.sync();
        { TileSched sc{p.qn, QL, p.Wt_q + (size_t)l * NQ * QL, QL, 32, NQ / 256, G, c}; EpiQ e{p.Q, p.cs}; gemm_fast(lds, QL, QL, QL, sc, e); }
        { TileSched sc{p.kvn, KVL, p.Wt_kv + (size_t)l * NKV * KVL, KVL, 32, NKV / 256, G, (c + 128) % G}; EpiKV e{p.Kf, p.Vf}; gemm_fast(lds, KVL, KVL, KVL, sc, e); }
        grid.sync();
        for (int hh = 0; hh < NH; ++hh) {
            { TriSched sc{p.Q + hh * QD, NQ, p.Kf + (size_t)hh * S * QD, QD, G, c}; EpiF32 e{p.sc, S}; gemm_simple<0>(lds, QD, NQ, QD, sc, e); }
            grid.sync();
            phase_softmax(p);
            grid.sync();
            { RowSched sc{p.Pm, S, p.Vf + (size_t)hh * S * VH, G, c}; EpiPV e{p.zB, p.OH, hh}; gemm_simple<1>(lds, S, S, VH, sc, e); }
            grid.sync();
        }
        { LruSched sc{{p.xc, DM, p.Wt_lru + (size_t)l * LRUB * 65536, 256, 32, LRUB, G, c}}; EpiLru e{p.xc, p.b_rg + l * DM, p.b_ig + l * DM, p.nsp8 + l * DM, p.la, p.lb}; gemm_fast(lds, 256, DM, 256, sc, e); }
        grid.sync();
        phase_scan1(p);
        grid.sync();
        phase_scan2(p);
        grid.sync();
        phase_scan3(p);
        grid.sync();
        { MergeSched sc{{p.OH, 4096, p.Wt_o + (size_t)l * DM * 4096, 4096, 32, 8, G, c}}; EpiMerge e{p.zB, p.mg}; gemm_fast(lds, DM, 4096, 4096, sc, e); }
        grid.sync();
        { TileSched sc{p.mg, DM, p.Wt_out + (size_t)l * DM * DM, DM, 32, 8, G, c}; EpiOut e{xcur, p.xr}; gemm_fast(lds, DM, DM, DM, sc, e); }
        { TileSched sc{p.pb + (size_t)l * S * PLE, PLE, p.Wt_ple + (size_t)l * DM * PLE, PLE, 32, 8, G, c}; EpiF32 e{p.pp, DM}; gemm_fast(lds, PLE, PLE, PLE, sc, e); }
        grid.sync();
        phase_rmsnorm_bf16(p.xr, p.ple_norm + l * DM, p.hb);
        grid.sync();
        { TileSched sc{p.hb, DM, p.Wt_pg + (size_t)l * DM * DM, DM, 32, 8, G, c}; EpiPle e{p.xr, p.pp}; gemm_fast(lds, DM, DM, DM, sc, e); }
        grid.sync();
    }
    phase_final_norm(p.xr, p.final_norm);
}

constexpr size_t LDS_BYTES = 8 * HTB;

extern "C" void kernel_launch(void* const* d_in, const int* in_sizes, int n_in, void* d_out, int out_size, void* d_ws, size_t ws_size, hipStream_t st) {
    Params p{};
    p.x_in = (const float*)d_in[0]; p.p_in = (const float*)d_in[1]; p.pos = (const int*)d_in[2];
    p.attn_norm = (const float*)d_in[3]; p.w_in = (const float*)d_in[4]; p.q_a_norm = (const float*)d_in[5]; p.w_q_b = (const float*)d_in[6];
    p.kv_a_norm = (const float*)d_in[7]; p.w_kv_b = (const float*)d_in[8]; p.conv_w = (const float*)d_in[9]; p.conv_b = (const float*)d_in[10];
    p.w_rg = (const float*)d_in[11]; p.b_rg = (const float*)d_in[12]; p.w_ig = (const float*)d_in[13]; p.b_ig = (const float*)d_in[14]; p.lam = (const float*)d_in[15];
    p.w_o_mla = (const float*)d_in[16]; p.w_o_lru = (const float*)d_in[17]; p.w_out = (const float*)d_in[18]; p.ple_norm = (const float*)d_in[19];
    p.w_ple_gate = (const float*)d_in[20]; p.w_ple = (const float*)d_in[21]; p.final_norm = (const float*)d_in[22];
    p.xr = (float*)d_out;
    char* w = (char*)d_ws; size_t off = 0;
    auto take = [&](size_t bytes) { char* r = w + off; off += (bytes + 255) & ~(size_t)255; return r; };
    p.Wt_in = (u16*)take((size_t)DEPTH * NIN * DM * 2); p.Wt_q = (u16*)take((size_t)DEPTH * NQ * QL * 2); p.Wt_kv = (u16*)take((size_t)DEPTH * NKV * KVL * 2);
    p.Wt_lru = (u16*)take((size_t)DEPTH * LRUB * 65536 * 2); p.Wt_o = (u16*)take((size_t)DEPTH * DM * 4096 * 2); p.Wt_out = (u16*)take((size_t)DEPTH * DM * DM * 2);
    p.Wt_pg = (u16*)take((size_t)DEPTH * DM * DM * 2); p.Wt_ple = (u16*)take((size_t)DEPTH * DM * PLE * 2);
    p.hb = (u16*)take((size_t)S * DM * 2); p.zB = (u16*)take((size_t)S * ZB * 2); p.zA = (float*)take((size_t)S * ZA * 4);
    p.qn = (u16*)take((size_t)S * QL * 2); p.kvn = (u16*)take((size_t)S * KVL * 2); p.Q = (u16*)take((size_t)S * NQ * 2);
    p.Kf = (u16*)take((size_t)NH * S * QD * 2); p.Vf = (u16*)take((size_t)NH * S * VH * 2); p.xc = (u16*)take((size_t)S * DM * 2);
    p.OH = (u16*)take((size_t)S * 4096 * 2); p.pb = (u16*)take((size_t)DEPTH * S * PLE * 2); p.cs = (float*)take((size_t)S * 64 * 4); p.carry = (float*)take((size_t)3 * 128 * DM * 4); p.nsp8 = (float*)take((size_t)DEPTH * DM * 4);
    p.Pm = (u16*)take((size_t)S * S * 2);
    p.sc = (float*)take((size_t)S * S * 4);
    p.la = p.sc; p.lb = p.sc + (size_t)S * DM; p.pp = p.sc + (size_t)2 * S * DM; p.mg = (u16*)(p.sc + (size_t)3 * S * DM);
    if (off > ws_size) { fprintf(stderr, "workspace too small: need %zu have %zu\n", off, ws_size); return; }
    (void)hipFuncSetAttribute((const void*)mega, hipFuncAttributeMaxDynamicSharedMemorySize, (int)LDS_BYTES);
    int dev = 0, cus = 0; (void)hipGetDevice(&dev); (void)hipDeviceGetAttribute(&cus, hipDeviceAttributeMultiprocessorCount, dev);
    int per_cu = 0; (void)hipOccupancyMaxActiveBlocksPerMultiprocessor(&per_cu, mega, NTHR, LDS_BYTES);
    if (per_cu < 1 || cus < 1) { fprintf(stderr, "occupancy query failed\n"); return; }
    void* args[] = {&p};
    hipError_t e = hipLaunchCooperativeKernel((const void*)mega, dim3(cus), dim3(NTHR), args, LDS_BYTES, st);
    if (e != hipSuccess) fprintf(stderr, "cooperative launch failed: %s\n", hipGetErrorString(e));
}
```

```cpp
#include <hip/hip_runtime.h>
#include <hip/hip_cooperative_groups.h>
#include <cstdio>
#include <cstdint>
namespace cg = cooperative_groups;

constexpr int S = 8192, DM = 2048, DEPTH = 4, NH = 16, QL = 512, KVL = 512, NOPE = 128, ROPE = 64, VH = 128;
constexpr int INT = 11328, PLE = 256, LRUB = 16, LBD = 128;
constexpr int QD = 192, NQ = NH * QD  , NKV = NH * 256  ;
constexpr int NIN = 11520;
constexpr int ZB = 10240, ZA = 1280;
constexpr int NTHR = 512;
constexpr float QSCALE = 0.07216878364870322f * 1.4426950408889634f;

typedef unsigned short u16;
typedef short bf16x8 __attribute__((ext_vector_type(8)));
typedef float f32x4 __attribute__((ext_vector_type(4)));
typedef float f32x2 __attribute__((ext_vector_type(2)));
typedef unsigned u32x2 __attribute__((ext_vector_type(2)));
typedef unsigned u32x4 __attribute__((ext_vector_type(4)));

__device__ __forceinline__ u16 f2bf(float f) { unsigned u = __float_as_uint(f); u += 0x7FFFu + ((u >> 16) & 1u); return (u16)(u >> 16); }
__device__ __forceinline__ float bf2f(u16 b) { return __uint_as_float(((unsigned)b) << 16); }
__device__ __forceinline__ unsigned pk2(float lo, float hi) { return (unsigned)f2bf(lo) | ((unsigned)f2bf(hi) << 16); }
__device__ __forceinline__ float sigmoidf_(float x) { return 1.f / (1.f + __expf(-x)); }
__device__ __forceinline__ float siluf_(float x) { return x / (1.f + __expf(-x)); }
__device__ __forceinline__ int opaque_zero() { int z; asm volatile("s_mov_b32 %0, 0" : "=s"(z)); return z; }
#define TID() ((int)threadIdx.x + opaque_zero())
__device__ __forceinline__ float wsum(float s, int lane) { for (int off = 32; off; off >>= 1) s += __int_as_float(__builtin_amdgcn_ds_bpermute((lane ^ off) << 2, __float_as_int(s))); return s; }
__device__ __forceinline__ float wmax(float s, int lane) { for (int off = 32; off; off >>= 1) s = fmaxf(s, __int_as_float(__builtin_amdgcn_ds_bpermute((lane ^ off) << 2, __float_as_int(s)))); return s; }

struct Params {
    const float *x_in, *p_in; const int* pos;
    const float *attn_norm, *w_in, *q_a_norm, *w_q_b, *kv_a_norm, *w_kv_b, *conv_w, *conv_b, *w_rg, *b_rg, *w_ig, *b_ig, *lam, *w_o_mla, *w_o_lru, *w_out, *ple_norm, *w_ple_gate, *w_ple, *final_norm;
    float* xr;
    u16 *Wt_in, *Wt_q, *Wt_kv, *Wt_lru, *Wt_o, *Wt_out, *Wt_pg, *Wt_ple;
    u16 *hb, *zB, *qn, *kvn, *Q, *Kf, *Vf, *xc, *OH, *mg, *pb, *Pm;
    float *zA, *la, *lb, *pp, *cs, *carry, *sc, *nsp8;
};

struct Unit { const u16* a; const u16* b; int pm, pn, aux; };

struct TileSched {
    const u16* A; long lda; const u16* B; long ldb; int nM, nN, G, c;
    __device__ __forceinline__ bool tile(int i, int& pm, int& pn) const {
        const int nwg = nM * nN; const long L = (long)i * G + c; if (L >= nwg) return false;
        int wgid = (int)L; { const int q = nwg / 8, r = nwg % 8, xcd = wgid % 8, off = wgid / 8; wgid = (xcd < r ? xcd * (q + 1) : r * (q + 1) + (xcd - r) * q) + off; }
        const int nig = 8 * nN, gid = wgid / nig, fm = gid * 8, gsz = (nM - fm) < 8 ? (nM - fm) : 8;
        pm = fm + ((wgid % nig) % gsz); pn = (wgid % nig) / gsz; return true;
    }
    __device__ __forceinline__ bool next(int i, Unit& u) const {
        if (!tile(i, u.pm, u.pn)) return false;
        u.a = A + (long)u.pm * 256 * lda; u.b = B + (long)u.pn * 256 * ldb; u.aux = 0; return true;
    }
};
struct LruSched : TileSched {
    __device__ __forceinline__ bool next(int i, Unit& u) const {
        if (!tile(i, u.pm, u.pn)) return false;
        u.a = A + (long)u.pm * 256 * lda + (u.pn >> 1) * 256; u.b = B + (long)u.pn * 65536; u.aux = 0; return true;
    }
};
struct MergeSched : TileSched {
    __device__ __forceinline__ bool next(int i, Unit& u) const {
        if (!tile(i >> 1, u.pm, u.pn)) return false;
        u.aux = i & 1; u.a = A + (long)u.pm * 256 * lda + u.aux * 2048; u.b = B + (long)u.pn * 256 * ldb + u.aux * 2048; return true;
    }
};
struct TriSched {
    const u16* A; long lda; const u16* B; long ldb; int G, c;
    __device__ __forceinline__ bool next(int i, Unit& u) const {
        int t = i * G + c; if (t >= 528) return false;
        int pm = 0; while (t >= pm + 1) { t -= pm + 1; ++pm; }
        u.pm = pm; u.pn = t; u.a = A + (long)pm * 256 * lda; u.b = B + (long)t * 256 * ldb; u.aux = 0; return true;
    }
};
struct RowSched {
    const u16* A; long lda; const u16* B; int G, c;
    __device__ __forceinline__ bool next(int i, Unit& u) const {
        const int t = i * G + c; if (t >= 32) return false;
        u.pm = 31 - t; u.pn = 0; u.a = A + (long)u.pm * 256 * lda; u.b = B; u.aux = 0; return true;
    }
};

template <class F>
__device__ __forceinline__ void epi_foreach(f32x4 (&acc)[2][2][4][2], const Unit& u, int wr, int wc, int fr, int fq, F f) {
    const int row0 = u.pm * 256 + wr * 64 + fr, col0 = u.pn * 256 + wc * 32 + 4 * fq;
#pragma unroll
    for (int ai = 0; ai < 2; ++ai)
#pragma unroll
        for (int m = 0; m < 4; ++m) {
#pragma unroll
            for (int bj = 0; bj < 2; ++bj)
#pragma unroll
                for (int n = 0; n < 2; ++n) f(row0 + ai * 128 + m * 16, col0 + bj * 128 + n * 16, acc[ai][bj][m][n]);
            __builtin_amdgcn_sched_barrier(0);
        }
}
#define EPI_COMMON  __device__ __forceinline__ bool keep(const Unit&) const { return false; } __device__ __forceinline__ int klimit(const Unit&, int K) const { return K; }
#define EPI_SIG     __device__ __forceinline__ void operator()(f32x4 (&acc)[2][2][4][2], const Unit& u, int wr, int wc, int fr, int fq) const

struct EpiIn { EPI_COMMON u16* zB; float* zA;
    EPI_SIG { const int seg = u.pn >> 3;
        epi_foreach(acc, u, wr, wc, fr, fq, [&](int row, int col, f32x4& v) {
            if (seg >= 5) { if (col < ZB + 1088) *(f32x4*)(zA + (long)row * ZA + (col - ZB)) = v; }
            else { f32x4 o;
#pragma unroll
                for (int e = 0; e < 4; ++e) o[e] = (seg == 1) ? v[e] : ((seg == 0 || seg == 2) ? siluf_(v[e]) : sigmoidf_(v[e]));
                *(u32x2*)(zB + (long)row * ZB + col) = (u32x2){pk2(o[0], o[1]), pk2(o[2], o[3])}; }
        }); } };
struct EpiQ { EPI_COMMON u16* Q; const float* cs;
    EPI_SIG { epi_foreach(acc, u, wr, wc, fr, fq, [&](int row, int col, f32x4& v) {
            const int d = col % QD; f32x4 o;
            if (d < NOPE) { o = v * QSCALE; }
            else { const int i0 = (d - NOPE) >> 1; const float* t = cs + (long)row * 64;
                   const float c0 = t[i0], s0 = t[32 + i0], c1 = t[i0 + 1], s1 = t[32 + i0 + 1];
                   o[0] = (v[0] * c0 - v[1] * s0) * QSCALE; o[1] = (v[1] * c0 + v[0] * s0) * QSCALE;
                   o[2] = (v[2] * c1 - v[3] * s1) * QSCALE; o[3] = (v[3] * c1 + v[2] * s1) * QSCALE; }
            *(u32x2*)(Q + (long)row * NQ + col) = (u32x2){pk2(o[0], o[1]), pk2(o[2], o[3])};
        }); } };
struct EpiKV { EPI_COMMON u16* Kf; u16* Vf;
    EPI_SIG { epi_foreach(acc, u, wr, wc, fr, fq, [&](int row, int col, f32x4& v) {
            const int hh = col >> 8, j = col & 255;
            u16* dst = (j < 128) ? Kf + ((long)hh * S + row) * QD + j : Vf + ((long)hh * S + row) * VH + (j - 128);
            *(u32x2*)dst = (u32x2){pk2(v[0], v[1]), pk2(v[2], v[3])};
        }); } };
struct EpiLru { EPI_COMMON const u16* xc; const float *brg, *big, *nsp8; float *la, *lb;
    EPI_SIG { epi_foreach(acc, u, wr, wc, fr, fq, [&](int row, int col, f32x4& v) {
            const int ch = (col >> 1);
            const unsigned xw = *(const unsigned*)(xc + (long)row * DM + ch);
            const f32x2 b_r = *(const f32x2*)(brg + ch), b_i = *(const f32x2*)(big + ch), ns = *(const f32x2*)(nsp8 + ch);
            f32x2 av, bv;
#pragma unroll
            for (int e = 0; e < 2; ++e) {
                const float r = sigmoidf_(v[2 * e] + b_r[e]), ii = sigmoidf_(v[2 * e + 1] + b_i[e]);
                const float lg = r * ns[e], x2 = 2.f * lg;
                const float em = (x2 > -0.25f) ? x2 * (1.f + x2 * (0.5f + x2 * (0.16666667f + x2 * (0.041666668f + x2 * 0.0083333338f)))) : (__expf(x2) - 1.f);
                const float x = e ? __uint_as_float(xw & 0xffff0000u) : __uint_as_float(xw << 16);
                av[e] = __expf(lg); bv[e] = sqrtf(-em) * (ii * x); }
            *(f32x2*)(la + (long)row * DM + ch) = av; *(f32x2*)(lb + (long)row * DM + ch) = bv;
        }); } };
struct EpiMerge { const u16* zB; u16* mg;
    __device__ __forceinline__ bool keep(const Unit& u) const { return u.aux == 0; }
    __device__ __forceinline__ int klimit(const Unit&, int K) const { return K; }
    EPI_SIG { const int part = u.aux;
        epi_foreach(acc, u, wr, wc, fr, fq, [&](int row, int col, f32x4& v) {
            const u32x2 sm = *(const u32x2*)(zB + (long)row * ZB + 6144 + col), sl = *(const u32x2*)(zB + (long)row * ZB + 8192 + col);
            f32x4 fm = {__uint_as_float(sm[0] << 16), __uint_as_float(sm[0] & 0xffff0000u), __uint_as_float(sm[1] << 16), __uint_as_float(sm[1] & 0xffff0000u)};
            f32x4 fl = {__uint_as_float(sl[0] << 16), __uint_as_float(sl[0] & 0xffff0000u), __uint_as_float(sl[1] << 16), __uint_as_float(sl[1] & 0xffff0000u)};
#pragma unroll
            for (int e = 0; e < 4; ++e) fl[e] = fmaxf(fl[e], 1e-12f);
            if (part == 0) {
#pragma unroll
                for (int e = 0; e < 4; ++e) v[e] = v[e] * fm[e] / fl[e];
            } else { f32x4 o = v * fl; *(u32x2*)(mg + (long)row * DM + col) = (u32x2){pk2(o[0], o[1]), pk2(o[2], o[3])}; }
        }); } };
struct EpiOut { EPI_COMMON const float* xold; float* xnew;
    EPI_SIG { epi_foreach(acc, u, wr, wc, fr, fq, [&](int row, int col, f32x4& v) {
            const long idx = (long)row * DM + col; *(f32x4*)(xnew + idx) = *(const f32x4*)(xold + idx) + v; }); } };
struct EpiF32 { EPI_COMMON float* C; long ldc;
    EPI_SIG { epi_foreach(acc, u, wr, wc, fr, fq, [&](int row, int col, f32x4& v) { *(f32x4*)(C + (long)row * ldc + col) = v; }); } };
struct EpiPle { EPI_COMMON float* x; const float* pp;
    EPI_SIG { epi_foreach(acc, u, wr, wc, fr, fq, [&](int row, int col, f32x4& v) {
            const long idx = (long)row * DM + col; const f32x4 pv = *(const f32x4*)(pp + idx); f32x4 xv = *(const f32x4*)(x + idx);
#pragma unroll
            for (int e = 0; e < 4; ++e) xv[e] += pv[e] * sigmoidf_(v[e]);
            *(f32x4*)(x + idx) = xv; }); } };
struct EpiPV { const u16* zB; u16* OH; int head;
    __device__ __forceinline__ bool keep(const Unit&) const { return false; }
    __device__ __forceinline__ int klimit(const Unit& u, int K) const { return 256 * (u.pm + 1); }
    EPI_SIG { epi_foreach(acc, u, wr, wc, fr, fq, [&](int row, int col, f32x4& v) {
            if (col < VH) { const int c = head * VH + col; const u32x2 g = *(const u32x2*)(zB + (long)row * ZB + c);
                f32x4 o = {v[0] * __uint_as_float(g[0] << 16), v[1] * __uint_as_float(g[0] & 0xffff0000u), v[2] * __uint_as_float(g[1] << 16), v[3] * __uint_as_float(g[1] & 0xffff0000u)};
                *(u32x2*)(OH + (long)row * 4096 + c) = (u32x2){pk2(o[0], o[1]), pk2(o[2], o[3])}; }
        }); } };

template <int BMODE, class Epi, class Sched>
__device__ __forceinline__ void gemm_simple(char* lds, int K, long lda, long ldb, const Sched& Sc, const Epi& E) {
    u16 (*sa)[40] = (u16(*)[40])lds; u16 (*sb)[40] = (u16(*)[40])(lds + 256 * 40 * 2);
    const int tid = TID(), wid = tid >> 6, lane = tid & 63, wr = wid >> 2, wc = wid & 3, fr = lane & 15, fq = lane >> 4;
    f32x4 acc[2][2][4][2];
#pragma unroll
    for (int a = 0; a < 2; ++a)
#pragma unroll
        for (int b = 0; b < 2; ++b)
#pragma unroll
            for (int m = 0; m < 4; ++m)
#pragma unroll
                for (int n = 0; n < 2; ++n) acc[a][b][m][n] = (f32x4){0.f, 0.f, 0.f, 0.f};
    Unit u;
    for (int i = 0; Sc.next(i, u); ++i) {
        const int Ku = E.klimit(u, K);
        if (BMODE == 1) { for (int e = tid; e < 128 * 40; e += NTHR) sb[128 + e / 40][e % 40] = 0; }
        for (int k0 = 0; k0 < Ku; k0 += 32) {
#pragma unroll
            for (int j = 0; j < 2; ++j) { const int c = tid + j * NTHR, r = c >> 2, cc = (c & 3) * 8;
                *(u32x4*)&sa[r][cc] = *(const u32x4*)(u.a + (long)r * lda + k0 + cc);
                if (BMODE == 0) *(u32x4*)&sb[r][cc] = *(const u32x4*)(u.b + (long)r * ldb + k0 + cc); }
            if (BMODE == 1) { const int k = tid >> 4, n0 = (tid & 15) * 8; const u32x4 v = *(const u32x4*)(u.b + (long)(k0 + k) * ldb + n0);
#pragma unroll
                for (int e = 0; e < 4; ++e) { sb[n0 + 2 * e][k] = (u16)(v[e] & 0xffffu); sb[n0 + 2 * e + 1][k] = (u16)(v[e] >> 16); } }
            __syncthreads();
            bf16x8 bf[2][2];
#pragma unroll
            for (int bj = 0; bj < 2; ++bj)
#pragma unroll
                for (int n = 0; n < 2; ++n) bf[bj][n] = *(const bf16x8*)&sb[128 * bj + 32 * wc + 16 * n + fr][fq * 8];
#pragma unroll
            for (int ai = 0; ai < 2; ++ai) {
                bf16x8 af[4];
#pragma unroll
                for (int m = 0; m < 4; ++m) af[m] = *(const bf16x8*)&sa[128 * ai + 64 * wr + 16 * m + fr][fq * 8];
#pragma unroll
                for (int bj = 0; bj < 2; ++bj)
#pragma unroll
                    for (int m = 0; m < 4; ++m)
#pragma unroll
                        for (int n = 0; n < 2; ++n) acc[ai][bj][m][n] = __builtin_amdgcn_mfma_f32_16x16x32_bf16(bf[bj][n], af[m], acc[ai][bj][m][n], 0, 0, 0);
                __builtin_amdgcn_sched_barrier(0);
            }
            __syncthreads();
        }
        E(acc, u, wr, wc, fr, fq);
        if (!E.keep(u)) {
#pragma unroll
            for (int a = 0; a < 2; ++a)
#pragma unroll
                for (int b = 0; b < 2; ++b)
#pragma unroll
                    for (int m = 0; m < 4; ++m)
#pragma unroll
                        for (int n = 0; n < 2; ++n) acc[a][b][m][n] = (f32x4){0.f, 0.f, 0.f, 0.f};
        }
    }
}


#define LAS __attribute__((address_space(3)))
constexpr int HTB = 128 * 64 * 2;
__device__ __forceinline__ int lds_byte(int r, int c) { const int st = (r >> 4) * 2 + (c >> 5), rr = r & 15, cc = c & 31, ob = rr * 64 + cc * 2; return st * 1024 + (ob ^ (((ob >> 9) & 1) << 5)); }
__device__ __forceinline__ void stage_rc(int b, int& R, int& C) { const int st = b / 1024, sb = b % 1024, swz = sb ^ (((sb >> 9) & 1) << 5); R = (st >> 1) * 16 + swz / 64; C = (st & 1) * 32 + (swz % 64) / 2; }

template <class Epi, class Sched>
__device__ __forceinline__ void gemm_fast(char* lds_, int K, long lda, long ldb, const Sched& S_, const Epi& E) {
    LAS unsigned char* lds = (LAS unsigned char*)lds_;
    const int tid = TID(), wid = __builtin_amdgcn_readfirstlane(tid >> 6), lane = tid & 63, wr = wid >> 2, wc = wid & 3, fr = lane & 15, fq = lane >> 4;
    const int nt = K / 64;
    unsigned voffA[2], voffB[2];
#pragma unroll
    for (int i = 0; i < 2; ++i) { int R, C; stage_rc(tid * 16 + i * 8192, R, C); voffA[i] = (unsigned)(R * lda + C) * 2u; voffB[i] = (unsigned)(R * ldb + C) * 2u; }
    const size_t kstep = 128;
    const size_t hstepA = (size_t)128 * lda * 2, hstepB = (size_t)128 * ldb * 2;
    const unsigned ldsw = (unsigned)wid * 1024u;
    const int aoff = lds_byte(wr * 64 + fr, fq * 8), boff = lds_byte(wc * 32 + fr, fq * 8);
#define G_SA(b, h) (((b) * 2 + (h)) * HTB)
#define G_SB(b, h) ((4 + (b) * 2 + (h)) * HTB)
#define G_STAGE(bufoff, gbase, voff) do { _Pragma("unroll") for (int _i = 0; _i < 2; ++_i) \
        __builtin_amdgcn_global_load_lds((const unsigned*)((const char*)(gbase) + (voff)[_i]), (LAS unsigned*)(lds + (bufoff) + ldsw + _i * 8192), 16, 0, 0); } while (0)
#define G_LDA(dst, b, h) do { _Pragma("unroll") for (int m = 0; m < 4; ++m) _Pragma("unroll") for (int k = 0; k < 2; ++k) dst[m][k] = *(const LAS bf16x8*)(lds + G_SA(b, h) + aoff + m * 2048 + k * 1024); } while (0)
#define G_LDB(dst, b, h) do { _Pragma("unroll") for (int n = 0; n < 2; ++n) _Pragma("unroll") for (int k = 0; k < 2; ++k) dst[n][k] = *(const LAS bf16x8*)(lds + G_SB(b, h) + boff + n * 2048 + k * 1024); } while (0)
#define G_MMA(ai, bj, At, Bt) do { __builtin_amdgcn_s_setprio(1); _Pragma("unroll") for (int m = 0; m < 4; ++m) _Pragma("unroll") for (int n = 0; n < 2; ++n) _Pragma("unroll") for (int k = 0; k < 2; ++k) \
        acc[ai][bj][m][n] = __builtin_amdgcn_mfma_f32_16x16x32_bf16(Bt[n][k], At[m][k], acc[ai][bj][m][n], 0, 0, 0); __builtin_amdgcn_s_setprio(0); } while (0)
#define G_WAIT_V(n) asm volatile("s_waitcnt vmcnt(" #n ")" ::: "memory")
#define G_WAIT_L(n) asm volatile("s_waitcnt lgkmcnt(" #n ")" ::: "memory")
#define G_BAR __builtin_amdgcn_s_barrier()
#define G_SCHED __builtin_amdgcn_sched_barrier(0)
    Unit cur, nxt; int ui = 0;
    if (!S_.next(0, cur)) return;
    f32x4 acc[2][2][4][2];
#pragma unroll
    for (int a = 0; a < 2; ++a)
#pragma unroll
        for (int b = 0; b < 2; ++b)
#pragma unroll
            for (int m = 0; m < 4; ++m)
#pragma unroll
                for (int n = 0; n < 2; ++n) acc[a][b][m][n] = (f32x4){0.f, 0.f, 0.f, 0.f};
    bf16x8 At[4][2], B0[2][2], B1[2][2];
    const char* cA = (const char*)cur.a; const char* cB = (const char*)cur.b;
    G_STAGE(G_SB(0, 0), cB, voffB); G_STAGE(G_SA(0, 0), cA, voffA); G_STAGE(G_SB(0, 1), cB + hstepB, voffB); G_STAGE(G_SA(0, 1), cA + hstepA, voffA);
    if (wr == 1) G_BAR;
    G_WAIT_V(4); G_BAR;
    G_STAGE(G_SB(1, 0), cB + kstep, voffB); G_STAGE(G_SA(1, 0), cA + kstep, voffA); G_STAGE(G_SB(1, 1), cB + hstepB + kstep, voffB);
    G_WAIT_V(6); G_BAR;
    for (;;) {
        const bool has_next = S_.next(ui + 1, nxt);
        const char* nA = has_next ? (const char*)nxt.a : cA; const char* nB = has_next ? (const char*)nxt.b : cB;
#pragma unroll 1
        for (int t = 0; t < nt; t += 2) {
            const bool last = (t == nt - 2);
            const char* a1 = cA + (size_t)(t + 1) * kstep;
            const char* a2 = last ? nA : cA + (size_t)(t + 2) * kstep; const char* b2 = last ? nB : cB + (size_t)(t + 2) * kstep;
            const char* a3 = a2 + kstep; const char* b3 = b2 + kstep;
            G_LDB(B0, 0, 0); G_SCHED; G_LDA(At, 0, 0); G_STAGE(G_SA(1, 1), a1 + hstepA, voffA);
            G_WAIT_L(8); G_BAR; G_WAIT_L(0); G_MMA(0, 0, At, B0); G_BAR; G_SCHED;
            G_LDB(B1, 0, 1); G_STAGE(G_SB(0, 0), b2, voffB);
            G_BAR; G_WAIT_L(0); G_MMA(0, 1, At, B1); G_BAR;
            G_LDA(At, 0, 1); G_STAGE(G_SA(0, 0), a2, voffA);
            G_BAR; G_WAIT_L(0); G_MMA(1, 0, At, B0); G_BAR; G_SCHED;
            G_STAGE(G_SB(0, 1), b2 + hstepB, voffB);
            G_WAIT_V(6); G_BAR; G_MMA(1, 1, At, B1); G_BAR;
            G_LDB(B0, 1, 0); G_SCHED; G_LDA(At, 1, 0); G_STAGE(G_SA(0, 1), a2 + hstepA, voffA);
            G_WAIT_L(8); G_BAR; G_WAIT_L(0); G_MMA(0, 0, At, B0); G_BAR; G_SCHED;
            G_LDB(B1, 1, 1); G_STAGE(G_SB(1, 0), b3, voffB);
            G_BAR; G_WAIT_L(0); G_MMA(0, 1, At, B1); G_BAR;
            G_LDA(At, 1, 1); G_STAGE(G_SA(1, 0), a3, voffA);
            G_BAR; G_WAIT_L(0); G_MMA(1, 0, At, B0); G_BAR; G_SCHED;
            G_STAGE(G_SB(1, 1), b3 + hstepB, voffB);
            G_WAIT_V(6); G_BAR; G_MMA(1, 1, At, B1); G_BAR;
        }
        { const int t2 = TID(), w2 = t2 >> 6, l2 = t2 & 63;
          E(acc, cur, w2 >> 2, w2 & 3, l2 & 15, l2 >> 4); }
        if (!has_next) break;
        if (!E.keep(cur)) {
#pragma unroll
            for (int a = 0; a < 2; ++a)
#pragma unroll
                for (int b = 0; b < 2; ++b)
#pragma unroll
                    for (int m = 0; m < 4; ++m)
#pragma unroll
                        for (int n = 0; n < 2; ++n) acc[a][b][m][n] = (f32x4){0.f, 0.f, 0.f, 0.f};
        }
        cur = nxt; cA = nA; cB = nB; ++ui;
    }
    G_WAIT_V(0);
    if (wr == 0) G_BAR;
    G_BAR;
#undef G_SA
#undef G_SB
#undef G_STAGE
#undef G_LDA
#undef G_LDB
#undef G_MMA
#undef G_WAIT_V
#undef G_WAIT_L
#undef G_BAR
#undef G_SCHED
}

template <class RM>
__device__ __forceinline__ void transpose_cvt(char* lds, const float* __restrict__ src, int K, int N, u16* __restrict__ dst, long ldd, int coff, RM rowmap) {
    u16 (*t)[72] = (u16(*)[72])lds;
    const int tk = K / 64, tn = N / 64, tid = TID();
    for (int tix = blockIdx.x; tix < tk * tn; tix += gridDim.x) {
        const int k0 = (tix / tn) * 64, n0 = (tix % tn) * 64;
        { const int k = tid >> 3, nn = (tid & 7) * 8; const float* p = src + (long)(k0 + k) * N + n0 + nn;
          const f32x4 v0 = *(const f32x4*)p, v1 = *(const f32x4*)(p + 4);
          *(u32x4*)&t[k][nn] = (u32x4){pk2(v0[0], v0[1]), pk2(v0[2], v0[3]), pk2(v1[0], v1[1]), pk2(v1[2], v1[3])}; }
        __syncthreads();
        { const int n = tid >> 3, kk = (tid & 7) * 8; u32x4 o;
#pragma unroll
          for (int e = 0; e < 4; ++e) o[e] = (unsigned)t[kk + 2 * e][n] | ((unsigned)t[kk + 2 * e + 1][n] << 16);
          *(u32x4*)(dst + (long)rowmap(n0 + n) * ldd + coff + k0 + kk) = o; }
        __syncthreads();
    }
}

__device__ __forceinline__ void phase_prologue(const Params& p, char* lds) {
    const long gtid = (long)blockIdx.x * NTHR + TID(), gsz = (long)gridDim.x * NTHR;
    for (int l = 0; l < DEPTH; ++l) {
        transpose_cvt(lds, p.w_in + (size_t)l * DM * INT, DM, INT, p.Wt_in + (size_t)l * NIN * DM, DM, 0, [](int n) { return n >= 1088 ? n - 1088 : n + ZB; });
        transpose_cvt(lds, p.w_q_b + (size_t)l * QL * NQ, QL, NQ, p.Wt_q + (size_t)l * NQ * QL, QL, 0, [](int n) {
            const int hh = n / QD, d = n % QD; if (d < NOPE) return n; const int e = d - NOPE; return hh * QD + NOPE + ((e & 31) << 1) + (e >> 5); });
        transpose_cvt(lds, p.w_kv_b + (size_t)l * KVL * NKV, KVL, NKV, p.Wt_kv + (size_t)l * NKV * KVL, KVL, 0, [](int n) { return n; });
        transpose_cvt(lds, p.w_o_mla + (size_t)l * DM * DM, DM, DM, p.Wt_o + (size_t)l * DM * 4096, 4096, 0, [](int n) { return n; });
        transpose_cvt(lds, p.w_o_lru + (size_t)l * DM * DM, DM, DM, p.Wt_o + (size_t)l * DM * 4096, 4096, 2048, [](int n) { return n; });
        transpose_cvt(lds, p.w_out + (size_t)l * DM * DM, DM, DM, p.Wt_out + (size_t)l * DM * DM, DM, 0, [](int n) { return n; });
        transpose_cvt(lds, p.w_ple_gate + (size_t)l * DM * DM, DM, DM, p.Wt_pg + (size_t)l * DM * DM, DM, 0, [](int n) { return n; });
        transpose_cvt(lds, p.w_ple + (size_t)l * PLE * DM, PLE, DM, p.Wt_ple + (size_t)l * DM * PLE, PLE, 0, [](int n) { return n; });
    }
    for (long i = gtid; i < (long)DEPTH * (NIN - INT) * DM / 8; i += gsz) { const long per = (long)(NIN - INT) * DM / 8; const int l = (int)(i / per); const long r = i % per;
        *(u32x4*)(p.Wt_in + ((size_t)l * NIN + INT) * DM + r * 8) = (u32x4){0u, 0u, 0u, 0u}; }
    for (long i = gtid; i < (long)DEPTH * LRUB * 256 * 256; i += gsz) {
        const int k = (int)(i & 255), o = (int)((i >> 8) & 255), blk = (int)((i >> 16) & 15), l = (int)(i >> 20);
        const int kk = k - 128 * (blk & 1), cl = o >> 1; float v = 0.f;
        if (kk >= 0 && kk < 128) v = ((o & 1) ? p.w_ig : p.w_rg)[(((size_t)l * LRUB + blk) * LBD + kk) * LBD + cl];
        p.Wt_lru[i] = f2bf(v); }
    for (long i = gtid; i < (long)DEPTH * S * PLE / 8; i += gsz) { const float* s = p.p_in + i * 8; const f32x4 v0 = *(const f32x4*)s, v1 = *(const f32x4*)(s + 4);
        *(u32x4*)(p.pb + i * 8) = (u32x4){pk2(v0[0], v0[1]), pk2(v0[2], v0[3]), pk2(v1[0], v1[1]), pk2(v1[2], v1[3])}; }
    for (long i = gtid; i < (long)DEPTH * DM; i += gsz) p.nsp8[i] = -8.f * log1pf(expf(-p.lam[i]));
    for (long i = gtid; i < (long)S * 32; i += gsz) { const int s = (int)(i >> 5), f = (int)(i & 31);
        const float inv = powf(10000.f, -(float)(2 * f) / 64.f), ang = (float)p.pos[s] * inv;
        p.cs[(long)s * 64 + f] = (float)cos((double)ang); p.cs[(long)s * 64 + 32 + f] = (float)sin((double)ang); }
}

__device__ __forceinline__ void phase_rmsnorm_bf16(const float* __restrict__ x, const float* __restrict__ g, u16* __restrict__ out) {
    const int tid = TID(), lane = tid & 63, gw = blockIdx.x * (NTHR / 64) + (tid >> 6), nw = gridDim.x * (NTHR / 64);
    for (int row = gw; row < S; row += nw) {
        const float* p = x + (long)row * DM; f32x4 v[8]; float s = 0.f;
#pragma unroll
        for (int j = 0; j < 8; ++j) { v[j] = *(const f32x4*)(p + j * 256 + lane * 4); s += v[j][0] * v[j][0] + v[j][1] * v[j][1] + v[j][2] * v[j][2] + v[j][3] * v[j][3]; }
        s = wsum(s, lane); const float rinv = rsqrtf(s * (1.f / DM) + 1e-6f);
#pragma unroll
        for (int j = 0; j < 8; ++j) { const f32x4 gg = *(const f32x4*)(g + j * 256 + lane * 4);
            *(u32x2*)(out + (long)row * DM + j * 256 + lane * 4) = (u32x2){pk2(v[j][0] * rinv * gg[0], v[j][1] * rinv * gg[1]), pk2(v[j][2] * rinv * gg[2], v[j][3] * rinv * gg[3])}; }
    }
}
__device__ __forceinline__ void phase_final_norm(float* __restrict__ x, const float* __restrict__ g) {
    const int tid = TID(), lane = tid & 63, gw = blockIdx.x * (NTHR / 64) + (tid >> 6), nw = gridDim.x * (NTHR / 64);
    for (int row = gw; row < S; row += nw) {
        float* p = x + (long)row * DM; f32x4 v[8]; float s = 0.f;
#pragma unroll
        for (int j = 0; j < 8; ++j) { v[j] = *(const f32x4*)(p + j * 256 + lane * 4); s += v[j][0] * v[j][0] + v[j][1] * v[j][1] + v[j][2] * v[j][2] + v[j][3] * v[j][3]; }
        s = wsum(s, lane); const float rinv = rsqrtf(s * (1.f / DM) + 1e-6f);
#pragma unroll
        for (int j = 0; j < 8; ++j) { const f32x4 gg = *(const f32x4*)(g + j * 256 + lane * 4); *(f32x4*)(p + j * 256 + lane * 4) = v[j] * rinv * gg; }
    }
}
__device__ __forceinline__ void phase_t2(const Params& p, int l) {
    const int tid = TID(), lane = tid & 63, gw = blockIdx.x * (NTHR / 64) + (tid >> 6), nw = gridDim.x * (NTHR / 64);
    const float* cw = p.conv_w + (size_t)l * 4 * DM; const float* cb = p.conv_b + (size_t)l * DM;
    for (int row = gw; row < S; row += nw) {
        const float* zr = p.zA + (long)row * ZA;
#pragma unroll
        for (int part = 0; part < 2; ++part) {
            const float* src = zr + part * 512; const float* g = (part ? p.kv_a_norm : p.q_a_norm) + l * 512; u16* dst = (part ? p.kvn : p.qn) + (long)row * 512;
            const f32x4 v0 = *(const f32x4*)(src + lane * 4), v1 = *(const f32x4*)(src + 256 + lane * 4);
            float s = v0[0] * v0[0] + v0[1] * v0[1] + v0[2] * v0[2] + v0[3] * v0[3] + v1[0] * v1[0] + v1[1] * v1[1] + v1[2] * v1[2] + v1[3] * v1[3];
            s = wsum(s, lane); const float rinv = rsqrtf(s * (1.f / 512.f) + 1e-6f);
            const f32x4 g0 = *(const f32x4*)(g + lane * 4), g1 = *(const f32x4*)(g + 256 + lane * 4);
            *(u32x2*)(dst + lane * 4) = (u32x2){pk2(v0[0] * rinv * g0[0], v0[1] * rinv * g0[1]), pk2(v0[2] * rinv * g0[2], v0[3] * rinv * g0[3])};
            *(u32x2*)(dst + 256 + lane * 4) = (u32x2){pk2(v1[0] * rinv * g1[0], v1[1] * rinv * g1[1]), pk2(v1[2] * rinv * g1[2], v1[3] * rinv * g1[3])};
        }
        if (lane < 32) { const float x1 = zr[1024 + lane], x2 = zr[1056 + lane], c = p.cs[(long)row * 64 + lane], sn = p.cs[(long)row * 64 + 32 + lane];
            const unsigned w = pk2(x1 * c - x2 * sn, x2 * c + x1 * sn);
#pragma unroll
            for (int hh = 0; hh < NH; ++hh) *(unsigned*)(p.Kf + ((long)hh * S + row) * QD + NOPE + 2 * lane) = w; }
#pragma unroll
        for (int j = 0; j < 8; ++j) { const int c = j * 256 + lane * 4; f32x4 y = *(const f32x4*)(cb + c);
#pragma unroll
            for (int k = 0; k < 4; ++k) { const int sp = row - 3 + k; if (sp >= 0) { const u32x2 uu = *(const u32x2*)(p.zB + (long)sp * ZB + 2048 + c); const f32x4 w = *(const f32x4*)(cw + k * DM + c);
                y[0] += __uint_as_float(uu[0] << 16) * w[0]; y[1] += __uint_as_float(uu[0] & 0xffff0000u) * w[1]; y[2] += __uint_as_float(uu[1] << 16) * w[2]; y[3] += __uint_as_float(uu[1] & 0xffff0000u) * w[3]; } }
            *(u32x2*)(p.xc + (long)row * DM + c) = (u32x2){pk2(y[0], y[1]), pk2(y[2], y[3])}; }
    }
}
__device__ __forceinline__ void phase_scan1(const Params& p) {
    float* Pc = p.carry; float* Hc = p.carry + 128 * DM;
    for (long i = (long)blockIdx.x * NTHR + TID(); i < 128L * DM; i += (long)gridDim.x * NTHR) {
        const int c = (int)(i % DM), ch = (int)(i / DM); float P = 1.f, H = 0.f;
        for (int t = 0; t < 64; ++t) { const long idx = (long)(ch * 64 + t) * DM + c; const float a = p.la[idx]; H = a * H + p.lb[idx]; P *= a; }
        Pc[i] = P; Hc[i] = H; }
}
__device__ __forceinline__ void phase_scan3(const Params& p) {
    const float* Pc = p.carry; const float* Hc = p.carry + 128 * DM;
    for (long i = (long)blockIdx.x * NTHR + TID(); i < 128L * DM; i += (long)gridDim.x * NTHR) {
        const int c = (int)(i % DM), ch = (int)(i / DM); float H = 0.f;
        for (int k = 0; k < ch; ++k) H = Pc[(long)k * DM + c] * H + Hc[(long)k * DM + c];
        for (int t = 0; t < 64; ++t) { const long r = ch * 64 + t, idx = r * DM + c; H = p.la[idx] * H + p.lb[idx];
            p.OH[r * 4096 + 2048 + c] = f2bf(H * bf2f(p.zB[r * ZB + 4096 + c])); } }
}

typedef float f32x16 __attribute__((ext_vector_type(16)));
typedef short s16x4 __attribute__((ext_vector_type(4)));
constexpr int SHM_V = 64 * 128 * 2, SHM_K = 64 * 192 * 2, ATT_WS = 2 * SHM_V + 2 * SHM_K;
#define KSWZ(row, colB) ((row) * 384 + ((colB) ^ (((row) & 7) << 4)))
__device__ __forceinline__ int v_st(int k, int c) { const int kk = (k & ~0xC) | ((k & 4) << 1) | ((k & 8) >> 1); return ((kk >> 3) * 4 + (c >> 5)) * 512 + ((kk & 7) * 32 + (c & 31)) * 2; }
__device__ __forceinline__ int v_rd_base(int lane) { return ((lane & 3) << 3) | (((lane >> 2) & 3) << 6) | (((lane >> 4) & 1) << 5) | (((lane >> 5) & 1) << 8); }
constexpr int v_rd_off(int d0, int ks, int half) { return d0 * 512 + ks * 4096 + half * 2048; }
__device__ __forceinline__ int crow(int r, int hi) { return (r & 3) + 8 * (r >> 2) + 4 * hi; }
__device__ __forceinline__ unsigned cvtpk(float lo, float hi) { unsigned r; asm volatile("v_cvt_pk_bf16_f32 %0, %1, %2" : "=v"(r) : "v"(lo), "v"(hi)); return r; }

__device__ __forceinline__ void partialSM(f32x16& p0, f32x16& p1, float& m_reg, float& mn, float& alpha) {
    float pmax = p0[0];
#pragma unroll
    for (int r = 1; r < 16; ++r) pmax = fmaxf(pmax, p0[r]);
#pragma unroll
    for (int r = 0; r < 16; ++r) pmax = fmaxf(pmax, p1[r]);
    { auto rr = __builtin_amdgcn_permlane32_swap(__float_as_uint(pmax), __float_as_uint(pmax), false, false);
      pmax = fmaxf(__uint_as_float(rr[0]), __uint_as_float(rr[1])); }
    if (__builtin_expect(__all(pmax - m_reg <= 11.5f), 1)) { mn = m_reg; alpha = 1.f; }
    else { mn = fmaxf(m_reg, pmax); alpha = __builtin_amdgcn_exp2f(m_reg - mn); m_reg = mn; }
#pragma unroll
    for (int r = 0; r < 16; ++r) p0[r] = p0[r] - mn;
#pragma unroll
    for (int r = 0; r < 16; ++r) p1[r] = p1[r] - mn;
#pragma unroll
    for (int r = 0; r < 16; ++r) p0[r] = __builtin_amdgcn_exp2f(p0[r]);
}
__device__ __forceinline__ void finishSM(f32x16& p0, f32x16& p1, float alpha, float& l_reg, bf16x8& pa0, bf16x8& pa1, bf16x8& pa2, bf16x8& pa3) {
#pragma unroll
    for (int r = 0; r < 16; ++r) p1[r] = __builtin_amdgcn_exp2f(p1[r]);
    float ps = 0;
#pragma unroll
    for (int r = 0; r < 16; ++r) ps += p0[r];
#pragma unroll
    for (int r = 0; r < 16; ++r) ps += p1[r];
    { auto rr = __builtin_amdgcn_permlane32_swap(__float_as_uint(ps), __float_as_uint(ps), false, false);
      ps = __uint_as_float(rr[0]) + __uint_as_float(rr[1]); }
    l_reg = l_reg * alpha + ps;
#define PK4(P, B_, OUT) do { unsigned a0 = cvtpk(P[B_+0], P[B_+1]), a1 = cvtpk(P[B_+2], P[B_+3]);                          \
        unsigned b0 = cvtpk(P[B_+4], P[B_+5]), b1 = cvtpk(P[B_+6], P[B_+7]);                                             \
        auto r0 = __builtin_amdgcn_permlane32_swap(a0, b0, false, false); auto r1 = __builtin_amdgcn_permlane32_swap(a1, b1, false, false); \
        u32x4 w = {r0[0], r1[0], r0[1], r1[1]}; OUT = *reinterpret_cast<bf16x8*>(&w); } while (0)
    PK4(p0, 0, pa0); PK4(p0, 8, pa1); PK4(p1, 0, pa2); PK4(p1, 8, pa3);
#undef PK4
}
template <int KB>
__device__ __forceinline__ void qkt(f32x16& p0, f32x16& p1, LAS char* K_lds, int r32, int hi, const bf16x8* qr, bool act) {
    if (!act) { const float NEG = -__builtin_inff();
#pragma unroll
        for (int r = 0; r < 16; ++r) { p0[r] = NEG; p1[r] = NEG; } return; }
#pragma unroll
    for (int r = 0; r < 16; ++r) { p0[r] = 0.f; p1[r] = 0.f; }
    LAS char* kb[4];
#pragma unroll
    for (int dd = 0; dd < 4; ++dd) kb[dd] = K_lds + KB * SHM_K + KSWZ(r32, (dd * 16 + hi * 8) * 2);
#pragma unroll
    for (int d0 = 0; d0 < 12; ++d0) { LAS char* a = kb[d0 & 3] + (d0 >> 2) * 128;
        const bf16x8 b0 = *(const LAS bf16x8*)a;
        const bf16x8 b1 = *(const LAS bf16x8*)(a + 32 * 384);
        p0 = __builtin_amdgcn_mfma_f32_32x32x16_bf16(b0, qr[d0], p0, 0, 0, 0);
        p1 = __builtin_amdgcn_mfma_f32_32x32x16_bf16(b1, qr[d0], p1, 0, 0, 0); }
}
template <int VB>
__device__ __forceinline__ void pv_tile(f32x16* o, int vb0, bf16x8 pa0, bf16x8 pa1, bf16x8 pa2, bf16x8 pa3, bool act) {
    if (!act) return;
#define TRRD(dst, off) asm volatile("ds_read_b64_tr_b16 %0, %1 offset:%2" : "=&v"(dst) : "v"(vb0), "i"(off) : "memory")
#define PV_D0(d0) do { s16x4 l0, l1, l2, l3, h0, h1, h2, h3; constexpr int b_ = VB * SHM_V + v_rd_off(d0, 0, 0); \
        TRRD(l0, b_); TRRD(h0, b_ + 2048); TRRD(l1, b_ + 4096); TRRD(h1, b_ + 6144); TRRD(l2, b_ + 8192); TRRD(h2, b_ + 10240); TRRD(l3, b_ + 12288); TRRD(h3, b_ + 14336); \
        asm volatile("s_waitcnt lgkmcnt(0)" ::: "memory"); __builtin_amdgcn_sched_barrier(0); \
        o[d0] = __builtin_amdgcn_mfma_f32_32x32x16_bf16(pa0, (bf16x8){l0[0], l0[1], l0[2], l0[3], h0[0], h0[1], h0[2], h0[3]}, o[d0], 0, 0, 0);   \
        o[d0] = __builtin_amdgcn_mfma_f32_32x32x16_bf16(pa1, (bf16x8){l1[0], l1[1], l1[2], l1[3], h1[0], h1[1], h1[2], h1[3]}, o[d0], 0, 0, 0);   \
        o[d0] = __builtin_amdgcn_mfma_f32_32x32x16_bf16(pa2, (bf16x8){l2[0], l2[1], l2[2], l2[3], h2[0], h2[1], h2[2], h2[3]}, o[d0], 0, 0, 0);   \
        o[d0] = __builtin_amdgcn_mfma_f32_32x32x16_bf16(pa3, (bf16x8){l3[0], l3[1], l3[2], l3[3], h3[0], h3[1], h3[2], h3[3]}, o[d0], 0, 0, 0); } while (0)
    PV_D0(0); PV_D0(1); PV_D0(2); PV_D0(3);
#undef PV_D0
#undef TRRD
}

__device__ __forceinline__ void attn_block(char* lds, const u16* __restrict__ Qb, const u16* __restrict__ Kh, const u16* __restrict__ Vh,
                                           const u16* __restrict__ sg, u16* __restrict__ Ob, int P0) {
    const int tid = TID(), wid = __builtin_amdgcn_readfirstlane(tid >> 6), lane = tid & 63, r32 = lane & 31, hi = lane >> 5;
    const int NT = (P0 >> 6) + 4;
    const int wchunk = (P0 >> 6) + (wid >> 1);
    LAS char* L = (LAS char*)lds; LAS char* V_lds = L; LAS char* K_lds = L + 2 * SHM_V;
    LAS float* wsf = (LAS float*)(L + ATT_WS) + wid * 64; LAS float* li_l = wsf; LAS float* al_l = wsf + 32;
    float m_reg = -1e30f, l_reg = 0.f; f32x16 o[4];
#pragma unroll
    for (int d = 0; d < 4; ++d)
#pragma unroll
        for (int r = 0; r < 16; ++r) o[d][r] = 0.f;
    const int sr = tid >> 4, sc = (tid & 15) * 8, vst0 = v_st(sr, sc), vst1 = v_st(32 + sr, sc);
    const int kc0 = tid, kc1 = tid + 512, kc2 = tid + 1024;
    const int kws0 = KSWZ(kc0 / 24, (kc0 % 24) * 16), kws1 = KSWZ(kc1 / 24, (kc1 % 24) * 16), kws2 = KSWZ(kc2 / 24, (kc2 % 24) * 16);
    const int vb0 = (int)(unsigned)(uintptr_t)V_lds + v_rd_base(lane);
    bf16x8 qr[12];
#pragma unroll
    for (int d0 = 0; d0 < 12; ++d0) qr[d0] = *(const bf16x8*)(Qb + (long)(wid * 32 + r32) * NQ + d0 * 16 + hi * 8);
    bf16x8 st_k0, st_k1, st_k2, st_v0, st_v1;
#define VMW() asm volatile("s_waitcnt vmcnt(0)" ::: "memory")
#define SBAR() __builtin_amdgcn_sched_barrier(0)
#define SLOAD(t) do { const u16* kp_ = Kh + (long)(t) * 64 * QD + tid * 8; st_k0 = *(const bf16x8*)kp_; st_k1 = *(const bf16x8*)(kp_ + 4096); st_k2 = *(const bf16x8*)(kp_ + 8192); \
                      const u16* vp_ = Vh + ((long)(t) * 64 + sr) * VH + sc; st_v0 = *(const bf16x8*)vp_; st_v1 = *(const bf16x8*)(vp_ + 32 * VH); } while (0)
#define SWRITE(bf) do { *(LAS bf16x8*)(K_lds + (bf) * SHM_K + kws0) = st_k0; *(LAS bf16x8*)(K_lds + (bf) * SHM_K + kws1) = st_k1; *(LAS bf16x8*)(K_lds + (bf) * SHM_K + kws2) = st_k2; \
                        *(LAS bf16x8*)(V_lds + (bf) * SHM_V + vst0) = st_v0; *(LAS bf16x8*)(V_lds + (bf) * SHM_V + vst1) = st_v1; } while (0)
#define RESC(a) do { if (__any((a) < 1.f)) { if (hi == 0) al_l[r32] = (a); asm volatile("s_waitcnt lgkmcnt(0)" ::: "memory");              \
                     _Pragma("unroll") for (int d_ = 0; d_ < 4; ++d_) _Pragma("unroll") for (int r = 0; r < 16; ++r) o[d_][r] *= al_l[crow(r, hi)]; } } while (0)
#define ACT(t) ((t) <= wchunk)
    f32x16 pA0, pA1, pB0, pB1; float mnA, mnB, alA, alB; bf16x8 pa0, pa1, pa2, pa3;
    SLOAD(0); VMW(); SWRITE(0); SBAR();
    SLOAD(1);
    __syncthreads();
    SBAR(); qkt<0>(pA0, pA1, K_lds, r32, hi, qr, ACT(0));
    partialSM(pA0, pA1, m_reg, mnA, alA);
    VMW(); SWRITE(1);
    __syncthreads();
#define HALF_STEP(PX0, PX1, mnX, alX, PY0, PY1, alY, t, KB, VB, SB) do {                                                      \
        SBAR(); qkt<KB>(PX0, PX1, K_lds, r32, hi, qr, ACT(t));                                                                \
        finishSM(PY0, PY1, alY, l_reg, pa0, pa1, pa2, pa3); SBAR();                                                           \
        if ((t) + 1 < NT) { SLOAD((t) + 1); SBAR(); }                                                                          \
        pv_tile<VB>(o, vb0, pa0, pa1, pa2, pa3, ACT((t) - 1)); partialSM(PX0, PX1, m_reg, mnX, alX);                          \
        __syncthreads();                                                                                                      \
        if ((t) + 1 < NT) { VMW(); SWRITE(SB); }                                                                               \
        RESC(alX); __syncthreads(); } while (0)
    for (int t = 1; t + 1 < NT; t += 2) {
        HALF_STEP(pB0, pB1, mnB, alB, pA0, pA1, alA, t, 1, 0, 0);
        HALF_STEP(pA0, pA1, mnA, alA, pB0, pB1, alB, t + 1, 0, 1, 1);
    }
    SBAR(); qkt<1>(pB0, pB1, K_lds, r32, hi, qr, ACT(NT - 1)); SBAR();
    finishSM(pA0, pA1, alA, l_reg, pa0, pa1, pa2, pa3); SBAR();
    pv_tile<0>(o, vb0, pa0, pa1, pa2, pa3, ACT(NT - 2));
    partialSM(pB0, pB1, m_reg, mnB, alB); __syncthreads(); RESC(alB);
    finishSM(pB0, pB1, alB, l_reg, pa0, pa1, pa2, pa3); SBAR(); pv_tile<1>(o, vb0, pa0, pa1, pa2, pa3, ACT(NT - 1));
    SBAR();
    if (hi == 0) li_l[r32] = l_reg; asm volatile("s_waitcnt lgkmcnt(0)" ::: "memory");
    float rli[16];
#pragma unroll
    for (int r = 0; r < 16; ++r) rli[r] = __builtin_amdgcn_rcpf(li_l[crow(r, hi)]);
    const int xl = (lane ^ 1) << 2;
#pragma unroll
    for (int r = 0; r < 16; ++r) { const int orow = wid * 32 + crow(r, hi);
#pragma unroll
        for (int d0 = 0; d0 < 4; ++d0) { const float v = o[d0][r] * rli[r];
            const float vn = __int_as_float(__builtin_amdgcn_ds_bpermute(xl, __float_as_int(v)));
            if ((r32 & 1) == 0) { const unsigned g = *(const unsigned*)(sg + (long)orow * ZB + d0 * 32 + r32);
                *(unsigned*)(Ob + (long)orow * 4096 + d0 * 32 + r32) = cvtpk(v * __uint_as_float(g << 16), vn * __uint_as_float(g & 0xffff0000u)); } } }
    __syncthreads();
#undef VMW
#undef SBAR
#undef SLOAD
#undef SWRITE
#undef RESC
#undef ACT
#undef HALF_STEP
}
__device__ __forceinline__ void phase_attention(const Params& p, char* lds) {
    for (int it = blockIdx.x; it < 256; it += gridDim.x) {
        const int xcd = it & 7, idx = it >> 3, hh = xcd * 2 + (idx >> 4), x = idx & 15;
        for (int half = 0; half < 2; ++half) { const int P0 = (half ? x : 31 - x) * 256;
            attn_block(lds, p.Q + (long)P0 * NQ + hh * QD, p.Kf + (long)hh * S * QD, p.Vf + (long)hh * S * VH, p.zB + (long)P0 * ZB + hh * VH, p.OH + (long)P0 * 4096 + hh * VH, P0); }
    }
}

__global__ __launch_bounds__(NTHR, 2) void mega(Params p) {
    extern __shared__ __attribute__((aligned(16))) char lds[];
    cg::grid_group grid = cg::this_grid();
    const int G = gridDim.x, c = blockIdx.x;
    phase_prologue(p, lds);
    grid.sync();
    for (int l = 0; l < DEPTH; ++l) {
        const float* xcur = l ? p.xr : p.x_in;
        phase_rmsnorm_bf16(xcur, p.attn_norm + l * DM, p.hb);
        grid.sync();
        { TileSched sc{p.hb, DM, p.Wt_in + (size_t)l * NIN * DM, DM, 32, NIN / 256, G, c}; EpiIn e{p.zB, p.zA}; gemm_fast(lds, DM, DM, DM, sc, e); }
        grid.sync();
        phase_t2(p, l);
        grid.sync();
        { TileSched sc{p.qn, QL, p.Wt_q + (size_t)l * NQ * QL, QL, 32, NQ / 256, G, c}; EpiQ e{p.Q, p.cs}; gemm_fast(lds, QL, QL, QL, sc, e); }
        { TileSched sc{p.kvn, KVL, p.Wt_kv + (size_t)l * NKV * KVL, KVL, 32, NKV / 256, G, (c + 128) % G}; EpiKV e{p.Kf, p.Vf}; gemm_fast(lds, KVL, KVL, KVL, sc, e); }
        { LruSched sc{{p.xc, DM, p.Wt_lru + (size_t)l * LRUB * 65536, 256, 32, LRUB, G, c}}; EpiLru e{p.xc, p.b_rg + l * DM, p.b_ig + l * DM, p.nsp8 + l * DM, p.la, p.lb}; gemm_fast(lds, 256, DM, 256, sc, e); }
        grid.sync();
        phase_scan1(p);
        phase_attention(p, lds);
        grid.sync();
        phase_scan3(p);
        grid.sync();
        { MergeSched sc{{p.OH, 4096, p.Wt_o + (size_t)l * DM * 4096, 4096, 32, 8, G, c}}; EpiMerge e{p.zB, p.mg}; gemm_fast(lds, DM, 4096, 4096, sc, e); }
        grid.sync();
        { TileSched sc{p.mg, DM, p.Wt_out + (size_t)l * DM * DM, DM, 32, 8, G, c}; EpiOut e{xcur, p.xr}; gemm_fast(lds, DM, DM, DM, sc, e); }
        { TileSched sc{p.pb + (size_t)l * S * PLE, PLE, p.Wt_ple + (size_t)l * DM * PLE, PLE, 32, 8, G, c}; EpiF32 e{p.pp, DM}; gemm_fast(lds, PLE, PLE, PLE, sc, e); }
        grid.sync();
        phase_rmsnorm_bf16(p.xr, p.ple_norm + l * DM, p.hb);
        grid.sync();
        { TileSched sc{p.hb, DM, p.Wt_pg + (size_t)l * DM * DM, DM, 32, 8, G, c}; EpiPle e{p.xr, p.pp}; gemm_fast(lds, DM, DM, DM, sc, e); }
        grid.sync();
    }
    phase_final_norm(p.xr, p.final_norm);
}

constexpr size_t LDS_BYTES = 8 * HTB;

extern "C" void kernel_launch(void* const* d_in, const int* in_sizes, int n_in, void* d_out, int out_size, void* d_ws, size_t ws_size, hipStream_t st) {
    Params p{};
    p.x_in = (const float*)d_in[0]; p.p_in = (const float*)d_in[1]; p.pos = (const int*)d_in[2];
    p.attn_norm = (const float*)d_in[3]; p.w_in = (const float*)d_in[4]; p.q_a_norm = (const float*)d_in[5]; p.w_q_b = (const float*)d_in[6];
    p.kv_a_norm = (const float*)d_in[7]; p.w_kv_b = (const float*)d_in[8]; p.conv_w = (const float*)d_in[9]; p.conv_b = (const float*)d_in[10];
    p.w_rg = (const float*)d_in[11]; p.b_rg = (const float*)d_in[12]; p.w_ig = (const float*)d_in[13]; p.b_ig = (const float*)d_in[14]; p.lam = (const float*)d_in[15];
    p.w_o_mla = (const float*)d_in[16]; p.w_o_lru = (const float*)d_in[17]; p.w_out = (const float*)d_in[18]; p.ple_norm = (const float*)d_in[19];
    p.w_ple_gate = (const float*)d_in[20]; p.w_ple = (const float*)d_in[21]; p.final_norm = (const float*)d_in[22];
    p.xr = (float*)d_out;
    char* w = (char*)d_ws; size_t off = 0;
    auto take = [&](size_t bytes) { char* r = w + off; off += (bytes + 255) & ~(size_t)255; return r; };
    p.Wt_in = (u16*)take((size_t)DEPTH * NIN * DM * 2); p.Wt_q = (u16*)take((size_t)DEPTH * NQ * QL * 2); p.Wt_kv = (u16*)take((size_t)DEPTH * NKV * KVL * 2);
    p.Wt_lru = (u16*)take((size_t)DEPTH * LRUB * 65536 * 2); p.Wt_o = (u16*)take((size_t)DEPTH * DM * 4096 * 2); p.Wt_out = (u16*)take((size_t)DEPTH * DM * DM * 2);
    p.Wt_pg = (u16*)take((size_t)DEPTH * DM * DM * 2); p.Wt_ple = (u16*)take((size_t)DEPTH * DM * PLE * 2);
    p.hb = (u16*)take((size_t)S * DM * 2); p.zB = (u16*)take((size_t)S * ZB * 2); p.zA = (float*)take((size_t)S * ZA * 4);
    p.qn = (u16*)take((size_t)S * QL * 2); p.kvn = (u16*)take((size_t)S * KVL * 2); p.Q = (u16*)take((size_t)S * NQ * 2);
    p.Kf = (u16*)take((size_t)NH * S * QD * 2); p.Vf = (u16*)take((size_t)NH * S * VH * 2); p.xc = (u16*)take((size_t)S * DM * 2);
    p.OH = (u16*)take((size_t)S * 4096 * 2); p.pb = (u16*)take((size_t)DEPTH * S * PLE * 2); p.cs = (float*)take((size_t)S * 64 * 4); p.carry = (float*)take((size_t)3 * 128 * DM * 4); p.nsp8 = (float*)take((size_t)DEPTH * DM * 4);
    p.la = (float*)take((size_t)S * DM * 4); p.lb = (float*)take((size_t)S * DM * 4); p.pp = (float*)take((size_t)S * DM * 4); p.mg = (u16*)take((size_t)S * DM * 2);
    if (off > ws_size) { fprintf(stderr, "workspace too small: need %zu have %zu\n", off, ws_size); return; }
    (void)hipFuncSetAttribute((const void*)mega, hipFuncAttributeMaxDynamicSharedMemorySize, (int)LDS_BYTES);
    int dev = 0, cus = 0; (void)hipGetDevice(&dev); (void)hipDeviceGetAttribute(&cus, hipDeviceAttributeMultiprocessorCount, dev);
    int per_cu = 0; (void)hipOccupancyMaxActiveBlocksPerMultiprocessor(&per_cu, mega, NTHR, LDS_BYTES);
    if (per_cu < 1 || cus < 1) { fprintf(stderr, "occupancy query failed\n"); return; }
    void* args[] = {&p};
    hipError_t e = hipLaunchCooperativeKernel((const void*)mega, dim3(cus), dim3(NTHR), args, LDS_BYTES, st);
    if (e != hipSuccess) fprintf(stderr, "cooperative launch failed: %s\n", hipGetErrorString(e));
}
```

```cpp
#include <hip/hip_runtime.h>
#include <hip/hip_cooperative_groups.h>
#include <cstdio>
#include <cstdint>
namespace cg = cooperative_groups;

constexpr int S = 8192, DM = 2048, DEPTH = 4, NH = 16, QL = 512, KVL = 512, NOPE = 128, ROPE = 64, VH = 128;
constexpr int INT = 11328, PLE = 256, LRUB = 16, LBD = 128;
constexpr int QD = 192, NQ = NH * QD  , NKV = NH * 256  ;
constexpr int NIN = 11520;
constexpr int ZB = 10240, ZA = 1280;
constexpr int NTHR = 512;
constexpr float QSCALE = 0.07216878364870322f * 1.4426950408889634f;

typedef unsigned short u16;
typedef short bf16x8 __attribute__((ext_vector_type(8)));
typedef float f32x4 __attribute__((ext_vector_type(4)));
typedef float f32x2 __attribute__((ext_vector_type(2)));
typedef unsigned u32x2 __attribute__((ext_vector_type(2)));
typedef unsigned u32x4 __attribute__((ext_vector_type(4)));

__device__ __forceinline__ u16 f2bf(float f) { unsigned u = __float_as_uint(f); u += 0x7FFFu + ((u >> 16) & 1u); return (u16)(u >> 16); }
__device__ __forceinline__ float bf2f(u16 b) { return __uint_as_float(((unsigned)b) << 16); }
__device__ __forceinline__ unsigned pk2(float lo, float hi) { return (unsigned)f2bf(lo) | ((unsigned)f2bf(hi) << 16); }
__device__ __forceinline__ float sigmoidf_(float x) { return 1.f / (1.f + __expf(-x)); }
__device__ __forceinline__ float siluf_(float x) { return x / (1.f + __expf(-x)); }
__device__ __forceinline__ int opaque_zero() { int z; asm volatile("s_mov_b32 %0, 0" : "=s"(z)); return z; }
#define TID() ((int)threadIdx.x + opaque_zero())
__device__ __forceinline__ float wsum(float s, int lane) { for (int off = 32; off; off >>= 1) s += __int_as_float(__builtin_amdgcn_ds_bpermute((lane ^ off) << 2, __float_as_int(s))); return s; }
__device__ __forceinline__ float wmax(float s, int lane) { for (int off = 32; off; off >>= 1) s = fmaxf(s, __int_as_float(__builtin_amdgcn_ds_bpermute((lane ^ off) << 2, __float_as_int(s)))); return s; }

struct Params {
    const float *x_in, *p_in; const int* pos;
    const float *attn_norm, *w_in, *q_a_norm, *w_q_b, *kv_a_norm, *w_kv_b, *conv_w, *conv_b, *w_rg, *b_rg, *w_ig, *b_ig, *lam, *w_o_mla, *w_o_lru, *w_out, *ple_norm, *w_ple_gate, *w_ple, *final_norm;
    float* xr;
    u16 *Wt_in, *Wt_q, *Wt_kv, *Wt_lru, *Wt_o, *Wt_out, *Wt_pg, *Wt_ple;
    u16 *hb, *zB, *qn, *kvn, *Q, *Kf, *Vf, *xc, *OH, *mg, *pb, *Pm;
    float *zA, *la, *lb, *pp, *cs, *carry, *sc, *nsp8; unsigned* bar;
};

struct Unit { const u16* a; const u16* b; int pm, pn, aux; };

struct TileSched {
    const u16* A; long lda; const u16* B; long ldb; int nM, nN, G, c;
    __device__ __forceinline__ bool tile(int i, int& pm, int& pn) const {
        const int nwg = nM * nN; const long L = (long)i * G + c; if (L >= nwg) return false;
        int wgid = (int)L; { const int q = nwg / 8, r = nwg % 8, xcd = wgid % 8, off = wgid / 8; wgid = (xcd < r ? xcd * (q + 1) : r * (q + 1) + (xcd - r) * q) + off; }
        const int nig = 8 * nN, gid = wgid / nig, fm = gid * 8, gsz = (nM - fm) < 8 ? (nM - fm) : 8;
        pm = fm + ((wgid % nig) % gsz); pn = (wgid % nig) / gsz; return true;
    }
    __device__ __forceinline__ bool next(int i, Unit& u) const {
        if (!tile(i, u.pm, u.pn)) return false;
        u.a = A + (long)u.pm * 256 * lda; u.b = B + (long)u.pn * 256 * ldb; u.aux = 0; return true;
    }
};
struct LruSched : TileSched {
    __device__ __forceinline__ bool next(int i, Unit& u) const {
        if (!tile(i, u.pm, u.pn)) return false;
        u.a = A + (long)u.pm * 256 * lda + (u.pn >> 1) * 256; u.b = B + (long)u.pn * 65536; u.aux = 0; return true;
    }
};
struct MergeSched : TileSched {
    __device__ __forceinline__ bool next(int i, Unit& u) const {
        if (!tile(i >> 1, u.pm, u.pn)) return false;
        u.aux = i & 1; u.a = A + (long)u.pm * 256 * lda + u.aux * 2048; u.b = B + (long)u.pn * 256 * ldb + u.aux * 2048; return true;
    }
};
struct TriSched {
    const u16* A; long lda; const u16* B; long ldb; int G, c;
    __device__ __forceinline__ bool next(int i, Unit& u) const {
        int t = i * G + c; if (t >= 528) return false;
        int pm = 0; while (t >= pm + 1) { t -= pm + 1; ++pm; }
        u.pm = pm; u.pn = t; u.a = A + (long)pm * 256 * lda; u.b = B + (long)t * 256 * ldb; u.aux = 0; return true;
    }
};
struct RowSched {
    const u16* A; long lda; const u16* B; int G, c;
    __device__ __forceinline__ bool next(int i, Unit& u) const {
        const int t = i * G + c; if (t >= 32) return false;
        u.pm = 31 - t; u.pn = 0; u.a = A + (long)u.pm * 256 * lda; u.b = B; u.aux = 0; return true;
    }
};

template <class F>
__device__ __forceinline__ void epi_foreach(f32x4 (&acc)[2][2][4][2], const Unit& u, int wr, int wc, int fr, int fq, F f) {
    const int row0 = u.pm * 256 + wr * 64 + fr, col0 = u.pn * 256 + wc * 32 + 4 * fq;
#pragma unroll
    for (int ai = 0; ai < 2; ++ai)
#pragma unroll
        for (int m = 0; m < 4; ++m) {
#pragma unroll
            for (int bj = 0; bj < 2; ++bj)
#pragma unroll
                for (int n = 0; n < 2; ++n) f(row0 + ai * 128 + m * 16, col0 + bj * 128 + n * 16, acc[ai][bj][m][n]);
            __builtin_amdgcn_sched_barrier(0);
        }
}
#define EPI_COMMON  __device__ __forceinline__ bool keep(const Unit&) const { return false; } __device__ __forceinline__ int klimit(const Unit&, int K) const { return K; }
#define EPI_SIG     __device__ __forceinline__ void operator()(f32x4 (&acc)[2][2][4][2], const Unit& u, int wr, int wc, int fr, int fq) const

struct EpiIn { EPI_COMMON u16* zB; float* zA;
    EPI_SIG { const int seg = u.pn >> 3;
        epi_foreach(acc, u, wr, wc, fr, fq, [&](int row, int col, f32x4& v) {
            if (seg >= 5) { if (col < ZB + 1088) *(f32x4*)(zA + (long)row * ZA + (col - ZB)) = v; }
            else { f32x4 o;
#pragma unroll
                for (int e = 0; e < 4; ++e) o[e] = (seg == 1) ? v[e] : ((seg == 0 || seg == 2) ? siluf_(v[e]) : sigmoidf_(v[e]));
                *(u32x2*)(zB + (long)row * ZB + col) = (u32x2){pk2(o[0], o[1]), pk2(o[2], o[3])}; }
        }); } };
struct EpiQ { EPI_COMMON u16* Q; const float* cs;
    EPI_SIG { epi_foreach(acc, u, wr, wc, fr, fq, [&](int row, int col, f32x4& v) {
            const int d = col % QD; f32x4 o;
            if (d < NOPE) { o = v * QSCALE; }
            else { const int i0 = (d - NOPE) >> 1; const float* t = cs + (long)row * 64;
                   const float c0 = t[i0], s0 = t[32 + i0], c1 = t[i0 + 1], s1 = t[32 + i0 + 1];
                   o[0] = (v[0] * c0 - v[1] * s0) * QSCALE; o[1] = (v[1] * c0 + v[0] * s0) * QSCALE;
                   o[2] = (v[2] * c1 - v[3] * s1) * QSCALE; o[3] = (v[3] * c1 + v[2] * s1) * QSCALE; }
            *(u32x2*)(Q + (long)row * NQ + col) = (u32x2){pk2(o[0], o[1]), pk2(o[2], o[3])};
        }); } };
struct EpiKV { EPI_COMMON u16* Kf; u16* Vf;
    EPI_SIG { epi_foreach(acc, u, wr, wc, fr, fq, [&](int row, int col, f32x4& v) {
            const int hh = col >> 8, j = col & 255;
            u16* dst = (j < 128) ? Kf + ((long)hh * S + row) * QD + j : Vf + ((long)hh * S + row) * VH + (j - 128);
            *(u32x2*)dst = (u32x2){pk2(v[0], v[1]), pk2(v[2], v[3])};
        }); } };
struct EpiLru { EPI_COMMON const u16* xc; const float *brg, *big, *nsp8; float *la, *lb;
    EPI_SIG { epi_foreach(acc, u, wr, wc, fr, fq, [&](int row, int col, f32x4& v) {
            const int ch = (col >> 1);
            const unsigned xw = *(const unsigned*)(xc + (long)row * DM + ch);
            const f32x2 b_r = *(const f32x2*)(brg + ch), b_i = *(const f32x2*)(big + ch), ns = *(const f32x2*)(nsp8 + ch);
            f32x2 av, bv;
#pragma unroll
            for (int e = 0; e < 2; ++e) {
                const float r = sigmoidf_(v[2 * e] + b_r[e]), ii = sigmoidf_(v[2 * e + 1] + b_i[e]);
                const float lg = r * ns[e], x2 = 2.f * lg;
                const float em = (x2 > -0.25f) ? x2 * (1.f + x2 * (0.5f + x2 * (0.16666667f + x2 * (0.041666668f + x2 * 0.0083333338f)))) : (__expf(x2) - 1.f);
                const float x = e ? __uint_as_float(xw & 0xffff0000u) : __uint_as_float(xw << 16);
                av[e] = __expf(lg); bv[e] = sqrtf(-em) * (ii * x); }
            *(f32x2*)(la + (long)row * DM + ch) = av; *(f32x2*)(lb + (long)row * DM + ch) = bv;
        }); } };
struct EpiMerge { const u16* zB; u16* mg;
    __device__ __forceinline__ bool keep(const Unit& u) const { return u.aux == 0; }
    __device__ __forceinline__ int klimit(const Unit&, int K) const { return K; }
    EPI_SIG { const int part = u.aux;
        epi_foreach(acc, u, wr, wc, fr, fq, [&](int row, int col, f32x4& v) {
            const u32x2 sm = *(const u32x2*)(zB + (long)row * ZB + 6144 + col), sl = *(const u32x2*)(zB + (long)row * ZB + 8192 + col);
            f32x4 fm = {__uint_as_float(sm[0] << 16), __uint_as_float(sm[0] & 0xffff0000u), __uint_as_float(sm[1] << 16), __uint_as_float(sm[1] & 0xffff0000u)};
            f32x4 fl = {__uint_as_float(sl[0] << 16), __uint_as_float(sl[0] & 0xffff0000u), __uint_as_float(sl[1] << 16), __uint_as_float(sl[1] & 0xffff0000u)};
#pragma unroll
            for (int e = 0; e < 4; ++e) fl[e] = fmaxf(fl[e], 1e-12f);
            if (part == 0) {
#pragma unroll
                for (int e = 0; e < 4; ++e) v[e] = v[e] * fm[e] / fl[e];
            } else { f32x4 o = v * fl; *(u32x2*)(mg + (long)row * DM + col) = (u32x2){pk2(o[0], o[1]), pk2(o[2], o[3])}; }
        }); } };
struct EpiOut { EPI_COMMON const float* xold; float* xnew;
    EPI_SIG { epi_foreach(acc, u, wr, wc, fr, fq, [&](int row, int col, f32x4& v) {
            const long idx = (long)row * DM + col; *(f32x4*)(xnew + idx) = *(const f32x4*)(xold + idx) + v; }); } };
struct EpiF32 { EPI_COMMON float* C; long ldc;
    EPI_SIG { epi_foreach(acc, u, wr, wc, fr, fq, [&](int row, int col, f32x4& v) { *(f32x4*)(C + (long)row * ldc + col) = v; }); } };
struct EpiPle { EPI_COMMON float* x; const float* pp;
    EPI_SIG { epi_foreach(acc, u, wr, wc, fr, fq, [&](int row, int col, f32x4& v) {
            const long idx = (long)row * DM + col; const f32x4 pv = *(const f32x4*)(pp + idx); f32x4 xv = *(const f32x4*)(x + idx);
#pragma unroll
            for (int e = 0; e < 4; ++e) xv[e] += pv[e] * sigmoidf_(v[e]);
            *(f32x4*)(x + idx) = xv; }); } };
struct EpiPV { const u16* zB; u16* OH; int head;
    __device__ __forceinline__ bool keep(const Unit&) const { return false; }
    __device__ __forceinline__ int klimit(const Unit& u, int K) const { return 256 * (u.pm + 1); }
    EPI_SIG { epi_foreach(acc, u, wr, wc, fr, fq, [&](int row, int col, f32x4& v) {
            if (col < VH) { const int c = head * VH + col; const u32x2 g = *(const u32x2*)(zB + (long)row * ZB + c);
                f32x4 o = {v[0] * __uint_as_float(g[0] << 16), v[1] * __uint_as_float(g[0] & 0xffff0000u), v[2] * __uint_as_float(g[1] << 16), v[3] * __uint_as_float(g[1] & 0xffff0000u)};
                *(u32x2*)(OH + (long)row * 4096 + c) = (u32x2){pk2(o[0], o[1]), pk2(o[2], o[3])}; }
        }); } };

template <int BMODE, class Epi, class Sched>
__device__ __forceinline__ void gemm_simple(char* lds, int K, long lda, long ldb, const Sched& Sc, const Epi& E) {
    u16 (*sa)[40] = (u16(*)[40])lds; u16 (*sb)[40] = (u16(*)[40])(lds + 256 * 40 * 2);
    const int tid = TID(), wid = tid >> 6, lane = tid & 63, wr = wid >> 2, wc = wid & 3, fr = lane & 15, fq = lane >> 4;
    f32x4 acc[2][2][4][2];
#pragma unroll
    for (int a = 0; a < 2; ++a)
#pragma unroll
        for (int b = 0; b < 2; ++b)
#pragma unroll
            for (int m = 0; m < 4; ++m)
#pragma unroll
                for (int n = 0; n < 2; ++n) acc[a][b][m][n] = (f32x4){0.f, 0.f, 0.f, 0.f};
    Unit u;
    for (int i = 0; Sc.next(i, u); ++i) {
        const int Ku = E.klimit(u, K);
        if (BMODE == 1) { for (int e = tid; e < 128 * 40; e += NTHR) sb[128 + e / 40][e % 40] = 0; }
        for (int k0 = 0; k0 < Ku; k0 += 32) {
#pragma unroll
            for (int j = 0; j < 2; ++j) { const int c = tid + j * NTHR, r = c >> 2, cc = (c & 3) * 8;
                *(u32x4*)&sa[r][cc] = *(const u32x4*)(u.a + (long)r * lda + k0 + cc);
                if (BMODE == 0) *(u32x4*)&sb[r][cc] = *(const u32x4*)(u.b + (long)r * ldb + k0 + cc); }
            if (BMODE == 1) { const int k = tid >> 4, n0 = (tid & 15) * 8; const u32x4 v = *(const u32x4*)(u.b + (long)(k0 + k) * ldb + n0);
#pragma unroll
                for (int e = 0; e < 4; ++e) { sb[n0 + 2 * e][k] = (u16)(v[e] & 0xffffu); sb[n0 + 2 * e + 1][k] = (u16)(v[e] >> 16); } }
            __syncthreads();
            bf16x8 bf[2][2];
#pragma unroll
            for (int bj = 0; bj < 2; ++bj)
#pragma unroll
                for (int n = 0; n < 2; ++n) bf[bj][n] = *(const bf16x8*)&sb[128 * bj + 32 * wc + 16 * n + fr][fq * 8];
#pragma unroll
            for (int ai = 0; ai < 2; ++ai) {
                bf16x8 af[4];
#pragma unroll
                for (int m = 0; m < 4; ++m) af[m] = *(const bf16x8*)&sa[128 * ai + 64 * wr + 16 * m + fr][fq * 8];
#pragma unroll
                for (int bj = 0; bj < 2; ++bj)
#pragma unroll
                    for (int m = 0; m < 4; ++m)
#pragma unroll
                        for (int n = 0; n < 2; ++n) acc[ai][bj][m][n] = __builtin_amdgcn_mfma_f32_16x16x32_bf16(bf[bj][n], af[m], acc[ai][bj][m][n], 0, 0, 0);
                __builtin_amdgcn_sched_barrier(0);
            }
            __syncthreads();
        }
        E(acc, u, wr, wc, fr, fq);
        if (!E.keep(u)) {
#pragma unroll
            for (int a = 0; a < 2; ++a)
#pragma unroll
                for (int b = 0; b < 2; ++b)
#pragma unroll
                    for (int m = 0; m < 4; ++m)
#pragma unroll
                        for (int n = 0; n < 2; ++n) acc[a][b][m][n] = (f32x4){0.f, 0.f, 0.f, 0.f};
        }
    }
}


#define LAS __attribute__((address_space(3)))
constexpr int HTB = 128 * 64 * 2;
__device__ __forceinline__ int lds_byte(int r, int c) { const int st = (r >> 4) * 2 + (c >> 5), rr = r & 15, cc = c & 31, ob = rr * 64 + cc * 2; return st * 1024 + (ob ^ (((ob >> 9) & 1) << 5)); }
__device__ __forceinline__ void stage_rc(int b, int& R, int& C) { const int st = b / 1024, sb = b % 1024, swz = sb ^ (((sb >> 9) & 1) << 5); R = (st >> 1) * 16 + swz / 64; C = (st & 1) * 32 + (swz % 64) / 2; }

template <class Epi, class Sched>
__device__ __forceinline__ void gemm_fast(char* lds_, int K, long lda, long ldb, const Sched& S_, const Epi& E) {
    LAS unsigned char* lds = (LAS unsigned char*)lds_;
    const int tid = TID(), wid = __builtin_amdgcn_readfirstlane(tid >> 6), lane = tid & 63, wr = wid >> 2, wc = wid & 3, fr = lane & 15, fq = lane >> 4;
    const int nt = K / 64;
    unsigned voffA[2], voffB[2];
#pragma unroll
    for (int i = 0; i < 2; ++i) { int R, C; stage_rc(tid * 16 + i * 8192, R, C); voffA[i] = (unsigned)(R * lda + C) * 2u; voffB[i] = (unsigned)(R * ldb + C) * 2u; }
    const size_t kstep = 128;
    const size_t hstepA = (size_t)128 * lda * 2, hstepB = (size_t)128 * ldb * 2;
    const unsigned ldsw = (unsigned)wid * 1024u;
    const int aoff = lds_byte(wr * 64 + fr, fq * 8), boff = lds_byte(wc * 32 + fr, fq * 8);
#define G_SA(b, h) (((b) * 2 + (h)) * HTB)
#define G_SB(b, h) ((4 + (b) * 2 + (h)) * HTB)
#define G_STAGE(bufoff, gbase, voff) do { _Pragma("unroll") for (int _i = 0; _i < 2; ++_i) \
        __builtin_amdgcn_global_load_lds((const unsigned*)((const char*)(gbase) + (voff)[_i]), (LAS unsigned*)(lds + (bufoff) + ldsw + _i * 8192), 16, 0, 0); } while (0)
#define G_LDA(dst, b, h) do { _Pragma("unroll") for (int m = 0; m < 4; ++m) _Pragma("unroll") for (int k = 0; k < 2; ++k) dst[m][k] = *(const LAS bf16x8*)(lds + G_SA(b, h) + aoff + m * 2048 + k * 1024); } while (0)
#define G_LDB(dst, b, h) do { _Pragma("unroll") for (int n = 0; n < 2; ++n) _Pragma("unroll") for (int k = 0; k < 2; ++k) dst[n][k] = *(const LAS bf16x8*)(lds + G_SB(b, h) + boff + n * 2048 + k * 1024); } while (0)
#define G_MMA(ai, bj, At, Bt) do { __builtin_amdgcn_s_setprio(1); _Pragma("unroll") for (int m = 0; m < 4; ++m) _Pragma("unroll") for (int n = 0; n < 2; ++n) _Pragma("unroll") for (int k = 0; k < 2; ++k) \
        acc[ai][bj][m][n] = __builtin_amdgcn_mfma_f32_16x16x32_bf16(Bt[n][k], At[m][k], acc[ai][bj][m][n], 0, 0, 0); __builtin_amdgcn_s_setprio(0); } while (0)
#define G_WAIT_V(n) asm volatile("s_waitcnt vmcnt(" #n ")" ::: "memory")
#define G_WAIT_L(n) asm volatile("s_waitcnt lgkmcnt(" #n ")" ::: "memory")
#define G_BAR __builtin_amdgcn_s_barrier()
#define G_SCHED __builtin_amdgcn_sched_barrier(0)
    Unit cur, nxt; int ui = 0;
    if (!S_.next(0, cur)) return;
    f32x4 acc[2][2][4][2];
#pragma unroll
    for (int a = 0; a < 2; ++a)
#pragma unroll
        for (int b = 0; b < 2; ++b)
#pragma unroll
            for (int m = 0; m < 4; ++m)
#pragma unroll
                for (int n = 0; n < 2; ++n) acc[a][b][m][n] = (f32x4){0.f, 0.f, 0.f, 0.f};
    bf16x8 At[4][2], B0[2][2], B1[2][2];
    const char* cA = (const char*)cur.a; const char* cB = (const char*)cur.b;
    G_STAGE(G_SB(0, 0), cB, voffB); G_STAGE(G_SA(0, 0), cA, voffA); G_STAGE(G_SB(0, 1), cB + hstepB, voffB); G_STAGE(G_SA(0, 1), cA + hstepA, voffA);
    if (wr == 1) G_BAR;
    G_WAIT_V(4); G_BAR;
    G_STAGE(G_SB(1, 0), cB + kstep, voffB); G_STAGE(G_SA(1, 0), cA + kstep, voffA); G_STAGE(G_SB(1, 1), cB + hstepB + kstep, voffB);
    G_WAIT_V(6); G_BAR;
    for (;;) {
        const bool has_next = S_.next(ui + 1, nxt);
        const char* nA = has_next ? (const char*)nxt.a : cA; const char* nB = has_next ? (const char*)nxt.b : cB;
#pragma unroll 1
        for (int t = 0; t < nt; t += 2) {
            const bool last = (t == nt - 2);
            const char* a1 = cA + (size_t)(t + 1) * kstep;
            const char* a2 = last ? nA : cA + (size_t)(t + 2) * kstep; const char* b2 = last ? nB : cB + (size_t)(t + 2) * kstep;
            const char* a3 = a2 + kstep; const char* b3 = b2 + kstep;
            G_LDB(B0, 0, 0); G_SCHED; G_LDA(At, 0, 0); G_STAGE(G_SA(1, 1), a1 + hstepA, voffA);
            G_WAIT_L(8); G_BAR; G_WAIT_L(0); G_MMA(0, 0, At, B0); G_BAR; G_SCHED;
            G_LDB(B1, 0, 1); G_STAGE(G_SB(0, 0), b2, voffB);
            G_BAR; G_WAIT_L(0); G_MMA(0, 1, At, B1); G_BAR;
            G_LDA(At, 0, 1); G_STAGE(G_SA(0, 0), a2, voffA);
            G_BAR; G_WAIT_L(0); G_MMA(1, 0, At, B0); G_BAR; G_SCHED;
            G_STAGE(G_SB(0, 1), b2 + hstepB, voffB);
            G_WAIT_V(6); G_BAR; G_MMA(1, 1, At, B1); G_BAR;
            G_LDB(B0, 1, 0); G_SCHED; G_LDA(At, 1, 0); G_STAGE(G_SA(0, 1), a2 + hstepA, voffA);
            G_WAIT_L(8); G_BAR; G_WAIT_L(0); G_MMA(0, 0, At, B0); G_BAR; G_SCHED;
            G_LDB(B1, 1, 1); G_STAGE(G_SB(1, 0), b3, voffB);
            G_BAR; G_WAIT_L(0); G_MMA(0, 1, At, B1); G_BAR;
            G_LDA(At, 1, 1); G_STAGE(G_SA(1, 0), a3, voffA);
            G_BAR; G_WAIT_L(0); G_MMA(1, 0, At, B0); G_BAR; G_SCHED;
            G_STAGE(G_SB(1, 1), b3 + hstepB, voffB);
            G_WAIT_V(6); G_BAR; G_MMA(1, 1, At, B1); G_BAR;
        }
        { const int t2 = TID(), w2 = t2 >> 6, l2 = t2 & 63;
          E(acc, cur, w2 >> 2, w2 & 3, l2 & 15, l2 >> 4); }
        if (!has_next) break;
        if (!E.keep(cur)) {
#pragma unroll
            for (int a = 0; a < 2; ++a)
#pragma unroll
                for (int b = 0; b < 2; ++b)
#pragma unroll
                    for (int m = 0; m < 4; ++m)
#pragma unroll
                        for (int n = 0; n < 2; ++n) acc[a][b][m][n] = (f32x4){0.f, 0.f, 0.f, 0.f};
        }
        cur = nxt; cA = nA; cB = nB; ++ui;
    }
    G_WAIT_V(0);
    if (wr == 0) G_BAR;
    G_BAR;
#undef G_SA
#undef G_SB
#undef G_STAGE
#undef G_LDA
#undef G_LDB
#undef G_MMA
#undef G_WAIT_V
#undef G_WAIT_L
#undef G_BAR
#undef G_SCHED
}


#define XB_TMO      128
#define XB_XCNT(j)  (256  + 64 * (j))
#define XB_XSUB(j)  (1280 + 64 * (j))
#define XB_XGEN(j)  (2304 + 64 * (j))
#define XB_TOP      3328
#define XB_TOPGEN   3392
#define XCD_BAR_WORDS 3456
#define XB_SPIN_CAP (1u << 18)
__device__ __forceinline__ unsigned xb_ld(unsigned* p)              { return __hip_atomic_load(p, __ATOMIC_RELAXED, __HIP_MEMORY_SCOPE_AGENT); }
__device__ __forceinline__ unsigned xb_add(unsigned* p, unsigned v) { return __hip_atomic_fetch_add(p, v, __ATOMIC_RELAXED, __HIP_MEMORY_SCOPE_AGENT); }
__device__ __forceinline__ unsigned xb_xcc_id() { return (unsigned)__builtin_amdgcn_s_getreg((3 << 11) | 20) & 0xFu; }
#define XB_SPIN(cond, bar) do { unsigned _sp = 0; while (cond) { __builtin_amdgcn_s_sleep(1); \
    if ((++_sp & 255u) == 0u) { if (xb_ld(&(bar)[XB_TMO])) break; if (_sp > XB_SPIN_CAP) { atomicAdd(&(bar)[XB_TMO], 1u); break; } } } } while (0)
struct XcdBarrier { unsigned* bar; unsigned x; volatile LAS unsigned* st; };
__device__ __forceinline__ XcdBarrier xcd_barrier_post(unsigned* bar, volatile LAS unsigned* st) {
    XcdBarrier b; b.bar = bar; b.x = xb_xcc_id(); b.st = st;
    if (threadIdx.x == 0) (void)xb_add(&bar[XB_XCNT(b.x)], 1u);
    return b;
}
__device__ __forceinline__ void xcd_barrier_complete(unsigned* bar, unsigned x, unsigned& nloc, unsigned& nx) {
    const unsigned G = gridDim.x * gridDim.y * gridDim.z;
    unsigned sum, cnt, mine, sp = 0u;
    for (;;) {
        sum = 0u; cnt = 0u; mine = 0u;
#pragma unroll
        for (unsigned j = 0; j < 16; ++j) { const unsigned c = xb_ld(&bar[XB_XCNT(j)]); sum += c; cnt += (c > 0u) ? 1u : 0u; mine = (j == x) ? c : mine; }
        if (sum == G) break;
        __builtin_amdgcn_s_sleep(1);
        if ((++sp & 255u) == 0u) { if (xb_ld(&bar[XB_TMO])) break; if (sp > XB_SPIN_CAP) { atomicAdd(&bar[XB_TMO], 1u); break; } }
    }
    nloc = mine > 0u ? mine : 1u; nx = cnt > 0u ? cnt : 1u;
}
__device__ __forceinline__ void xcd_barrier(const XcdBarrier& b) {
    asm volatile("s_waitcnt vmcnt(0)" ::: "memory");
    __syncthreads();
    if (threadIdx.x == 0) {
        unsigned* bar = b.bar;
        __builtin_amdgcn_s_waitcnt(0);
        unsigned nloc = b.st[0], nx = b.st[1];
        if (nloc == 0u) { xcd_barrier_complete(bar, b.x, nloc, nx); b.st[0] = nloc; b.st[1] = nx; }
        const unsigned old = xb_add(&bar[XB_XSUB(b.x)], 1u);
        const unsigned gen = old / nloc;
        if (old + 1u == (gen + 1u) * nloc) {
            __builtin_amdgcn_fence(__ATOMIC_RELEASE, "agent");
            asm volatile("s_waitcnt vmcnt(0)" ::: "memory");
            const unsigned og = xb_add(&bar[XB_TOP], 1u);
            const unsigned tg = og / nx;
            if (og + 1u == (tg + 1u) * nx) xb_add(&bar[XB_TOPGEN], 1u);
            else XB_SPIN(xb_ld(&bar[XB_TOPGEN]) == tg, bar);
            __builtin_amdgcn_fence(__ATOMIC_ACQUIRE, "agent");
            xb_add(&bar[XB_XGEN(b.x)], 1u);
            asm volatile("s_waitcnt vmcnt(0)" ::: "memory");
        } else {
            XB_SPIN(xb_ld(&bar[XB_XGEN(b.x)]) == gen, bar);
            __builtin_amdgcn_fence(__ATOMIC_ACQUIRE, "agent");
            asm volatile("s_waitcnt vmcnt(0)" ::: "memory");
        }
    }
    __syncthreads();
}

template <class RM>
__device__ __forceinline__ void transpose_cvt(char* lds, const float* __restrict__ src, int K, int N, u16* __restrict__ dst, long ldd, int coff, RM rowmap) {
    u16 (*t)[72] = (u16(*)[72])lds;
    const int tk = K / 256, tn = N / 64, tid = TID();
    for (int tix = blockIdx.x; tix < tk * tn; tix += gridDim.x) {
        const int k0 = (tix / tn) * 256, n0 = (tix % tn) * 64;
        { const int k = tid >> 3, nn = (tid & 7) * 8; f32x4 v[4][2];
#pragma unroll
          for (int j = 0; j < 4; ++j) { const float* p = src + (long)(k0 + k + 64 * j) * N + n0 + nn; v[j][0] = *(const f32x4*)p; v[j][1] = *(const f32x4*)(p + 4); }
#pragma unroll
          for (int j = 0; j < 4; ++j) *(u32x4*)&t[k + 64 * j][nn] = (u32x4){pk2(v[j][0][0], v[j][0][1]), pk2(v[j][0][2], v[j][0][3]), pk2(v[j][1][0], v[j][1][1]), pk2(v[j][1][2], v[j][1][3])}; }
        __syncthreads();
        { const int n = tid >> 3, kk = (tid & 7) * 8; u16* drow = dst + (long)rowmap(n0 + n) * ldd + coff + k0 + kk;
#pragma unroll
          for (int j = 0; j < 4; ++j) { u32x4 o;
#pragma unroll
            for (int e = 0; e < 4; ++e) o[e] = (unsigned)t[64 * j + kk + 2 * e][n] | ((unsigned)t[64 * j + kk + 2 * e + 1][n] << 16);
            *(u32x4*)(drow + 64 * j) = o; } }
        __syncthreads();
    }
}

__device__ __forceinline__ void phase_prologue(const Params& p, char* lds) {
    const long gtid = (long)blockIdx.x * NTHR + TID(), gsz = (long)gridDim.x * NTHR;
    for (int l = 0; l < DEPTH; ++l) {
        transpose_cvt(lds, p.w_in + (size_t)l * DM * INT, DM, INT, p.Wt_in + (size_t)l * NIN * DM, DM, 0, [](int n) { return n >= 1088 ? n - 1088 : n + ZB; });
        transpose_cvt(lds, p.w_q_b + (size_t)l * QL * NQ, QL, NQ, p.Wt_q + (size_t)l * NQ * QL, QL, 0, [](int n) {
            const int hh = n / QD, d = n % QD; if (d < NOPE) return n; const int e = d - NOPE; return hh * QD + NOPE + ((e & 31) << 1) + (e >> 5); });
        transpose_cvt(lds, p.w_kv_b + (size_t)l * KVL * NKV, KVL, NKV, p.Wt_kv + (size_t)l * NKV * KVL, KVL, 0, [](int n) { return n; });
        transpose_cvt(lds, p.w_o_mla + (size_t)l * DM * DM, DM, DM, p.Wt_o + (size_t)l * DM * 4096, 4096, 0, [](int n) { return n; });
        transpose_cvt(lds, p.w_o_lru + (size_t)l * DM * DM, DM, DM, p.Wt_o + (size_t)l * DM * 4096, 4096, 2048, [](int n) { return n; });
        transpose_cvt(lds, p.w_out + (size_t)l * DM * DM, DM, DM, p.Wt_out + (size_t)l * DM * DM, DM, 0, [](int n) { return n; });
        transpose_cvt(lds, p.w_ple_gate + (size_t)l * DM * DM, DM, DM, p.Wt_pg + (size_t)l * DM * DM, DM, 0, [](int n) { return n; });
        transpose_cvt(lds, p.w_ple + (size_t)l * PLE * DM, PLE, DM, p.Wt_ple + (size_t)l * DM * PLE, PLE, 0, [](int n) { return n; });
    }
    for (long i = gtid; i < (long)DEPTH * (NIN - INT) * DM / 8; i += gsz) { const long per = (long)(NIN - INT) * DM / 8; const int l = (int)(i / per); const long r = i % per;
        *(u32x4*)(p.Wt_in + ((size_t)l * NIN + INT) * DM + r * 8) = (u32x4){0u, 0u, 0u, 0u}; }
    for (long i = gtid; i < (long)DEPTH * LRUB * 256 * 256; i += gsz) {
        const int k = (int)(i & 255), o = (int)((i >> 8) & 255), blk = (int)((i >> 16) & 15), l = (int)(i >> 20);
        const int kk = k - 128 * (blk & 1), cl = o >> 1; float v = 0.f;
        if (kk >= 0 && kk < 128) v = ((o & 1) ? p.w_ig : p.w_rg)[(((size_t)l * LRUB + blk) * LBD + kk) * LBD + cl];
        p.Wt_lru[i] = f2bf(v); }
    for (long i = gtid; i < (long)DEPTH * S * PLE / 8; i += gsz) { const float* s = p.p_in + i * 8; const f32x4 v0 = *(const f32x4*)s, v1 = *(const f32x4*)(s + 4);
        *(u32x4*)(p.pb + i * 8) = (u32x4){pk2(v0[0], v0[1]), pk2(v0[2], v0[3]), pk2(v1[0], v1[1]), pk2(v1[2], v1[3])}; }
    for (long i = gtid; i < (long)DEPTH * DM; i += gsz) p.nsp8[i] = -8.f * log1pf(expf(-p.lam[i]));
    for (long i = gtid; i < (long)S * 32; i += gsz) { const int s = (int)(i >> 5), f = (int)(i & 31);
        const float inv = powf(10000.f, -(float)(2 * f) / 64.f), ang = (float)p.pos[s] * inv;
        p.cs[(long)s * 64 + f] = (float)cos((double)ang); p.cs[(long)s * 64 + 32 + f] = (float)sin((double)ang); }
}

__device__ __forceinline__ void phase_rmsnorm_bf16(const float* __restrict__ x, const float* __restrict__ g, u16* __restrict__ out) {
    const int tid = TID(), lane = tid & 63, gw = blockIdx.x * (NTHR / 64) + (tid >> 6), nw = gridDim.x * (NTHR / 64);
    for (int row = gw; row < S; row += nw) {
        const float* p = x + (long)row * DM; f32x4 v[8]; float s = 0.f;
#pragma unroll
        for (int j = 0; j < 8; ++j) { v[j] = *(const f32x4*)(p + j * 256 + lane * 4); s += v[j][0] * v[j][0] + v[j][1] * v[j][1] + v[j][2] * v[j][2] + v[j][3] * v[j][3]; }
        s = wsum(s, lane); const float rinv = rsqrtf(s * (1.f / DM) + 1e-6f);
#pragma unroll
        for (int j = 0; j < 8; ++j) { const f32x4 gg = *(const f32x4*)(g + j * 256 + lane * 4);
            *(u32x2*)(out + (long)row * DM + j * 256 + lane * 4) = (u32x2){pk2(v[j][0] * rinv * gg[0], v[j][1] * rinv * gg[1]), pk2(v[j][2] * rinv * gg[2], v[j][3] * rinv * gg[3])}; }
    }
}
__device__ __forceinline__ void phase_final_norm(float* __restrict__ x, const float* __restrict__ g) {
    const int tid = TID(), lane = tid & 63, gw = blockIdx.x * (NTHR / 64) + (tid >> 6), nw = gridDim.x * (NTHR / 64);
    for (int row = gw; row < S; row += nw) {
        float* p = x + (long)row * DM; f32x4 v[8]; float s = 0.f;
#pragma unroll
        for (int j = 0; j < 8; ++j) { v[j] = *(const f32x4*)(p + j * 256 + lane * 4); s += v[j][0] * v[j][0] + v[j][1] * v[j][1] + v[j][2] * v[j][2] + v[j][3] * v[j][3]; }
        s = wsum(s, lane); const float rinv = rsqrtf(s * (1.f / DM) + 1e-6f);
#pragma unroll
        for (int j = 0; j < 8; ++j) { const f32x4 gg = *(const f32x4*)(g + j * 256 + lane * 4); *(f32x4*)(p + j * 256 + lane * 4) = v[j] * rinv * gg; }
    }
}
__device__ __forceinline__ void phase_t2(const Params& p, int l) {
    const int tid = TID(), lane = tid & 63, gw = blockIdx.x * (NTHR / 64) + (tid >> 6), nw = gridDim.x * (NTHR / 64);
    const float* cw = p.conv_w + (size_t)l * 4 * DM; const float* cb = p.conv_b + (size_t)l * DM;
    for (int row = gw; row < S; row += nw) {
        const float* zr = p.zA + (long)row * ZA;
#pragma unroll
        for (int part = 0; part < 2; ++part) {
            const float* src = zr + part * 512; const float* g = (part ? p.kv_a_norm : p.q_a_norm) + l * 512; u16* dst = (part ? p.kvn : p.qn) + (long)row * 512;
            const f32x4 v0 = *(const f32x4*)(src + lane * 4), v1 = *(const f32x4*)(src + 256 + lane * 4);
            float s = v0[0] * v0[0] + v0[1] * v0[1] + v0[2] * v0[2] + v0[3] * v0[3] + v1[0] * v1[0] + v1[1] * v1[1] + v1[2] * v1[2] + v1[3] * v1[3];
            s = wsum(s, lane); const float rinv = rsqrtf(s * (1.f / 512.f) + 1e-6f);
            const f32x4 g0 = *(const f32x4*)(g + lane * 4), g1 = *(const f32x4*)(g + 256 + lane * 4);
            *(u32x2*)(dst + lane * 4) = (u32x2){pk2(v0[0] * rinv * g0[0], v0[1] * rinv * g0[1]), pk2(v0[2] * rinv * g0[2], v0[3] * rinv * g0[3])};
            *(u32x2*)(dst + 256 + lane * 4) = (u32x2){pk2(v1[0] * rinv * g1[0], v1[1] * rinv * g1[1]), pk2(v1[2] * rinv * g1[2], v1[3] * rinv * g1[3])};
        }
        if (lane < 32) { const float x1 = zr[1024 + lane], x2 = zr[1056 + lane], c = p.cs[(long)row * 64 + lane], sn = p.cs[(long)row * 64 + 32 + lane];
            const unsigned w = pk2(x1 * c - x2 * sn, x2 * c + x1 * sn);
#pragma unroll
            for (int hh = 0; hh < NH; ++hh) *(unsigned*)(p.Kf + ((long)hh * S + row) * QD + NOPE + 2 * lane) = w; }
#pragma unroll
        for (int j = 0; j < 8; ++j) { const int c = j * 256 + lane * 4; f32x4 y = *(const f32x4*)(cb + c);
#pragma unroll
            for (int k = 0; k < 4; ++k) { const int sp = row - 3 + k; if (sp >= 0) { const u32x2 uu = *(const u32x2*)(p.zB + (long)sp * ZB + 2048 + c); const f32x4 w = *(const f32x4*)(cw + k * DM + c);
                y[0] += __uint_as_float(uu[0] << 16) * w[0]; y[1] += __uint_as_float(uu[0] & 0xffff0000u) * w[1]; y[2] += __uint_as_float(uu[1] << 16) * w[2]; y[3] += __uint_as_float(uu[1] & 0xffff0000u) * w[3]; } }
            *(u32x2*)(p.xc + (long)row * DM + c) = (u32x2){pk2(y[0], y[1]), pk2(y[2], y[3])}; }
    }
}
__device__ __forceinline__ void phase_scan1(const Params& p) {
    float* Pc = p.carry; float* Hc = p.carry + 128 * DM;
    for (long i = (long)blockIdx.x * NTHR + TID(); i < 128L * DM; i += (long)gridDim.x * NTHR) {
        const int c = (int)(i % DM), ch = (int)(i / DM); float P = 1.f, H = 0.f;
        const float* pa = p.la + (long)ch * 64 * DM + c; const float* pb = p.lb + (long)ch * 64 * DM + c;
#pragma unroll 1
        for (int t0 = 0; t0 < 64; t0 += 16) { float a[16], b[16];
#pragma unroll
            for (int t = 0; t < 16; ++t) { a[t] = pa[(long)(t0 + t) * DM]; b[t] = pb[(long)(t0 + t) * DM]; }
#pragma unroll
            for (int t = 0; t < 16; ++t) { H = a[t] * H + b[t]; P *= a[t]; } }
        Pc[i] = P; Hc[i] = H; }
}
__device__ __forceinline__ void phase_scan3(const Params& p) {
    const float* Pc = p.carry; const float* Hc = p.carry + 128 * DM;
    for (long i = (long)blockIdx.x * NTHR + TID(); i < 128L * DM; i += (long)gridDim.x * NTHR) {
        const int c = (int)(i % DM), ch = (int)(i / DM); float H = 0.f;
        int k = 0;
#pragma unroll 1
        for (; k + 8 <= ch; k += 8) { float a[8], b[8];
#pragma unroll
            for (int t = 0; t < 8; ++t) { a[t] = Pc[(long)(k + t) * DM + c]; b[t] = Hc[(long)(k + t) * DM + c]; }
#pragma unroll
            for (int t = 0; t < 8; ++t) H = a[t] * H + b[t]; }
        for (; k < ch; ++k) H = Pc[(long)k * DM + c] * H + Hc[(long)k * DM + c];
        const float* pa = p.la + (long)ch * 64 * DM + c; const float* pb = p.lb + (long)ch * 64 * DM + c;
        const u16* pg = p.zB + (long)ch * 64 * ZB + 4096 + c; u16* po = p.OH + (long)ch * 64 * 4096 + 2048 + c;
#pragma unroll 1
        for (int t0 = 0; t0 < 64; t0 += 16) { float a[16], b[16]; u16 g[16];
#pragma unroll
            for (int t = 0; t < 16; ++t) { a[t] = pa[(long)(t0 + t) * DM]; b[t] = pb[(long)(t0 + t) * DM]; g[t] = pg[(long)(t0 + t) * ZB]; }
#pragma unroll
            for (int t = 0; t < 16; ++t) { H = a[t] * H + b[t]; po[(long)(t0 + t) * 4096] = f2bf(H * bf2f(g[t])); } } }
}

typedef float f32x16 __attribute__((ext_vector_type(16)));
typedef short s16x4 __attribute__((ext_vector_type(4)));
constexpr int SHM_V = 64 * 128 * 2, SHM_K = 64 * 192 * 2, ATT_WS = 2 * SHM_V + 2 * SHM_K;
#define KSWZ(row, colB) ((row) * 384 + ((colB) ^ (((row) & 7) << 4)))
__device__ __forceinline__ int v_st(int k, int c) { const int kk = (k & ~0xC) | ((k & 4) << 1) | ((k & 8) >> 1); return ((kk >> 3) * 4 + (c >> 5)) * 512 + ((kk & 7) * 32 + (c & 31)) * 2; }
__device__ __forceinline__ int v_rd_base(int lane) { return ((lane & 3) << 3) | (((lane >> 2) & 3) << 6) | (((lane >> 4) & 1) << 5) | (((lane >> 5) & 1) << 8); }
constexpr int v_rd_off(int d0, int ks, int half) { return d0 * 512 + ks * 4096 + half * 2048; }
__device__ __forceinline__ int crow(int r, int hi) { return (r & 3) + 8 * (r >> 2) + 4 * hi; }
__device__ __forceinline__ unsigned cvtpk(float lo, float hi) { unsigned r; asm volatile("v_cvt_pk_bf16_f32 %0, %1, %2" : "=v"(r) : "v"(lo), "v"(hi)); return r; }

__device__ __forceinline__ void partialSM(f32x16& p0, f32x16& p1, float& m_reg, float& mn, float& alpha) {
    float pmax = p0[0];
#pragma unroll
    for (int r = 1; r < 16; ++r) pmax = fmaxf(pmax, p0[r]);
#pragma unroll
    for (int r = 0; r < 16; ++r) pmax = fmaxf(pmax, p1[r]);
    { auto rr = __builtin_amdgcn_permlane32_swap(__float_as_uint(pmax), __float_as_uint(pmax), false, false);
      pmax = fmaxf(__uint_as_float(rr[0]), __uint_as_float(rr[1])); }
    if (__builtin_expect(__all(pmax - m_reg <= 11.5f), 1)) { mn = m_reg; alpha = 1.f; }
    else { mn = fmaxf(m_reg, pmax); alpha = __builtin_amdgcn_exp2f(m_reg - mn); m_reg = mn; }
#pragma unroll
    for (int r = 0; r < 16; ++r) p0[r] = p0[r] - mn;
#pragma unroll
    for (int r = 0; r < 16; ++r) p1[r] = p1[r] - mn;
#pragma unroll
    for (int r = 0; r < 16; ++r) p0[r] = __builtin_amdgcn_exp2f(p0[r]);
}
__device__ __forceinline__ void finishSM(f32x16& p0, f32x16& p1, float alpha, float& l_reg, bf16x8& pa0, bf16x8& pa1, bf16x8& pa2, bf16x8& pa3) {
#pragma unroll
    for (int r = 0; r < 16; ++r) p1[r] = __builtin_amdgcn_exp2f(p1[r]);
    float ps = 0;
#pragma unroll
    for (int r = 0; r < 16; ++r) ps += p0[r];
#pragma unroll
    for (int r = 0; r < 16; ++r) ps += p1[r];
    { auto rr = __builtin_amdgcn_permlane32_swap(__float_as_uint(ps), __float_as_uint(ps), false, false);
      ps = __uint_as_float(rr[0]) + __uint_as_float(rr[1]); }
    l_reg = l_reg * alpha + ps;
#define PK4(P, B_, OUT) do { unsigned a0 = cvtpk(P[B_+0], P[B_+1]), a1 = cvtpk(P[B_+2], P[B_+3]);                          \
        unsigned b0 = cvtpk(P[B_+4], P[B_+5]), b1 = cvtpk(P[B_+6], P[B_+7]);                                             \
        auto r0 = __builtin_amdgcn_permlane32_swap(a0, b0, false, false); auto r1 = __builtin_amdgcn_permlane32_swap(a1, b1, false, false); \
        u32x4 w = {r0[0], r1[0], r0[1], r1[1]}; OUT = *reinterpret_cast<bf16x8*>(&w); } while (0)
    PK4(p0, 0, pa0); PK4(p0, 8, pa1); PK4(p1, 0, pa2); PK4(p1, 8, pa3);
#undef PK4
}
template <int KB>
__device__ __forceinline__ void qkt(f32x16& p0, f32x16& p1, LAS char* K_lds, int r32, int hi, const bf16x8* qr, bool act) {
    if (!act) { const float NEG = -__builtin_inff();
#pragma unroll
        for (int r = 0; r < 16; ++r) { p0[r] = NEG; p1[r] = NEG; } return; }
#pragma unroll
    for (int r = 0; r < 16; ++r) { p0[r] = 0.f; p1[r] = 0.f; }
    LAS char* kb[4];
#pragma unroll
    for (int dd = 0; dd < 4; ++dd) kb[dd] = K_lds + KB * SHM_K + KSWZ(r32, (dd * 16 + hi * 8) * 2);
#pragma unroll
    for (int d0 = 0; d0 < 12; ++d0) { LAS char* a = kb[d0 & 3] + (d0 >> 2) * 128;
        const bf16x8 b0 = *(const LAS bf16x8*)a;
        const bf16x8 b1 = *(const LAS bf16x8*)(a + 32 * 384);
        p0 = __builtin_amdgcn_mfma_f32_32x32x16_bf16(b0, qr[d0], p0, 0, 0, 0);
        p1 = __builtin_amdgcn_mfma_f32_32x32x16_bf16(b1, qr[d0], p1, 0, 0, 0); }
}
template <int VB>
__device__ __forceinline__ void pv_tile(f32x16* o, int vb0, bf16x8 pa0, bf16x8 pa1, bf16x8 pa2, bf16x8 pa3, bool act) {
    if (!act) return;
#define TRRD(dst, off) asm volatile("ds_read_b64_tr_b16 %0, %1 offset:%2" : "=&v"(dst) : "v"(vb0), "i"(off) : "memory")
#define PV_D0(d0) do { s16x4 l0, l1, l2, l3, h0, h1, h2, h3; constexpr int b_ = VB * SHM_V + v_rd_off(d0, 0, 0); \
        TRRD(l0, b_); TRRD(h0, b_ + 2048); TRRD(l1, b_ + 4096); TRRD(h1, b_ + 6144); TRRD(l2, b_ + 8192); TRRD(h2, b_ + 10240); TRRD(l3, b_ + 12288); TRRD(h3, b_ + 14336); \
        asm volatile("s_waitcnt lgkmcnt(0)" ::: "memory"); __builtin_amdgcn_sched_barrier(0); \
        o[d0] = __builtin_amdgcn_mfma_f32_32x32x16_bf16(pa0, (bf16x8){l0[0], l0[1], l0[2], l0[3], h0[0], h0[1], h0[2], h0[3]}, o[d0], 0, 0, 0);   \
        o[d0] = __builtin_amdgcn_mfma_f32_32x32x16_bf16(pa1, (bf16x8){l1[0], l1[1], l1[2], l1[3], h1[0], h1[1], h1[2], h1[3]}, o[d0], 0, 0, 0);   \
        o[d0] = __builtin_amdgcn_mfma_f32_32x32x16_bf16(pa2, (bf16x8){l2[0], l2[1], l2[2], l2[3], h2[0], h2[1], h2[2], h2[3]}, o[d0], 0, 0, 0);   \
        o[d0] = __builtin_amdgcn_mfma_f32_32x32x16_bf16(pa3, (bf16x8){l3[0], l3[1], l3[2], l3[3], h3[0], h3[1], h3[2], h3[3]}, o[d0], 0, 0, 0); } while (0)
    PV_D0(0); PV_D0(1); PV_D0(2); PV_D0(3);
#undef PV_D0
#undef TRRD
}

__device__ __forceinline__ void attn_block(char* lds, const u16* __restrict__ Qb, const u16* __restrict__ Kh, const u16* __restrict__ Vh,
                                           const u16* __restrict__ sg, u16* __restrict__ Ob, int P0) {
    const int tid = TID(), wid = __builtin_amdgcn_readfirstlane(tid >> 6), lane = tid & 63, r32 = lane & 31, hi = lane >> 5;
    const int NT = (P0 >> 6) + 4;
    const int wchunk = (P0 >> 6) + (wid >> 1);
    LAS char* L = (LAS char*)lds; LAS char* V_lds = L; LAS char* K_lds = L + 2 * SHM_V;
    LAS float* wsf = (LAS float*)(L + ATT_WS) + wid * 64; LAS float* li_l = wsf; LAS float* al_l = wsf + 32;
    float m_reg = -1e30f, l_reg = 0.f; f32x16 o[4];
#pragma unroll
    for (int d = 0; d < 4; ++d)
#pragma unroll
        for (int r = 0; r < 16; ++r) o[d][r] = 0.f;
    const int sr = tid >> 4, sc = (tid & 15) * 8, vst0 = v_st(sr, sc), vst1 = v_st(32 + sr, sc);
    const int kc0 = tid, kc1 = tid + 512, kc2 = tid + 1024;
    const int kws0 = KSWZ(kc0 / 24, (kc0 % 24) * 16), kws1 = KSWZ(kc1 / 24, (kc1 % 24) * 16), kws2 = KSWZ(kc2 / 24, (kc2 % 24) * 16);
    const int vb0 = (int)(unsigned)(uintptr_t)V_lds + v_rd_base(lane);
    bf16x8 qr[12];
#pragma unroll
    for (int d0 = 0; d0 < 12; ++d0) qr[d0] = *(const bf16x8*)(Qb + (long)(wid * 32 + r32) * NQ + d0 * 16 + hi * 8);
    bf16x8 st_k0, st_k1, st_k2, st_v0, st_v1;
#define VMW() asm volatile("s_waitcnt vmcnt(0)" ::: "memory")
#define SBAR() __builtin_amdgcn_sched_barrier(0)
#define SLOAD(t) do { const u16* kp_ = Kh + (long)(t) * 64 * QD + tid * 8; st_k0 = *(const bf16x8*)kp_; st_k1 = *(const bf16x8*)(kp_ + 4096); st_k2 = *(const bf16x8*)(kp_ + 8192); \
                      const u16* vp_ = Vh + ((long)(t) * 64 + sr) * VH + sc; st_v0 = *(const bf16x8*)vp_; st_v1 = *(const bf16x8*)(vp_ + 32 * VH); } while (0)
#define SWRITE(bf) do { *(LAS bf16x8*)(K_lds + (bf) * SHM_K + kws0) = st_k0; *(LAS bf16x8*)(K_lds + (bf) * SHM_K + kws1) = st_k1; *(LAS bf16x8*)(K_lds + (bf) * SHM_K + kws2) = st_k2; \
                        *(LAS bf16x8*)(V_lds + (bf) * SHM_V + vst0) = st_v0; *(LAS bf16x8*)(V_lds + (bf) * SHM_V + vst1) = st_v1; } while (0)
#define RESC(a) do { if (__any((a) < 1.f)) { if (hi == 0) al_l[r32] = (a); asm volatile("s_waitcnt lgkmcnt(0)" ::: "memory");              \
                     _Pragma("unroll") for (int d_ = 0; d_ < 4; ++d_) _Pragma("unroll") for (int r = 0; r < 16; ++r) o[d_][r] *= al_l[crow(r, hi)]; } } while (0)
#define ACT(t) ((t) <= wchunk)
    f32x16 pA0, pA1, pB0, pB1; float mnA, mnB, alA, alB; bf16x8 pa0, pa1, pa2, pa3;
    SLOAD(0); VMW(); SWRITE(0); SBAR();
    SLOAD(1);
    __syncthreads();
    SBAR(); qkt<0>(pA0, pA1, K_lds, r32, hi, qr, ACT(0));
    partialSM(pA0, pA1, m_reg, mnA, alA);
    VMW(); SWRITE(1);
    __syncthreads();
#define HALF_STEP(PX0, PX1, mnX, alX, PY0, PY1, alY, t, KB, VB, SB) do {                                                      \
        SBAR(); qkt<KB>(PX0, PX1, K_lds, r32, hi, qr, ACT(t));                                                                \
        finishSM(PY0, PY1, alY, l_reg, pa0, pa1, pa2, pa3); SBAR();                                                           \
        if ((t) + 1 < NT) { SLOAD((t) + 1); SBAR(); }                                                                          \
        pv_tile<VB>(o, vb0, pa0, pa1, pa2, pa3, ACT((t) - 1)); partialSM(PX0, PX1, m_reg, mnX, alX);                          \
        __syncthreads();                                                                                                      \
        if ((t) + 1 < NT) { VMW(); SWRITE(SB); }                                                                               \
        RESC(alX); __syncthreads(); } while (0)
    for (int t = 1; t + 1 < NT; t += 2) {
        HALF_STEP(pB0, pB1, mnB, alB, pA0, pA1, alA, t, 1, 0, 0);
        HALF_STEP(pA0, pA1, mnA, alA, pB0, pB1, alB, t + 1, 0, 1, 1);
    }
    SBAR(); qkt<1>(pB0, pB1, K_lds, r32, hi, qr, ACT(NT - 1)); SBAR();
    finishSM(pA0, pA1, alA, l_reg, pa0, pa1, pa2, pa3); SBAR();
    pv_tile<0>(o, vb0, pa0, pa1, pa2, pa3, ACT(NT - 2));
    partialSM(pB0, pB1, m_reg, mnB, alB); __syncthreads(); RESC(alB);
    finishSM(pB0, pB1, alB, l_reg, pa0, pa1, pa2, pa3); SBAR(); pv_tile<1>(o, vb0, pa0, pa1, pa2, pa3, ACT(NT - 1));
    SBAR();
    if (hi == 0) li_l[r32] = l_reg; asm volatile("s_waitcnt lgkmcnt(0)" ::: "memory");
    float rli[16];
#pragma unroll
    for (int r = 0; r < 16; ++r) rli[r] = __builtin_amdgcn_rcpf(li_l[crow(r, hi)]);
    const int xl = (lane ^ 1) << 2;
#pragma unroll
    for (int r = 0; r < 16; ++r) { const int orow = wid * 32 + crow(r, hi);
#pragma unroll
        for (int d0 = 0; d0 < 4; ++d0) { const float v = o[d0][r] * rli[r];
            const float vn = __int_as_float(__builtin_amdgcn_ds_bpermute(xl, __float_as_int(v)));
            if ((r32 & 1) == 0) { const unsigned g = *(const unsigned*)(sg + (long)orow * ZB + d0 * 32 + r32);
                *(unsigned*)(Ob + (long)orow * 4096 + d0 * 32 + r32) = cvtpk(v * __uint_as_float(g << 16), vn * __uint_as_float(g & 0xffff0000u)); } } }
    __syncthreads();
#undef VMW
#undef SBAR
#undef SLOAD
#undef SWRITE
#undef RESC
#undef ACT
#undef HALF_STEP
}
__device__ __forceinline__ void phase_attention(const Params& p, char* lds) {
    for (int it = blockIdx.x; it < 256; it += gridDim.x) {
        const int xcd = it & 7, idx = it >> 3, hh = xcd * 2 + (idx >> 4), x = idx & 15;
        for (int half = 0; half < 2; ++half) { const int P0 = (half ? x : 31 - x) * 256;
            attn_block(lds, p.Q + (long)P0 * NQ + hh * QD, p.Kf + (long)hh * S * QD, p.Vf + (long)hh * S * VH, p.zB + (long)P0 * ZB + hh * VH, p.OH + (long)P0 * 4096 + hh * VH, P0); }
    }
}

__global__ __launch_bounds__(NTHR, 2) void mega(Params p) {
    extern __shared__ __attribute__((aligned(16))) char lds[];
    cg::grid_group grid = cg::this_grid();
    const int G = gridDim.x, c = blockIdx.x;
    volatile LAS unsigned* xbst = (volatile LAS unsigned*)((LAS char*)lds + 8 * HTB);
    if (threadIdx.x == 0) { xbst[0] = 0u; xbst[1] = 0u; xbst[2] = 0u; xbst[3] = 0u; }
    __syncthreads();
    const XcdBarrier xb = xcd_barrier_post(p.bar, xbst);
    phase_prologue(p, lds);
    grid.sync();
    for (int l = 0; l < DEPTH; ++l) {
        const float* xcur = l ? p.xr : p.x_in;
        phase_rmsnorm_bf16(xcur, p.attn_norm + l * DM, p.hb);
        xcd_barrier(xb);
        { TileSched sc{p.hb, DM, p.Wt_in + (size_t)l * NIN * DM, DM, 32, NIN / 256, G, c}; EpiIn e{p.zB, p.zA}; gemm_fast(lds, DM, DM, DM, sc, e); }
        xcd_barrier(xb);
        phase_t2(p, l);
        xcd_barrier(xb);
        { TileSched sc{p.qn, QL, p.Wt_q + (size_t)l * NQ * QL, QL, 32, NQ / 256, G, c}; EpiQ e{p.Q, p.cs}; gemm_fast(lds, QL, QL, QL, sc, e); }
        { TileSched sc{p.kvn, KVL, p.Wt_kv + (size_t)l * NKV * KVL, KVL, 32, NKV / 256, G, (c + 128) % G}; EpiKV e{p.Kf, p.Vf}; gemm_fast(lds, KVL, KVL, KVL, sc, e); }
        { LruSched sc{{p.xc, DM, p.Wt_lru + (size_t)l * LRUB * 65536, 256, 32, LRUB, G, c}}; EpiLru e{p.xc, p.b_rg + l * DM, p.b_ig + l * DM, p.nsp8 + l * DM, p.la, p.lb}; gemm_fast(lds, 256, DM, 256, sc, e); }
        xcd_barrier(xb);
        phase_scan1(p);
        phase_attention(p, lds);
        xcd_barrier(xb);
        phase_scan3(p);
        xcd_barrier(xb);
        { MergeSched sc{{p.OH, 4096, p.Wt_o + (size_t)l * DM * 4096, 4096, 32, 8, G, c}}; EpiMerge e{p.zB, p.mg}; gemm_fast(lds, DM, 4096, 4096, sc, e); }
        xcd_barrier(xb);
        { TileSched sc{p.mg, DM, p.Wt_out + (size_t)l * DM * DM, DM, 32, 8, G, c}; EpiOut e{xcur, p.xr}; gemm_fast(lds, DM, DM, DM, sc, e); }
        { TileSched sc{p.pb + (size_t)l * S * PLE, PLE, p.Wt_ple + (size_t)l * DM * PLE, PLE, 32, 8, G, c}; EpiF32 e{p.pp, DM}; gemm_fast(lds, PLE, PLE, PLE, sc, e); }
        xcd_barrier(xb);
        phase_rmsnorm_bf16(p.xr, p.ple_norm + l * DM, p.hb);
        xcd_barrier(xb);
        { TileSched sc{p.hb, DM, p.Wt_pg + (size_t)l * DM * DM, DM, 32, 8, G, c}; EpiPle e{p.xr, p.pp}; gemm_fast(lds, DM, DM, DM, sc, e); }
        xcd_barrier(xb);
    }
    phase_final_norm(p.xr, p.final_norm);
}

constexpr size_t LDS_BYTES = 8 * HTB + 16;

extern "C" void kernel_launch(void* const* d_in, const int* in_sizes, int n_in, void* d_out, int out_size, void* d_ws, size_t ws_size, hipStream_t st) {
    Params p{};
    p.x_in = (const float*)d_in[0]; p.p_in = (const float*)d_in[1]; p.pos = (const int*)d_in[2];
    p.attn_norm = (const float*)d_in[3]; p.w_in = (const float*)d_in[4]; p.q_a_norm = (const float*)d_in[5]; p.w_q_b = (const float*)d_in[6];
    p.kv_a_norm = (const float*)d_in[7]; p.w_kv_b = (const float*)d_in[8]; p.conv_w = (const float*)d_in[9]; p.conv_b = (const float*)d_in[10];
    p.w_rg = (const float*)d_in[11]; p.b_rg = (const float*)d_in[12]; p.w_ig = (const float*)d_in[13]; p.b_ig = (const float*)d_in[14]; p.lam = (const float*)d_in[15];
    p.w_o_mla = (const float*)d_in[16]; p.w_o_lru = (const float*)d_in[17]; p.w_out = (const float*)d_in[18]; p.ple_norm = (const float*)d_in[19];
    p.w_ple_gate = (const float*)d_in[20]; p.w_ple = (const float*)d_in[21]; p.final_norm = (const float*)d_in[22];
    p.xr = (float*)d_out;
    char* w = (char*)d_ws; size_t off = 0;
    auto take = [&](size_t bytes) { char* r = w + off; off += (bytes + 255) & ~(size_t)255; return r; };
    p.Wt_in = (u16*)take((size_t)DEPTH * NIN * DM * 2); p.Wt_q = (u16*)take((size_t)DEPTH * NQ * QL * 2); p.Wt_kv = (u16*)take((size_t)DEPTH * NKV * KVL * 2);
    p.Wt_lru = (u16*)take((size_t)DEPTH * LRUB * 65536 * 2); p.Wt_o = (u16*)take((size_t)DEPTH * DM * 4096 * 2); p.Wt_out = (u16*)take((size_t)DEPTH * DM * DM * 2);
    p.Wt_pg = (u16*)take((size_t)DEPTH * DM * DM * 2); p.Wt_ple = (u16*)take((size_t)DEPTH * DM * PLE * 2);
    p.hb = (u16*)take((size_t)S * DM * 2); p.zB = (u16*)take((size_t)S * ZB * 2); p.zA = (float*)take((size_t)S * ZA * 4);
    p.qn = (u16*)take((size_t)S * QL * 2); p.kvn = (u16*)take((size_t)S * KVL * 2); p.Q = (u16*)take((size_t)S * NQ * 2);
    p.Kf = (u16*)take((size_t)NH * S * QD * 2); p.Vf = (u16*)take((size_t)NH * S * VH * 2); p.xc = (u16*)take((size_t)S * DM * 2);
    p.OH = (u16*)take((size_t)S * 4096 * 2); p.pb = (u16*)take((size_t)DEPTH * S * PLE * 2); p.cs = (float*)take((size_t)S * 64 * 4); p.carry = (float*)take((size_t)3 * 128 * DM * 4); p.nsp8 = (float*)take((size_t)DEPTH * DM * 4); p.bar = (unsigned*)take((size_t)XCD_BAR_WORDS * 4);
    p.la = (float*)take((size_t)S * DM * 4); p.lb = (float*)take((size_t)S * DM * 4); p.pp = (float*)take((size_t)S * DM * 4); p.mg = (u16*)take((size_t)S * DM * 2);
    if (off > ws_size) { fprintf(stderr, "workspace too small: need %zu have %zu\n", off, ws_size); return; }
    (void)hipMemsetAsync(p.bar, 0, (size_t)XCD_BAR_WORDS * 4, st);
    (void)hipFuncSetAttribute((const void*)mega, hipFuncAttributeMaxDynamicSharedMemorySize, (int)LDS_BYTES);
    int dev = 0, cus = 0; (void)hipGetDevice(&dev); (void)hipDeviceGetAttribute(&cus, hipDeviceAttributeMultiprocessorCount, dev);
    int per_cu = 0; (void)hipOccupancyMaxActiveBlocksPerMultiprocessor(&per_cu, mega, NTHR, LDS_BYTES);
    if (per_cu < 1 || cus < 1) { fprintf(stderr, "occupancy query failed\n"); return; }
    void* args[] = {&p};
    hipError_t e = hipLaunchCooperativeKernel((const void*)mega, dim3(cus), dim3(NTHR), args, LDS_BYTES, st);
    if (e != hipSuccess) fprintf(stderr, "cooperative launch failed: %s\n", hipGetErrorString(e));
}
```

```cpp
#include <hip/hip_runtime.h>
#include <hip/hip_cooperative_groups.h>
#include <cstdio>
#include <cstdint>
namespace cg = cooperative_groups;

constexpr int S = 8192, DM = 2048, DEPTH = 4, NH = 16, QL = 512, KVL = 512, NOPE = 128, ROPE = 64, VH = 128;
constexpr int INT = 11328, PLE = 256, LRUB = 16, LBD = 128;
constexpr int QD = 192, NQ = NH * QD  , NKV = NH * 256  ;
constexpr int NIN = 11520;
constexpr int ZB = 10240, ZA = 1280;
constexpr int NTHR = 512;
constexpr float QSCALE = 0.07216878364870322f * 1.4426950408889634f;

typedef unsigned short u16;
typedef short bf16x8 __attribute__((ext_vector_type(8)));
typedef float f32x4 __attribute__((ext_vector_type(4)));
typedef float f32x2 __attribute__((ext_vector_type(2)));
typedef unsigned u32x2 __attribute__((ext_vector_type(2)));
typedef unsigned u32x4 __attribute__((ext_vector_type(4)));

__device__ __forceinline__ u16 f2bf(float f) { unsigned u = __float_as_uint(f); u += 0x7FFFu + ((u >> 16) & 1u); return (u16)(u >> 16); }
__device__ __forceinline__ float bf2f(u16 b) { return __uint_as_float(((unsigned)b) << 16); }
__device__ __forceinline__ unsigned pk2(float lo, float hi) { unsigned r; asm volatile("v_cvt_pk_bf16_f32 %0, %1, %2" : "=v"(r) : "v"(lo), "v"(hi)); return r; }
__device__ __forceinline__ float sigmoidf_(float x) { return __builtin_amdgcn_rcpf(1.f + __builtin_amdgcn_exp2f(-1.4426950408889634f * x)); }
__device__ __forceinline__ float siluf_(float x) { return x * __builtin_amdgcn_rcpf(1.f + __builtin_amdgcn_exp2f(-1.4426950408889634f * x)); }
__device__ __forceinline__ int opaque_zero() { int z; asm volatile("s_mov_b32 %0, 0" : "=s"(z)); return z; }
#define TID() ((int)threadIdx.x + opaque_zero())
__device__ __forceinline__ float wsum(float s, int lane) { for (int off = 32; off; off >>= 1) s += __int_as_float(__builtin_amdgcn_ds_bpermute((lane ^ off) << 2, __float_as_int(s))); return s; }
__device__ __forceinline__ float wmax(float s, int lane) { for (int off = 32; off; off >>= 1) s = fmaxf(s, __int_as_float(__builtin_amdgcn_ds_bpermute((lane ^ off) << 2, __float_as_int(s)))); return s; }

struct Params {
    const float *x_in, *p_in; const int* pos;
    const float *attn_norm, *w_in, *q_a_norm, *w_q_b, *kv_a_norm, *w_kv_b, *conv_w, *conv_b, *w_rg, *b_rg, *w_ig, *b_ig, *lam, *w_o_mla, *w_o_lru, *w_out, *ple_norm, *w_ple_gate, *w_ple, *final_norm;
    float* xr;
    u16 *Wt_in, *Wt_q, *Wt_kv, *Wt_lru, *Wt_o, *Wt_out, *Wt_pg, *Wt_ple;
    u16 *hb, *hb2, *zB, *qn, *kvn, *Q, *Kf, *Vf, *xc, *OH, *mg, *pb, *Pm;
    float *zA, *la, *lb, *pp, *cs, *carry, *sc, *nsp8, *ssqA, *ssqB; unsigned* bar;
};

struct Unit { const u16* a; const u16* b; int pm, pn, aux; };

struct TileSched {
    const u16* A; long lda; const u16* B; long ldb; int nM, nN, G, c;
    __device__ __forceinline__ bool tile(int i, int& pm, int& pn) const {
        const int nwg = nM * nN; const long L = (long)i * G + c; if (L >= nwg) return false;
        int wgid = (int)L; { const int q = nwg / 8, r = nwg % 8, xcd = wgid % 8, off = wgid / 8; wgid = (xcd < r ? xcd * (q + 1) : r * (q + 1) + (xcd - r) * q) + off; }
        const int nig = 8 * nN, gid = wgid / nig, fm = gid * 8, gsz = (nM - fm) < 8 ? (nM - fm) : 8;
        pm = fm + ((wgid % nig) % gsz); pn = (wgid % nig) / gsz; return true;
    }
    __device__ __forceinline__ bool next(int i, Unit& u) const {
        if (!tile(i, u.pm, u.pn)) return false;
        u.a = A + (long)u.pm * 256 * lda; u.b = B + (long)u.pn * 256 * ldb; u.aux = 0; return true;
    }
};
struct LruSched : TileSched {
    __device__ __forceinline__ bool next(int i, Unit& u) const {
        if (!tile(i, u.pm, u.pn)) return false;
        u.a = A + (long)u.pm * 256 * lda + (u.pn >> 1) * 256; u.b = B + (long)u.pn * 65536; u.aux = 0; return true;
    }
};
struct MergeSched : TileSched {
    __device__ __forceinline__ bool next(int i, Unit& u) const {
        if (!tile(i >> 1, u.pm, u.pn)) return false;
        u.aux = i & 1; u.a = A + (long)u.pm * 256 * lda + u.aux * 2048; u.b = B + (long)u.pn * 256 * ldb + u.aux * 2048; return true;
    }
};
struct TriSched {
    const u16* A; long lda; const u16* B; long ldb; int G, c;
    __device__ __forceinline__ bool next(int i, Unit& u) const {
        int t = i * G + c; if (t >= 528) return false;
        int pm = 0; while (t >= pm + 1) { t -= pm + 1; ++pm; }
        u.pm = pm; u.pn = t; u.a = A + (long)pm * 256 * lda; u.b = B + (long)t * 256 * ldb; u.aux = 0; return true;
    }
};
struct RowSched {
    const u16* A; long lda; const u16* B; int G, c;
    __device__ __forceinline__ bool next(int i, Unit& u) const {
        const int t = i * G + c; if (t >= 32) return false;
        u.pm = 31 - t; u.pn = 0; u.a = A + (long)u.pm * 256 * lda; u.b = B; u.aux = 0; return true;
    }
};

template <class F>
__device__ __forceinline__ void epi_foreach(f32x4 (&acc)[2][2][4][2], const Unit& u, int wr, int wc, int fr, int fq, F f) {
    const int row0 = u.pm * 256 + wr * 64 + fr, col0 = u.pn * 256 + wc * 32 + 4 * fq;
#pragma unroll
    for (int ai = 0; ai < 2; ++ai)
#pragma unroll
        for (int m = 0; m < 4; ++m) {
#pragma unroll
            for (int bj = 0; bj < 2; ++bj)
#pragma unroll
                for (int n = 0; n < 2; ++n) f(row0 + ai * 128 + m * 16, col0 + bj * 128 + n * 16, acc[ai][bj][m][n]);
        }
}
template <int GM, class T, class LF, class F>
__device__ __forceinline__ void epi_foreach_ld(f32x4 (&acc)[2][2][4][2], const Unit& u, int wr, int wc, int fr, int fq, LF lf, F f) {
    const int row0 = u.pm * 256 + wr * 64 + fr, col0 = u.pn * 256 + wc * 32 + 4 * fq;
#pragma unroll
    for (int ai = 0; ai < 2; ++ai)
#pragma unroll
        for (int mg = 0; mg < 4; mg += GM) {
            T regs[GM][2][2];
#pragma unroll
            for (int m = 0; m < GM; ++m)
#pragma unroll
                for (int bj = 0; bj < 2; ++bj)
#pragma unroll
                    for (int n = 0; n < 2; ++n) regs[m][bj][n] = lf(row0 + ai * 128 + (mg + m) * 16, col0 + bj * 128 + n * 16);
#pragma unroll
            for (int m = 0; m < GM; ++m)
#pragma unroll
                for (int bj = 0; bj < 2; ++bj)
#pragma unroll
                    for (int n = 0; n < 2; ++n) f(row0 + ai * 128 + (mg + m) * 16, col0 + bj * 128 + n * 16, acc[ai][bj][mg + m][n], regs[m][bj][n]);
        }
}
#define EPI_COMMON  __device__ __forceinline__ bool keep(const Unit&) const { return false; } __device__ __forceinline__ int klimit(const Unit&, int K) const { return K; }
#define EPI_SIG     __device__ __forceinline__ void operator()(f32x4 (&acc)[2][2][4][2], const Unit& u, int wr, int wc, int fr, int fq) const

__device__ __forceinline__ float rinv_of(float ss) { return rsqrtf(ss * (1.f / DM) + 1e-6f); }
struct EpiIn { EPI_COMMON u16* zB; float* zA; const float* ssq;
    EPI_SIG { const int seg = u.pn >> 3;
        const int row0 = u.pm * 256 + wr * 64 + fr, col0 = u.pn * 256 + wc * 32 + 4 * fq;
        float ri[2][4];
#pragma unroll
        for (int ai = 0; ai < 2; ++ai)
#pragma unroll
            for (int m = 0; m < 4; ++m) ri[ai][m] = ssq[row0 + ai * 128 + m * 16];
#pragma unroll
        for (int ai = 0; ai < 2; ++ai)
#pragma unroll
            for (int m = 0; m < 4; ++m) ri[ai][m] = rinv_of(ri[ai][m]);
        if (seg >= 5) {
#pragma unroll
            for (int ai = 0; ai < 2; ++ai)
#pragma unroll
                for (int m = 0; m < 4; ++m)
#pragma unroll
                    for (int bj = 0; bj < 2; ++bj)
#pragma unroll
                        for (int n = 0; n < 2; ++n) { const int row = row0 + ai * 128 + m * 16, col = col0 + bj * 128 + n * 16;
                            if (col < ZB + 1088) *(f32x4*)(zA + (long)row * ZA + (col - ZB)) = acc[ai][bj][m][n] * ri[ai][m]; }
        } else { const bool sil = seg == 0 || seg == 2, ident = seg == 1;
#pragma unroll
            for (int ai = 0; ai < 2; ++ai)
#pragma unroll
                for (int m = 0; m < 4; ++m)
#pragma unroll
                    for (int bj = 0; bj < 2; ++bj)
#pragma unroll
                        for (int n = 0; n < 2; ++n) { const int row = row0 + ai * 128 + m * 16, col = col0 + bj * 128 + n * 16;
                            const f32x4 z = acc[ai][bj][m][n] * ri[ai][m]; f32x4 o = z;
                            if (!ident) {
#pragma unroll
                                for (int e = 0; e < 4; ++e) { const float sg = sigmoidf_(z[e]); o[e] = sil ? z[e] * sg : sg; } }
                            *(u32x2*)(zB + (long)row * ZB + col) = (u32x2){pk2(o[0], o[1]), pk2(o[2], o[3])}; }
        }
    } };
struct EpiQ { EPI_COMMON u16* Q; const float* cs;
    EPI_SIG { epi_foreach_ld<4, f32x4>(acc, u, wr, wc, fr, fq,
            [&](int row, int col) { const int d = col % QD; f32x4 t = {1.f, 0.f, 1.f, 0.f};
                if (d >= NOPE) { const int i0 = (d - NOPE) >> 1; const float* tp = cs + (long)row * 64 + i0; const f32x2 cc = *(const f32x2*)tp, ss = *(const f32x2*)(tp + 32); t = (f32x4){cc[0], ss[0], cc[1], ss[1]}; }
                return t; },
            [&](int row, int col, f32x4& v, const f32x4& t) { f32x4 o;
                const int d = col % QD;
                if (d < NOPE) o = v * QSCALE;
                else { o[0] = (v[0] * t[0] - v[1] * t[1]) * QSCALE; o[1] = (v[1] * t[0] + v[0] * t[1]) * QSCALE;
                       o[2] = (v[2] * t[2] - v[3] * t[3]) * QSCALE; o[3] = (v[3] * t[2] + v[2] * t[3]) * QSCALE; }
                *(u32x2*)(Q + (long)row * NQ + col) = (u32x2){pk2(o[0], o[1]), pk2(o[2], o[3])}; }); } };
struct EpiKV { EPI_COMMON u16* Kf; u16* Vf;
    EPI_SIG { epi_foreach(acc, u, wr, wc, fr, fq, [&](int row, int col, f32x4& v) {
            const int hh = col >> 8, j = col & 255;
            u16* dst = (j < 128) ? Kf + ((long)hh * S + row) * QD + j : Vf + ((long)hh * S + row) * VH + (j - 128);
            *(u32x2*)dst = (u32x2){pk2(v[0], v[1]), pk2(v[2], v[3])};
        }); } };
struct EpiLru { EPI_COMMON const u16* xc; const float *brg, *big, *nsp8; float *la, *lb;
    EPI_SIG {
        const int row0 = u.pm * 256 + wr * 64 + fr, col0 = u.pn * 256 + wc * 32 + 4 * fq;
        f32x2 cr[2][2], ci[2][2], cn[2][2];
#pragma unroll
        for (int bj = 0; bj < 2; ++bj)
#pragma unroll
            for (int n = 0; n < 2; ++n) { const int ch = (col0 + bj * 128 + n * 16) >> 1; cr[bj][n] = *(const f32x2*)(brg + ch); ci[bj][n] = *(const f32x2*)(big + ch); cn[bj][n] = *(const f32x2*)(nsp8 + ch); }
#pragma unroll
        for (int ai = 0; ai < 2; ++ai) {
            unsigned xw[4][2][2];
#pragma unroll
            for (int m = 0; m < 4; ++m)
#pragma unroll
                for (int bj = 0; bj < 2; ++bj)
#pragma unroll
                    for (int n = 0; n < 2; ++n) xw[m][bj][n] = *(const unsigned*)(xc + (long)(row0 + ai * 128 + m * 16) * DM + ((col0 + bj * 128 + n * 16) >> 1));
#pragma unroll
            for (int m = 0; m < 4; ++m)
#pragma unroll
                for (int bj = 0; bj < 2; ++bj)
#pragma unroll
                    for (int n = 0; n < 2; ++n) {
                        const f32x4 v = acc[ai][bj][m][n]; const long o = (long)(row0 + ai * 128 + m * 16) * DM + ((col0 + bj * 128 + n * 16) >> 1);
                        f32x2 av, bv;
#pragma unroll
                        for (int e = 0; e < 2; ++e) {
                            const float r = sigmoidf_(v[2 * e] + cr[bj][n][e]), ii = sigmoidf_(v[2 * e + 1] + ci[bj][n][e]);
                            const float lg = r * cn[bj][n][e], x2 = 2.f * lg;
                            const float a = __builtin_amdgcn_exp2f(1.4426950408889634f * lg);
                            const float em = (x2 > -0.25f) ? x2 * (1.f + x2 * (0.5f + x2 * (0.16666667f + x2 * (0.041666668f + x2 * 0.0083333338f)))) : (a * a - 1.f);
                            const float x = e ? __uint_as_float(xw[m][bj][n] & 0xffff0000u) : __uint_as_float(xw[m][bj][n] << 16);
                            av[e] = a; bv[e] = __builtin_amdgcn_sqrtf(-em) * (ii * x); }
                        *(f32x2*)(la + o) = av; *(f32x2*)(lb + o) = bv; }
        }
    } };
struct SmSl { u32x2 sm, sl; };
struct EpiMerge { const u16* zB; u16* mg;
    __device__ __forceinline__ bool keep(const Unit& u) const { return u.aux == 0; }
    __device__ __forceinline__ int klimit(const Unit&, int K) const { return K; }
    EPI_SIG { const int part = u.aux;
        epi_foreach_ld<4, SmSl>(acc, u, wr, wc, fr, fq,
            [&](int row, int col) { SmSl t; t.sl = *(const u32x2*)(zB + (long)row * ZB + 8192 + col); t.sm = t.sl; if (part == 0) t.sm = *(const u32x2*)(zB + (long)row * ZB + 6144 + col); return t; },
            [&](int row, int col, f32x4& v, const SmSl& t) {
            f32x4 fl = {__uint_as_float(t.sl[0] << 16), __uint_as_float(t.sl[0] & 0xffff0000u), __uint_as_float(t.sl[1] << 16), __uint_as_float(t.sl[1] & 0xffff0000u)};
#pragma unroll
            for (int e = 0; e < 4; ++e) fl[e] = fmaxf(fl[e], 1e-12f);
            if (part == 0) {
                const f32x4 fm = {__uint_as_float(t.sm[0] << 16), __uint_as_float(t.sm[0] & 0xffff0000u), __uint_as_float(t.sm[1] << 16), __uint_as_float(t.sm[1] & 0xffff0000u)};
#pragma unroll
                for (int e = 0; e < 4; ++e) v[e] = v[e] * fm[e] * __builtin_amdgcn_rcpf(fl[e]);
            } else { f32x4 o = v * fl; *(u32x2*)(mg + (long)row * DM + col) = (u32x2){pk2(o[0], o[1]), pk2(o[2], o[3])}; }
        }); } };
__device__ __forceinline__ void row_ssq_add(float sq, float* ssq, int row, int lane) {
    sq += __int_as_float(__builtin_amdgcn_ds_bpermute((lane ^ 16) << 2, __float_as_int(sq)));
    sq += __int_as_float(__builtin_amdgcn_ds_bpermute((lane ^ 32) << 2, __float_as_int(sq)));
    if (lane < 16) atomicAdd(ssq + row, sq);
}
struct EpiOut { EPI_COMMON const float* xold; float* xnew; u16* xb; float* ssq;
    EPI_SIG {
        const int row0 = u.pm * 256 + wr * 64 + fr, col0 = u.pn * 256 + wc * 32 + 4 * fq, lane = fq * 16 + fr;
#pragma unroll
        for (int ai = 0; ai < 2; ++ai) {
            f32x4 xo[4][2][2];
#pragma unroll
            for (int m = 0; m < 4; ++m)
#pragma unroll
                for (int bj = 0; bj < 2; ++bj)
#pragma unroll
                    for (int n = 0; n < 2; ++n) xo[m][bj][n] = *(const f32x4*)(xold + (long)(row0 + ai * 128 + m * 16) * DM + col0 + bj * 128 + n * 16);
#pragma unroll
            for (int m = 0; m < 4; ++m) { const int row = row0 + ai * 128 + m * 16; float sq = 0.f;
#pragma unroll
                for (int bj = 0; bj < 2; ++bj)
#pragma unroll
                    for (int n = 0; n < 2; ++n) { const f32x4 xv = xo[m][bj][n] + acc[ai][bj][m][n]; const long idx = (long)row * DM + col0 + bj * 128 + n * 16;
                        *(f32x4*)(xnew + idx) = xv; *(u32x2*)(xb + idx) = (u32x2){pk2(xv[0], xv[1]), pk2(xv[2], xv[3])};
                        sq += xv[0] * xv[0] + xv[1] * xv[1] + xv[2] * xv[2] + xv[3] * xv[3]; }
                row_ssq_add(sq, ssq, row, lane); }
        }
    } };
struct EpiF32 { EPI_COMMON float* C; long ldc;
    EPI_SIG { epi_foreach(acc, u, wr, wc, fr, fq, [&](int row, int col, f32x4& v) { *(f32x4*)(C + (long)row * ldc + col) = v; }); } };
struct EpiPle { EPI_COMMON float* x; const float* pp; const float* ssq_in; u16* xb; float* ssq_out;
    EPI_SIG {
        const int row0 = u.pm * 256 + wr * 64 + fr, col0 = u.pn * 256 + wc * 32 + 4 * fq, lane = fq * 16 + fr;
#pragma unroll
        for (int ai = 0; ai < 2; ++ai)
#pragma unroll
            for (int mg = 0; mg < 4; mg += 2) {
                f32x4 xo[2][2][2], po[2][2][2]; float ss[2];
#pragma unroll
                for (int m = 0; m < 2; ++m) { const int row = row0 + ai * 128 + (mg + m) * 16; ss[m] = ssq_in[row];
#pragma unroll
                    for (int bj = 0; bj < 2; ++bj)
#pragma unroll
                        for (int n = 0; n < 2; ++n) { const long idx = (long)row * DM + col0 + bj * 128 + n * 16; xo[m][bj][n] = *(const f32x4*)(x + idx); po[m][bj][n] = *(const f32x4*)(pp + idx); } }
#pragma unroll
                for (int m = 0; m < 2; ++m) { const int row = row0 + ai * 128 + (mg + m) * 16; const float ri = rinv_of(ss[m]); float sq = 0.f;
#pragma unroll
                    for (int bj = 0; bj < 2; ++bj)
#pragma unroll
                        for (int n = 0; n < 2; ++n) { f32x4 xv = xo[m][bj][n]; const f32x4 v = acc[ai][bj][mg + m][n]; const long idx = (long)row * DM + col0 + bj * 128 + n * 16;
#pragma unroll
                            for (int e = 0; e < 4; ++e) xv[e] += po[m][bj][n][e] * sigmoidf_(v[e] * ri);
                            *(f32x4*)(x + idx) = xv; *(u32x2*)(xb + idx) = (u32x2){pk2(xv[0], xv[1]), pk2(xv[2], xv[3])};
                            sq += xv[0] * xv[0] + xv[1] * xv[1] + xv[2] * xv[2] + xv[3] * xv[3]; }
                    row_ssq_add(sq, ssq_out, row, lane); }
            }
    } };

#define LAS __attribute__((address_space(3)))
constexpr int HTB = 128 * 64 * 2;
__device__ __forceinline__ int lds_byte(int r, int c) { const int st = (r >> 4) * 2 + (c >> 5), rr = r & 15, cc = c & 31, ob = rr * 64 + cc * 2; return st * 1024 + (ob ^ (((ob >> 9) & 1) << 5)); }
__device__ __forceinline__ void stage_rc(int b, int& R, int& C) { const int st = b / 1024, sb = b % 1024, swz = sb ^ (((sb >> 9) & 1) << 5); R = (st >> 1) * 16 + swz / 64; C = (st & 1) * 32 + (swz % 64) / 2; }

template <class Epi, class Sched>
__device__ __forceinline__ void gemm_fast(char* lds_, int K, long lda, long ldb, const Sched& S_, const Epi& E) {
    LAS unsigned char* lds = (LAS unsigned char*)lds_;
    const int tid = TID(), wid = __builtin_amdgcn_readfirstlane(tid >> 6), lane = tid & 63, wr = wid >> 2, wc = wid & 3, fr = lane & 15, fq = lane >> 4;
    const int nt = K / 64;
    unsigned voffA[2], voffB[2];
#pragma unroll
    for (int i = 0; i < 2; ++i) { int R, C; stage_rc(tid * 16 + i * 8192, R, C); voffA[i] = (unsigned)(R * lda + C) * 2u; voffB[i] = (unsigned)(R * ldb + C) * 2u; }
    const size_t kstep = 128;
    const size_t hstepA = (size_t)128 * lda * 2, hstepB = (size_t)128 * ldb * 2;
    const unsigned ldsw = (unsigned)wid * 1024u;
    const int aoff = lds_byte(wr * 64 + fr, fq * 8), boff = lds_byte(wc * 32 + fr, fq * 8);
#define G_SA(b, h) (((b) * 2 + (h)) * HTB)
#define G_SB(b, h) ((4 + (b) * 2 + (h)) * HTB)
#define G_STAGE(bufoff, gbase, voff) do { _Pragma("unroll") for (int _i = 0; _i < 2; ++_i) \
        __builtin_amdgcn_global_load_lds((const unsigned*)((const char*)(gbase) + (voff)[_i]), (LAS unsigned*)(lds + (bufoff) + ldsw + _i * 8192), 16, 0, 0); } while (0)
#define G_LDA(dst, b, h) do { _Pragma("unroll") for (int m = 0; m < 4; ++m) _Pragma("unroll") for (int k = 0; k < 2; ++k) dst[m][k] = *(const LAS bf16x8*)(lds + G_SA(b, h) + aoff + m * 2048 + k * 1024); } while (0)
#define G_LDB(dst, b, h) do { _Pragma("unroll") for (int n = 0; n < 2; ++n) _Pragma("unroll") for (int k = 0; k < 2; ++k) dst[n][k] = *(const LAS bf16x8*)(lds + G_SB(b, h) + boff + n * 2048 + k * 1024); } while (0)
#define G_MMA(ai, bj, At, Bt) do { __builtin_amdgcn_s_setprio(1); _Pragma("unroll") for (int m = 0; m < 4; ++m) _Pragma("unroll") for (int n = 0; n < 2; ++n) _Pragma("unroll") for (int k = 0; k < 2; ++k) \
        acc[ai][bj][m][n] = __builtin_amdgcn_mfma_f32_16x16x32_bf16(Bt[n][k], At[m][k], acc[ai][bj][m][n], 0, 0, 0); __builtin_amdgcn_s_setprio(0); } while (0)
#define G_WAIT_V(n) asm volatile("s_waitcnt vmcnt(" #n ")" ::: "memory")
#define G_WAIT_L(n) asm volatile("s_waitcnt lgkmcnt(" #n ")" ::: "memory")
#define G_BAR __builtin_amdgcn_s_barrier()
#define G_SCHED __builtin_amdgcn_sched_barrier(0)
    Unit cur, nxt; int ui = 0;
    if (!S_.next(0, cur)) return;
    f32x4 acc[2][2][4][2];
#pragma unroll
    for (int a = 0; a < 2; ++a)
#pragma unroll
        for (int b = 0; b < 2; ++b)
#pragma unroll
            for (int m = 0; m < 4; ++m)
#pragma unroll
                for (int n = 0; n < 2; ++n) acc[a][b][m][n] = (f32x4){0.f, 0.f, 0.f, 0.f};
    bf16x8 At[4][2], B0[2][2], B1[2][2];
    const char* cA = (const char*)cur.a; const char* cB = (const char*)cur.b;
    G_STAGE(G_SB(0, 0), cB, voffB); G_STAGE(G_SA(0, 0), cA, voffA); G_STAGE(G_SB(0, 1), cB + hstepB, voffB); G_STAGE(G_SA(0, 1), cA + hstepA, voffA);
    if (wr == 1) G_BAR;
    G_WAIT_V(4); G_BAR;
    G_STAGE(G_SB(1, 0), cB + kstep, voffB); G_STAGE(G_SA(1, 0), cA + kstep, voffA); G_STAGE(G_SB(1, 1), cB + hstepB + kstep, voffB);
    G_WAIT_V(6); G_BAR;
    for (;;) {
        const bool has_next = S_.next(ui + 1, nxt);
        const char* nA = has_next ? (const char*)nxt.a : cA; const char* nB = has_next ? (const char*)nxt.b : cB;
#pragma unroll 1
        for (int t = 0; t < nt; t += 2) {
            const bool last = (t == nt - 2);
            const char* a1 = cA + (size_t)(t + 1) * kstep;
            const char* a2 = last ? nA : cA + (size_t)(t + 2) * kstep; const char* b2 = last ? nB : cB + (size_t)(t + 2) * kstep;
            const char* a3 = a2 + kstep; const char* b3 = b2 + kstep;
            G_LDB(B0, 0, 0); G_SCHED; G_LDA(At, 0, 0); G_STAGE(G_SA(1, 1), a1 + hstepA, voffA);
            G_WAIT_L(8); G_BAR; G_WAIT_L(0); G_MMA(0, 0, At, B0); G_BAR; G_SCHED;
            G_LDB(B1, 0, 1); G_STAGE(G_SB(0, 0), b2, voffB);
            G_BAR; G_WAIT_L(0); G_MMA(0, 1, At, B1); G_BAR;
            G_LDA(At, 0, 1); G_STAGE(G_SA(0, 0), a2, voffA);
            G_BAR; G_WAIT_L(0); G_MMA(1, 0, At, B0); G_BAR; G_SCHED;
            G_STAGE(G_SB(0, 1), b2 + hstepB, voffB);
            G_WAIT_V(6); G_BAR; G_MMA(1, 1, At, B1); G_BAR;
            G_LDB(B0, 1, 0); G_SCHED; G_LDA(At, 1, 0); G_STAGE(G_SA(0, 1), a2 + hstepA, voffA);
            G_WAIT_L(8); G_BAR; G_WAIT_L(0); G_MMA(0, 0, At, B0); G_BAR; G_SCHED;
            G_LDB(B1, 1, 1); G_STAGE(G_SB(1, 0), b3, voffB);
            G_BAR; G_WAIT_L(0); G_MMA(0, 1, At, B1); G_BAR;
            G_LDA(At, 1, 1); G_STAGE(G_SA(1, 0), a3, voffA);
            G_BAR; G_WAIT_L(0); G_MMA(1, 0, At, B0); G_BAR; G_SCHED;
            G_STAGE(G_SB(1, 1), b3 + hstepB, voffB);
            G_WAIT_V(6); G_BAR; G_MMA(1, 1, At, B1); G_BAR;
        }
        { const int t2 = TID(), w2 = t2 >> 6, l2 = t2 & 63;
          E(acc, cur, w2 >> 2, w2 & 3, l2 & 15, l2 >> 4); }
        if (!has_next) break;
        if (!E.keep(cur)) {
#pragma unroll
            for (int a = 0; a < 2; ++a)
#pragma unroll
                for (int b = 0; b < 2; ++b)
#pragma unroll
                    for (int m = 0; m < 4; ++m)
#pragma unroll
                        for (int n = 0; n < 2; ++n) acc[a][b][m][n] = (f32x4){0.f, 0.f, 0.f, 0.f};
        }
        cur = nxt; cA = nA; cB = nB; ++ui;
    }
    G_WAIT_V(0);
    if (wr == 0) G_BAR;
    G_BAR;
#undef G_SA
#undef G_SB
#undef G_STAGE
#undef G_LDA
#undef G_LDB
#undef G_MMA
#undef G_WAIT_V
#undef G_WAIT_L
#undef G_BAR
#undef G_SCHED
}


#define XB_TMO      128
#define XB_XCNT(j)  (256  + 64 * (j))
#define XB_XSUB(j)  (1280 + 64 * (j))
#define XB_XGEN(j)  (2304 + 64 * (j))
#define XB_TOP      3328
#define XB_TOPGEN   3392
#define XCD_BAR_WORDS 3456
#define XB_SPIN_CAP (1u << 18)
__device__ __forceinline__ unsigned xb_ld(unsigned* p)              { return __hip_atomic_load(p, __ATOMIC_RELAXED, __HIP_MEMORY_SCOPE_AGENT); }
__device__ __forceinline__ unsigned xb_add(unsigned* p, unsigned v) { return __hip_atomic_fetch_add(p, v, __ATOMIC_RELAXED, __HIP_MEMORY_SCOPE_AGENT); }
__device__ __forceinline__ unsigned xb_xcc_id() { return (unsigned)__builtin_amdgcn_s_getreg((3 << 11) | 20) & 0xFu; }
#define XB_SPIN(cond, bar) do { unsigned _sp = 0; while (cond) { __builtin_amdgcn_s_sleep(1); \
    if ((++_sp & 255u) == 0u) { if (xb_ld(&(bar)[XB_TMO])) break; if (_sp > XB_SPIN_CAP) { atomicAdd(&(bar)[XB_TMO], 1u); break; } } } } while (0)
struct XcdBarrier { unsigned* bar; unsigned x; volatile LAS unsigned* st; };
__device__ __forceinline__ XcdBarrier xcd_barrier_post(unsigned* bar, volatile LAS unsigned* st) {
    XcdBarrier b; b.bar = bar; b.x = xb_xcc_id(); b.st = st;
    if (TID() == 0) (void)xb_add(&bar[XB_XCNT(b.x)], 1u);
    return b;
}
__device__ __forceinline__ void xcd_barrier_complete(unsigned* bar, unsigned x, unsigned& nloc, unsigned& nx) {
    const unsigned G = gridDim.x * gridDim.y * gridDim.z;
    unsigned sum, cnt, mine, sp = 0u;
    for (;;) {
        sum = 0u; cnt = 0u; mine = 0u;
#pragma unroll
        for (unsigned j = 0; j < 16; ++j) { const unsigned c = xb_ld(&bar[XB_XCNT(j)]); sum += c; cnt += (c > 0u) ? 1u : 0u; mine = (j == x) ? c : mine; }
        if (sum == G) break;
        __builtin_amdgcn_s_sleep(1);
        if ((++sp & 255u) == 0u) { if (xb_ld(&bar[XB_TMO])) break; if (sp > XB_SPIN_CAP) { atomicAdd(&bar[XB_TMO], 1u); break; } }
    }
    nloc = mine > 0u ? mine : 1u; nx = cnt > 0u ? cnt : 1u;
}
__device__ __forceinline__ void xcd_barrier(const XcdBarrier& b) {
    asm volatile("s_waitcnt vmcnt(0)" ::: "memory");
    __syncthreads();
    if (TID() == 0) {
        unsigned* bar = b.bar;
        __builtin_amdgcn_s_waitcnt(0);
        unsigned nloc = b.st[0], nx = b.st[1];
        if (nloc == 0u) { xcd_barrier_complete(bar, b.x, nloc, nx); b.st[0] = nloc; b.st[1] = nx; }
        const unsigned old = xb_add(&bar[XB_XSUB(b.x)], 1u);
        const unsigned gen = old / nloc;
        if (old + 1u == (gen + 1u) * nloc) {
            __builtin_amdgcn_fence(__ATOMIC_RELEASE, "agent");
            asm volatile("s_waitcnt vmcnt(0)" ::: "memory");
            const unsigned og = xb_add(&bar[XB_TOP], 1u);
            const unsigned tg = og / nx;
            if (og + 1u == (tg + 1u) * nx) xb_add(&bar[XB_TOPGEN], 1u);
            else XB_SPIN(xb_ld(&bar[XB_TOPGEN]) == tg, bar);
            __builtin_amdgcn_fence(__ATOMIC_ACQUIRE, "agent");
            xb_add(&bar[XB_XGEN(b.x)], 1u);
            asm volatile("s_waitcnt vmcnt(0)" ::: "memory");
        } else {
            XB_SPIN(xb_ld(&bar[XB_XGEN(b.x)]) == gen, bar);
            __builtin_amdgcn_fence(__ATOMIC_ACQUIRE, "agent");
            asm volatile("s_waitcnt vmcnt(0)" ::: "memory");
        }
    }
    __syncthreads();
}

struct TDesc { const float* src; const float* ks; u16* dst; long ldd; int N, coff, rm, tix; };
constexpr int TS_IN = (DM / 256) * (INT / 64), TS_Q = (QL / 256) * (NQ / 64), TS_KV = (KVL / 256) * (NKV / 64), TS_SQ = (DM / 256) * (DM / 64), TS_PLE = (PLE / 256) * (DM / 64);
constexpr int TS_LAYER = TS_IN + TS_Q + TS_KV + 4 * TS_SQ + TS_PLE, TS_TOTAL = DEPTH * TS_LAYER;
__device__ __forceinline__ TDesc tdesc(const Params& p, int g) {
    const int l = g / TS_LAYER; int r = g % TS_LAYER; TDesc d; d.ks = nullptr; d.coff = 0; d.rm = 0;
    if (r < TS_IN) { d.src = p.w_in + (size_t)l * DM * INT; d.N = INT; d.dst = p.Wt_in + (size_t)l * NIN * DM; d.ldd = DM; d.rm = 1; d.ks = p.attn_norm + l * DM; d.tix = r; return d; }
    r -= TS_IN;
    if (r < TS_Q) { d.src = p.w_q_b + (size_t)l * QL * NQ; d.N = NQ; d.dst = p.Wt_q + (size_t)l * NQ * QL; d.ldd = QL; d.rm = 2; d.tix = r; return d; }
    r -= TS_Q;
    if (r < TS_KV) { d.src = p.w_kv_b + (size_t)l * KVL * NKV; d.N = NKV; d.dst = p.Wt_kv + (size_t)l * NKV * KVL; d.ldd = KVL; d.tix = r; return d; }
    r -= TS_KV;
    if (r < TS_SQ) { d.src = p.w_o_mla + (size_t)l * DM * DM; d.N = DM; d.dst = p.Wt_o + (size_t)l * DM * 4096; d.ldd = 4096; d.tix = r; return d; }
    r -= TS_SQ;
    if (r < TS_SQ) { d.src = p.w_o_lru + (size_t)l * DM * DM; d.N = DM; d.dst = p.Wt_o + (size_t)l * DM * 4096; d.ldd = 4096; d.coff = 2048; d.tix = r; return d; }
    r -= TS_SQ;
    if (r < TS_SQ) { d.src = p.w_out + (size_t)l * DM * DM; d.N = DM; d.dst = p.Wt_out + (size_t)l * DM * DM; d.ldd = DM; d.tix = r; return d; }
    r -= TS_SQ;
    if (r < TS_SQ) { d.src = p.w_ple_gate + (size_t)l * DM * DM; d.N = DM; d.dst = p.Wt_pg + (size_t)l * DM * DM; d.ldd = DM; d.ks = p.ple_norm + l * DM; d.tix = r; return d; }
    r -= TS_SQ;
    d.src = p.w_ple + (size_t)l * PLE * DM; d.N = DM; d.dst = p.Wt_ple + (size_t)l * DM * PLE; d.ldd = PLE; d.tix = r; return d;
}
__device__ __forceinline__ int trowmap(int rm, int n) {
    if (rm == 1) return n >= 1088 ? n - 1088 : n + ZB;
    if (rm == 2) { const int hh = n / QD, d = n % QD; if (d < NOPE) return n; const int e = d - NOPE; return hh * QD + NOPE + ((e & 31) << 1) + (e >> 5); }
    return n;
}
__device__ __forceinline__ void transpose_all(const Params& p, char* lds) {
    u16 (*t)[72] = (u16(*)[72])lds;
    const int tid = TID(), k = tid >> 3, nn = (tid & 7) * 8, G = gridDim.x;
    f32x4 vA[4][2], vB[4][2];
#define TC_LOAD(v_, d_) do { const int tn_ = (d_).N / 64, k0_ = ((d_).tix / tn_) * 256, n0_ = ((d_).tix % tn_) * 64; _Pragma("unroll") for (int j = 0; j < 4; ++j) { \
        const float* p_ = (d_).src + (long)(k0_ + k + 64 * j) * (d_).N + n0_ + nn; v_[j][0] = *(const f32x4*)p_; v_[j][1] = *(const f32x4*)(p_ + 4); \
        if ((d_).ks) { const float g_ = (d_).ks[k0_ + k + 64 * j]; v_[j][0] = v_[j][0] * g_; v_[j][1] = v_[j][1] * g_; } } } while (0)
#define TC_LDSW(v_) do { _Pragma("unroll") for (int j = 0; j < 4; ++j) *(u32x4*)&t[k + 64 * j][nn ^ (((k >> 3) & 7) << 3)] = (u32x4){pk2(v_[j][0][0], v_[j][0][1]), pk2(v_[j][0][2], v_[j][0][3]), pk2(v_[j][1][0], v_[j][1][1]), pk2(v_[j][1][2], v_[j][1][3])}; } while (0)
#define TC_STORE(d_) do { const int tn_ = (d_).N / 64, k0_ = ((d_).tix / tn_) * 256, n0_ = ((d_).tix % tn_) * 64; const int n_ = tid >> 3, kk_ = (tid & 7) * 8; \
        u16* drow_ = (d_).dst + (long)trowmap((d_).rm, n0_ + n_) * (d_).ldd + (d_).coff + k0_ + kk_; \
        _Pragma("unroll") for (int j = 0; j < 4; ++j) { u32x4 o_; _Pragma("unroll") for (int e = 0; e < 4; ++e) o_[e] = (unsigned)t[64 * j + kk_ + 2 * e][n_ ^ kk_] | ((unsigned)t[64 * j + kk_ + 2 * e + 1][n_ ^ kk_] << 16); \
            *(u32x4*)(drow_ + 64 * j) = o_; } } while (0)
    int gA = blockIdx.x, gB = gA + G; TDesc dA, dB, dc;
    if (gA < TS_TOTAL) { dA = tdesc(p, gA); TC_LOAD(vA, dA); }
    if (gB < TS_TOTAL) { dB = tdesc(p, gB); TC_LOAD(vB, dB); }
    while (gA < TS_TOTAL) {
        TC_LDSW(vA); __syncthreads(); dc = dA; gA += 2 * G; if (gA < TS_TOTAL) { dA = tdesc(p, gA); TC_LOAD(vA, dA); } TC_STORE(dc); __syncthreads();
        if (gB >= TS_TOTAL) break;
        TC_LDSW(vB); __syncthreads(); dc = dB; gB += 2 * G; if (gB < TS_TOTAL) { dB = tdesc(p, gB); TC_LOAD(vB, dB); } TC_STORE(dc); __syncthreads();
    }
#undef TC_LOAD
#undef TC_LDSW
#undef TC_STORE
}

__device__ __forceinline__ void phase_prologue(const Params& p, char* lds) {
    const long gtid = (long)blockIdx.x * NTHR + TID(), gsz = (long)gridDim.x * NTHR;
    transpose_all(p, lds);
    for (long i = gtid; i < (long)DEPTH * (NIN - INT) * DM / 8; i += gsz) { const long per = (long)(NIN - INT) * DM / 8; const int l = (int)(i / per); const long r = i % per;
        *(u32x4*)(p.Wt_in + ((size_t)l * NIN + INT) * DM + r * 8) = (u32x4){0u, 0u, 0u, 0u}; }
    for (long i = gtid; i < (long)DEPTH * LRUB * 256 * 256; i += gsz) {
        const int k = (int)(i & 255), o = (int)((i >> 8) & 255), blk = (int)((i >> 16) & 15), l = (int)(i >> 20);
        const int kk = k - 128 * (blk & 1), cl = o >> 1; float v = 0.f;
        if (kk >= 0 && kk < 128) v = ((o & 1) ? p.w_ig : p.w_rg)[(((size_t)l * LRUB + blk) * LBD + kk) * LBD + cl];
        p.Wt_lru[i] = f2bf(v); }
    for (long i = gtid; i < (long)DEPTH * S * PLE / 8; i += gsz) { const float* s = p.p_in + i * 8; const f32x4 v0 = *(const f32x4*)s, v1 = *(const f32x4*)(s + 4);
        *(u32x4*)(p.pb + i * 8) = (u32x4){pk2(v0[0], v0[1]), pk2(v0[2], v0[3]), pk2(v1[0], v1[1]), pk2(v1[2], v1[3])}; }
    for (long i = gtid; i < (long)DEPTH * DM; i += gsz) p.nsp8[i] = -8.f * log1pf(expf(-p.lam[i]));
    for (long i = gtid; i < (long)S * 32; i += gsz) { const int s = (int)(i >> 5), f = (int)(i & 31);
        const float inv = powf(10000.f, -(float)(2 * f) / 64.f), ang = (float)p.pos[s] * inv;
        p.cs[(long)s * 64 + f] = (float)cos((double)ang); p.cs[(long)s * 64 + 32 + f] = (float)sin((double)ang); }
}

__device__ __forceinline__ void phase_xb_ssq(const float* __restrict__ x, u16* __restrict__ out, float* __restrict__ ssq) {
    const int tid = TID(), lane = tid & 63, gw = blockIdx.x * (NTHR / 64) + (tid >> 6), nw = gridDim.x * (NTHR / 64);
    for (int row = gw; row < S; row += nw) {
        const float* p = x + (long)row * DM; f32x4 v[8]; float s = 0.f;
#pragma unroll
        for (int j = 0; j < 8; ++j) { v[j] = *(const f32x4*)(p + j * 256 + lane * 4); s += v[j][0] * v[j][0] + v[j][1] * v[j][1] + v[j][2] * v[j][2] + v[j][3] * v[j][3]; }
        s = wsum(s, lane);
#pragma unroll
        for (int j = 0; j < 8; ++j) *(u32x2*)(out + (long)row * DM + j * 256 + lane * 4) = (u32x2){pk2(v[j][0], v[j][1]), pk2(v[j][2], v[j][3])};
        if (lane == 0) ssq[row] = s;
    }
}
__device__ __forceinline__ void phase_final_norm(float* __restrict__ x, const float* __restrict__ g) {
    const int tid = TID(), lane = tid & 63, gw = blockIdx.x * (NTHR / 64) + (tid >> 6), nw = gridDim.x * (NTHR / 64);
    for (int row = gw; row < S; row += nw) {
        float* p = x + (long)row * DM; f32x4 v[8]; float s = 0.f;
#pragma unroll
        for (int j = 0; j < 8; ++j) { v[j] = *(const f32x4*)(p + j * 256 + lane * 4); s += v[j][0] * v[j][0] + v[j][1] * v[j][1] + v[j][2] * v[j][2] + v[j][3] * v[j][3]; }
        s = wsum(s, lane); const float rinv = rsqrtf(s * (1.f / DM) + 1e-6f);
#pragma unroll
        for (int j = 0; j < 8; ++j) { const f32x4 gg = *(const f32x4*)(g + j * 256 + lane * 4); *(f32x4*)(p + j * 256 + lane * 4) = v[j] * rinv * gg; }
    }
}
__device__ __forceinline__ void t2_rows(const float* __restrict__ zA, const u16* __restrict__ zB, const float* __restrict__ cs, const float* __restrict__ cw, const float* __restrict__ cb,
                                        const float* __restrict__ gq, const float* __restrict__ gkv, u16* __restrict__ qn, u16* __restrict__ kvn, u16* __restrict__ Kf, u16* __restrict__ xc, float* __restrict__ ssqB) {
    const int tid = TID(), lane = tid & 63, gw = blockIdx.x * (NTHR / 64) + (tid >> 6), nw = gridDim.x * (NTHR / 64);
    for (int row = gw; row < S; row += nw) {
        const float* zr = zA + (long)row * ZA;
        f32x4 v[2][2];
#pragma unroll
        for (int part = 0; part < 2; ++part) { v[part][0] = *(const f32x4*)(zr + part * 512 + lane * 4); v[part][1] = *(const f32x4*)(zr + part * 512 + 256 + lane * 4); }
        const int l32 = lane & 31;
        const float x1 = zr[1024 + l32], x2 = zr[1056 + l32], cc = cs[(long)row * 64 + l32], sn = cs[(long)row * 64 + 32 + l32];
        u32x2 uu[8][4];
#pragma unroll
        for (int j = 0; j < 8; ++j)
#pragma unroll
            for (int k = 0; k < 4; ++k) { const int sp = row - 3 + k; uu[j][k] = (u32x2){0u, 0u}; if (sp >= 0) uu[j][k] = *(const u32x2*)(zB + (long)sp * ZB + 2048 + j * 256 + lane * 4); }
        if (lane == 0) ssqB[row] = 0.f;
#pragma unroll
        for (int part = 0; part < 2; ++part) {
            const float* g = part ? gkv : gq; u16* dst = (part ? kvn : qn) + (long)row * 512;
            const f32x4 v0 = v[part][0], v1 = v[part][1];
            float s = v0[0] * v0[0] + v0[1] * v0[1] + v0[2] * v0[2] + v0[3] * v0[3] + v1[0] * v1[0] + v1[1] * v1[1] + v1[2] * v1[2] + v1[3] * v1[3];
            s = wsum(s, lane); const float rinv = rsqrtf(s * (1.f / 512.f) + 1e-6f);
            const f32x4 g0 = *(const f32x4*)(g + lane * 4), g1 = *(const f32x4*)(g + 256 + lane * 4);
            *(u32x2*)(dst + lane * 4) = (u32x2){pk2(v0[0] * rinv * g0[0], v0[1] * rinv * g0[1]), pk2(v0[2] * rinv * g0[2], v0[3] * rinv * g0[3])};
            *(u32x2*)(dst + 256 + lane * 4) = (u32x2){pk2(v1[0] * rinv * g1[0], v1[1] * rinv * g1[1]), pk2(v1[2] * rinv * g1[2], v1[3] * rinv * g1[3])};
        }
        if (lane < 32) { const unsigned w = pk2(x1 * cc - x2 * sn, x2 * cc + x1 * sn);
#pragma unroll
            for (int hh = 0; hh < NH; ++hh) *(unsigned*)(Kf + ((long)hh * S + row) * QD + NOPE + 2 * lane) = w; }
#pragma unroll
        for (int j = 0; j < 8; ++j) { const int c = j * 256 + lane * 4; f32x4 y = *(const f32x4*)(cb + c);
#pragma unroll
            for (int k = 0; k < 4; ++k) { const f32x4 w = *(const f32x4*)(cw + k * DM + c); const u32x2 u2 = uu[j][k];
                y[0] += __uint_as_float(u2[0] << 16) * w[0]; y[1] += __uint_as_float(u2[0] & 0xffff0000u) * w[1]; y[2] += __uint_as_float(u2[1] << 16) * w[2]; y[3] += __uint_as_float(u2[1] & 0xffff0000u) * w[3]; }
            *(u32x2*)(xc + (long)row * DM + c) = (u32x2){pk2(y[0], y[1]), pk2(y[2], y[3])}; }
    }
}
__device__ __forceinline__ void phase_t2(const Params& p, int l) {
    t2_rows(p.zA, p.zB, p.cs, p.conv_w + (size_t)l * 4 * DM, p.conv_b + (size_t)l * DM, p.q_a_norm + l * 512, p.kv_a_norm + l * 512, p.qn, p.kvn, p.Kf, p.xc, p.ssqB);
}
__device__ __forceinline__ void phase_scan1(const Params& p) {
    float* Pc = p.carry; float* Hc = p.carry + 128 * DM;
    for (long i = (long)blockIdx.x * NTHR + TID(); i < 128L * DM; i += (long)gridDim.x * NTHR) {
        const int c = (int)(i % DM), ch = (int)(i / DM); float P = 1.f, H = 0.f;
        const float* pa = p.la + (long)ch * 64 * DM + c; const float* pb = p.lb + (long)ch * 64 * DM + c;
#pragma unroll 1
        for (int t0 = 0; t0 < 64; t0 += 16) { float a[16], b[16];
#pragma unroll
            for (int t = 0; t < 16; ++t) { a[t] = pa[(long)(t0 + t) * DM]; b[t] = pb[(long)(t0 + t) * DM]; }
#pragma unroll
            for (int t = 0; t < 16; ++t) { H = a[t] * H + b[t]; P *= a[t]; } }
        Pc[i] = P; Hc[i] = H; }
}
__device__ __forceinline__ void scan3_rows(const float* __restrict__ Pc, const float* __restrict__ Hc, const float* __restrict__ la, const float* __restrict__ lb, const u16* __restrict__ zB,
                                           u16* __restrict__ OH, float* __restrict__ ssqA) {
    for (long i = (long)blockIdx.x * NTHR + TID(); i < 128L * DM; i += (long)gridDim.x * NTHR) {
        if (i < S) ssqA[i] = 0.f;
        const int c = (int)(i % DM), ch = (int)(i / DM); float H = 0.f;
        int k = 0;
#pragma unroll 1
        for (; k + 16 <= ch; k += 16) { float a[16], b[16];
#pragma unroll
            for (int t = 0; t < 16; ++t) { a[t] = Pc[(long)(k + t) * DM + c]; b[t] = Hc[(long)(k + t) * DM + c]; }
#pragma unroll
            for (int t = 0; t < 16; ++t) H = a[t] * H + b[t]; }
        for (; k < ch; ++k) H = Pc[(long)k * DM + c] * H + Hc[(long)k * DM + c];
        const float* pa = la + (long)ch * 64 * DM + c; const float* pb = lb + (long)ch * 64 * DM + c;
        const u16* pg = zB + (long)ch * 64 * ZB + 4096 + c; u16* po = OH + (long)ch * 64 * 4096 + 2048 + c;
#pragma unroll
        for (int t0 = 0; t0 < 64; t0 += 16) { float a[16], b[16]; u16 g[16];
#pragma unroll
            for (int t = 0; t < 16; ++t) { a[t] = pa[(long)(t0 + t) * DM]; b[t] = pb[(long)(t0 + t) * DM]; g[t] = pg[(long)(t0 + t) * ZB]; }
#pragma unroll
            for (int t = 0; t < 16; ++t) { H = a[t] * H + b[t]; po[(long)(t0 + t) * 4096] = f2bf(H * bf2f(g[t])); } } }
}
__device__ __forceinline__ void phase_scan3(const Params& p) { scan3_rows(p.carry, p.carry + 128 * DM, p.la, p.lb, p.zB, p.OH, p.ssqA); }

typedef float f32x16 __attribute__((ext_vector_type(16)));
typedef short s16x4 __attribute__((ext_vector_type(4)));
constexpr int SHM_V = 64 * 128 * 2, SHM_K = 64 * 192 * 2, ATT_WS = 2 * SHM_V + 2 * SHM_K;
#define KSWZ(row, colB) ((row) * 384 + ((colB) ^ (((row) & 7) << 4)))
__device__ __forceinline__ int v_st(int k, int c) { const int kk = (k & ~0xC) | ((k & 4) << 1) | ((k & 8) >> 1); return ((kk >> 3) * 4 + (c >> 5)) * 512 + ((kk & 7) * 32 + (c & 31)) * 2; }
__device__ __forceinline__ int v_rd_base(int lane) { return ((lane & 3) << 3) | (((lane >> 2) & 3) << 6) | (((lane >> 4) & 1) << 5) | (((lane >> 5) & 1) << 8); }
constexpr int v_rd_off(int d0, int ks, int half) { return d0 * 512 + ks * 4096 + half * 2048; }
__device__ __forceinline__ int crow(int r, int hi) { return (r & 3) + 8 * (r >> 2) + 4 * hi; }
__device__ __forceinline__ unsigned cvtpk(float lo, float hi) { unsigned r; asm volatile("v_cvt_pk_bf16_f32 %0, %1, %2" : "=v"(r) : "v"(lo), "v"(hi)); return r; }

__device__ __forceinline__ void partialSM(f32x16& p0, f32x16& p1, float& m_reg, float& mn, float& alpha) {
    float pmax = p0[0];
#pragma unroll
    for (int r = 1; r < 16; ++r) pmax = fmaxf(pmax, p0[r]);
#pragma unroll
    for (int r = 0; r < 16; ++r) pmax = fmaxf(pmax, p1[r]);
    { auto rr = __builtin_amdgcn_permlane32_swap(__float_as_uint(pmax), __float_as_uint(pmax), false, false);
      pmax = fmaxf(__uint_as_float(rr[0]), __uint_as_float(rr[1])); }
    if (__builtin_expect(__all(pmax - m_reg <= 11.5f), 1)) { mn = m_reg; alpha = 1.f; }
    else { mn = fmaxf(m_reg, pmax); alpha = __builtin_amdgcn_exp2f(m_reg - mn); m_reg = mn; }
#pragma unroll
    for (int r = 0; r < 16; ++r) p0[r] = p0[r] - mn;
#pragma unroll
    for (int r = 0; r < 16; ++r) p1[r] = p1[r] - mn;
#pragma unroll
    for (int r = 0; r < 16; ++r) p0[r] = __builtin_amdgcn_exp2f(p0[r]);
}
__device__ __forceinline__ void finishSM(f32x16& p0, f32x16& p1, float alpha, float& l_reg, bf16x8& pa0, bf16x8& pa1, bf16x8& pa2, bf16x8& pa3) {
#pragma unroll
    for (int r = 0; r < 16; ++r) p1[r] = __builtin_amdgcn_exp2f(p1[r]);
    float ps = 0;
#pragma unroll
    for (int r = 0; r < 16; ++r) ps += p0[r];
#pragma unroll
    for (int r = 0; r < 16; ++r) ps += p1[r];
    { auto rr = __builtin_amdgcn_permlane32_swap(__float_as_uint(ps), __float_as_uint(ps), false, false);
      ps = __uint_as_float(rr[0]) + __uint_as_float(rr[1]); }
    l_reg = l_reg * alpha + ps;
#define PK4(P, B_, OUT) do { unsigned a0 = cvtpk(P[B_+0], P[B_+1]), a1 = cvtpk(P[B_+2], P[B_+3]);                          \
        unsigned b0 = cvtpk(P[B_+4], P[B_+5]), b1 = cvtpk(P[B_+6], P[B_+7]);                                             \
        auto r0 = __builtin_amdgcn_permlane32_swap(a0, b0, false, false); auto r1 = __builtin_amdgcn_permlane32_swap(a1, b1, false, false); \
        u32x4 w = {r0[0], r1[0], r0[1], r1[1]}; OUT = *reinterpret_cast<bf16x8*>(&w); } while (0)
    PK4(p0, 0, pa0); PK4(p0, 8, pa1); PK4(p1, 0, pa2); PK4(p1, 8, pa3);
#undef PK4
}
template <int KB>
__device__ __forceinline__ void qkt(f32x16& p0, f32x16& p1, LAS char* K_lds, int r32, int hi, const bf16x8* qr, bool act) {
    if (!act) { const float NEG = -__builtin_inff();
#pragma unroll
        for (int r = 0; r < 16; ++r) { p0[r] = NEG; p1[r] = NEG; } return; }
#pragma unroll
    for (int r = 0; r < 16; ++r) { p0[r] = 0.f; p1[r] = 0.f; }
    LAS char* kb[4];
#pragma unroll
    for (int dd = 0; dd < 4; ++dd) kb[dd] = K_lds + KB * SHM_K + KSWZ(r32, (dd * 16 + hi * 8) * 2);
#pragma unroll
    for (int d0 = 0; d0 < 12; ++d0) { LAS char* a = kb[d0 & 3] + (d0 >> 2) * 128;
        const bf16x8 b0 = *(const LAS bf16x8*)a;
        const bf16x8 b1 = *(const LAS bf16x8*)(a + 32 * 384);
        p0 = __builtin_amdgcn_mfma_f32_32x32x16_bf16(b0, qr[d0], p0, 0, 0, 0);
        p1 = __builtin_amdgcn_mfma_f32_32x32x16_bf16(b1, qr[d0], p1, 0, 0, 0); }
}
template <int VB>
__device__ __forceinline__ void pv_tile(f32x16* o, int vb0, bf16x8 pa0, bf16x8 pa1, bf16x8 pa2, bf16x8 pa3, bool act) {
    if (!act) return;
#define TRRD(dst, off) asm volatile("ds_read_b64_tr_b16 %0, %1 offset:%2" : "=&v"(dst) : "v"(vb0), "i"(off) : "memory")
#define PV_D0(d0) do { s16x4 l0, l1, l2, l3, h0, h1, h2, h3; constexpr int b_ = VB * SHM_V + v_rd_off(d0, 0, 0); \
        TRRD(l0, b_); TRRD(h0, b_ + 2048); TRRD(l1, b_ + 4096); TRRD(h1, b_ + 6144); TRRD(l2, b_ + 8192); TRRD(h2, b_ + 10240); TRRD(l3, b_ + 12288); TRRD(h3, b_ + 14336); \
        asm volatile("s_waitcnt lgkmcnt(0)" ::: "memory"); __builtin_amdgcn_sched_barrier(0); \
        o[d0] = __builtin_amdgcn_mfma_f32_32x32x16_bf16(pa0, (bf16x8){l0[0], l0[1], l0[2], l0[3], h0[0], h0[1], h0[2], h0[3]}, o[d0], 0, 0, 0);   \
        o[d0] = __builtin_amdgcn_mfma_f32_32x32x16_bf16(pa1, (bf16x8){l1[0], l1[1], l1[2], l1[3], h1[0], h1[1], h1[2], h1[3]}, o[d0], 0, 0, 0);   \
        o[d0] = __builtin_amdgcn_mfma_f32_32x32x16_bf16(pa2, (bf16x8){l2[0], l2[1], l2[2], l2[3], h2[0], h2[1], h2[2], h2[3]}, o[d0], 0, 0, 0);   \
        o[d0] = __builtin_amdgcn_mfma_f32_32x32x16_bf16(pa3, (bf16x8){l3[0], l3[1], l3[2], l3[3], h3[0], h3[1], h3[2], h3[3]}, o[d0], 0, 0, 0); } while (0)
    PV_D0(0); PV_D0(1); PV_D0(2); PV_D0(3);
#undef PV_D0
#undef TRRD
}

__device__ __forceinline__ void attn_block(char* lds, const u16* __restrict__ Qb, const u16* __restrict__ Kh, const u16* __restrict__ Vh,
                                           const u16* __restrict__ sg, u16* __restrict__ Ob, int P0) {
    const int tid = TID(), wid = __builtin_amdgcn_readfirstlane(tid >> 6), lane = tid & 63, r32 = lane & 31, hi = lane >> 5;
    const int NT = (P0 >> 6) + 4;
    const int wchunk = (P0 >> 6) + (wid >> 1);
    LAS char* L = (LAS char*)lds; LAS char* V_lds = L; LAS char* K_lds = L + 2 * SHM_V;
    LAS float* wsf = (LAS float*)(L + ATT_WS) + wid * 64; LAS float* li_l = wsf; LAS float* al_l = wsf + 32;
    float m_reg = -1e30f, l_reg = 0.f; f32x16 o[4];
#pragma unroll
    for (int d = 0; d < 4; ++d)
#pragma unroll
        for (int r = 0; r < 16; ++r) o[d][r] = 0.f;
    const int sr = tid >> 4, sc = (tid & 15) * 8, vst0 = v_st(sr, sc), vst1 = v_st(32 + sr, sc);
    const int kc0 = tid, kc1 = tid + 512, kc2 = tid + 1024;
    const int kws0 = KSWZ(kc0 / 24, (kc0 % 24) * 16), kws1 = KSWZ(kc1 / 24, (kc1 % 24) * 16), kws2 = KSWZ(kc2 / 24, (kc2 % 24) * 16);
    const int vb0 = (int)(unsigned)(uintptr_t)V_lds + v_rd_base(lane);
    bf16x8 qr[12];
#pragma unroll
    for (int d0 = 0; d0 < 12; ++d0) qr[d0] = *(const bf16x8*)(Qb + (long)(wid * 32 + r32) * NQ + d0 * 16 + hi * 8);
    bf16x8 st_k0, st_k1, st_k2, st_v0, st_v1;
#define VMW() asm volatile("s_waitcnt vmcnt(0)" ::: "memory")
#define SBAR() __builtin_amdgcn_sched_barrier(0)
#define SLOAD(t) do { const u16* kp_ = Kh + (long)(t) * 64 * QD + tid * 8; st_k0 = *(const bf16x8*)kp_; st_k1 = *(const bf16x8*)(kp_ + 4096); st_k2 = *(const bf16x8*)(kp_ + 8192); \
                      const u16* vp_ = Vh + ((long)(t) * 64 + sr) * VH + sc; st_v0 = *(const bf16x8*)vp_; st_v1 = *(const bf16x8*)(vp_ + 32 * VH); } while (0)
#define SWRITE(bf) do { *(LAS bf16x8*)(K_lds + (bf) * SHM_K + kws0) = st_k0; *(LAS bf16x8*)(K_lds + (bf) * SHM_K + kws1) = st_k1; *(LAS bf16x8*)(K_lds + (bf) * SHM_K + kws2) = st_k2; \
                        *(LAS bf16x8*)(V_lds + (bf) * SHM_V + vst0) = st_v0; *(LAS bf16x8*)(V_lds + (bf) * SHM_V + vst1) = st_v1; } while (0)
#define RESC(a) do { if (__any((a) < 1.f)) { if (hi == 0) al_l[r32] = (a); asm volatile("s_waitcnt lgkmcnt(0)" ::: "memory");              \
                     _Pragma("unroll") for (int d_ = 0; d_ < 4; ++d_) _Pragma("unroll") for (int r = 0; r < 16; ++r) o[d_][r] *= al_l[crow(r, hi)]; } } while (0)
#define ACT(t) ((t) <= wchunk)
    f32x16 pA0, pA1, pB0, pB1; float mnA, mnB, alA, alB; bf16x8 pa0, pa1, pa2, pa3;
    SLOAD(0); VMW(); SWRITE(0); SBAR();
    SLOAD(1);
    __syncthreads();
    SBAR(); qkt<0>(pA0, pA1, K_lds, r32, hi, qr, ACT(0));
    partialSM(pA0, pA1, m_reg, mnA, alA);
    VMW(); SWRITE(1);
    __syncthreads();
#define HALF_STEP(PX0, PX1, mnX, alX, PY0, PY1, alY, t, KB, VB, SB) do {                                                      \
        SBAR(); qkt<KB>(PX0, PX1, K_lds, r32, hi, qr, ACT(t));                                                                \
        finishSM(PY0, PY1, alY, l_reg, pa0, pa1, pa2, pa3); SBAR();                                                           \
        if ((t) + 1 < NT) { SLOAD((t) + 1); SBAR(); }                                                                          \
        pv_tile<VB>(o, vb0, pa0, pa1, pa2, pa3, ACT((t) - 1)); partialSM(PX0, PX1, m_reg, mnX, alX);                          \
        __syncthreads();                                                                                                      \
        if ((t) + 1 < NT) { VMW(); SWRITE(SB); }                                                                               \
        RESC(alX); __syncthreads(); } while (0)
    for (int t = 1; t + 1 < NT; t += 2) {
        HALF_STEP(pB0, pB1, mnB, alB, pA0, pA1, alA, t, 1, 0, 0);
        HALF_STEP(pA0, pA1, mnA, alA, pB0, pB1, alB, t + 1, 0, 1, 1);
    }
    SBAR(); qkt<1>(pB0, pB1, K_lds, r32, hi, qr, ACT(NT - 1)); SBAR();
    finishSM(pA0, pA1, alA, l_reg, pa0, pa1, pa2, pa3); SBAR();
    pv_tile<0>(o, vb0, pa0, pa1, pa2, pa3, ACT(NT - 2));
    partialSM(pB0, pB1, m_reg, mnB, alB); __syncthreads(); RESC(alB);
    finishSM(pB0, pB1, alB, l_reg, pa0, pa1, pa2, pa3); SBAR(); pv_tile<1>(o, vb0, pa0, pa1, pa2, pa3, ACT(NT - 1));
    SBAR();
    if (hi == 0) li_l[r32] = l_reg; asm volatile("s_waitcnt lgkmcnt(0)" ::: "memory");
    float rli[16];
#pragma unroll
    for (int r = 0; r < 16; ++r) rli[r] = __builtin_amdgcn_rcpf(li_l[crow(r, hi)]);
    const int xl = (lane ^ 1) << 2;
    unsigned gg[16][4];
#pragma unroll
    for (int r = 0; r < 16; ++r)
#pragma unroll
        for (int d0 = 0; d0 < 4; ++d0) gg[r][d0] = *(const unsigned*)(sg + (long)(wid * 32 + crow(r, hi)) * ZB + d0 * 32 + (r32 & ~1));
#pragma unroll
    for (int r = 0; r < 16; ++r) { const int orow = wid * 32 + crow(r, hi);
#pragma unroll
        for (int d0 = 0; d0 < 4; ++d0) { const float v = o[d0][r] * rli[r];
            const float vn = __int_as_float(__builtin_amdgcn_ds_bpermute(xl, __float_as_int(v)));
            const unsigned g = gg[r][d0];
            if ((r32 & 1) == 0) *(unsigned*)(Ob + (long)orow * 4096 + d0 * 32 + r32) = cvtpk(v * __uint_as_float(g << 16), vn * __uint_as_float(g & 0xffff0000u)); } }
    __syncthreads();
#undef VMW
#undef SBAR
#undef SLOAD
#undef SWRITE
#undef RESC
#undef ACT
#undef HALF_STEP
}
__device__ __forceinline__ void phase_attention(const Params& p, char* lds) {
    for (int it = blockIdx.x; it < 256; it += gridDim.x) {
        const int xcd = it & 7, idx = it >> 3, hh = xcd * 2 + (idx >> 4), x = idx & 15;
        for (int half = 0; half < 2; ++half) { const int P0 = (half ? x : 31 - x) * 256;
            attn_block(lds, p.Q + (long)P0 * NQ + hh * QD, p.Kf + (long)hh * S * QD, p.Vf + (long)hh * S * VH, p.zB + (long)P0 * ZB + hh * VH, p.OH + (long)P0 * 4096 + hh * VH, P0); }
    }
}

#ifndef PROBE_MASK
#define PROBE_MASK 0
#endif
#if PROBE_MASK
#define TICK(cls) do { const unsigned long long now_ = __builtin_amdgcn_s_memrealtime(); if ((PROBE_MASK >> (cls)) & 1) t_acc += now_ - t_last; t_last = now_; } while (0)
#else
#define TICK(cls) do { } while (0)
#endif
__global__ __launch_bounds__(NTHR, 2) void mega(Params p) {
    extern __shared__ __attribute__((aligned(16))) char lds[];
    cg::grid_group grid = cg::this_grid();
    const int G = gridDim.x;
    volatile LAS unsigned* xbst = (volatile LAS unsigned*)((LAS char*)lds + 8 * HTB);
    if (TID() == 0) { xbst[0] = 0u; xbst[1] = 0u; xbst[2] = 0u; xbst[3] = 0u; }
    __syncthreads();
    if (blockIdx.x == 0) for (int i = TID(); i < XCD_BAR_WORDS; i += NTHR) p.bar[i] = 0u;
#if PROBE_MASK
    unsigned long long t_acc = 0, t_last = __builtin_amdgcn_s_memrealtime();
#endif
    phase_prologue(p, lds);
    phase_xb_ssq(p.x_in, p.hb, p.ssqA);
    grid.sync();
    const XcdBarrier xb = xcd_barrier_post(p.bar, xbst);
    TICK(0);
    for (int l = 0; l < DEPTH; ++l) {
        const int c = (int)blockIdx.x + opaque_zero();
        const float* xcur = l ? p.xr : p.x_in;
        { TileSched sc{p.hb, DM, p.Wt_in + (size_t)l * NIN * DM, DM, 32, NIN / 256, G, c}; EpiIn e{p.zB, p.zA, p.ssqA}; gemm_fast(lds, DM, DM, DM, sc, e); }
        xcd_barrier(xb); TICK(2);
        phase_t2(p, l);
        xcd_barrier(xb); TICK(3);
        { TileSched sc{p.qn, QL, p.Wt_q + (size_t)l * NQ * QL, QL, 32, NQ / 256, G, c}; EpiQ e{p.Q, p.cs}; gemm_fast(lds, QL, QL, QL, sc, e); }
        { TileSched sc{p.kvn, KVL, p.Wt_kv + (size_t)l * NKV * KVL, KVL, 32, NKV / 256, G, (c + 128) % G}; EpiKV e{p.Kf, p.Vf}; gemm_fast(lds, KVL, KVL, KVL, sc, e); }
        { LruSched sc{{p.xc, DM, p.Wt_lru + (size_t)l * LRUB * 65536, 256, 32, LRUB, G, c}}; EpiLru e{p.xc, p.b_rg + l * DM, p.b_ig + l * DM, p.nsp8 + l * DM, p.la, p.lb}; gemm_fast(lds, 256, DM, 256, sc, e); }
        { const int heavy = (32 * (NQ / 256)) % G;
          const bool spread = heavy > 0 && heavy < G;
          if (!spread || c >= heavy) { TileSched sc{p.pb + (size_t)l * S * PLE, PLE, p.Wt_ple + (size_t)l * DM * PLE, PLE, 32, 8, spread ? G - heavy : G, spread ? c - heavy : c}; EpiF32 e{p.pp, DM}; gemm_fast(lds, PLE, PLE, PLE, sc, e); } }
        xcd_barrier(xb); TICK(4);
        phase_scan1(p);
        phase_attention(p, lds);
        xcd_barrier(xb); TICK(5);
        phase_scan3(p);
        xcd_barrier(xb); TICK(6);
        { MergeSched sc{{p.OH, 4096, p.Wt_o + (size_t)l * DM * 4096, 4096, 32, 8, G, c}}; EpiMerge e{p.zB, p.mg}; gemm_fast(lds, DM, 4096, 4096, sc, e); }
        xcd_barrier(xb); TICK(7);
        { TileSched sc{p.mg, DM, p.Wt_out + (size_t)l * DM * DM, DM, 32, 8, G, c}; EpiOut e{xcur, p.xr, p.hb2, p.ssqB}; gemm_fast(lds, DM, DM, DM, sc, e); }
        xcd_barrier(xb); TICK(8);
        { TileSched sc{p.hb2, DM, p.Wt_pg + (size_t)l * DM * DM, DM, 32, 8, G, c}; EpiPle e{p.xr, p.pp, p.ssqB, p.hb, p.ssqA}; gemm_fast(lds, DM, DM, DM, sc, e); }
        xcd_barrier(xb); TICK(9);
    }
    phase_final_norm(p.xr, p.final_norm);
#if PROBE_MASK
    __syncthreads();
    if (blockIdx.x == 0) { const float d = sqrtf((float)t_acc * 0.01f * 4.096e-8f);
        for (int j = 0; j < 8; ++j) p.xr[threadIdx.x * 8 + j] += d; }
#endif
}

constexpr size_t LDS_BYTES = 8 * HTB + 16;

extern "C" void kernel_launch(void* const* d_in, const int* in_sizes, int n_in, void* d_out, int out_size, void* d_ws, size_t ws_size, hipStream_t st) {
    Params p{};
    p.x_in = (const float*)d_in[0]; p.p_in = (const float*)d_in[1]; p.pos = (const int*)d_in[2];
    p.attn_norm = (const float*)d_in[3]; p.w_in = (const float*)d_in[4]; p.q_a_norm = (const float*)d_in[5]; p.w_q_b = (const float*)d_in[6];
    p.kv_a_norm = (const float*)d_in[7]; p.w_kv_b = (const float*)d_in[8]; p.conv_w = (const float*)d_in[9]; p.conv_b = (const float*)d_in[10];
    p.w_rg = (const float*)d_in[11]; p.b_rg = (const float*)d_in[12]; p.w_ig = (const float*)d_in[13]; p.b_ig = (const float*)d_in[14]; p.lam = (const float*)d_in[15];
    p.w_o_mla = (const float*)d_in[16]; p.w_o_lru = (const float*)d_in[17]; p.w_out = (const float*)d_in[18]; p.ple_norm = (const float*)d_in[19];
    p.w_ple_gate = (const float*)d_in[20]; p.w_ple = (const float*)d_in[21]; p.final_norm = (const float*)d_in[22];
    p.xr = (float*)d_out;
    char* w = (char*)d_ws; size_t off = 0;
    auto take = [&](size_t bytes) { char* r = w + off; off += (bytes + 255) & ~(size_t)255; return r; };
    p.Wt_in = (u16*)take((size_t)DEPTH * NIN * DM * 2); p.Wt_q = (u16*)take((size_t)DEPTH * NQ * QL * 2); p.Wt_kv = (u16*)take((size_t)DEPTH * NKV * KVL * 2);
    p.Wt_lru = (u16*)take((size_t)DEPTH * LRUB * 65536 * 2); p.Wt_o = (u16*)take((size_t)DEPTH * DM * 4096 * 2); p.Wt_out = (u16*)take((size_t)DEPTH * DM * DM * 2);
    p.Wt_pg = (u16*)take((size_t)DEPTH * DM * DM * 2); p.Wt_ple = (u16*)take((size_t)DEPTH * DM * PLE * 2);
    p.hb = (u16*)take((size_t)S * DM * 2); p.hb2 = (u16*)take((size_t)S * DM * 2); p.ssqA = (float*)take((size_t)S * 4); p.ssqB = (float*)take((size_t)S * 4); p.zB = (u16*)take((size_t)S * ZB * 2); p.zA = (float*)take((size_t)S * ZA * 4);
    p.qn = (u16*)take((size_t)S * QL * 2); p.kvn = (u16*)take((size_t)S * KVL * 2); p.Q = (u16*)take((size_t)S * NQ * 2);
    p.Kf = (u16*)take((size_t)NH * S * QD * 2); p.Vf = (u16*)take((size_t)NH * S * VH * 2); p.xc = (u16*)take((size_t)S * DM * 2);
    p.OH = (u16*)take((size_t)S * 4096 * 2); p.pb = (u16*)take((size_t)DEPTH * S * PLE * 2); p.cs = (float*)take((size_t)S * 64 * 4); p.carry = (float*)take((size_t)3 * 128 * DM * 4); p.nsp8 = (float*)take((size_t)DEPTH * DM * 4); p.bar = (unsigned*)take((size_t)XCD_BAR_WORDS * 4);
    p.la = (float*)take((size_t)S * DM * 4); p.lb = (float*)take((size_t)S * DM * 4); p.pp = (float*)take((size_t)S * DM * 4); p.mg = (u16*)take((size_t)S * DM * 2);
    if (off > ws_size) { fprintf(stderr, "workspace too small: need %zu have %zu\n", off, ws_size); return; }
    (void)hipFuncSetAttribute((const void*)mega, hipFuncAttributeMaxDynamicSharedMemorySize, (int)LDS_BYTES);
    int dev = 0, cus = 0; (void)hipGetDevice(&dev); (void)hipDeviceGetAttribute(&cus, hipDeviceAttributeMultiprocessorCount, dev);
    int per_cu = 0; (void)hipOccupancyMaxActiveBlocksPerMultiprocessor(&per_cu, mega, NTHR, LDS_BYTES);
    if (per_cu < 1 || cus < 1) { fprintf(stderr, "occupancy query failed\n"); return; }
    void* args[] = {&p};
    hipError_t e = hipLaunchCooperativeKernel((const void*)mega, dim3(cus), dim3(NTHR), args, LDS_BYTES, st);
    if (e != hipSuccess) fprintf(stderr, "cooperative launch failed: %s\n", hipGetErrorString(e));
}
```

```cpp
#include <hip/hip_runtime.h>
#include <hip/hip_cooperative_groups.h>
#include <cstdio>
#include <cstdint>
namespace cg = cooperative_groups;

constexpr int S = 8192, DM = 2048, DEPTH = 4, NH = 16, QL = 512, KVL = 512, NOPE = 128, ROPE = 64, VH = 128;
constexpr int INT = 11328, PLE = 256, LRUB = 16, LBD = 128;
constexpr int QD = 192, NQ = NH * QD  , NKV = NH * 256  ;
constexpr int NIN = 11520;
constexpr int ZB = 10240, ZA = 1280;
constexpr int NTHR = 512;
constexpr float QSCALE = 0.07216878364870322f * 1.4426950408889634f;

typedef unsigned short u16;
typedef short bf16x8 __attribute__((ext_vector_type(8)));
typedef float f32x4 __attribute__((ext_vector_type(4)));
typedef float f32x2 __attribute__((ext_vector_type(2)));
typedef unsigned u32x2 __attribute__((ext_vector_type(2)));
typedef unsigned u32x4 __attribute__((ext_vector_type(4)));

__device__ __forceinline__ u16 f2bf(float f) { unsigned u = __float_as_uint(f); u += 0x7FFFu + ((u >> 16) & 1u); return (u16)(u >> 16); }
__device__ __forceinline__ float bf2f(u16 b) { return __uint_as_float(((unsigned)b) << 16); }
__device__ __forceinline__ unsigned pk2(float lo, float hi) { unsigned r; asm volatile("v_cvt_pk_bf16_f32 %0, %1, %2" : "=v"(r) : "v"(lo), "v"(hi)); return r; }
__device__ __forceinline__ float sigmoidf_(float x) { return __builtin_amdgcn_rcpf(1.f + __builtin_amdgcn_exp2f(-1.4426950408889634f * x)); }
__device__ __forceinline__ float siluf_(float x) { return x * __builtin_amdgcn_rcpf(1.f + __builtin_amdgcn_exp2f(-1.4426950408889634f * x)); }
__device__ __forceinline__ int opaque_zero() { int z; asm volatile("s_mov_b32 %0, 0" : "=s"(z)); return z; }
#define TID() ((int)threadIdx.x + opaque_zero())
__device__ __forceinline__ float wsum(float s, int lane) { for (int off = 32; off; off >>= 1) s += __int_as_float(__builtin_amdgcn_ds_bpermute((lane ^ off) << 2, __float_as_int(s))); return s; }
__device__ __forceinline__ float wmax(float s, int lane) { for (int off = 32; off; off >>= 1) s = fmaxf(s, __int_as_float(__builtin_amdgcn_ds_bpermute((lane ^ off) << 2, __float_as_int(s)))); return s; }

struct Params {
    const float *x_in, *p_in; const int* pos;
    const float *attn_norm, *w_in, *q_a_norm, *w_q_b, *kv_a_norm, *w_kv_b, *conv_w, *conv_b, *w_rg, *b_rg, *w_ig, *b_ig, *lam, *w_o_mla, *w_o_lru, *w_out, *ple_norm, *w_ple_gate, *w_ple, *final_norm;
    float* xr;
    u16 *Wt_in, *Wt_q, *Wt_kv, *Wt_lru, *Wt_o, *Wt_out, *Wt_pg, *Wt_ple;
    u16 *hb, *hb2, *zB, *qn, *kvn, *Q, *Kf, *Vf, *xc, *OH, *mg, *pb, *Pm;
    float *zA, *la, *lb, *pp, *cs, *carry, *sc, *nsp8, *ssqA, *ssqB; unsigned* bar;
};

struct Unit { const u16* a; const u16* b; int pm, pn, aux; };

struct TileSched {
    const u16* A; long lda; const u16* B; long ldb; int nM, nN, G, c;
    __device__ __forceinline__ bool tile(int i, int& pm, int& pn) const {
        const int nwg = nM * nN; const long L = (long)i * G + c; if (L >= nwg) return false;
        int wgid = (int)L; { const int q = nwg / 8, r = nwg % 8, xcd = wgid % 8, off = wgid / 8; wgid = (xcd < r ? xcd * (q + 1) : r * (q + 1) + (xcd - r) * q) + off; }
        const int nig = 8 * nN, gid = wgid / nig, fm = gid * 8, gsz = (nM - fm) < 8 ? (nM - fm) : 8;
        pm = fm + ((wgid % nig) % gsz); pn = (wgid % nig) / gsz; return true;
    }
    __device__ __forceinline__ bool next(int i, Unit& u) const {
        if (!tile(i, u.pm, u.pn)) return false;
        u.a = A + (long)u.pm * 256 * lda; u.b = B + (long)u.pn * 256 * ldb; u.aux = 0; return true;
    }
};
struct LruSched : TileSched {
    __device__ __forceinline__ bool next(int i, Unit& u) const {
        if (!tile(i, u.pm, u.pn)) return false;
        u.a = A + (long)u.pm * 256 * lda + (u.pn >> 1) * 256; u.b = B + (long)u.pn * 65536; u.aux = 0; return true;
    }
};
struct MergeSched : TileSched {
    __device__ __forceinline__ bool next(int i, Unit& u) const {
        if (!tile(i >> 1, u.pm, u.pn)) return false;
        u.aux = i & 1; u.a = A + (long)u.pm * 256 * lda + u.aux * 2048; u.b = B + (long)u.pn * 256 * ldb + u.aux * 2048; return true;
    }
};
struct TriSched {
    const u16* A; long lda; const u16* B; long ldb; int G, c;
    __device__ __forceinline__ bool next(int i, Unit& u) const {
        int t = i * G + c; if (t >= 528) return false;
        int pm = 0; while (t >= pm + 1) { t -= pm + 1; ++pm; }
        u.pm = pm; u.pn = t; u.a = A + (long)pm * 256 * lda; u.b = B + (long)t * 256 * ldb; u.aux = 0; return true;
    }
};
struct RowSched {
    const u16* A; long lda; const u16* B; int G, c;
    __device__ __forceinline__ bool next(int i, Unit& u) const {
        const int t = i * G + c; if (t >= 32) return false;
        u.pm = 31 - t; u.pn = 0; u.a = A + (long)u.pm * 256 * lda; u.b = B; u.aux = 0; return true;
    }
};

template <class F>
__device__ __forceinline__ void epi_foreach(f32x4 (&acc)[2][2][4][2], const Unit& u, int wr, int wc, int fr, int fq, F f) {
    const int row0 = u.pm * 256 + wr * 64 + fr, col0 = u.pn * 256 + wc * 32 + 4 * fq;
#pragma unroll
    for (int ai = 0; ai < 2; ++ai)
#pragma unroll
        for (int m = 0; m < 4; ++m) {
#pragma unroll
            for (int bj = 0; bj < 2; ++bj)
#pragma unroll
                for (int n = 0; n < 2; ++n) f(row0 + ai * 128 + m * 16, col0 + bj * 128 + n * 16, acc[ai][bj][m][n]);
        }
}
template <int GM, class T, class LF, class F>
__device__ __forceinline__ void epi_foreach_ld(f32x4 (&acc)[2][2][4][2], const Unit& u, int wr, int wc, int fr, int fq, LF lf, F f) {
    const int row0 = u.pm * 256 + wr * 64 + fr, col0 = u.pn * 256 + wc * 32 + 4 * fq;
#pragma unroll
    for (int ai = 0; ai < 2; ++ai)
#pragma unroll
        for (int mg = 0; mg < 4; mg += GM) {
            T regs[GM][2][2];
#pragma unroll
            for (int m = 0; m < GM; ++m)
#pragma unroll
                for (int bj = 0; bj < 2; ++bj)
#pragma unroll
                    for (int n = 0; n < 2; ++n) regs[m][bj][n] = lf(row0 + ai * 128 + (mg + m) * 16, col0 + bj * 128 + n * 16);
#pragma unroll
            for (int m = 0; m < GM; ++m)
#pragma unroll
                for (int bj = 0; bj < 2; ++bj)
#pragma unroll
                    for (int n = 0; n < 2; ++n) f(row0 + ai * 128 + (mg + m) * 16, col0 + bj * 128 + n * 16, acc[ai][bj][mg + m][n], regs[m][bj][n]);
        }
}
#define EPI_COMMON  __device__ __forceinline__ bool keep(const Unit&) const { return false; } __device__ __forceinline__ int klimit(const Unit&, int K) const { return K; }
#define EPI_SIG     __device__ __forceinline__ void operator()(f32x4 (&acc)[2][2][4][2], const Unit& u, int wr, int wc, int fr, int fq) const

__device__ __forceinline__ float rinv_of(float ss) { return rsqrtf(ss * (1.f / DM) + 1e-6f); }
struct EpiIn { EPI_COMMON u16* zB; float* zA; const float* ssq;
    EPI_SIG { const int seg = u.pn >> 3;
        const int row0 = u.pm * 256 + wr * 64 + fr, col0 = u.pn * 256 + wc * 32 + 8 * fq;
        float ri[2][4];
#pragma unroll
        for (int ai = 0; ai < 2; ++ai)
#pragma unroll
            for (int m = 0; m < 4; ++m) ri[ai][m] = ssq[row0 + ai * 128 + m * 16];
#pragma unroll
        for (int ai = 0; ai < 2; ++ai)
#pragma unroll
            for (int m = 0; m < 4; ++m) ri[ai][m] = rinv_of(ri[ai][m]);
        if (seg >= 5) {
#pragma unroll
            for (int ai = 0; ai < 2; ++ai)
#pragma unroll
                for (int m = 0; m < 4; ++m)
#pragma unroll
                    for (int bj = 0; bj < 2; ++bj) { const int row = row0 + ai * 128 + m * 16, col = col0 + bj * 128;
                        if (col < ZB + 1088) { float* d = zA + (long)row * ZA + (col - ZB); *(f32x4*)d = acc[ai][bj][m][0] * ri[ai][m]; *(f32x4*)(d + 4) = acc[ai][bj][m][1] * ri[ai][m]; } }
        } else { const bool sil = seg == 0 || seg == 2, ident = seg == 1;
#pragma unroll
            for (int ai = 0; ai < 2; ++ai)
#pragma unroll
                for (int m = 0; m < 4; ++m)
#pragma unroll
                    for (int bj = 0; bj < 2; ++bj) { const int row = row0 + ai * 128 + m * 16, col = col0 + bj * 128;
                        f32x4 o0 = acc[ai][bj][m][0] * ri[ai][m], o1 = acc[ai][bj][m][1] * ri[ai][m];
                        if (!ident) {
#pragma unroll
                            for (int e = 0; e < 4; ++e) { const float s0 = sigmoidf_(o0[e]), s1 = sigmoidf_(o1[e]); o0[e] = sil ? o0[e] * s0 : s0; o1[e] = sil ? o1[e] * s1 : s1; } }
                        *(u32x4*)(zB + (long)row * ZB + col) = (u32x4){pk2(o0[0], o0[1]), pk2(o0[2], o0[3]), pk2(o1[0], o1[1]), pk2(o1[2], o1[3])}; }
        }
    } };
struct EpiQ { EPI_COMMON u16* Q; const float* cs;
    EPI_SIG { epi_foreach_ld<4, f32x4>(acc, u, wr, wc, fr, fq,
            [&](int row, int col) { const int d = col % QD; f32x4 t = {1.f, 0.f, 1.f, 0.f};
                if (d >= NOPE) { const int i0 = (d - NOPE) >> 1; const float* tp = cs + (long)row * 64 + i0; const f32x2 cc = *(const f32x2*)tp, ss = *(const f32x2*)(tp + 32); t = (f32x4){cc[0], ss[0], cc[1], ss[1]}; }
                return t; },
            [&](int row, int col, f32x4& v, const f32x4& t) { f32x4 o;
                const int d = col % QD;
                if (d < NOPE) o = v * QSCALE;
                else { o[0] = (v[0] * t[0] - v[1] * t[1]) * QSCALE; o[1] = (v[1] * t[0] + v[0] * t[1]) * QSCALE;
                       o[2] = (v[2] * t[2] - v[3] * t[3]) * QSCALE; o[3] = (v[3] * t[2] + v[2] * t[3]) * QSCALE; }
                *(u32x2*)(Q + (long)row * NQ + col) = (u32x2){pk2(o[0], o[1]), pk2(o[2], o[3])}; }); } };
struct EpiKV { EPI_COMMON u16* Kf; u16* Vf;
    EPI_SIG { epi_foreach(acc, u, wr, wc, fr, fq, [&](int row, int col, f32x4& v) {
            const int hh = col >> 8, j = col & 255;
            u16* dst = (j < 128) ? Kf + ((long)hh * S + row) * QD + j : Vf + ((long)hh * S + row) * VH + (j - 128);
            *(u32x2*)dst = (u32x2){pk2(v[0], v[1]), pk2(v[2], v[3])};
        }); } };
struct EpiLru { EPI_COMMON const u16* xc; const float *brg, *big, *nsp8; float *la, *lb;
    EPI_SIG {
        const int row0 = u.pm * 256 + wr * 64 + fr, col0 = u.pn * 256 + wc * 32 + 4 * fq;
        f32x2 cr[2][2], ci[2][2], cn[2][2];
#pragma unroll
        for (int bj = 0; bj < 2; ++bj)
#pragma unroll
            for (int n = 0; n < 2; ++n) { const int ch = (col0 + bj * 128 + n * 16) >> 1; cr[bj][n] = *(const f32x2*)(brg + ch); ci[bj][n] = *(const f32x2*)(big + ch); cn[bj][n] = *(const f32x2*)(nsp8 + ch); }
#pragma unroll
        for (int ai = 0; ai < 2; ++ai) {
            unsigned xw[4][2][2];
#pragma unroll
            for (int m = 0; m < 4; ++m)
#pragma unroll
                for (int bj = 0; bj < 2; ++bj)
#pragma unroll
                    for (int n = 0; n < 2; ++n) xw[m][bj][n] = *(const unsigned*)(xc + (long)(row0 + ai * 128 + m * 16) * DM + ((col0 + bj * 128 + n * 16) >> 1));
#pragma unroll
            for (int m = 0; m < 4; ++m)
#pragma unroll
                for (int bj = 0; bj < 2; ++bj)
#pragma unroll
                    for (int n = 0; n < 2; ++n) {
                        const f32x4 v = acc[ai][bj][m][n]; const long o = (long)(row0 + ai * 128 + m * 16) * DM + ((col0 + bj * 128 + n * 16) >> 1);
                        f32x2 av, bv;
#pragma unroll
                        for (int e = 0; e < 2; ++e) {
                            const float r = sigmoidf_(v[2 * e] + cr[bj][n][e]), ii = sigmoidf_(v[2 * e + 1] + ci[bj][n][e]);
                            const float lg = r * cn[bj][n][e], x2 = 2.f * lg;
                            const float a = __builtin_amdgcn_exp2f(1.4426950408889634f * lg);
                            const float em = (x2 > -0.25f) ? x2 * (1.f + x2 * (0.5f + x2 * (0.16666667f + x2 * (0.041666668f + x2 * 0.0083333338f)))) : (a * a - 1.f);
                            const float x = e ? __uint_as_float(xw[m][bj][n] & 0xffff0000u) : __uint_as_float(xw[m][bj][n] << 16);
                            av[e] = a; bv[e] = __builtin_amdgcn_sqrtf(-em) * (ii * x); }
                        *(f32x2*)(la + o) = av; *(f32x2*)(lb + o) = bv; }
        }
    } };
struct SmSl { u32x2 sm, sl; };
struct EpiMerge { const u16* zB; u16* mg;
    __device__ __forceinline__ bool keep(const Unit& u) const { return u.aux == 0; }
    __device__ __forceinline__ int klimit(const Unit&, int K) const { return K; }
    EPI_SIG { const int part = u.aux;
        epi_foreach_ld<4, SmSl>(acc, u, wr, wc, fr, fq,
            [&](int row, int col) { SmSl t; t.sl = *(const u32x2*)(zB + (long)row * ZB + 8192 + col); t.sm = t.sl; if (part == 0) t.sm = *(const u32x2*)(zB + (long)row * ZB + 6144 + col); return t; },
            [&](int row, int col, f32x4& v, const SmSl& t) {
            f32x4 fl = {__uint_as_float(t.sl[0] << 16), __uint_as_float(t.sl[0] & 0xffff0000u), __uint_as_float(t.sl[1] << 16), __uint_as_float(t.sl[1] & 0xffff0000u)};
#pragma unroll
            for (int e = 0; e < 4; ++e) fl[e] = fmaxf(fl[e], 1e-12f);
            if (part == 0) {
                const f32x4 fm = {__uint_as_float(t.sm[0] << 16), __uint_as_float(t.sm[0] & 0xffff0000u), __uint_as_float(t.sm[1] << 16), __uint_as_float(t.sm[1] & 0xffff0000u)};
#pragma unroll
                for (int e = 0; e < 4; ++e) v[e] = v[e] * fm[e] * __builtin_amdgcn_rcpf(fl[e]);
            } else { f32x4 o = v * fl; *(u32x2*)(mg + (long)row * DM + col) = (u32x2){pk2(o[0], o[1]), pk2(o[2], o[3])}; }
        }); } };
__device__ __forceinline__ void row_ssq_add(float sq, float* ssq, int row, int lane) {
    sq += __int_as_float(__builtin_amdgcn_ds_bpermute((lane ^ 16) << 2, __float_as_int(sq)));
    sq += __int_as_float(__builtin_amdgcn_ds_bpermute((lane ^ 32) << 2, __float_as_int(sq)));
    if (lane < 16) atomicAdd(ssq + row, sq);
}
struct EpiOut { EPI_COMMON const float* xold; float* xnew; u16* xb; float* ssq;
    EPI_SIG {
        const int row0 = u.pm * 256 + wr * 64 + fr, col0 = u.pn * 256 + wc * 32 + 4 * fq, lane = fq * 16 + fr;
#pragma unroll
        for (int ai = 0; ai < 2; ++ai) {
            f32x4 xo[4][2][2];
#pragma unroll
            for (int m = 0; m < 4; ++m)
#pragma unroll
                for (int bj = 0; bj < 2; ++bj)
#pragma unroll
                    for (int n = 0; n < 2; ++n) xo[m][bj][n] = *(const f32x4*)(xold + (long)(row0 + ai * 128 + m * 16) * DM + col0 + bj * 128 + n * 16);
#pragma unroll
            for (int m = 0; m < 4; ++m) { const int row = row0 + ai * 128 + m * 16; float sq = 0.f;
#pragma unroll
                for (int bj = 0; bj < 2; ++bj)
#pragma unroll
                    for (int n = 0; n < 2; ++n) { const f32x4 xv = xo[m][bj][n] + acc[ai][bj][m][n]; const long idx = (long)row * DM + col0 + bj * 128 + n * 16;
                        *(f32x4*)(xnew + idx) = xv; *(u32x2*)(xb + idx) = (u32x2){pk2(xv[0], xv[1]), pk2(xv[2], xv[3])};
                        sq += xv[0] * xv[0] + xv[1] * xv[1] + xv[2] * xv[2] + xv[3] * xv[3]; }
                row_ssq_add(sq, ssq, row, lane); }
        }
    } };
struct EpiF32 { EPI_COMMON float* C; long ldc;
    EPI_SIG { epi_foreach(acc, u, wr, wc, fr, fq, [&](int row, int col, f32x4& v) { *(f32x4*)(C + (long)row * ldc + col) = v; }); } };
struct EpiPle { EPI_COMMON float* x; const float* pp; const float* ssq_in; u16* xb; float* ssq_out;
    EPI_SIG {
        const int row0 = u.pm * 256 + wr * 64 + fr, col0 = u.pn * 256 + wc * 32 + 4 * fq, lane = fq * 16 + fr;
#pragma unroll
        for (int ai = 0; ai < 2; ++ai)
#pragma unroll
            for (int mg = 0; mg < 4; mg += 2) {
                f32x4 xo[2][2][2], po[2][2][2]; float ss[2];
#pragma unroll
                for (int m = 0; m < 2; ++m) { const int row = row0 + ai * 128 + (mg + m) * 16; ss[m] = ssq_in[row];
#pragma unroll
                    for (int bj = 0; bj < 2; ++bj)
#pragma unroll
                        for (int n = 0; n < 2; ++n) { const long idx = (long)row * DM + col0 + bj * 128 + n * 16; xo[m][bj][n] = *(const f32x4*)(x + idx); po[m][bj][n] = *(const f32x4*)(pp + idx); } }
#pragma unroll
                for (int m = 0; m < 2; ++m) { const int row = row0 + ai * 128 + (mg + m) * 16; const float ri = rinv_of(ss[m]); float sq = 0.f;
#pragma unroll
                    for (int bj = 0; bj < 2; ++bj)
#pragma unroll
                        for (int n = 0; n < 2; ++n) { f32x4 xv = xo[m][bj][n]; const f32x4 v = acc[ai][bj][mg + m][n]; const long idx = (long)row * DM + col0 + bj * 128 + n * 16;
#pragma unroll
                            for (int e = 0; e < 4; ++e) xv[e] += po[m][bj][n][e] * sigmoidf_(v[e] * ri);
                            *(f32x4*)(x + idx) = xv; *(u32x2*)(xb + idx) = (u32x2){pk2(xv[0], xv[1]), pk2(xv[2], xv[3])};
                            sq += xv[0] * xv[0] + xv[1] * xv[1] + xv[2] * xv[2] + xv[3] * xv[3]; }
                    row_ssq_add(sq, ssq_out, row, lane); }
            }
    } };

#define LAS __attribute__((address_space(3)))
constexpr int HTB = 128 * 64 * 2;
__device__ __forceinline__ int lds_byte(int r, int c) { const int st = (r >> 4) * 2 + (c >> 5), rr = r & 15, cc = c & 31, ob = rr * 64 + cc * 2; return st * 1024 + (ob ^ (((ob >> 9) & 1) << 5)); }
__device__ __forceinline__ void stage_rc(int b, int& R, int& C) { const int st = b / 1024, sb = b % 1024, swz = sb ^ (((sb >> 9) & 1) << 5); R = (st >> 1) * 16 + swz / 64; C = (st & 1) * 32 + (swz % 64) / 2; }

template <class Epi, class Sched>
__device__ __forceinline__ void gemm_fast(char* lds_, int K, long lda, long ldb, const Sched& S_, const Epi& E) {
    LAS unsigned char* lds = (LAS unsigned char*)lds_;
    const int tid = TID(), wid = __builtin_amdgcn_readfirstlane(tid >> 6), lane = tid & 63, wr = wid >> 2, wc = wid & 3, fr = lane & 15, fq = lane >> 4;
    const int nt = K / 64;
    unsigned voffA[2], voffB[2];
#pragma unroll
    for (int i = 0; i < 2; ++i) { int R, C; stage_rc(tid * 16 + i * 8192, R, C); voffA[i] = (unsigned)(R * lda + C) * 2u; voffB[i] = (unsigned)(R * ldb + C) * 2u; }
    const size_t kstep = 128;
    const size_t hstepA = (size_t)128 * lda * 2, hstepB = (size_t)128 * ldb * 2;
    const unsigned ldsw = (unsigned)wid * 1024u;
    const int aoff = lds_byte(wr * 64 + fr, fq * 8), boff = lds_byte(wc * 32 + fr, fq * 8);
#define G_SA(b, h) (((b) * 2 + (h)) * HTB)
#define G_SB(b, h) ((4 + (b) * 2 + (h)) * HTB)
#define G_STAGE(bufoff, gbase, voff) do { _Pragma("unroll") for (int _i = 0; _i < 2; ++_i) \
        __builtin_amdgcn_global_load_lds((const unsigned*)((const char*)(gbase) + (voff)[_i]), (LAS unsigned*)(lds + (bufoff) + ldsw + _i * 8192), 16, 0, 0); } while (0)
#define G_LDA(dst, b, h) do { _Pragma("unroll") for (int m = 0; m < 4; ++m) _Pragma("unroll") for (int k = 0; k < 2; ++k) dst[m][k] = *(const LAS bf16x8*)(lds + G_SA(b, h) + aoff + m * 2048 + k * 1024); } while (0)
#define G_LDB(dst, b, h) do { _Pragma("unroll") for (int n = 0; n < 2; ++n) _Pragma("unroll") for (int k = 0; k < 2; ++k) dst[n][k] = *(const LAS bf16x8*)(lds + G_SB(b, h) + boff + n * 2048 + k * 1024); } while (0)
#define G_MMA(ai, bj, At, Bt) do { __builtin_amdgcn_s_setprio(1); _Pragma("unroll") for (int m = 0; m < 4; ++m) _Pragma("unroll") for (int n = 0; n < 2; ++n) _Pragma("unroll") for (int k = 0; k < 2; ++k) \
        acc[ai][bj][m][n] = __builtin_amdgcn_mfma_f32_16x16x32_bf16(Bt[n][k], At[m][k], acc[ai][bj][m][n], 0, 0, 0); __builtin_amdgcn_s_setprio(0); } while (0)
#define G_WAIT_V(n) asm volatile("s_waitcnt vmcnt(" #n ")" ::: "memory")
#define G_WAIT_L(n) asm volatile("s_waitcnt lgkmcnt(" #n ")" ::: "memory")
#define G_BAR __builtin_amdgcn_s_barrier()
#define G_SCHED __builtin_amdgcn_sched_barrier(0)
    Unit cur, nxt; int ui = 0;
    if (!S_.next(0, cur)) return;
    f32x4 acc[2][2][4][2];
#pragma unroll
    for (int a = 0; a < 2; ++a)
#pragma unroll
        for (int b = 0; b < 2; ++b)
#pragma unroll
            for (int m = 0; m < 4; ++m)
#pragma unroll
                for (int n = 0; n < 2; ++n) acc[a][b][m][n] = (f32x4){0.f, 0.f, 0.f, 0.f};
    bf16x8 At[4][2], B0[2][2], B1[2][2];
    const char* cA = (const char*)cur.a; const char* cB = (const char*)cur.b;
    G_STAGE(G_SB(0, 0), cB, voffB); G_STAGE(G_SA(0, 0), cA, voffA); G_STAGE(G_SB(0, 1), cB + hstepB, voffB); G_STAGE(G_SA(0, 1), cA + hstepA, voffA);
    if (wr == 1) G_BAR;
    G_WAIT_V(4); G_BAR;
    G_STAGE(G_SB(1, 0), cB + kstep, voffB); G_STAGE(G_SA(1, 0), cA + kstep, voffA); G_STAGE(G_SB(1, 1), cB + hstepB + kstep, voffB);
    G_WAIT_V(6); G_BAR;
    for (;;) {
        const bool has_next = S_.next(ui + 1, nxt);
        const char* nA = has_next ? (const char*)nxt.a : cA; const char* nB = has_next ? (const char*)nxt.b : cB;
#pragma unroll 1
        for (int t = 0; t < nt; t += 2) {
            const bool last = (t == nt - 2);
            const char* a1 = cA + (size_t)(t + 1) * kstep;
            const char* a2 = last ? nA : cA + (size_t)(t + 2) * kstep; const char* b2 = last ? nB : cB + (size_t)(t + 2) * kstep;
            const char* a3 = a2 + kstep; const char* b3 = b2 + kstep;
            G_LDB(B0, 0, 0); G_SCHED; G_LDA(At, 0, 0); G_STAGE(G_SA(1, 1), a1 + hstepA, voffA);
            G_WAIT_L(8); G_BAR; G_WAIT_L(0); G_MMA(0, 0, At, B0); G_BAR; G_SCHED;
            G_LDB(B1, 0, 1); G_STAGE(G_SB(0, 0), b2, voffB);
            G_BAR; G_WAIT_L(0); G_MMA(0, 1, At, B1); G_BAR;
            G_LDA(At, 0, 1); G_STAGE(G_SA(0, 0), a2, voffA);
            G_BAR; G_WAIT_L(0); G_MMA(1, 0, At, B0); G_BAR; G_SCHED;
            G_STAGE(G_SB(0, 1), b2 + hstepB, voffB);
            G_WAIT_V(6); G_BAR; G_MMA(1, 1, At, B1); G_BAR;
            G_LDB(B0, 1, 0); G_SCHED; G_LDA(At, 1, 0); G_STAGE(G_SA(0, 1), a2 + hstepA, voffA);
            G_WAIT_L(8); G_BAR; G_WAIT_L(0); G_MMA(0, 0, At, B0); G_BAR; G_SCHED;
            G_LDB(B1, 1, 1); G_STAGE(G_SB(1, 0), b3, voffB);
            G_BAR; G_WAIT_L(0); G_MMA(0, 1, At, B1); G_BAR;
            G_LDA(At, 1, 1); G_STAGE(G_SA(1, 0), a3, voffA);
            G_BAR; G_WAIT_L(0); G_MMA(1, 0, At, B0); G_BAR; G_SCHED;
            G_STAGE(G_SB(1, 1), b3 + hstepB, voffB);
            G_WAIT_V(6); G_BAR; G_MMA(1, 1, At, B1); G_BAR;
        }
        { const int t2 = TID(), w2 = t2 >> 6, l2 = t2 & 63;
          E(acc, cur, w2 >> 2, w2 & 3, l2 & 15, l2 >> 4); }
        if (!has_next) break;
        if (!E.keep(cur)) {
#pragma unroll
            for (int a = 0; a < 2; ++a)
#pragma unroll
                for (int b = 0; b < 2; ++b)
#pragma unroll
                    for (int m = 0; m < 4; ++m)
#pragma unroll
                        for (int n = 0; n < 2; ++n) acc[a][b][m][n] = (f32x4){0.f, 0.f, 0.f, 0.f};
        }
        cur = nxt; cA = nA; cB = nB; ++ui;
    }
    G_WAIT_V(0);
    if (wr == 0) G_BAR;
    G_BAR;
#undef G_SA
#undef G_SB
#undef G_STAGE
#undef G_LDA
#undef G_LDB
#undef G_MMA
#undef G_WAIT_V
#undef G_WAIT_L
#undef G_BAR
#undef G_SCHED
}


#define XB_TMO      128
#define XB_XCNT(j)  (256  + 64 * (j))
#define XB_XSUB(j)  (1280 + 64 * (j))
#define XB_XGEN(j)  (2304 + 64 * (j))
#define XB_TOP      3328
#define XB_TOPGEN   3392
#define XCD_BAR_WORDS 3456
#define XB_SPIN_CAP (1u << 18)
__device__ __forceinline__ unsigned xb_ld(unsigned* p)              { return __hip_atomic_load(p, __ATOMIC_RELAXED, __HIP_MEMORY_SCOPE_AGENT); }
__device__ __forceinline__ unsigned xb_add(unsigned* p, unsigned v) { return __hip_atomic_fetch_add(p, v, __ATOMIC_RELAXED, __HIP_MEMORY_SCOPE_AGENT); }
__device__ __forceinline__ unsigned xb_xcc_id() { return (unsigned)__builtin_amdgcn_s_getreg((3 << 11) | 20) & 0xFu; }
#define XB_SPIN(cond, bar) do { unsigned _sp = 0; while (cond) { __builtin_amdgcn_s_sleep(1); \
    if ((++_sp & 255u) == 0u) { if (xb_ld(&(bar)[XB_TMO])) break; if (_sp > XB_SPIN_CAP) { atomicAdd(&(bar)[XB_TMO], 1u); break; } } } } while (0)
struct XcdBarrier { unsigned* bar; unsigned x; volatile LAS unsigned* st; };
__device__ __forceinline__ XcdBarrier xcd_barrier_post(unsigned* bar, volatile LAS unsigned* st) {
    XcdBarrier b; b.bar = bar; b.x = xb_xcc_id(); b.st = st;
    if (TID() == 0) (void)xb_add(&bar[XB_XCNT(b.x)], 1u);
    return b;
}
__device__ __forceinline__ void xcd_barrier_complete(unsigned* bar, unsigned x, unsigned& nloc, unsigned& nx) {
    const unsigned G = gridDim.x * gridDim.y * gridDim.z;
    unsigned sum, cnt, mine, sp = 0u;
    for (;;) {
        sum = 0u; cnt = 0u; mine = 0u;
#pragma unroll
        for (unsigned j = 0; j < 16; ++j) { const unsigned c = xb_ld(&bar[XB_XCNT(j)]); sum += c; cnt += (c > 0u) ? 1u : 0u; mine = (j == x) ? c : mine; }
        if (sum == G) break;
        __builtin_amdgcn_s_sleep(1);
        if ((++sp & 255u) == 0u) { if (xb_ld(&bar[XB_TMO])) break; if (sp > XB_SPIN_CAP) { atomicAdd(&bar[XB_TMO], 1u); break; } }
    }
    nloc = mine > 0u ? mine : 1u; nx = cnt > 0u ? cnt : 1u;
}
__device__ __forceinline__ void xcd_barrier(const XcdBarrier& b) {
    asm volatile("s_waitcnt vmcnt(0)" ::: "memory");
    __syncthreads();
    if (TID() == 0) {
        unsigned* bar = b.bar;
        __builtin_amdgcn_s_waitcnt(0);
        unsigned nloc = b.st[0], nx = b.st[1];
        if (nloc == 0u) { xcd_barrier_complete(bar, b.x, nloc, nx); b.st[0] = nloc; b.st[1] = nx; }
        const unsigned old = xb_add(&bar[XB_XSUB(b.x)], 1u);
        const unsigned gen = old / nloc;
        if (old + 1u == (gen + 1u) * nloc) {
            __builtin_amdgcn_fence(__ATOMIC_RELEASE, "agent");
            asm volatile("s_waitcnt vmcnt(0)" ::: "memory");
            const unsigned og = xb_add(&bar[XB_TOP], 1u);
            const unsigned tg = og / nx;
            if (og + 1u == (tg + 1u) * nx) xb_add(&bar[XB_TOPGEN], 1u);
            else XB_SPIN(xb_ld(&bar[XB_TOPGEN]) == tg, bar);
            __builtin_amdgcn_fence(__ATOMIC_ACQUIRE, "agent");
            xb_add(&bar[XB_XGEN(b.x)], 1u);
            asm volatile("s_waitcnt vmcnt(0)" ::: "memory");
        } else {
            XB_SPIN(xb_ld(&bar[XB_XGEN(b.x)]) == gen, bar);
            __builtin_amdgcn_fence(__ATOMIC_ACQUIRE, "agent");
            asm volatile("s_waitcnt vmcnt(0)" ::: "memory");
        }
    }
    __syncthreads();
}

struct TDesc { const float* src; const float* ks; u16* dst; long ldd; int N, coff, rm, tix; };
constexpr int TS_IN = (DM / 256) * (INT / 64), TS_Q = (QL / 256) * (NQ / 64), TS_KV = (KVL / 256) * (NKV / 64), TS_SQ = (DM / 256) * (DM / 64), TS_PLE = (PLE / 256) * (DM / 64);
constexpr int TS_LAYER = TS_IN + TS_Q + TS_KV + 4 * TS_SQ + TS_PLE, TS_TOTAL = DEPTH * TS_LAYER;
__device__ __forceinline__ TDesc tdesc(const Params& p, int g) {
    const int l = g / TS_LAYER; int r = g % TS_LAYER; TDesc d; d.ks = nullptr; d.coff = 0; d.rm = 0;
    if (r < TS_IN) { d.src = p.w_in + (size_t)l * DM * INT; d.N = INT; d.dst = p.Wt_in + (size_t)l * NIN * DM; d.ldd = DM; d.rm = 1; d.ks = p.attn_norm + l * DM; d.tix = r; return d; }
    r -= TS_IN;
    if (r < TS_Q) { d.src = p.w_q_b + (size_t)l * QL * NQ; d.N = NQ; d.dst = p.Wt_q + (size_t)l * NQ * QL; d.ldd = QL; d.rm = 2; d.tix = r; return d; }
    r -= TS_Q;
    if (r < TS_KV) { d.src = p.w_kv_b + (size_t)l * KVL * NKV; d.N = NKV; d.dst = p.Wt_kv + (size_t)l * NKV * KVL; d.ldd = KVL; d.tix = r; return d; }
    r -= TS_KV;
    if (r < TS_SQ) { d.src = p.w_o_mla + (size_t)l * DM * DM; d.N = DM; d.dst = p.Wt_o + (size_t)l * DM * 4096; d.ldd = 4096; d.tix = r; return d; }
    r -= TS_SQ;
    if (r < TS_SQ) { d.src = p.w_o_lru + (size_t)l * DM * DM; d.N = DM; d.dst = p.Wt_o + (size_t)l * DM * 4096; d.ldd = 4096; d.coff = 2048; d.tix = r; return d; }
    r -= TS_SQ;
    if (r < TS_SQ) { d.src = p.w_out + (size_t)l * DM * DM; d.N = DM; d.dst = p.Wt_out + (size_t)l * DM * DM; d.ldd = DM; d.tix = r; return d; }
    r -= TS_SQ;
    if (r < TS_SQ) { d.src = p.w_ple_gate + (size_t)l * DM * DM; d.N = DM; d.dst = p.Wt_pg + (size_t)l * DM * DM; d.ldd = DM; d.ks = p.ple_norm + l * DM; d.tix = r; return d; }
    r -= TS_SQ;
    d.src = p.w_ple + (size_t)l * PLE * DM; d.N = DM; d.dst = p.Wt_ple + (size_t)l * DM * PLE; d.ldd = PLE; d.tix = r; return d;
}
__device__ __forceinline__ int trowmap(int rm, int n) {
    if (rm == 1) { const int r = n >= 1088 ? n - 1088 : n + ZB, c = r & 31;
                   return (r & ~31) + 16 * ((c >> 2) & 1) + ((c >> 3) << 2) + (c & 3); }
    if (rm == 2) { const int hh = n / QD, d = n % QD; if (d < NOPE) return n; const int e = d - NOPE; return hh * QD + NOPE + ((e & 31) << 1) + (e >> 5); }
    return n;
}
__device__ __forceinline__ void transpose_all(const Params& p, char* lds) {
    u16 (*t)[72] = (u16(*)[72])lds;
    const int tid = TID(), k = tid >> 3, nn = (tid & 7) * 8, G = gridDim.x;
    f32x4 vA[4][2], vB[4][2];
#define TC_LOAD(v_, d_) do { const int tn_ = (d_).N / 64, k0_ = ((d_).tix / tn_) * 256, n0_ = ((d_).tix % tn_) * 64; _Pragma("unroll") for (int j = 0; j < 4; ++j) { \
        const float* p_ = (d_).src + (long)(k0_ + k + 64 * j) * (d_).N + n0_ + nn; v_[j][0] = *(const f32x4*)p_; v_[j][1] = *(const f32x4*)(p_ + 4); \
        if ((d_).ks) { const float g_ = (d_).ks[k0_ + k + 64 * j]; v_[j][0] = v_[j][0] * g_; v_[j][1] = v_[j][1] * g_; } } } while (0)
#define TC_LDSW(v_) do { _Pragma("unroll") for (int j = 0; j < 4; ++j) *(u32x4*)&t[k + 64 * j][nn ^ (((k >> 3) & 7) << 3)] = (u32x4){pk2(v_[j][0][0], v_[j][0][1]), pk2(v_[j][0][2], v_[j][0][3]), pk2(v_[j][1][0], v_[j][1][1]), pk2(v_[j][1][2], v_[j][1][3])}; } while (0)
#define TC_STORE(d_) do { const int tn_ = (d_).N / 64, k0_ = ((d_).tix / tn_) * 256, n0_ = ((d_).tix % tn_) * 64; const int n_ = tid >> 3, kk_ = (tid & 7) * 8; \
        u16* drow_ = (d_).dst + (long)trowmap((d_).rm, n0_ + n_) * (d_).ldd + (d_).coff + k0_ + kk_; \
        _Pragma("unroll") for (int j = 0; j < 4; ++j) { u32x4 o_; _Pragma("unroll") for (int e = 0; e < 4; ++e) o_[e] = (unsigned)t[64 * j + kk_ + 2 * e][n_ ^ kk_] | ((unsigned)t[64 * j + kk_ + 2 * e + 1][n_ ^ kk_] << 16); \
            *(u32x4*)(drow_ + 64 * j) = o_; } } while (0)
    int gA = blockIdx.x, gB = gA + G; TDesc dA, dB, dc;
    if (gA < TS_TOTAL) { dA = tdesc(p, gA); TC_LOAD(vA, dA); }
    if (gB < TS_TOTAL) { dB = tdesc(p, gB); TC_LOAD(vB, dB); }
    while (gA < TS_TOTAL) {
        TC_LDSW(vA); __syncthreads(); dc = dA; gA += 2 * G; if (gA < TS_TOTAL) { dA = tdesc(p, gA); TC_LOAD(vA, dA); } TC_STORE(dc); __syncthreads();
        if (gB >= TS_TOTAL) break;
        TC_LDSW(vB); __syncthreads(); dc = dB; gB += 2 * G; if (gB < TS_TOTAL) { dB = tdesc(p, gB); TC_LOAD(vB, dB); } TC_STORE(dc); __syncthreads();
    }
#undef TC_LOAD
#undef TC_LDSW
#undef TC_STORE
}

__device__ __forceinline__ void phase_prologue(const Params& p, char* lds) {
    const long gtid = (long)blockIdx.x * NTHR + TID(), gsz = (long)gridDim.x * NTHR;
    transpose_all(p, lds);
    for (long i = gtid; i < (long)DEPTH * (NIN - INT) * DM / 8; i += gsz) { const long per = (long)(NIN - INT) * DM / 8; const int l = (int)(i / per); const long r = i % per;
        *(u32x4*)(p.Wt_in + ((size_t)l * NIN + INT) * DM + r * 8) = (u32x4){0u, 0u, 0u, 0u}; }
    for (long i = gtid; i < (long)DEPTH * LRUB * 256 * 256; i += gsz) {
        const int k = (int)(i & 255), o = (int)((i >> 8) & 255), blk = (int)((i >> 16) & 15), l = (int)(i >> 20);
        const int kk = k - 128 * (blk & 1), cl = o >> 1; float v = 0.f;
        if (kk >= 0 && kk < 128) v = ((o & 1) ? p.w_ig : p.w_rg)[(((size_t)l * LRUB + blk) * LBD + kk) * LBD + cl];
        p.Wt_lru[i] = f2bf(v); }
    for (long i = gtid; i < (long)DEPTH * S * PLE / 8; i += gsz) { const float* s = p.p_in + i * 8; const f32x4 v0 = *(const f32x4*)s, v1 = *(const f32x4*)(s + 4);
        *(u32x4*)(p.pb + i * 8) = (u32x4){pk2(v0[0], v0[1]), pk2(v0[2], v0[3]), pk2(v1[0], v1[1]), pk2(v1[2], v1[3])}; }
    for (long i = gtid; i < (long)DEPTH * DM; i += gsz) p.nsp8[i] = -8.f * log1pf(expf(-p.lam[i]));
    for (long i = gtid; i < (long)S * 32; i += gsz) { const int s = (int)(i >> 5), f = (int)(i & 31);
        const float inv = powf(10000.f, -(float)(2 * f) / 64.f), ang = (float)p.pos[s] * inv;
        p.cs[(long)s * 64 + f] = (float)cos((double)ang); p.cs[(long)s * 64 + 32 + f] = (float)sin((double)ang); }
}

__device__ __forceinline__ void phase_xb_ssq(const float* __restrict__ x, u16* __restrict__ out, float* __restrict__ ssq) {
    const int tid = TID(), lane = tid & 63, gw = blockIdx.x * (NTHR / 64) + (tid >> 6), nw = gridDim.x * (NTHR / 64);
    for (int row = gw; row < S; row += nw) {
        const float* p = x + (long)row * DM; f32x4 v[8]; float s = 0.f;
#pragma unroll
        for (int j = 0; j < 8; ++j) { v[j] = *(const f32x4*)(p + j * 256 + lane * 4); s += v[j][0] * v[j][0] + v[j][1] * v[j][1] + v[j][2] * v[j][2] + v[j][3] * v[j][3]; }
        s = wsum(s, lane);
#pragma unroll
        for (int j = 0; j < 8; ++j) *(u32x2*)(out + (long)row * DM + j * 256 + lane * 4) = (u32x2){pk2(v[j][0], v[j][1]), pk2(v[j][2], v[j][3])};
        if (lane == 0) ssq[row] = s;
    }
}
__device__ __forceinline__ void phase_final_norm(float* __restrict__ x, const float* __restrict__ g) {
    const int tid = TID(), lane = tid & 63, gw = blockIdx.x * (NTHR / 64) + (tid >> 6), nw = gridDim.x * (NTHR / 64);
    for (int row = gw; row < S; row += nw) {
        float* p = x + (long)row * DM; f32x4 v[8]; float s = 0.f;
#pragma unroll
        for (int j = 0; j < 8; ++j) { v[j] = *(const f32x4*)(p + j * 256 + lane * 4); s += v[j][0] * v[j][0] + v[j][1] * v[j][1] + v[j][2] * v[j][2] + v[j][3] * v[j][3]; }
        s = wsum(s, lane); const float rinv = rsqrtf(s * (1.f / DM) + 1e-6f);
#pragma unroll
        for (int j = 0; j < 8; ++j) { const f32x4 gg = *(const f32x4*)(g + j * 256 + lane * 4); *(f32x4*)(p + j * 256 + lane * 4) = v[j] * rinv * gg; }
    }
}
__device__ __forceinline__ void t2_rows(const float* __restrict__ zA, const u16* __restrict__ zB, const float* __restrict__ cs, const float* __restrict__ cw, const float* __restrict__ cb,
                                        const float* __restrict__ gq, const float* __restrict__ gkv, u16* __restrict__ qn, u16* __restrict__ kvn, u16* __restrict__ Kf, u16* __restrict__ xc, float* __restrict__ ssqB) {
    const int tid = TID(), lane = tid & 63, gw = blockIdx.x * (NTHR / 64) + (tid >> 6), nw = gridDim.x * (NTHR / 64);
    for (int row = gw; row < S; row += nw) {
        const float* zr = zA + (long)row * ZA;
        f32x4 v[2][2];
#pragma unroll
        for (int part = 0; part < 2; ++part) { v[part][0] = *(const f32x4*)(zr + part * 512 + lane * 4); v[part][1] = *(const f32x4*)(zr + part * 512 + 256 + lane * 4); }
        const int l32 = lane & 31;
        const float x1 = zr[1024 + l32], x2 = zr[1056 + l32], cc = cs[(long)row * 64 + l32], sn = cs[(long)row * 64 + 32 + l32];
        u32x2 uu[8][4];
#pragma unroll
        for (int j = 0; j < 8; ++j)
#pragma unroll
            for (int k = 0; k < 4; ++k) { const int sp = row - 3 + k; uu[j][k] = (u32x2){0u, 0u}; if (sp >= 0) uu[j][k] = *(const u32x2*)(zB + (long)sp * ZB + 2048 + j * 256 + lane * 4); }
        if (lane == 0) ssqB[row] = 0.f;
#pragma unroll
        for (int part = 0; part < 2; ++part) {
            const float* g = part ? gkv : gq; u16* dst = (part ? kvn : qn) + (long)row * 512;
            const f32x4 v0 = v[part][0], v1 = v[part][1];
            float s = v0[0] * v0[0] + v0[1] * v0[1] + v0[2] * v0[2] + v0[3] * v0[3] + v1[0] * v1[0] + v1[1] * v1[1] + v1[2] * v1[2] + v1[3] * v1[3];
            s = wsum(s, lane); const float rinv = rsqrtf(s * (1.f / 512.f) + 1e-6f);
            const f32x4 g0 = *(const f32x4*)(g + lane * 4), g1 = *(const f32x4*)(g + 256 + lane * 4);
            *(u32x2*)(dst + lane * 4) = (u32x2){pk2(v0[0] * rinv * g0[0], v0[1] * rinv * g0[1]), pk2(v0[2] * rinv * g0[2], v0[3] * rinv * g0[3])};
            *(u32x2*)(dst + 256 + lane * 4) = (u32x2){pk2(v1[0] * rinv * g1[0], v1[1] * rinv * g1[1]), pk2(v1[2] * rinv * g1[2], v1[3] * rinv * g1[3])};
        }
        if (lane < 32) { const unsigned w = pk2(x1 * cc - x2 * sn, x2 * cc + x1 * sn);
#pragma unroll
            for (int hh = 0; hh < NH; ++hh) *(unsigned*)(Kf + ((long)hh * S + row) * QD + NOPE + 2 * lane) = w; }
#pragma unroll
        for (int j = 0; j < 8; ++j) { const int c = j * 256 + lane * 4; f32x4 y = *(const f32x4*)(cb + c);
#pragma unroll
            for (int k = 0; k < 4; ++k) { const f32x4 w = *(const f32x4*)(cw + k * DM + c); const u32x2 u2 = uu[j][k];
                y[0] += __uint_as_float(u2[0] << 16) * w[0]; y[1] += __uint_as_float(u2[0] & 0xffff0000u) * w[1]; y[2] += __uint_as_float(u2[1] << 16) * w[2]; y[3] += __uint_as_float(u2[1] & 0xffff0000u) * w[3]; }
            *(u32x2*)(xc + (long)row * DM + c) = (u32x2){pk2(y[0], y[1]), pk2(y[2], y[3])}; }
    }
}
__device__ __forceinline__ void phase_t2(const Params& p, int l) {
    t2_rows(p.zA, p.zB, p.cs, p.conv_w + (size_t)l * 4 * DM, p.conv_b + (size_t)l * DM, p.q_a_norm + l * 512, p.kv_a_norm + l * 512, p.qn, p.kvn, p.Kf, p.xc, p.ssqB);
}
__device__ __forceinline__ void phase_scan1(const Params& p) {
    float* Pc = p.carry; float* Hc = p.carry + 128 * DM;
    for (long i = (long)blockIdx.x * NTHR + TID(); i < 128L * DM; i += (long)gridDim.x * NTHR) {
        const int c = (int)(i % DM), ch = (int)(i / DM); float P = 1.f, H = 0.f;
        const float* pa = p.la + (long)ch * 64 * DM + c; const float* pb = p.lb + (long)ch * 64 * DM + c;
#pragma unroll 1
        for (int t0 = 0; t0 < 64; t0 += 16) { float a[16], b[16];
#pragma unroll
            for (int t = 0; t < 16; ++t) { a[t] = pa[(long)(t0 + t) * DM]; b[t] = pb[(long)(t0 + t) * DM]; }
#pragma unroll
            for (int t = 0; t < 16; ++t) { H = a[t] * H + b[t]; P *= a[t]; } }
        Pc[i] = P; Hc[i] = H; }
}
__device__ __forceinline__ void scan3_rows(const float* __restrict__ Pc, const float* __restrict__ Hc, const float* __restrict__ la, const float* __restrict__ lb, const u16* __restrict__ zB,
                                           u16* __restrict__ OH, float* __restrict__ ssqA) {
    for (long i = (long)blockIdx.x * NTHR + TID(); i < 128L * DM; i += (long)gridDim.x * NTHR) {
        if (i < S) ssqA[i] = 0.f;
        const int c = (int)(i % DM), ch = (int)(i / DM); float H = 0.f;
        int k = 0;
#pragma unroll 1
        for (; k + 16 <= ch; k += 16) { float a[16], b[16];
#pragma unroll
            for (int t = 0; t < 16; ++t) { a[t] = Pc[(long)(k + t) * DM + c]; b[t] = Hc[(long)(k + t) * DM + c]; }
#pragma unroll
            for (int t = 0; t < 16; ++t) H = a[t] * H + b[t]; }
        for (; k < ch; ++k) H = Pc[(long)k * DM + c] * H + Hc[(long)k * DM + c];
        const float* pa = la + (long)ch * 64 * DM + c; const float* pb = lb + (long)ch * 64 * DM + c;
        const u16* pg = zB + (long)ch * 64 * ZB + 4096 + c; u16* po = OH + (long)ch * 64 * 4096 + 2048 + c;
#pragma unroll
        for (int t0 = 0; t0 < 64; t0 += 16) { float a[16], b[16]; u16 g[16];
#pragma unroll
            for (int t = 0; t < 16; ++t) { a[t] = pa[(long)(t0 + t) * DM]; b[t] = pb[(long)(t0 + t) * DM]; g[t] = pg[(long)(t0 + t) * ZB]; }
#pragma unroll
            for (int t = 0; t < 16; ++t) { H = a[t] * H + b[t]; po[(long)(t0 + t) * 4096] = f2bf(H * bf2f(g[t])); } } }
}
__device__ __forceinline__ void phase_scan3(const Params& p) { scan3_rows(p.carry, p.carry + 128 * DM, p.la, p.lb, p.zB, p.OH, p.ssqA); }

typedef float f32x16 __attribute__((ext_vector_type(16)));
typedef short s16x4 __attribute__((ext_vector_type(4)));
constexpr int SHM_V = 64 * 128 * 2, SHM_K = 64 * 192 * 2, ATT_WS = 2 * SHM_V + 2 * SHM_K;
#define KSWZ(row, colB) ((row) * 384 + ((colB) ^ (((row) & 7) << 4)))
__device__ __forceinline__ int v_st(int k, int c) { const int kk = (k & ~0xC) | ((k & 4) << 1) | ((k & 8) >> 1); return ((kk >> 3) * 4 + (c >> 5)) * 512 + ((kk & 7) * 32 + (c & 31)) * 2; }
__device__ __forceinline__ int v_rd_base(int lane) { return ((lane & 3) << 3) | (((lane >> 2) & 3) << 6) | (((lane >> 4) & 1) << 5) | (((lane >> 5) & 1) << 8); }
constexpr int v_rd_off(int d0, int ks, int half) { return d0 * 512 + ks * 4096 + half * 2048; }
__device__ __forceinline__ int crow(int r, int hi) { return (r & 3) + 8 * (r >> 2) + 4 * hi; }
__device__ __forceinline__ unsigned cvtpk(float lo, float hi) { unsigned r; asm volatile("v_cvt_pk_bf16_f32 %0, %1, %2" : "=v"(r) : "v"(lo), "v"(hi)); return r; }

__device__ __forceinline__ void partialSM(f32x16& p0, f32x16& p1, float& m_reg, float& mn, float& alpha) {
    float pmax = p0[0];
#pragma unroll
    for (int r = 1; r < 16; ++r) pmax = fmaxf(pmax, p0[r]);
#pragma unroll
    for (int r = 0; r < 16; ++r) pmax = fmaxf(pmax, p1[r]);
    { auto rr = __builtin_amdgcn_permlane32_swap(__float_as_uint(pmax), __float_as_uint(pmax), false, false);
      pmax = fmaxf(__uint_as_float(rr[0]), __uint_as_float(rr[1])); }
    if (__builtin_expect(__all(pmax - m_reg <= 11.5f), 1)) { mn = m_reg; alpha = 1.f; }
    else { mn = fmaxf(m_reg, pmax); alpha = __builtin_amdgcn_exp2f(m_reg - mn); m_reg = mn; }
#pragma unroll
    for (int r = 0; r < 16; ++r) p0[r] = p0[r] - mn;
#pragma unroll
    for (int r = 0; r < 16; ++r) p1[r] = p1[r] - mn;
#pragma unroll
    for (int r = 0; r < 16; ++r) p0[r] = __builtin_amdgcn_exp2f(p0[r]);
}
__device__ __forceinline__ void finishSM(f32x16& p0, f32x16& p1, float alpha, float& l_reg, bf16x8& pa0, bf16x8& pa1, bf16x8& pa2, bf16x8& pa3) {
#pragma unroll
    for (int r = 0; r < 16; ++r) p1[r] = __builtin_amdgcn_exp2f(p1[r]);
    float ps = 0;
#pragma unroll
    for (int r = 0; r < 16; ++r) ps += p0[r];
#pragma unroll
    for (int r = 0; r < 16; ++r) ps += p1[r];
    { auto rr = __builtin_amdgcn_permlane32_swap(__float_as_uint(ps), __float_as_uint(ps), false, false);
      ps = __uint_as_float(rr[0]) + __uint_as_float(rr[1]); }
    l_reg = l_reg * alpha + ps;
#define PK4(P, B_, OUT) do { unsigned a0 = cvtpk(P[B_+0], P[B_+1]), a1 = cvtpk(P[B_+2], P[B_+3]);                          \
        unsigned b0 = cvtpk(P[B_+4], P[B_+5]), b1 = cvtpk(P[B_+6], P[B_+7]);                                             \
        auto r0 = __builtin_amdgcn_permlane32_swap(a0, b0, false, false); auto r1 = __builtin_amdgcn_permlane32_swap(a1, b1, false, false); \
        u32x4 w = {r0[0], r1[0], r0[1], r1[1]}; OUT = *reinterpret_cast<bf16x8*>(&w); } while (0)
    PK4(p0, 0, pa0); PK4(p0, 8, pa1); PK4(p1, 0, pa2); PK4(p1, 8, pa3);
#undef PK4
}
template <int KB>
__device__ __forceinline__ void qkt(f32x16& p0, f32x16& p1, LAS char* K_lds, int r32, int hi, const bf16x8* qr, bool act) {
    if (!act) { const float NEG = -__builtin_inff();
#pragma unroll
        for (int r = 0; r < 16; ++r) { p0[r] = NEG; p1[r] = NEG; } return; }
#pragma unroll
    for (int r = 0; r < 16; ++r) { p0[r] = 0.f; p1[r] = 0.f; }
    LAS char* kb[4];
#pragma unroll
    for (int dd = 0; dd < 4; ++dd) kb[dd] = K_lds + KB * SHM_K + KSWZ(r32, (dd * 16 + hi * 8) * 2);
#pragma unroll
    for (int d0 = 0; d0 < 12; ++d0) { LAS char* a = kb[d0 & 3] + (d0 >> 2) * 128;
        const bf16x8 b0 = *(const LAS bf16x8*)a;
        const bf16x8 b1 = *(const LAS bf16x8*)(a + 32 * 384);
        p0 = __builtin_amdgcn_mfma_f32_32x32x16_bf16(b0, qr[d0], p0, 0, 0, 0);
        p1 = __builtin_amdgcn_mfma_f32_32x32x16_bf16(b1, qr[d0], p1, 0, 0, 0); }
}
template <int VB>
__device__ __forceinline__ void pv_tile(f32x16* o, int vb0, bf16x8 pa0, bf16x8 pa1, bf16x8 pa2, bf16x8 pa3, bool act) {
    if (!act) return;
#define TRRD(dst, off) asm volatile("ds_read_b64_tr_b16 %0, %1 offset:%2" : "=&v"(dst) : "v"(vb0), "i"(off) : "memory")
#define PV_D0(d0) do { s16x4 l0, l1, l2, l3, h0, h1, h2, h3; constexpr int b_ = VB * SHM_V + v_rd_off(d0, 0, 0); \
        TRRD(l0, b_); TRRD(h0, b_ + 2048); TRRD(l1, b_ + 4096); TRRD(h1, b_ + 6144); TRRD(l2, b_ + 8192); TRRD(h2, b_ + 10240); TRRD(l3, b_ + 12288); TRRD(h3, b_ + 14336); \
        asm volatile("s_waitcnt lgkmcnt(0)" ::: "memory"); __builtin_amdgcn_sched_barrier(0); \
        o[d0] = __builtin_amdgcn_mfma_f32_32x32x16_bf16(pa0, (bf16x8){l0[0], l0[1], l0[2], l0[3], h0[0], h0[1], h0[2], h0[3]}, o[d0], 0, 0, 0);   \
        o[d0] = __builtin_amdgcn_mfma_f32_32x32x16_bf16(pa1, (bf16x8){l1[0], l1[1], l1[2], l1[3], h1[0], h1[1], h1[2], h1[3]}, o[d0], 0, 0, 0);   \
        o[d0] = __builtin_amdgcn_mfma_f32_32x32x16_bf16(pa2, (bf16x8){l2[0], l2[1], l2[2], l2[3], h2[0], h2[1], h2[2], h2[3]}, o[d0], 0, 0, 0);   \
        o[d0] = __builtin_amdgcn_mfma_f32_32x32x16_bf16(pa3, (bf16x8){l3[0], l3[1], l3[2], l3[3], h3[0], h3[1], h3[2], h3[3]}, o[d0], 0, 0, 0); } while (0)
    PV_D0(0); PV_D0(1); PV_D0(2); PV_D0(3);
#undef PV_D0
#undef TRRD
}

__device__ __forceinline__ void attn_block(char* lds, const u16* __restrict__ Qb, const u16* __restrict__ Kh, const u16* __restrict__ Vh,
                                           const u16* __restrict__ sg, u16* __restrict__ Ob, int P0) {
    const int tid = TID(), wid = __builtin_amdgcn_readfirstlane(tid >> 6), lane = tid & 63, r32 = lane & 31, hi = lane >> 5;
    const int NT = (P0 >> 6) + 4;
    const int wchunk = (P0 >> 6) + (wid >> 1);
    LAS char* L = (LAS char*)lds; LAS char* V_lds = L; LAS char* K_lds = L + 2 * SHM_V;
    LAS float* wsf = (LAS float*)(L + ATT_WS) + wid * 64; LAS float* li_l = wsf; LAS float* al_l = wsf + 32;
    float m_reg = -1e30f, l_reg = 0.f; f32x16 o[4];
#pragma unroll
    for (int d = 0; d < 4; ++d)
#pragma unroll
        for (int r = 0; r < 16; ++r) o[d][r] = 0.f;
    const int sr = tid >> 4, sc = (tid & 15) * 8, vst0 = v_st(sr, sc), vst1 = v_st(32 + sr, sc);
    const int kc0 = tid, kc1 = tid + 512, kc2 = tid + 1024;
    const int kws0 = KSWZ(kc0 / 24, (kc0 % 24) * 16), kws1 = KSWZ(kc1 / 24, (kc1 % 24) * 16), kws2 = KSWZ(kc2 / 24, (kc2 % 24) * 16);
    const int vb0 = (int)(unsigned)(uintptr_t)V_lds + v_rd_base(lane);
    bf16x8 qr[12];
#pragma unroll
    for (int d0 = 0; d0 < 12; ++d0) qr[d0] = *(const bf16x8*)(Qb + (long)(wid * 32 + r32) * NQ + d0 * 16 + hi * 8);
    bf16x8 st_k0, st_k1, st_k2, st_v0, st_v1;
#define VMW() asm volatile("s_waitcnt vmcnt(0)" ::: "memory")
#define SBAR() __builtin_amdgcn_sched_barrier(0)
#define SLOAD(t) do { const u16* kp_ = Kh + (long)(t) * 64 * QD + tid * 8; st_k0 = *(const bf16x8*)kp_; st_k1 = *(const bf16x8*)(kp_ + 4096); st_k2 = *(const bf16x8*)(kp_ + 8192); \
                      const u16* vp_ = Vh + ((long)(t) * 64 + sr) * VH + sc; st_v0 = *(const bf16x8*)vp_; st_v1 = *(const bf16x8*)(vp_ + 32 * VH); } while (0)
#define SWRITE(bf) do { *(LAS bf16x8*)(K_lds + (bf) * SHM_K + kws0) = st_k0; *(LAS bf16x8*)(K_lds + (bf) * SHM_K + kws1) = st_k1; *(LAS bf16x8*)(K_lds + (bf) * SHM_K + kws2) = st_k2; \
                        *(LAS bf16x8*)(V_lds + (bf) * SHM_V + vst0) = st_v0; *(LAS bf16x8*)(V_lds + (bf) * SHM_V + vst1) = st_v1; } while (0)
#define RESC(a) do { if (__any((a) < 1.f)) { if (hi == 0) al_l[r32] = (a); asm volatile("s_waitcnt lgkmcnt(0)" ::: "memory");              \
                     _Pragma("unroll") for (int d_ = 0; d_ < 4; ++d_) _Pragma("unroll") for (int r = 0; r < 16; ++r) o[d_][r] *= al_l[crow(r, hi)]; } } while (0)
#define ACT(t) ((t) <= wchunk)
    f32x16 pA0, pA1, pB0, pB1; float mnA, mnB, alA, alB; bf16x8 pa0, pa1, pa2, pa3;
    SLOAD(0); VMW(); SWRITE(0); SBAR();
    SLOAD(1);
    __syncthreads();
    SBAR(); qkt<0>(pA0, pA1, K_lds, r32, hi, qr, ACT(0));
    partialSM(pA0, pA1, m_reg, mnA, alA);
    VMW(); SWRITE(1);
    __syncthreads();
#define HALF_STEP(PX0, PX1, mnX, alX, PY0, PY1, alY, t, KB, VB, SB) do {                                                      \
        SBAR(); qkt<KB>(PX0, PX1, K_lds, r32, hi, qr, ACT(t));                                                                \
        finishSM(PY0, PY1, alY, l_reg, pa0, pa1, pa2, pa3); SBAR();                                                           \
        if ((t) + 1 < NT) { SLOAD((t) + 1); SBAR(); }                                                                          \
        pv_tile<VB>(o, vb0, pa0, pa1, pa2, pa3, ACT((t) - 1)); partialSM(PX0, PX1, m_reg, mnX, alX);                          \
        __syncthreads();                                                                                                      \
        if ((t) + 1 < NT) { VMW(); SWRITE(SB); }                                                                               \
        RESC(alX); __syncthreads(); } while (0)
    for (int t = 1; t + 1 < NT; t += 2) {
        HALF_STEP(pB0, pB1, mnB, alB, pA0, pA1, alA, t, 1, 0, 0);
        HALF_STEP(pA0, pA1, mnA, alA, pB0, pB1, alB, t + 1, 0, 1, 1);
    }
    SBAR(); qkt<1>(pB0, pB1, K_lds, r32, hi, qr, ACT(NT - 1)); SBAR();
    finishSM(pA0, pA1, alA, l_reg, pa0, pa1, pa2, pa3); SBAR();
    pv_tile<0>(o, vb0, pa0, pa1, pa2, pa3, ACT(NT - 2));
    partialSM(pB0, pB1, m_reg, mnB, alB); __syncthreads(); RESC(alB);
    finishSM(pB0, pB1, alB, l_reg, pa0, pa1, pa2, pa3); SBAR(); pv_tile<1>(o, vb0, pa0, pa1, pa2, pa3, ACT(NT - 1));
    SBAR();
    if (hi == 0) li_l[r32] = l_reg; asm volatile("s_waitcnt lgkmcnt(0)" ::: "memory");
    float rli[16];
#pragma unroll
    for (int r = 0; r < 16; ++r) rli[r] = __builtin_amdgcn_rcpf(li_l[crow(r, hi)]);
    const int xl = (lane ^ 1) << 2;
    unsigned gg[16][4];
#pragma unroll
    for (int r = 0; r < 16; ++r)
#pragma unroll
        for (int d0 = 0; d0 < 4; ++d0) gg[r][d0] = *(const unsigned*)(sg + (long)(wid * 32 + crow(r, hi)) * ZB + d0 * 32 + (r32 & ~1));
#pragma unroll
    for (int r = 0; r < 16; ++r) { const int orow = wid * 32 + crow(r, hi);
#pragma unroll
        for (int d0 = 0; d0 < 4; ++d0) { const float v = o[d0][r] * rli[r];
            const float vn = __int_as_float(__builtin_amdgcn_ds_bpermute(xl, __float_as_int(v)));
            const unsigned g = gg[r][d0];
            if ((r32 & 1) == 0) *(unsigned*)(Ob + (long)orow * 4096 + d0 * 32 + r32) = cvtpk(v * __uint_as_float(g << 16), vn * __uint_as_float(g & 0xffff0000u)); } }
    __syncthreads();
#undef VMW
#undef SBAR
#undef SLOAD
#undef SWRITE
#undef RESC
#undef ACT
#undef HALF_STEP
}
__device__ __forceinline__ void phase_attention(const Params& p, char* lds) {
    for (int it = blockIdx.x; it < 256; it += gridDim.x) {
        const int xcd = it & 7, idx = it >> 3, hh = xcd * 2 + (idx >> 4), x = idx & 15;
        for (int half = 0; half < 2; ++half) { const int P0 = (half ? x : 31 - x) * 256;
            attn_block(lds, p.Q + (long)P0 * NQ + hh * QD, p.Kf + (long)hh * S * QD, p.Vf + (long)hh * S * VH, p.zB + (long)P0 * ZB + hh * VH, p.OH + (long)P0 * 4096 + hh * VH, P0); }
    }
}

#ifndef PROBE_MASK
#define PROBE_MASK 0
#endif
#if PROBE_MASK
#define TICK(cls) do { const unsigned long long now_ = __builtin_amdgcn_s_memrealtime(); if ((PROBE_MASK >> (cls)) & 1) t_acc += now_ - t_last; t_last = now_; } while (0)
#else
#define TICK(cls) do { } while (0)
#endif
__global__ __launch_bounds__(NTHR, 2) void mega(Params p) {
    extern __shared__ __attribute__((aligned(16))) char lds[];
    cg::grid_group grid = cg::this_grid();
    const int G = gridDim.x;
    volatile LAS unsigned* xbst = (volatile LAS unsigned*)((LAS char*)lds + 8 * HTB);
    if (TID() == 0) { xbst[0] = 0u; xbst[1] = 0u; xbst[2] = 0u; xbst[3] = 0u; }
    __syncthreads();
    if (blockIdx.x == 0) for (int i = TID(); i < XCD_BAR_WORDS; i += NTHR) p.bar[i] = 0u;
#if PROBE_MASK
    unsigned long long t_acc = 0, t_last = __builtin_amdgcn_s_memrealtime();
#endif
    phase_prologue(p, lds);
    phase_xb_ssq(p.x_in, p.hb, p.ssqA);
    grid.sync();
    const XcdBarrier xb = xcd_barrier_post(p.bar, xbst);
    TICK(0);
    for (int l = 0; l < DEPTH; ++l) {
        const int c = (int)blockIdx.x + opaque_zero();
        const float* xcur = l ? p.xr : p.x_in;
        { TileSched sc{p.hb, DM, p.Wt_in + (size_t)l * NIN * DM, DM, 32, NIN / 256, G, c}; EpiIn e{p.zB, p.zA, p.ssqA}; gemm_fast(lds, DM, DM, DM, sc, e); }
        xcd_barrier(xb); TICK(2);
        phase_t2(p, l);
        xcd_barrier(xb); TICK(3);
        { TileSched sc{p.qn, QL, p.Wt_q + (size_t)l * NQ * QL, QL, 32, NQ / 256, G, c}; EpiQ e{p.Q, p.cs}; gemm_fast(lds, QL, QL, QL, sc, e); }
        { TileSched sc{p.kvn, KVL, p.Wt_kv + (size_t)l * NKV * KVL, KVL, 32, NKV / 256, G, (c + 128) % G}; EpiKV e{p.Kf, p.Vf}; gemm_fast(lds, KVL, KVL, KVL, sc, e); }
        { LruSched sc{{p.xc, DM, p.Wt_lru + (size_t)l * LRUB * 65536, 256, 32, LRUB, G, c}}; EpiLru e{p.xc, p.b_rg + l * DM, p.b_ig + l * DM, p.nsp8 + l * DM, p.la, p.lb}; gemm_fast(lds, 256, DM, 256, sc, e); }
        xcd_barrier(xb); TICK(4);
        phase_scan1(p);
        phase_attention(p, lds);
        xcd_barrier(xb); TICK(5);
        phase_scan3(p);
        xcd_barrier(xb); TICK(6);
        { MergeSched sc{{p.OH, 4096, p.Wt_o + (size_t)l * DM * 4096, 4096, 32, 8, G, c}}; EpiMerge e{p.zB, p.mg}; gemm_fast(lds, DM, 4096, 4096, sc, e); }
        xcd_barrier(xb); TICK(7);
        { TileSched sc{p.mg, DM, p.Wt_out + (size_t)l * DM * DM, DM, 32, 8, G, c}; EpiOut e{xcur, p.xr, p.hb2, p.ssqB}; gemm_fast(lds, DM, DM, DM, sc, e); }
        { TileSched sc{p.pb + (size_t)l * S * PLE, PLE, p.Wt_ple + (size_t)l * DM * PLE, PLE, 32, 8, G, c}; EpiF32 e{p.pp, DM}; gemm_fast(lds, PLE, PLE, PLE, sc, e); }
        xcd_barrier(xb); TICK(8);
        { TileSched sc{p.hb2, DM, p.Wt_pg + (size_t)l * DM * DM, DM, 32, 8, G, c}; EpiPle e{p.xr, p.pp, p.ssqB, p.hb, p.ssqA}; gemm_fast(lds, DM, DM, DM, sc, e); }
        xcd_barrier(xb); TICK(9);
    }
    phase_final_norm(p.xr, p.final_norm);
#if PROBE_MASK
    __syncthreads();
    if (blockIdx.x == 0) { const float d = sqrtf((float)t_acc * 0.01f * 4.096e-8f);
        for (int j = 0; j < 8; ++j) p.xr[threadIdx.x * 8 + j] += d; }
#endif
}

constexpr size_t LDS_BYTES = 8 * HTB + 16;

extern "C" void kernel_launch(void* const* d_in, const int* in_sizes, int n_in, void* d_out, int out_size, void* d_ws, size_t ws_size, hipStream_t st) {
    Params p{};
    p.x_in = (const float*)d_in[0]; p.p_in = (const float*)d_in[1]; p.pos = (const int*)d_in[2];
    p.attn_norm = (const float*)d_in[3]; p.w_in = (const float*)d_in[4]; p.q_a_norm = (const float*)d_in[5]; p.w_q_b = (const float*)d_in[6];
    p.kv_a_norm = (const float*)d_in[7]; p.w_kv_b = (const float*)d_in[8]; p.conv_w = (const float*)d_in[9]; p.conv_b = (const float*)d_in[10];
    p.w_rg = (const float*)d_in[11]; p.b_rg = (const float*)d_in[12]; p.w_ig = (const float*)d_in[13]; p.b_ig = (const float*)d_in[14]; p.lam = (const float*)d_in[15];
    p.w_o_mla = (const float*)d_in[16]; p.w_o_lru = (const float*)d_in[17]; p.w_out = (const float*)d_in[18]; p.ple_norm = (const float*)d_in[19];
    p.w_ple_gate = (const float*)d_in[20]; p.w_ple = (const float*)d_in[21]; p.final_norm = (const float*)d_in[22];
    p.xr = (float*)d_out;
    char* w = (char*)d_ws; size_t off = 0;
    auto take = [&](size_t bytes) { char* r = w + off; off += (bytes + 255) & ~(size_t)255; return r; };
    p.Wt_in = (u16*)take((size_t)DEPTH * NIN * DM * 2); p.Wt_q = (u16*)take((size_t)DEPTH * NQ * QL * 2); p.Wt_kv = (u16*)take((size_t)DEPTH * NKV * KVL * 2);
    p.Wt_lru = (u16*)take((size_t)DEPTH * LRUB * 65536 * 2); p.Wt_o = (u16*)take((size_t)DEPTH * DM * 4096 * 2); p.Wt_out = (u16*)take((size_t)DEPTH * DM * DM * 2);
    p.Wt_pg = (u16*)take((size_t)DEPTH * DM * DM * 2); p.Wt_ple = (u16*)take((size_t)DEPTH * DM * PLE * 2);
    p.hb = (u16*)take((size_t)S * DM * 2); p.hb2 = (u16*)take((size_t)S * DM * 2); p.ssqA = (float*)take((size_t)S * 4); p.ssqB = (float*)take((size_t)S * 4); p.zB = (u16*)take((size_t)S * ZB * 2); p.zA = (float*)take((size_t)S * ZA * 4);
    p.qn = (u16*)take((size_t)S * QL * 2); p.kvn = (u16*)take((size_t)S * KVL * 2); p.Q = (u16*)take((size_t)S * NQ * 2);
    p.Kf = (u16*)take((size_t)NH * S * QD * 2); p.Vf = (u16*)take((size_t)NH * S * VH * 2); p.xc = (u16*)take((size_t)S * DM * 2);
    p.OH = (u16*)take((size_t)S * 4096 * 2); p.pb = (u16*)take((size_t)DEPTH * S * PLE * 2); p.cs = (float*)take((size_t)S * 64 * 4); p.carry = (float*)take((size_t)3 * 128 * DM * 4); p.nsp8 = (float*)take((size_t)DEPTH * DM * 4); p.bar = (unsigned*)take((size_t)XCD_BAR_WORDS * 4);
    p.la = (float*)take((size_t)S * DM * 4); p.lb = (float*)take((size_t)S * DM * 4); p.pp = (float*)take((size_t)S * DM * 4); p.mg = (u16*)take((size_t)S * DM * 2);
    if (off > ws_size) { fprintf(stderr, "workspace too small: need %zu have %zu\n", off, ws_size); return; }
    (void)hipFuncSetAttribute((const void*)mega, hipFuncAttributeMaxDynamicSharedMemorySize, (int)LDS_BYTES);
    int dev = 0, cus = 0; (void)hipGetDevice(&dev); (void)hipDeviceGetAttribute(&cus, hipDeviceAttributeMultiprocessorCount, dev);
    int per_cu = 0; (void)hipOccupancyMaxActiveBlocksPerMultiprocessor(&per_cu, mega, NTHR, LDS_BYTES);
    if (per_cu < 1 || cus < 1) { fprintf(stderr, "occupancy query failed\n"); return; }
    void* args[] = {&p};
    hipError_t e = hipLaunchCooperativeKernel((const void*)mega, dim3(cus), dim3(NTHR), args, LDS_BYTES, st);
    if (e != hipSuccess) fprintf(stderr, "cooperative launch failed: %s\n", hipGetErrorString(e));
}
```

```cpp
#include <hip/hip_runtime.h>
#include <hip/hip_cooperative_groups.h>
#include <cstdio>
#include <cstdint>
namespace cg = cooperative_groups;

constexpr int S = 8192, DM = 2048, DEPTH = 4, NH = 16, QL = 512, KVL = 512, NOPE = 128, ROPE = 64, VH = 128;
constexpr int INT = 11328, PLE = 256, LRUB = 16, LBD = 128;
constexpr int QD = 192, NQ = NH * QD  , NKV = NH * 256  ;
constexpr int NIN = 11520;
constexpr int ZB = 10240, ZA = 1280;
constexpr int NTHR = 512;
constexpr float QSCALE = 0.07216878364870322f * 1.4426950408889634f;

typedef unsigned short u16;
typedef short bf16x8 __attribute__((ext_vector_type(8)));
typedef float f32x4 __attribute__((ext_vector_type(4)));
typedef float f32x2 __attribute__((ext_vector_type(2)));
typedef unsigned u32x2 __attribute__((ext_vector_type(2)));
typedef unsigned u32x4 __attribute__((ext_vector_type(4)));

__device__ __forceinline__ u16 f2bf(float f) { unsigned u = __float_as_uint(f); u += 0x7FFFu + ((u >> 16) & 1u); return (u16)(u >> 16); }
__device__ __forceinline__ float bf2f(u16 b) { return __uint_as_float(((unsigned)b) << 16); }
__device__ __forceinline__ unsigned pk2(float lo, float hi) { unsigned r; asm volatile("v_cvt_pk_bf16_f32 %0, %1, %2" : "=v"(r) : "v"(lo), "v"(hi)); return r; }
__device__ __forceinline__ float sigmoidf_(float x) { return __builtin_amdgcn_rcpf(1.f + __builtin_amdgcn_exp2f(-1.4426950408889634f * x)); }
__device__ __forceinline__ float siluf_(float x) { return x * __builtin_amdgcn_rcpf(1.f + __builtin_amdgcn_exp2f(-1.4426950408889634f * x)); }
__device__ __forceinline__ int opaque_zero() { int z; asm volatile("s_mov_b32 %0, 0" : "=s"(z)); return z; }
#define TID() ((int)threadIdx.x + opaque_zero())
__device__ __forceinline__ float wsum(float s, int lane) { for (int off = 32; off; off >>= 1) s += __int_as_float(__builtin_amdgcn_ds_bpermute((lane ^ off) << 2, __float_as_int(s))); return s; }
__device__ __forceinline__ float wmax(float s, int lane) { for (int off = 32; off; off >>= 1) s = fmaxf(s, __int_as_float(__builtin_amdgcn_ds_bpermute((lane ^ off) << 2, __float_as_int(s)))); return s; }

struct Params {
    const float *x_in, *p_in; const int* pos;
    const float *attn_norm, *w_in, *q_a_norm, *w_q_b, *kv_a_norm, *w_kv_b, *conv_w, *conv_b, *w_rg, *b_rg, *w_ig, *b_ig, *lam, *w_o_mla, *w_o_lru, *w_out, *ple_norm, *w_ple_gate, *w_ple, *final_norm;
    float* xr;
    u16 *Wt_in, *Wt_q, *Wt_kv, *Wt_lru, *Wt_o, *Wt_out, *Wt_pg, *Wt_ple;
    u16 *hb, *hb2, *zB, *qn, *kvn, *Q, *Kf, *Vf, *xc, *OH, *mg, *pb, *Pm;
    float *zA, *la, *lb, *pp, *cs, *carry, *sc, *nsp8, *ssqA, *ssqB; unsigned* bar;
};

struct Unit { const u16* a; const u16* b; int pm, pn, aux; };

struct TileSched {
    const u16* A; long lda; const u16* B; long ldb; int nM, nN, G, c;
    __device__ __forceinline__ bool tile(int i, int& pm, int& pn) const {
        const int nwg = nM * nN; const long L = (long)i * G + c; if (L >= nwg) return false;
        int wgid = (int)L; { const int q = nwg / 8, r = nwg % 8, xcd = wgid % 8, off = wgid / 8; wgid = (xcd < r ? xcd * (q + 1) : r * (q + 1) + (xcd - r) * q) + off; }
        const int nig = 8 * nN, gid = wgid / nig, fm = gid * 8, gsz = (nM - fm) < 8 ? (nM - fm) : 8;
        pm = fm + ((wgid % nig) % gsz); pn = (wgid % nig) / gsz; return true;
    }
    __device__ __forceinline__ bool next(int i, Unit& u) const {
        if (!tile(i, u.pm, u.pn)) return false;
        u.a = A + (long)u.pm * 256 * lda; u.b = B + (long)u.pn * 256 * ldb; u.aux = 0; return true;
    }
};
struct LruSched : TileSched {
    __device__ __forceinline__ bool next(int i, Unit& u) const {
        if (!tile(i, u.pm, u.pn)) return false;
        u.a = A + (long)u.pm * 256 * lda + (u.pn >> 1) * 256; u.b = B + (long)u.pn * 65536; u.aux = 0; return true;
    }
};
struct MergeSched : TileSched {
    __device__ __forceinline__ bool next(int i, Unit& u) const {
        if (!tile(i >> 1, u.pm, u.pn)) return false;
        u.aux = i & 1; u.a = A + (long)u.pm * 256 * lda + u.aux * 2048; u.b = B + (long)u.pn * 256 * ldb + u.aux * 2048; return true;
    }
};
struct TriSched {
    const u16* A; long lda; const u16* B; long ldb; int G, c;
    __device__ __forceinline__ bool next(int i, Unit& u) const {
        int t = i * G + c; if (t >= 528) return false;
        int pm = 0; while (t >= pm + 1) { t -= pm + 1; ++pm; }
        u.pm = pm; u.pn = t; u.a = A + (long)pm * 256 * lda; u.b = B + (long)t * 256 * ldb; u.aux = 0; return true;
    }
};
struct RowSched {
    const u16* A; long lda; const u16* B; int G, c;
    __device__ __forceinline__ bool next(int i, Unit& u) const {
        const int t = i * G + c; if (t >= 32) return false;
        u.pm = 31 - t; u.pn = 0; u.a = A + (long)u.pm * 256 * lda; u.b = B; u.aux = 0; return true;
    }
};

template <class F>
__device__ __forceinline__ void epi_foreach(f32x4 (&acc)[2][2][4][2], const Unit& u, int wr, int wc, int fr, int fq, F f) {
    const int row0 = u.pm * 256 + wr * 64 + fr, col0 = u.pn * 256 + wc * 32 + 4 * fq;
#pragma unroll
    for (int ai = 0; ai < 2; ++ai)
#pragma unroll
        for (int m = 0; m < 4; ++m) {
#pragma unroll
            for (int bj = 0; bj < 2; ++bj)
#pragma unroll
                for (int n = 0; n < 2; ++n) f(row0 + ai * 128 + m * 16, col0 + bj * 128 + n * 16, acc[ai][bj][m][n]);
        }
}
template <int GM, class T, class LF, class F>
__device__ __forceinline__ void epi_foreach_ld(f32x4 (&acc)[2][2][4][2], const Unit& u, int wr, int wc, int fr, int fq, LF lf, F f) {
    const int row0 = u.pm * 256 + wr * 64 + fr, col0 = u.pn * 256 + wc * 32 + 4 * fq;
#pragma unroll
    for (int ai = 0; ai < 2; ++ai)
#pragma unroll
        for (int mg = 0; mg < 4; mg += GM) {
            T regs[GM][2][2];
#pragma unroll
            for (int m = 0; m < GM; ++m)
#pragma unroll
                for (int bj = 0; bj < 2; ++bj)
#pragma unroll
                    for (int n = 0; n < 2; ++n) regs[m][bj][n] = lf(row0 + ai * 128 + (mg + m) * 16, col0 + bj * 128 + n * 16);
#pragma unroll
            for (int m = 0; m < GM; ++m)
#pragma unroll
                for (int bj = 0; bj < 2; ++bj)
#pragma unroll
                    for (int n = 0; n < 2; ++n) f(row0 + ai * 128 + (mg + m) * 16, col0 + bj * 128 + n * 16, acc[ai][bj][mg + m][n], regs[m][bj][n]);
        }
}
template <class F>
__device__ __forceinline__ void epi_foreach8(f32x4 (&acc)[2][2][4][2], const Unit& u, int wr, int wc, int fr, int fq, F f) {
    const int row0 = u.pm * 256 + wr * 64 + fr, col0 = u.pn * 256 + wc * 32 + 8 * fq;
#pragma unroll
    for (int ai = 0; ai < 2; ++ai)
#pragma unroll
        for (int m = 0; m < 4; ++m)
#pragma unroll
            for (int bj = 0; bj < 2; ++bj) f(row0 + ai * 128 + m * 16, col0 + bj * 128, acc[ai][bj][m][0], acc[ai][bj][m][1]);
}
template <class T, class LF, class F>
__device__ __forceinline__ void epi_foreach8_ld(f32x4 (&acc)[2][2][4][2], const Unit& u, int wr, int wc, int fr, int fq, LF lf, F f) {
    const int row0 = u.pm * 256 + wr * 64 + fr, col0 = u.pn * 256 + wc * 32 + 8 * fq;
#pragma unroll
    for (int ai = 0; ai < 2; ++ai) {
        T regs[4][2];
#pragma unroll
        for (int m = 0; m < 4; ++m)
#pragma unroll
            for (int bj = 0; bj < 2; ++bj) regs[m][bj] = lf(row0 + ai * 128 + m * 16, col0 + bj * 128);
#pragma unroll
        for (int m = 0; m < 4; ++m)
#pragma unroll
            for (int bj = 0; bj < 2; ++bj) f(row0 + ai * 128 + m * 16, col0 + bj * 128, acc[ai][bj][m][0], acc[ai][bj][m][1], regs[m][bj]);
    }
}
__device__ __forceinline__ u32x4 pack8(const f32x4& a, const f32x4& b) { return (u32x4){pk2(a[0], a[1]), pk2(a[2], a[3]), pk2(b[0], b[1]), pk2(b[2], b[3])}; }
#define EPI_COMMON  __device__ __forceinline__ bool keep(const Unit&) const { return false; } __device__ __forceinline__ int klimit(const Unit&, int K) const { return K; }
#define EPI_SIG     __device__ __forceinline__ void operator()(f32x4 (&acc)[2][2][4][2], const Unit& u, int wr, int wc, int fr, int fq) const

__device__ __forceinline__ float rinv_of(float ss) { return rsqrtf(ss * (1.f / DM) + 1e-6f); }
struct EpiIn { EPI_COMMON u16* zB; float* zA; const float* ssq;
    EPI_SIG { const int seg = u.pn >> 3;
        const int row0 = u.pm * 256 + wr * 64 + fr, col0 = u.pn * 256 + wc * 32 + 8 * fq;
        float ri[2][4];
#pragma unroll
        for (int ai = 0; ai < 2; ++ai)
#pragma unroll
            for (int m = 0; m < 4; ++m) ri[ai][m] = ssq[row0 + ai * 128 + m * 16];
#pragma unroll
        for (int ai = 0; ai < 2; ++ai)
#pragma unroll
            for (int m = 0; m < 4; ++m) ri[ai][m] = rinv_of(ri[ai][m]);
        if (seg >= 5) {
#pragma unroll
            for (int ai = 0; ai < 2; ++ai)
#pragma unroll
                for (int m = 0; m < 4; ++m)
#pragma unroll
                    for (int bj = 0; bj < 2; ++bj) { const int row = row0 + ai * 128 + m * 16, col = col0 + bj * 128;
                        if (col < ZB + 1088) { float* d = zA + (long)row * ZA + (col - ZB); *(f32x4*)d = acc[ai][bj][m][0] * ri[ai][m]; *(f32x4*)(d + 4) = acc[ai][bj][m][1] * ri[ai][m]; } }
        } else { const bool sil = seg == 0 || seg == 2, ident = seg == 1;
#pragma unroll
            for (int ai = 0; ai < 2; ++ai)
#pragma unroll
                for (int m = 0; m < 4; ++m)
#pragma unroll
                    for (int bj = 0; bj < 2; ++bj) { const int row = row0 + ai * 128 + m * 16, col = col0 + bj * 128;
                        f32x4 o0 = acc[ai][bj][m][0] * ri[ai][m], o1 = acc[ai][bj][m][1] * ri[ai][m];
                        if (!ident) {
#pragma unroll
                            for (int e = 0; e < 4; ++e) { const float s0 = sigmoidf_(o0[e]), s1 = sigmoidf_(o1[e]); o0[e] = sil ? o0[e] * s0 : s0; o1[e] = sil ? o1[e] * s1 : s1; } }
                        *(u32x4*)(zB + (long)row * ZB + col) = (u32x4){pk2(o0[0], o0[1]), pk2(o0[2], o0[3]), pk2(o1[0], o1[1]), pk2(o1[2], o1[3])}; }
        }
    } };
struct CsT { f32x4 c, s; };
struct EpiQ { EPI_COMMON u16* Q; const float* cs;
    EPI_SIG { epi_foreach8_ld<CsT>(acc, u, wr, wc, fr, fq,
            [&](int row, int col) { const int d = col % QD; CsT t; t.c = (f32x4){1.f, 1.f, 1.f, 1.f}; t.s = (f32x4){0.f, 0.f, 0.f, 0.f};
                if (d >= NOPE) { const float* tp = cs + (long)row * 64 + ((d - NOPE) >> 1); t.c = *(const f32x4*)tp; t.s = *(const f32x4*)(tp + 32); }
                return t; },
            [&](int row, int col, f32x4& v0, f32x4& v1, const CsT& t) { f32x4 o0, o1;
                const int d = col % QD;
                if (d < NOPE) { o0 = v0 * QSCALE; o1 = v1 * QSCALE; }
                else { o0[0] = (v0[0] * t.c[0] - v0[1] * t.s[0]) * QSCALE; o0[1] = (v0[1] * t.c[0] + v0[0] * t.s[0]) * QSCALE;
                       o0[2] = (v0[2] * t.c[1] - v0[3] * t.s[1]) * QSCALE; o0[3] = (v0[3] * t.c[1] + v0[2] * t.s[1]) * QSCALE;
                       o1[0] = (v1[0] * t.c[2] - v1[1] * t.s[2]) * QSCALE; o1[1] = (v1[1] * t.c[2] + v1[0] * t.s[2]) * QSCALE;
                       o1[2] = (v1[2] * t.c[3] - v1[3] * t.s[3]) * QSCALE; o1[3] = (v1[3] * t.c[3] + v1[2] * t.s[3]) * QSCALE; }
                *(u32x4*)(Q + (long)row * NQ + col) = pack8(o0, o1); }); } };
struct EpiKV { EPI_COMMON u16* Kf; u16* Vf;
    EPI_SIG { epi_foreach8(acc, u, wr, wc, fr, fq, [&](int row, int col, f32x4& v0, f32x4& v1) {
            const int hh = col >> 8, j = col & 255;
            u16* dst = (j < 128) ? Kf + ((long)hh * S + row) * QD + j : Vf + ((long)hh * S + row) * VH + (j - 128);
            *(u32x4*)dst = pack8(v0, v1);
        }); } };
struct EpiLru { EPI_COMMON const u16* xc; const float *brg, *big, *nsp8; float *la, *lb;
    EPI_SIG {
        const int row0 = u.pm * 256 + wr * 64 + fr, col0 = u.pn * 256 + wc * 32 + 4 * fq;
        f32x2 cr[2][2], ci[2][2], cn[2][2];
#pragma unroll
        for (int bj = 0; bj < 2; ++bj)
#pragma unroll
            for (int n = 0; n < 2; ++n) { const int ch = (col0 + bj * 128 + n * 16) >> 1; cr[bj][n] = *(const f32x2*)(brg + ch); ci[bj][n] = *(const f32x2*)(big + ch); cn[bj][n] = *(const f32x2*)(nsp8 + ch); }
#pragma unroll
        for (int ai = 0; ai < 2; ++ai) {
            unsigned xw[4][2][2];
#pragma unroll
            for (int m = 0; m < 4; ++m)
#pragma unroll
                for (int bj = 0; bj < 2; ++bj)
#pragma unroll
                    for (int n = 0; n < 2; ++n) xw[m][bj][n] = *(const unsigned*)(xc + (long)(row0 + ai * 128 + m * 16) * DM + ((col0 + bj * 128 + n * 16) >> 1));
#pragma unroll
            for (int m = 0; m < 4; ++m)
#pragma unroll
                for (int bj = 0; bj < 2; ++bj)
#pragma unroll
                    for (int n = 0; n < 2; ++n) {
                        const f32x4 v = acc[ai][bj][m][n]; const long o = (long)(row0 + ai * 128 + m * 16) * DM + ((col0 + bj * 128 + n * 16) >> 1);
                        f32x2 av, bv;
#pragma unroll
                        for (int e = 0; e < 2; ++e) {
                            const float r = sigmoidf_(v[2 * e] + cr[bj][n][e]), ii = sigmoidf_(v[2 * e + 1] + ci[bj][n][e]);
                            const float lg = r * cn[bj][n][e], x2 = 2.f * lg;
                            const float a = __builtin_amdgcn_exp2f(1.4426950408889634f * lg);
                            const float em = (x2 > -0.25f) ? x2 * (1.f + x2 * (0.5f + x2 * (0.16666667f + x2 * (0.041666668f + x2 * 0.0083333338f)))) : (a * a - 1.f);
                            const float x = e ? __uint_as_float(xw[m][bj][n] & 0xffff0000u) : __uint_as_float(xw[m][bj][n] << 16);
                            av[e] = a; bv[e] = __builtin_amdgcn_sqrtf(-em) * (ii * x); }
                        *(f32x2*)(la + o) = av; *(f32x2*)(lb + o) = bv; }
        }
    } };
struct SmSl { u32x4 sm, sl; };
__device__ __forceinline__ void unpack8(const u32x4& w, f32x4& a, f32x4& b) {
    a = (f32x4){__uint_as_float(w[0] << 16), __uint_as_float(w[0] & 0xffff0000u), __uint_as_float(w[1] << 16), __uint_as_float(w[1] & 0xffff0000u)};
    b = (f32x4){__uint_as_float(w[2] << 16), __uint_as_float(w[2] & 0xffff0000u), __uint_as_float(w[3] << 16), __uint_as_float(w[3] & 0xffff0000u)}; }
struct EpiMerge { const u16* zB; u16* mg;
    __device__ __forceinline__ bool keep(const Unit& u) const { return u.aux == 0; }
    __device__ __forceinline__ int klimit(const Unit&, int K) const { return K; }
    EPI_SIG { const int part = u.aux;
        epi_foreach8_ld<SmSl>(acc, u, wr, wc, fr, fq,
            [&](int row, int col) { SmSl t; t.sl = *(const u32x4*)(zB + (long)row * ZB + 8192 + col); t.sm = t.sl; if (part == 0) t.sm = *(const u32x4*)(zB + (long)row * ZB + 6144 + col); return t; },
            [&](int row, int col, f32x4& v0, f32x4& v1, const SmSl& t) {
            f32x4 l0, l1; unpack8(t.sl, l0, l1);
#pragma unroll
            for (int e = 0; e < 4; ++e) { l0[e] = fmaxf(l0[e], 1e-12f); l1[e] = fmaxf(l1[e], 1e-12f); }
            if (part == 0) { f32x4 m0, m1; unpack8(t.sm, m0, m1);
#pragma unroll
                for (int e = 0; e < 4; ++e) { v0[e] = v0[e] * m0[e] * __builtin_amdgcn_rcpf(l0[e]); v1[e] = v1[e] * m1[e] * __builtin_amdgcn_rcpf(l1[e]); }
            } else { *(u32x4*)(mg + (long)row * DM + col) = pack8(v0 * l0, v1 * l1); }
        }); } };
__device__ __forceinline__ void row_ssq_add(float sq, float* ssq, int row, int lane) {
    sq += __int_as_float(__builtin_amdgcn_ds_bpermute((lane ^ 16) << 2, __float_as_int(sq)));
    sq += __int_as_float(__builtin_amdgcn_ds_bpermute((lane ^ 32) << 2, __float_as_int(sq)));
    if (lane < 16) atomicAdd(ssq + row, sq);
}
struct EpiOut { EPI_COMMON const float* xold; float* xnew; u16* xb; float* ssq;
    EPI_SIG {
        const int row0 = u.pm * 256 + wr * 64 + fr, col0 = u.pn * 256 + wc * 32 + 4 * fq, lane = fq * 16 + fr;
#pragma unroll
        for (int ai = 0; ai < 2; ++ai) {
            f32x4 xo[4][2][2];
#pragma unroll
            for (int m = 0; m < 4; ++m)
#pragma unroll
                for (int bj = 0; bj < 2; ++bj)
#pragma unroll
                    for (int n = 0; n < 2; ++n) xo[m][bj][n] = *(const f32x4*)(xold + (long)(row0 + ai * 128 + m * 16) * DM + col0 + bj * 128 + n * 16);
#pragma unroll
            for (int m = 0; m < 4; ++m) { const int row = row0 + ai * 128 + m * 16; float sq = 0.f;
#pragma unroll
                for (int bj = 0; bj < 2; ++bj)
#pragma unroll
                    for (int n = 0; n < 2; ++n) { const f32x4 xv = xo[m][bj][n] + acc[ai][bj][m][n]; const long idx = (long)row * DM + col0 + bj * 128 + n * 16;
                        *(f32x4*)(xnew + idx) = xv; *(u32x2*)(xb + idx) = (u32x2){pk2(xv[0], xv[1]), pk2(xv[2], xv[3])};
                        sq += xv[0] * xv[0] + xv[1] * xv[1] + xv[2] * xv[2] + xv[3] * xv[3]; }
                row_ssq_add(sq, ssq, row, lane); }
        }
    } };
struct EpiF32 { EPI_COMMON float* C; long ldc;
    EPI_SIG { epi_foreach(acc, u, wr, wc, fr, fq, [&](int row, int col, f32x4& v) { *(f32x4*)(C + (long)row * ldc + col) = v; }); } };
struct EpiPle { EPI_COMMON float* x; const float* pp; const float* ssq_in; u16* xb; float* ssq_out;
    EPI_SIG {
        const int row0 = u.pm * 256 + wr * 64 + fr, col0 = u.pn * 256 + wc * 32 + 4 * fq, lane = fq * 16 + fr;
#pragma unroll
        for (int ai = 0; ai < 2; ++ai)
#pragma unroll
            for (int mg = 0; mg < 4; mg += 2) {
                f32x4 xo[2][2][2], po[2][2][2]; float ss[2];
#pragma unroll
                for (int m = 0; m < 2; ++m) { const int row = row0 + ai * 128 + (mg + m) * 16; ss[m] = ssq_in[row];
#pragma unroll
                    for (int bj = 0; bj < 2; ++bj)
#pragma unroll
                        for (int n = 0; n < 2; ++n) { const long idx = (long)row * DM + col0 + bj * 128 + n * 16; xo[m][bj][n] = *(const f32x4*)(x + idx); po[m][bj][n] = *(const f32x4*)(pp + idx); } }
#pragma unroll
                for (int m = 0; m < 2; ++m) { const int row = row0 + ai * 128 + (mg + m) * 16; const float ri = rinv_of(ss[m]); float sq = 0.f;
#pragma unroll
                    for (int bj = 0; bj < 2; ++bj)
#pragma unroll
                        for (int n = 0; n < 2; ++n) { f32x4 xv = xo[m][bj][n]; const f32x4 v = acc[ai][bj][mg + m][n]; const long idx = (long)row * DM + col0 + bj * 128 + n * 16;
#pragma unroll
                            for (int e = 0; e < 4; ++e) xv[e] += po[m][bj][n][e] * sigmoidf_(v[e] * ri);
                            *(f32x4*)(x + idx) = xv; *(u32x2*)(xb + idx) = (u32x2){pk2(xv[0], xv[1]), pk2(xv[2], xv[3])};
                            sq += xv[0] * xv[0] + xv[1] * xv[1] + xv[2] * xv[2] + xv[3] * xv[3]; }
                    row_ssq_add(sq, ssq_out, row, lane); }
            }
    } };

#define LAS __attribute__((address_space(3)))
constexpr int HTB = 128 * 64 * 2;
__device__ __forceinline__ int lds_byte(int r, int c) { const int st = (r >> 4) * 2 + (c >> 5), rr = r & 15, cc = c & 31, ob = rr * 64 + cc * 2; return st * 1024 + (ob ^ (((ob >> 9) & 1) << 5)); }
__device__ __forceinline__ void stage_rc(int b, int& R, int& C) { const int st = b / 1024, sb = b % 1024, swz = sb ^ (((sb >> 9) & 1) << 5); R = (st >> 1) * 16 + swz / 64; C = (st & 1) * 32 + (swz % 64) / 2; }

template <class Epi, class Sched>
__device__ __forceinline__ void gemm_fast(char* lds_, int K, long lda, long ldb, const Sched& S_, const Epi& E) {
    LAS unsigned char* lds = (LAS unsigned char*)lds_;
    const int tid = TID(), wid = __builtin_amdgcn_readfirstlane(tid >> 6), lane = tid & 63, wr = wid >> 2, wc = wid & 3, fr = lane & 15, fq = lane >> 4;
    const int nt = K / 64;
    unsigned voffA[2], voffB[2];
#pragma unroll
    for (int i = 0; i < 2; ++i) { int R, C; stage_rc(tid * 16 + i * 8192, R, C); voffA[i] = (unsigned)(R * lda + C) * 2u; voffB[i] = (unsigned)(R * ldb + C) * 2u; }
    const size_t kstep = 128;
    const size_t hstepA = (size_t)128 * lda * 2, hstepB = (size_t)128 * ldb * 2;
    const unsigned ldsw = (unsigned)wid * 1024u;
    const int aoff = lds_byte(wr * 64 + fr, fq * 8), boff = lds_byte(wc * 32 + fr, fq * 8);
#define G_SA(b, h) (((b) * 2 + (h)) * HTB)
#define G_SB(b, h) ((4 + (b) * 2 + (h)) * HTB)
#define G_STAGE(bufoff, gbase, voff) do { _Pragma("unroll") for (int _i = 0; _i < 2; ++_i) \
        __builtin_amdgcn_global_load_lds((const unsigned*)((const char*)(gbase) + (voff)[_i]), (LAS unsigned*)(lds + (bufoff) + ldsw + _i * 8192), 16, 0, 0); } while (0)
#define G_LDA(dst, b, h) do { _Pragma("unroll") for (int m = 0; m < 4; ++m) _Pragma("unroll") for (int k = 0; k < 2; ++k) dst[m][k] = *(const LAS bf16x8*)(lds + G_SA(b, h) + aoff + m * 2048 + k * 1024); } while (0)
#define G_LDB(dst, b, h) do { _Pragma("unroll") for (int n = 0; n < 2; ++n) _Pragma("unroll") for (int k = 0; k < 2; ++k) dst[n][k] = *(const LAS bf16x8*)(lds + G_SB(b, h) + boff + n * 2048 + k * 1024); } while (0)
#define G_MMA(ai, bj, At, Bt) do { __builtin_amdgcn_s_setprio(1); _Pragma("unroll") for (int m = 0; m < 4; ++m) _Pragma("unroll") for (int n = 0; n < 2; ++n) _Pragma("unroll") for (int k = 0; k < 2; ++k) \
        acc[ai][bj][m][n] = __builtin_amdgcn_mfma_f32_16x16x32_bf16(Bt[n][k], At[m][k], acc[ai][bj][m][n], 0, 0, 0); __builtin_amdgcn_s_setprio(0); } while (0)
#define G_WAIT_V(n) asm volatile("s_waitcnt vmcnt(" #n ")" ::: "memory")
#define G_WAIT_L(n) asm volatile("s_waitcnt lgkmcnt(" #n ")" ::: "memory")
#define G_BAR __builtin_amdgcn_s_barrier()
#define G_SCHED __builtin_amdgcn_sched_barrier(0)
    Unit cur, nxt; int ui = 0;
    if (!S_.next(0, cur)) return;
    f32x4 acc[2][2][4][2];
#pragma unroll
    for (int a = 0; a < 2; ++a)
#pragma unroll
        for (int b = 0; b < 2; ++b)
#pragma unroll
            for (int m = 0; m < 4; ++m)
#pragma unroll
                for (int n = 0; n < 2; ++n) acc[a][b][m][n] = (f32x4){0.f, 0.f, 0.f, 0.f};
    bf16x8 At[4][2], B0[2][2], B1[2][2];
    const char* cA = (const char*)cur.a; const char* cB = (const char*)cur.b;
    G_STAGE(G_SB(0, 0), cB, voffB); G_STAGE(G_SA(0, 0), cA, voffA); G_STAGE(G_SB(0, 1), cB + hstepB, voffB); G_STAGE(G_SA(0, 1), cA + hstepA, voffA);
    if (wr == 1) G_BAR;
    G_WAIT_V(4); G_BAR;
    G_STAGE(G_SB(1, 0), cB + kstep, voffB); G_STAGE(G_SA(1, 0), cA + kstep, voffA); G_STAGE(G_SB(1, 1), cB + hstepB + kstep, voffB);
    G_WAIT_V(6); G_BAR;
    for (;;) {
        const bool has_next = S_.next(ui + 1, nxt);
        const char* nA = has_next ? (const char*)nxt.a : cA; const char* nB = has_next ? (const char*)nxt.b : cB;
#pragma unroll 1
        for (int t = 0; t < nt; t += 2) {
            const bool last = (t == nt - 2);
            const char* a1 = cA + (size_t)(t + 1) * kstep;
            const char* a2 = last ? nA : cA + (size_t)(t + 2) * kstep; const char* b2 = last ? nB : cB + (size_t)(t + 2) * kstep;
            const char* a3 = a2 + kstep; const char* b3 = b2 + kstep;
            G_LDB(B0, 0, 0); G_SCHED; G_LDA(At, 0, 0); G_STAGE(G_SA(1, 1), a1 + hstepA, voffA);
            G_WAIT_L(8); G_BAR; G_WAIT_L(0); G_MMA(0, 0, At, B0); G_BAR; G_SCHED;
            G_LDB(B1, 0, 1); G_STAGE(G_SB(0, 0), b2, voffB);
            G_BAR; G_WAIT_L(0); G_MMA(0, 1, At, B1); G_BAR;
            G_LDA(At, 0, 1); G_STAGE(G_SA(0, 0), a2, voffA);
            G_BAR; G_WAIT_L(0); G_MMA(1, 0, At, B0); G_BAR; G_SCHED;
            G_STAGE(G_SB(0, 1), b2 + hstepB, voffB);
            G_WAIT_V(6); G_BAR; G_MMA(1, 1, At, B1); G_BAR;
            G_LDB(B0, 1, 0); G_SCHED; G_LDA(At, 1, 0); G_STAGE(G_SA(0, 1), a2 + hstepA, voffA);
            G_WAIT_L(8); G_BAR; G_WAIT_L(0); G_MMA(0, 0, At, B0); G_BAR; G_SCHED;
            G_LDB(B1, 1, 1); G_STAGE(G_SB(1, 0), b3, voffB);
            G_BAR; G_WAIT_L(0); G_MMA(0, 1, At, B1); G_BAR;
            G_LDA(At, 1, 1); G_STAGE(G_SA(1, 0), a3, voffA);
            G_BAR; G_WAIT_L(0); G_MMA(1, 0, At, B0); G_BAR; G_SCHED;
            G_STAGE(G_SB(1, 1), b3 + hstepB, voffB);
            G_WAIT_V(6); G_BAR; G_MMA(1, 1, At, B1); G_BAR;
        }
        { const int t2 = TID(), w2 = t2 >> 6, l2 = t2 & 63;
          E(acc, cur, w2 >> 2, w2 & 3, l2 & 15, l2 >> 4); }
        if (!has_next) break;
        if (!E.keep(cur)) {
#pragma unroll
            for (int a = 0; a < 2; ++a)
#pragma unroll
                for (int b = 0; b < 2; ++b)
#pragma unroll
                    for (int m = 0; m < 4; ++m)
#pragma unroll
                        for (int n = 0; n < 2; ++n) acc[a][b][m][n] = (f32x4){0.f, 0.f, 0.f, 0.f};
        }
        cur = nxt; cA = nA; cB = nB; ++ui;
    }
    G_WAIT_V(0);
    if (wr == 0) G_BAR;
    G_BAR;
#undef G_SA
#undef G_SB
#undef G_STAGE
#undef G_LDA
#undef G_LDB
#undef G_MMA
#undef G_WAIT_V
#undef G_WAIT_L
#undef G_BAR
#undef G_SCHED
}


#define XB_TMO      128
#define XB_XCNT(j)  (256  + 64 * (j))
#define XB_XSUB(j)  (1280 + 64 * (j))
#define XB_XGEN(j)  (2304 + 64 * (j))
#define XB_TOP      3328
#define XB_TOPGEN   3392
#define XCD_BAR_WORDS 3456
#define XB_SPIN_CAP (1u << 18)
__device__ __forceinline__ unsigned xb_ld(unsigned* p)              { return __hip_atomic_load(p, __ATOMIC_RELAXED, __HIP_MEMORY_SCOPE_AGENT); }
__device__ __forceinline__ unsigned xb_add(unsigned* p, unsigned v) { return __hip_atomic_fetch_add(p, v, __ATOMIC_RELAXED, __HIP_MEMORY_SCOPE_AGENT); }
__device__ __forceinline__ unsigned xb_xcc_id() { return (unsigned)__builtin_amdgcn_s_getreg((3 << 11) | 20) & 0xFu; }
#define XB_SPIN(cond, bar) do { unsigned _sp = 0; while (cond) { __builtin_amdgcn_s_sleep(1); \
    if ((++_sp & 255u) == 0u) { if (xb_ld(&(bar)[XB_TMO])) break; if (_sp > XB_SPIN_CAP) { atomicAdd(&(bar)[XB_TMO], 1u); break; } } } } while (0)
struct XcdBarrier { unsigned* bar; unsigned x; volatile LAS unsigned* st; };
__device__ __forceinline__ XcdBarrier xcd_barrier_post(unsigned* bar, volatile LAS unsigned* st) {
    XcdBarrier b; b.bar = bar; b.x = xb_xcc_id(); b.st = st;
    if (TID() == 0) (void)xb_add(&bar[XB_XCNT(b.x)], 1u);
    return b;
}
__device__ __forceinline__ void xcd_barrier_complete(unsigned* bar, unsigned x, unsigned& nloc, unsigned& nx) {
    const unsigned G = gridDim.x * gridDim.y * gridDim.z;
    unsigned sum, cnt, mine, sp = 0u;
    for (;;) {
        sum = 0u; cnt = 0u; mine = 0u;
#pragma unroll
        for (unsigned j = 0; j < 16; ++j) { const unsigned c = xb_ld(&bar[XB_XCNT(j)]); sum += c; cnt += (c > 0u) ? 1u : 0u; mine = (j == x) ? c : mine; }
        if (sum == G) break;
        __builtin_amdgcn_s_sleep(1);
        if ((++sp & 255u) == 0u) { if (xb_ld(&bar[XB_TMO])) break; if (sp > XB_SPIN_CAP) { atomicAdd(&bar[XB_TMO], 1u); break; } }
    }
    nloc = mine > 0u ? mine : 1u; nx = cnt > 0u ? cnt : 1u;
}
__device__ __forceinline__ void xcd_barrier(const XcdBarrier& b) {
    asm volatile("s_waitcnt vmcnt(0)" ::: "memory");
    __syncthreads();
    if (TID() == 0) {
        unsigned* bar = b.bar;
        __builtin_amdgcn_s_waitcnt(0);
        unsigned nloc = b.st[0], nx = b.st[1];
        if (nloc == 0u) { xcd_barrier_complete(bar, b.x, nloc, nx); b.st[0] = nloc; b.st[1] = nx; }
        const unsigned old = xb_add(&bar[XB_XSUB(b.x)], 1u);
        const unsigned gen = old / nloc;
        if (old + 1u == (gen + 1u) * nloc) {
            __builtin_amdgcn_fence(__ATOMIC_RELEASE, "agent");
            asm volatile("s_waitcnt vmcnt(0)" ::: "memory");
            const unsigned og = xb_add(&bar[XB_TOP], 1u);
            const unsigned tg = og / nx;
            if (og + 1u == (tg + 1u) * nx) xb_add(&bar[XB_TOPGEN], 1u);
            else XB_SPIN(xb_ld(&bar[XB_TOPGEN]) == tg, bar);
            __builtin_amdgcn_fence(__ATOMIC_ACQUIRE, "agent");
            xb_add(&bar[XB_XGEN(b.x)], 1u);
            asm volatile("s_waitcnt vmcnt(0)" ::: "memory");
        } else {
            XB_SPIN(xb_ld(&bar[XB_XGEN(b.x)]) == gen, bar);
            __builtin_amdgcn_fence(__ATOMIC_ACQUIRE, "agent");
            asm volatile("s_waitcnt vmcnt(0)" ::: "memory");
        }
    }
    __syncthreads();
}

struct TDesc { const float* src; const float* ks; u16* dst; long ldd; int N, coff, rm, tix; };
constexpr int TS_IN = (DM / 256) * (INT / 64), TS_Q = (QL / 256) * (NQ / 64), TS_KV = (KVL / 256) * (NKV / 64), TS_SQ = (DM / 256) * (DM / 64), TS_PLE = (PLE / 256) * (DM / 64);
constexpr int TS_LAYER = TS_IN + TS_Q + TS_KV + 4 * TS_SQ + TS_PLE, TS_TOTAL = DEPTH * TS_LAYER;
__device__ __forceinline__ TDesc tdesc(const Params& p, int g) {
    const int l = g / TS_LAYER; int r = g % TS_LAYER; TDesc d; d.ks = nullptr; d.coff = 0; d.rm = 0;
    if (r < TS_IN) { d.src = p.w_in + (size_t)l * DM * INT; d.N = INT; d.dst = p.Wt_in + (size_t)l * NIN * DM; d.ldd = DM; d.rm = 1; d.ks = p.attn_norm + l * DM; d.tix = r; return d; }
    r -= TS_IN;
    if (r < TS_Q) { d.src = p.w_q_b + (size_t)l * QL * NQ; d.N = NQ; d.dst = p.Wt_q + (size_t)l * NQ * QL; d.ldd = QL; d.rm = 2; d.tix = r; return d; }
    r -= TS_Q;
    if (r < TS_KV) { d.src = p.w_kv_b + (size_t)l * KVL * NKV; d.N = NKV; d.dst = p.Wt_kv + (size_t)l * NKV * KVL; d.ldd = KVL; d.rm = 3; d.tix = r; return d; }
    r -= TS_KV;
    if (r < TS_SQ) { d.src = p.w_o_mla + (size_t)l * DM * DM; d.N = DM; d.dst = p.Wt_o + (size_t)l * DM * 4096; d.ldd = 4096; d.rm = 3; d.tix = r; return d; }
    r -= TS_SQ;
    if (r < TS_SQ) { d.src = p.w_o_lru + (size_t)l * DM * DM; d.N = DM; d.dst = p.Wt_o + (size_t)l * DM * 4096; d.ldd = 4096; d.coff = 2048; d.rm = 3; d.tix = r; return d; }
    r -= TS_SQ;
    if (r < TS_SQ) { d.src = p.w_out + (size_t)l * DM * DM; d.N = DM; d.dst = p.Wt_out + (size_t)l * DM * DM; d.ldd = DM; d.tix = r; return d; }
    r -= TS_SQ;
    if (r < TS_SQ) { d.src = p.w_ple_gate + (size_t)l * DM * DM; d.N = DM; d.dst = p.Wt_pg + (size_t)l * DM * DM; d.ldd = DM; d.ks = p.ple_norm + l * DM; d.tix = r; return d; }
    r -= TS_SQ;
    d.src = p.w_ple + (size_t)l * PLE * DM; d.N = DM; d.dst = p.Wt_ple + (size_t)l * DM * PLE; d.ldd = PLE; d.tix = r; return d;
}
__device__ __forceinline__ int pslot(int r) { const int c = r & 31; return (r & ~31) + 16 * ((c >> 2) & 1) + ((c >> 3) << 2) + (c & 3); }
__device__ __forceinline__ int trowmap(int rm, int n) {
    if (rm == 1) return pslot(n >= 1088 ? n - 1088 : n + ZB);
    if (rm == 2) { const int hh = n / QD, d = n % QD; if (d < NOPE) return pslot(n); const int e = d - NOPE; return pslot(hh * QD + NOPE + ((e & 31) << 1) + (e >> 5)); }
    if (rm == 3) return pslot(n);
    return n;
}
__device__ __forceinline__ void transpose_all(const Params& p, char* lds) {
    u16 (*t)[72] = (u16(*)[72])lds;
    const int tid = TID(), k = tid >> 3, nn = (tid & 7) * 8, G = gridDim.x;
    f32x4 vA[4][2], vB[4][2];
#define TC_LOAD(v_, d_) do { const int tn_ = (d_).N / 64, k0_ = ((d_).tix / tn_) * 256, n0_ = ((d_).tix % tn_) * 64; _Pragma("unroll") for (int j = 0; j < 4; ++j) { \
        const float* p_ = (d_).src + (long)(k0_ + k + 64 * j) * (d_).N + n0_ + nn; v_[j][0] = *(const f32x4*)p_; v_[j][1] = *(const f32x4*)(p_ + 4); \
        if ((d_).ks) { const float g_ = (d_).ks[k0_ + k + 64 * j]; v_[j][0] = v_[j][0] * g_; v_[j][1] = v_[j][1] * g_; } } } while (0)
#define TC_LDSW(v_) do { _Pragma("unroll") for (int j = 0; j < 4; ++j) *(u32x4*)&t[k + 64 * j][nn ^ (((k >> 3) & 7) << 3)] = (u32x4){pk2(v_[j][0][0], v_[j][0][1]), pk2(v_[j][0][2], v_[j][0][3]), pk2(v_[j][1][0], v_[j][1][1]), pk2(v_[j][1][2], v_[j][1][3])}; } while (0)
#define TC_STORE(d_) do { const int tn_ = (d_).N / 64, k0_ = ((d_).tix / tn_) * 256, n0_ = ((d_).tix % tn_) * 64; const int n_ = tid >> 3, kk_ = (tid & 7) * 8; \
        u16* drow_ = (d_).dst + (long)trowmap((d_).rm, n0_ + n_) * (d_).ldd + (d_).coff + k0_ + kk_; \
        _Pragma("unroll") for (int j = 0; j < 4; ++j) { u32x4 o_; _Pragma("unroll") for (int e = 0; e < 4; ++e) o_[e] = (unsigned)t[64 * j + kk_ + 2 * e][n_ ^ kk_] | ((unsigned)t[64 * j + kk_ + 2 * e + 1][n_ ^ kk_] << 16); \
            *(u32x4*)(drow_ + 64 * j) = o_; } } while (0)
    int gA = blockIdx.x, gB = gA + G; TDesc dA, dB, dc;
    if (gA < TS_TOTAL) { dA = tdesc(p, gA); TC_LOAD(vA, dA); }
    if (gB < TS_TOTAL) { dB = tdesc(p, gB); TC_LOAD(vB, dB); }
    while (gA < TS_TOTAL) {
        TC_LDSW(vA); __syncthreads(); dc = dA; gA += 2 * G; if (gA < TS_TOTAL) { dA = tdesc(p, gA); TC_LOAD(vA, dA); } TC_STORE(dc); __syncthreads();
        if (gB >= TS_TOTAL) break;
        TC_LDSW(vB); __syncthreads(); dc = dB; gB += 2 * G; if (gB < TS_TOTAL) { dB = tdesc(p, gB); TC_LOAD(vB, dB); } TC_STORE(dc); __syncthreads();
    }
#undef TC_LOAD
#undef TC_LDSW
#undef TC_STORE
}

__device__ __forceinline__ void phase_prologue(const Params& p, char* lds) {
    const long gtid = (long)blockIdx.x * NTHR + TID(), gsz = (long)gridDim.x * NTHR;
    transpose_all(p, lds);
    for (long i = gtid; i < (long)DEPTH * (NIN - INT) * DM / 8; i += gsz) { const long per = (long)(NIN - INT) * DM / 8; const int l = (int)(i / per); const long r = i % per;
        *(u32x4*)(p.Wt_in + ((size_t)l * NIN + INT) * DM + r * 8) = (u32x4){0u, 0u, 0u, 0u}; }
    for (long i = gtid; i < (long)DEPTH * LRUB * 256 * 256; i += gsz) {
        const int k = (int)(i & 255), o = (int)((i >> 8) & 255), blk = (int)((i >> 16) & 15), l = (int)(i >> 20);
        const int kk = k - 128 * (blk & 1), cl = o >> 1; float v = 0.f;
        if (kk >= 0 && kk < 128) v = ((o & 1) ? p.w_ig : p.w_rg)[(((size_t)l * LRUB + blk) * LBD + kk) * LBD + cl];
        p.Wt_lru[i] = f2bf(v); }
    for (long i = gtid; i < (long)DEPTH * S * PLE / 8; i += gsz) { const float* s = p.p_in + i * 8; const f32x4 v0 = *(const f32x4*)s, v1 = *(const f32x4*)(s + 4);
        *(u32x4*)(p.pb + i * 8) = (u32x4){pk2(v0[0], v0[1]), pk2(v0[2], v0[3]), pk2(v1[0], v1[1]), pk2(v1[2], v1[3])}; }
    for (long i = gtid; i < (long)DEPTH * DM; i += gsz) p.nsp8[i] = -8.f * log1pf(expf(-p.lam[i]));
    for (long i = gtid; i < (long)S * 32; i += gsz) { const int s = (int)(i >> 5), f = (int)(i & 31);
        const float inv = powf(10000.f, -(float)(2 * f) / 64.f), ang = (float)p.pos[s] * inv;
        p.cs[(long)s * 64 + f] = (float)cos((double)ang); p.cs[(long)s * 64 + 32 + f] = (float)sin((double)ang); }
}

__device__ __forceinline__ void phase_xb_ssq(const float* __restrict__ x, u16* __restrict__ out, float* __restrict__ ssq) {
    const int tid = TID(), lane = tid & 63, gw = blockIdx.x * (NTHR / 64) + (tid >> 6), nw = gridDim.x * (NTHR / 64);
    for (int row = gw; row < S; row += nw) {
        const float* p = x + (long)row * DM; f32x4 v[8]; float s = 0.f;
#pragma unroll
        for (int j = 0; j < 8; ++j) { v[j] = *(const f32x4*)(p + j * 256 + lane * 4); s += v[j][0] * v[j][0] + v[j][1] * v[j][1] + v[j][2] * v[j][2] + v[j][3] * v[j][3]; }
        s = wsum(s, lane);
#pragma unroll
        for (int j = 0; j < 8; ++j) *(u32x2*)(out + (long)row * DM + j * 256 + lane * 4) = (u32x2){pk2(v[j][0], v[j][1]), pk2(v[j][2], v[j][3])};
        if (lane == 0) ssq[row] = s;
    }
}
__device__ __forceinline__ void phase_final_norm(float* __restrict__ x, const float* __restrict__ g) {
    const int tid = TID(), lane = tid & 63, gw = blockIdx.x * (NTHR / 64) + (tid >> 6), nw = gridDim.x * (NTHR / 64);
    for (int row = gw; row < S; row += nw) {
        float* p = x + (long)row * DM; f32x4 v[8]; float s = 0.f;
#pragma unroll
        for (int j = 0; j < 8; ++j) { v[j] = *(const f32x4*)(p + j * 256 + lane * 4); s += v[j][0] * v[j][0] + v[j][1] * v[j][1] + v[j][2] * v[j][2] + v[j][3] * v[j][3]; }
        s = wsum(s, lane); const float rinv = rsqrtf(s * (1.f / DM) + 1e-6f);
#pragma unroll
        for (int j = 0; j < 8; ++j) { const f32x4 gg = *(const f32x4*)(g + j * 256 + lane * 4); *(f32x4*)(p + j * 256 + lane * 4) = v[j] * rinv * gg; }
    }
}
__device__ __forceinline__ void t2_rows(const float* __restrict__ zA, const u16* __restrict__ zB, const float* __restrict__ cs, const float* __restrict__ cw, const float* __restrict__ cb,
                                        const float* __restrict__ gq, const float* __restrict__ gkv, u16* __restrict__ qn, u16* __restrict__ kvn, u16* __restrict__ Kf, u16* __restrict__ xc, float* __restrict__ ssqB) {
    const int tid = TID(), lane = tid & 63, gw = blockIdx.x * (NTHR / 64) + (tid >> 6), nw = gridDim.x * (NTHR / 64);
    for (int row = gw; row < S; row += nw) {
        const float* zr = zA + (long)row * ZA;
        f32x4 v[2][2];
#pragma unroll
        for (int part = 0; part < 2; ++part) { v[part][0] = *(const f32x4*)(zr + part * 512 + lane * 4); v[part][1] = *(const f32x4*)(zr + part * 512 + 256 + lane * 4); }
        const int l32 = lane & 31;
        const float x1 = zr[1024 + l32], x2 = zr[1056 + l32], cc = cs[(long)row * 64 + l32], sn = cs[(long)row * 64 + 32 + l32];
        u32x2 uu[8][4];
#pragma unroll
        for (int j = 0; j < 8; ++j)
#pragma unroll
            for (int k = 0; k < 4; ++k) { const int sp = row - 3 + k; uu[j][k] = (u32x2){0u, 0u}; if (sp >= 0) uu[j][k] = *(const u32x2*)(zB + (long)sp * ZB + 2048 + j * 256 + lane * 4); }
        if (lane == 0) ssqB[row] = 0.f;
#pragma unroll
        for (int part = 0; part < 2; ++part) {
            const float* g = part ? gkv : gq; u16* dst = (part ? kvn : qn) + (long)row * 512;
            const f32x4 v0 = v[part][0], v1 = v[part][1];
            float s = v0[0] * v0[0] + v0[1] * v0[1] + v0[2] * v0[2] + v0[3] * v0[3] + v1[0] * v1[0] + v1[1] * v1[1] + v1[2] * v1[2] + v1[3] * v1[3];
            s = wsum(s, lane); const float rinv = rsqrtf(s * (1.f / 512.f) + 1e-6f);
            const f32x4 g0 = *(const f32x4*)(g + lane * 4), g1 = *(const f32x4*)(g + 256 + lane * 4);
            *(u32x2*)(dst + lane * 4) = (u32x2){pk2(v0[0] * rinv * g0[0], v0[1] * rinv * g0[1]), pk2(v0[2] * rinv * g0[2], v0[3] * rinv * g0[3])};
            *(u32x2*)(dst + 256 + lane * 4) = (u32x2){pk2(v1[0] * rinv * g1[0], v1[1] * rinv * g1[1]), pk2(v1[2] * rinv * g1[2], v1[3] * rinv * g1[3])};
        }
        if (lane < 32) { const unsigned w = pk2(x1 * cc - x2 * sn, x2 * cc + x1 * sn);
#pragma unroll
            for (int hh = 0; hh < NH; ++hh) *(unsigned*)(Kf + ((long)hh * S + row) * QD + NOPE + 2 * lane) = w; }
#pragma unroll
        for (int j = 0; j < 8; ++j) { const int c = j * 256 + lane * 4; f32x4 y = *(const f32x4*)(cb + c);
#pragma unroll
            for (int k = 0; k < 4; ++k) { const f32x4 w = *(const f32x4*)(cw + k * DM + c); const u32x2 u2 = uu[j][k];
                y[0] += __uint_as_float(u2[0] << 16) * w[0]; y[1] += __uint_as_float(u2[0] & 0xffff0000u) * w[1]; y[2] += __uint_as_float(u2[1] << 16) * w[2]; y[3] += __uint_as_float(u2[1] & 0xffff0000u) * w[3]; }
            *(u32x2*)(xc + (long)row * DM + c) = (u32x2){pk2(y[0], y[1]), pk2(y[2], y[3])}; }
    }
}
__device__ __forceinline__ void phase_t2(const Params& p, int l) {
    t2_rows(p.zA, p.zB, p.cs, p.conv_w + (size_t)l * 4 * DM, p.conv_b + (size_t)l * DM, p.q_a_norm + l * 512, p.kv_a_norm + l * 512, p.qn, p.kvn, p.Kf, p.xc, p.ssqB);
}
__device__ __forceinline__ void phase_scan1(const Params& p) {
    float* Pc = p.carry; float* Hc = p.carry + 128 * DM;
    for (long i = (long)blockIdx.x * NTHR + TID(); i < 128L * DM; i += (long)gridDim.x * NTHR) {
        const int c = (int)(i % DM), ch = (int)(i / DM); float P = 1.f, H = 0.f;
        const float* pa = p.la + (long)ch * 64 * DM + c; const float* pb = p.lb + (long)ch * 64 * DM + c;
#pragma unroll 1
        for (int t0 = 0; t0 < 64; t0 += 16) { float a[16], b[16];
#pragma unroll
            for (int t = 0; t < 16; ++t) { a[t] = pa[(long)(t0 + t) * DM]; b[t] = pb[(long)(t0 + t) * DM]; }
#pragma unroll
            for (int t = 0; t < 16; ++t) { H = a[t] * H + b[t]; P *= a[t]; } }
        Pc[i] = P; Hc[i] = H; }
}
__device__ __forceinline__ void scan3_rows(const float* __restrict__ Pc, const float* __restrict__ Hc, const float* __restrict__ la, const float* __restrict__ lb, const u16* __restrict__ zB,
                                           u16* __restrict__ OH, float* __restrict__ ssqA) {
    for (long i = (long)blockIdx.x * NTHR + TID(); i < 128L * DM; i += (long)gridDim.x * NTHR) {
        if (i < S) ssqA[i] = 0.f;
        const int c = (int)(i % DM), ch = (int)(i / DM); float H = 0.f;
        int k = 0;
#pragma unroll 1
        for (; k + 16 <= ch; k += 16) { float a[16], b[16];
#pragma unroll
            for (int t = 0; t < 16; ++t) { a[t] = Pc[(long)(k + t) * DM + c]; b[t] = Hc[(long)(k + t) * DM + c]; }
#pragma unroll
            for (int t = 0; t < 16; ++t) H = a[t] * H + b[t]; }
        for (; k < ch; ++k) H = Pc[(long)k * DM + c] * H + Hc[(long)k * DM + c];
        const float* pa = la + (long)ch * 64 * DM + c; const float* pb = lb + (long)ch * 64 * DM + c;
        const u16* pg = zB + (long)ch * 64 * ZB + 4096 + c; u16* po = OH + (long)ch * 64 * 4096 + 2048 + c;
#pragma unroll
        for (int t0 = 0; t0 < 64; t0 += 16) { float a[16], b[16]; u16 g[16];
#pragma unroll
            for (int t = 0; t < 16; ++t) { a[t] = pa[(long)(t0 + t) * DM]; b[t] = pb[(long)(t0 + t) * DM]; g[t] = pg[(long)(t0 + t) * ZB]; }
#pragma unroll
            for (int t = 0; t < 16; ++t) { H = a[t] * H + b[t]; po[(long)(t0 + t) * 4096] = f2bf(H * bf2f(g[t])); } } }
}
__device__ __forceinline__ void phase_scan3(const Params& p) { scan3_rows(p.carry, p.carry + 128 * DM, p.la, p.lb, p.zB, p.OH, p.ssqA); }

typedef float f32x16 __attribute__((ext_vector_type(16)));
typedef short s16x4 __attribute__((ext_vector_type(4)));
constexpr int SHM_V = 64 * 128 * 2, SHM_K = 64 * 192 * 2, ATT_WS = 2 * SHM_V + 2 * SHM_K;
#define KSWZ(row, colB) ((row) * 384 + ((colB) ^ (((row) & 7) << 4)))
__device__ __forceinline__ int v_st(int k, int c) { const int kk = (k & ~0xC) | ((k & 4) << 1) | ((k & 8) >> 1); return ((kk >> 3) * 4 + (c >> 5)) * 512 + ((kk & 7) * 32 + (c & 31)) * 2; }
__device__ __forceinline__ int v_rd_base(int lane) { return ((lane & 3) << 3) | (((lane >> 2) & 3) << 6) | (((lane >> 4) & 1) << 5) | (((lane >> 5) & 1) << 8); }
constexpr int v_rd_off(int d0, int ks, int half) { return d0 * 512 + ks * 4096 + half * 2048; }
__device__ __forceinline__ int crow(int r, int hi) { return (r & 3) + 8 * (r >> 2) + 4 * hi; }
__device__ __forceinline__ unsigned cvtpk(float lo, float hi) { unsigned r; asm volatile("v_cvt_pk_bf16_f32 %0, %1, %2" : "=v"(r) : "v"(lo), "v"(hi)); return r; }

__device__ __forceinline__ void partialSM(f32x16& p0, f32x16& p1, float& m_reg, float& mn, float& alpha) {
    float pmax = p0[0];
#pragma unroll
    for (int r = 1; r < 16; ++r) pmax = fmaxf(pmax, p0[r]);
#pragma unroll
    for (int r = 0; r < 16; ++r) pmax = fmaxf(pmax, p1[r]);
    { auto rr = __builtin_amdgcn_permlane32_swap(__float_as_uint(pmax), __float_as_uint(pmax), false, false);
      pmax = fmaxf(__uint_as_float(rr[0]), __uint_as_float(rr[1])); }
    if (__builtin_expect(__all(pmax - m_reg <= 11.5f), 1)) { mn = m_reg; alpha = 1.f; }
    else { mn = fmaxf(m_reg, pmax); alpha = __builtin_amdgcn_exp2f(m_reg - mn); m_reg = mn; }
#pragma unroll
    for (int r = 0; r < 16; ++r) p0[r] = p0[r] - mn;
#pragma unroll
    for (int r = 0; r < 16; ++r) p1[r] = p1[r] - mn;
#pragma unroll
    for (int r = 0; r < 16; ++r) p0[r] = __builtin_amdgcn_exp2f(p0[r]);
}
__device__ __forceinline__ void finishSM(f32x16& p0, f32x16& p1, float alpha, float& l_reg, bf16x8& pa0, bf16x8& pa1, bf16x8& pa2, bf16x8& pa3) {
#pragma unroll
    for (int r = 0; r < 16; ++r) p1[r] = __builtin_amdgcn_exp2f(p1[r]);
    float ps = 0;
#pragma unroll
    for (int r = 0; r < 16; ++r) ps += p0[r];
#pragma unroll
    for (int r = 0; r < 16; ++r) ps += p1[r];
    { auto rr = __builtin_amdgcn_permlane32_swap(__float_as_uint(ps), __float_as_uint(ps), false, false);
      ps = __uint_as_float(rr[0]) + __uint_as_float(rr[1]); }
    l_reg = l_reg * alpha + ps;
#define PK4(P, B_, OUT) do { unsigned a0 = cvtpk(P[B_+0], P[B_+1]), a1 = cvtpk(P[B_+2], P[B_+3]);                          \
        unsigned b0 = cvtpk(P[B_+4], P[B_+5]), b1 = cvtpk(P[B_+6], P[B_+7]);                                             \
        auto r0 = __builtin_amdgcn_permlane32_swap(a0, b0, false, false); auto r1 = __builtin_amdgcn_permlane32_swap(a1, b1, false, false); \
        u32x4 w = {r0[0], r1[0], r0[1], r1[1]}; OUT = *reinterpret_cast<bf16x8*>(&w); } while (0)
    PK4(p0, 0, pa0); PK4(p0, 8, pa1); PK4(p1, 0, pa2); PK4(p1, 8, pa3);
#undef PK4
}
template <int KB>
__device__ __forceinline__ void qkt(f32x16& p0, f32x16& p1, LAS char* K_lds, int r32, int hi, const bf16x8* qr, bool act) {
    if (!act) { const float NEG = -__builtin_inff();
#pragma unroll
        for (int r = 0; r < 16; ++r) { p0[r] = NEG; p1[r] = NEG; } return; }
#pragma unroll
    for (int r = 0; r < 16; ++r) { p0[r] = 0.f; p1[r] = 0.f; }
    LAS char* kb[4];
#pragma unroll
    for (int dd = 0; dd < 4; ++dd) kb[dd] = K_lds + KB * SHM_K + KSWZ(r32, (dd * 16 + hi * 8) * 2);
#pragma unroll
    for (int d0 = 0; d0 < 12; ++d0) { LAS char* a = kb[d0 & 3] + (d0 >> 2) * 128;
        const bf16x8 b0 = *(const LAS bf16x8*)a;
        const bf16x8 b1 = *(const LAS bf16x8*)(a + 32 * 384);
        p0 = __builtin_amdgcn_mfma_f32_32x32x16_bf16(b0, qr[d0], p0, 0, 0, 0);
        p1 = __builtin_amdgcn_mfma_f32_32x32x16_bf16(b1, qr[d0], p1, 0, 0, 0); }
}
template <int VB>
__device__ __forceinline__ void pv_tile(f32x16* o, int vb0, bf16x8 pa0, bf16x8 pa1, bf16x8 pa2, bf16x8 pa3, bool act) {
    if (!act) return;
#define TRRD(dst, off) asm volatile("ds_read_b64_tr_b16 %0, %1 offset:%2" : "=&v"(dst) : "v"(vb0), "i"(off) : "memory")
#define PV_D0(d0) do { s16x4 l0, l1, l2, l3, h0, h1, h2, h3; constexpr int b_ = VB * SHM_V + v_rd_off(d0, 0, 0); \
        TRRD(l0, b_); TRRD(h0, b_ + 2048); TRRD(l1, b_ + 4096); TRRD(h1, b_ + 6144); TRRD(l2, b_ + 8192); TRRD(h2, b_ + 10240); TRRD(l3, b_ + 12288); TRRD(h3, b_ + 14336); \
        asm volatile("s_waitcnt lgkmcnt(0)" ::: "memory"); __builtin_amdgcn_sched_barrier(0); \
        o[d0] = __builtin_amdgcn_mfma_f32_32x32x16_bf16(pa0, (bf16x8){l0[0], l0[1], l0[2], l0[3], h0[0], h0[1], h0[2], h0[3]}, o[d0], 0, 0, 0);   \
        o[d0] = __builtin_amdgcn_mfma_f32_32x32x16_bf16(pa1, (bf16x8){l1[0], l1[1], l1[2], l1[3], h1[0], h1[1], h1[2], h1[3]}, o[d0], 0, 0, 0);   \
        o[d0] = __builtin_amdgcn_mfma_f32_32x32x16_bf16(pa2, (bf16x8){l2[0], l2[1], l2[2], l2[3], h2[0], h2[1], h2[2], h2[3]}, o[d0], 0, 0, 0);   \
        o[d0] = __builtin_amdgcn_mfma_f32_32x32x16_bf16(pa3, (bf16x8){l3[0], l3[1], l3[2], l3[3], h3[0], h3[1], h3[2], h3[3]}, o[d0], 0, 0, 0); } while (0)
    PV_D0(0); PV_D0(1); PV_D0(2); PV_D0(3);
#undef PV_D0
#undef TRRD
}

__device__ __forceinline__ void attn_block(char* lds, const u16* __restrict__ Qb, const u16* __restrict__ Kh, const u16* __restrict__ Vh,
                                           const u16* __restrict__ sg, u16* __restrict__ Ob, int P0) {
    const int tid = TID(), wid = __builtin_amdgcn_readfirstlane(tid >> 6), lane = tid & 63, r32 = lane & 31, hi = lane >> 5;
    const int NT = (P0 >> 6) + 4;
    const int wchunk = (P0 >> 6) + (wid >> 1);
    LAS char* L = (LAS char*)lds; LAS char* V_lds = L; LAS char* K_lds = L + 2 * SHM_V;
    LAS float* wsf = (LAS float*)(L + ATT_WS) + wid * 64; LAS float* li_l = wsf; LAS float* al_l = wsf + 32;
    float m_reg = -1e30f, l_reg = 0.f; f32x16 o[4];
#pragma unroll
    for (int d = 0; d < 4; ++d)
#pragma unroll
        for (int r = 0; r < 16; ++r) o[d][r] = 0.f;
    const int sr = tid >> 4, sc = (tid & 15) * 8, vst0 = v_st(sr, sc), vst1 = v_st(32 + sr, sc);
    const int kc0 = tid, kc1 = tid + 512, kc2 = tid + 1024;
    const int kws0 = KSWZ(kc0 / 24, (kc0 % 24) * 16), kws1 = KSWZ(kc1 / 24, (kc1 % 24) * 16), kws2 = KSWZ(kc2 / 24, (kc2 % 24) * 16);
    const int vb0 = (int)(unsigned)(uintptr_t)V_lds + v_rd_base(lane);
    bf16x8 qr[12];
#pragma unroll
    for (int d0 = 0; d0 < 12; ++d0) qr[d0] = *(const bf16x8*)(Qb + (long)(wid * 32 + r32) * NQ + d0 * 16 + hi * 8);
    bf16x8 st_k0, st_k1, st_k2, st_v0, st_v1;
#define VMW() asm volatile("s_waitcnt vmcnt(0)" ::: "memory")
#define SBAR() __builtin_amdgcn_sched_barrier(0)
#define SLOAD(t) do { const u16* kp_ = Kh + (long)(t) * 64 * QD + tid * 8; st_k0 = *(const bf16x8*)kp_; st_k1 = *(const bf16x8*)(kp_ + 4096); st_k2 = *(const bf16x8*)(kp_ + 8192); \
                      const u16* vp_ = Vh + ((long)(t) * 64 + sr) * VH + sc; st_v0 = *(const bf16x8*)vp_; st_v1 = *(const bf16x8*)(vp_ + 32 * VH); } while (0)
#define SWRITE(bf) do { *(LAS bf16x8*)(K_lds + (bf) * SHM_K + kws0) = st_k0; *(LAS bf16x8*)(K_lds + (bf) * SHM_K + kws1) = st_k1; *(LAS bf16x8*)(K_lds + (bf) * SHM_K + kws2) = st_k2; \
                        *(LAS bf16x8*)(V_lds + (bf) * SHM_V + vst0) = st_v0; *(LAS bf16x8*)(V_lds + (bf) * SHM_V + vst1) = st_v1; } while (0)
#define RESC(a) do { if (__any((a) < 1.f)) { if (hi == 0) al_l[r32] = (a); asm volatile("s_waitcnt lgkmcnt(0)" ::: "memory");              \
                     _Pragma("unroll") for (int d_ = 0; d_ < 4; ++d_) _Pragma("unroll") for (int r = 0; r < 16; ++r) o[d_][r] *= al_l[crow(r, hi)]; } } while (0)
#define ACT(t) ((t) <= wchunk)
    f32x16 pA0, pA1, pB0, pB1; float mnA, mnB, alA, alB; bf16x8 pa0, pa1, pa2, pa3;
    SLOAD(0); VMW(); SWRITE(0); SBAR();
    SLOAD(1);
    __syncthreads();
    SBAR(); qkt<0>(pA0, pA1, K_lds, r32, hi, qr, ACT(0));
    partialSM(pA0, pA1, m_reg, mnA, alA);
    VMW(); SWRITE(1);
    __syncthreads();
#define HALF_STEP(PX0, PX1, mnX, alX, PY0, PY1, alY, t, KB, VB, SB) do {                                                      \
        SBAR(); qkt<KB>(PX0, PX1, K_lds, r32, hi, qr, ACT(t));                                                                \
        finishSM(PY0, PY1, alY, l_reg, pa0, pa1, pa2, pa3); SBAR();                                                           \
        if ((t) + 1 < NT) { SLOAD((t) + 1); SBAR(); }                                                                          \
        pv_tile<VB>(o, vb0, pa0, pa1, pa2, pa3, ACT((t) - 1)); partialSM(PX0, PX1, m_reg, mnX, alX);                          \
        __syncthreads();                                                                                                      \
        if ((t) + 1 < NT) { VMW(); SWRITE(SB); }                                                                               \
        RESC(alX); __syncthreads(); } while (0)
    for (int t = 1; t + 1 < NT; t += 2) {
        HALF_STEP(pB0, pB1, mnB, alB, pA0, pA1, alA, t, 1, 0, 0);
        HALF_STEP(pA0, pA1, mnA, alA, pB0, pB1, alB, t + 1, 0, 1, 1);
    }
    SBAR(); qkt<1>(pB0, pB1, K_lds, r32, hi, qr, ACT(NT - 1)); SBAR();
    finishSM(pA0, pA1, alA, l_reg, pa0, pa1, pa2, pa3); SBAR();
    pv_tile<0>(o, vb0, pa0, pa1, pa2, pa3, ACT(NT - 2));
    partialSM(pB0, pB1, m_reg, mnB, alB); __syncthreads(); RESC(alB);
    finishSM(pB0, pB1, alB, l_reg, pa0, pa1, pa2, pa3); SBAR(); pv_tile<1>(o, vb0, pa0, pa1, pa2, pa3, ACT(NT - 1));
    SBAR();
    if (hi == 0) li_l[r32] = l_reg; asm volatile("s_waitcnt lgkmcnt(0)" ::: "memory");
    float rli[16];
#pragma unroll
    for (int r = 0; r < 16; ++r) rli[r] = __builtin_amdgcn_rcpf(li_l[crow(r, hi)]);
    const int xl = (lane ^ 1) << 2;
    unsigned gg[16][4];
#pragma unroll
    for (int r = 0; r < 16; ++r)
#pragma unroll
        for (int d0 = 0; d0 < 4; ++d0) gg[r][d0] = *(const unsigned*)(sg + (long)(wid * 32 + crow(r, hi)) * ZB + d0 * 32 + (r32 & ~1));
#pragma unroll
    for (int r = 0; r < 16; ++r) { const int orow = wid * 32 + crow(r, hi);
#pragma unroll
        for (int d0 = 0; d0 < 4; ++d0) { const float v = o[d0][r] * rli[r];
            const float vn = __int_as_float(__builtin_amdgcn_ds_bpermute(xl, __float_as_int(v)));
            const unsigned g = gg[r][d0];
            if ((r32 & 1) == 0) *(unsigned*)(Ob + (long)orow * 4096 + d0 * 32 + r32) = cvtpk(v * __uint_as_float(g << 16), vn * __uint_as_float(g & 0xffff0000u)); } }
    __syncthreads();
#undef VMW
#undef SBAR
#undef SLOAD
#undef SWRITE
#undef RESC
#undef ACT
#undef HALF_STEP
}
__device__ __forceinline__ void phase_attention(const Params& p, char* lds) {
    for (int it = blockIdx.x; it < 256; it += gridDim.x) {
        const int xcd = it & 7, idx = it >> 3, hh = xcd * 2 + (idx >> 4), x = idx & 15;
        for (int half = 0; half < 2; ++half) { const int P0 = (half ? x : 31 - x) * 256;
            attn_block(lds, p.Q + (long)P0 * NQ + hh * QD, p.Kf + (long)hh * S * QD, p.Vf + (long)hh * S * VH, p.zB + (long)P0 * ZB + hh * VH, p.OH + (long)P0 * 4096 + hh * VH, P0); }
    }
}

#ifndef PROBE_MASK
#define PROBE_MASK 0
#endif
#if PROBE_MASK
#define TICK(cls) do { const unsigned long long now_ = __builtin_amdgcn_s_memrealtime(); if ((PROBE_MASK >> (cls)) & 1) t_acc += now_ - t_last; t_last = now_; } while (0)
#else
#define TICK(cls) do { } while (0)
#endif
__global__ __launch_bounds__(NTHR, 2) void mega(Params p) {
    extern __shared__ __attribute__((aligned(16))) char lds[];
    cg::grid_group grid = cg::this_grid();
    const int G = gridDim.x;
    volatile LAS unsigned* xbst = (volatile LAS unsigned*)((LAS char*)lds + 8 * HTB);
    if (TID() == 0) { xbst[0] = 0u; xbst[1] = 0u; xbst[2] = 0u; xbst[3] = 0u; }
    __syncthreads();
    if (blockIdx.x == 0) for (int i = TID(); i < XCD_BAR_WORDS; i += NTHR) p.bar[i] = 0u;
#if PROBE_MASK
    unsigned long long t_acc = 0, t_last = __builtin_amdgcn_s_memrealtime();
#endif
    phase_prologue(p, lds);
    phase_xb_ssq(p.x_in, p.hb, p.ssqA);
    grid.sync();
    const XcdBarrier xb = xcd_barrier_post(p.bar, xbst);
    TICK(0);
    for (int l = 0; l < DEPTH; ++l) {
        const int c = (int)blockIdx.x + opaque_zero();
        const float* xcur = l ? p.xr : p.x_in;
        { TileSched sc{p.hb, DM, p.Wt_in + (size_t)l * NIN * DM, DM, 32, NIN / 256, G, c}; EpiIn e{p.zB, p.zA, p.ssqA}; gemm_fast(lds, DM, DM, DM, sc, e); }
        xcd_barrier(xb); TICK(2);
        phase_t2(p, l);
        xcd_barrier(xb); TICK(3);
        { TileSched sc{p.qn, QL, p.Wt_q + (size_t)l * NQ * QL, QL, 32, NQ / 256, G, c}; EpiQ e{p.Q, p.cs}; gemm_fast(lds, QL, QL, QL, sc, e); }
        { TileSched sc{p.kvn, KVL, p.Wt_kv + (size_t)l * NKV * KVL, KVL, 32, NKV / 256, G, (c + 128) % G}; EpiKV e{p.Kf, p.Vf}; gemm_fast(lds, KVL, KVL, KVL, sc, e); }
        { LruSched sc{{p.xc, DM, p.Wt_lru + (size_t)l * LRUB * 65536, 256, 32, LRUB, G, c}}; EpiLru e{p.xc, p.b_rg + l * DM, p.b_ig + l * DM, p.nsp8 + l * DM, p.la, p.lb}; gemm_fast(lds, 256, DM, 256, sc, e); }
        xcd_barrier(xb); TICK(4);
        phase_scan1(p);
        phase_attention(p, lds);
        xcd_barrier(xb); TICK(5);
        phase_scan3(p);
        xcd_barrier(xb); TICK(6);
        { MergeSched sc{{p.OH, 4096, p.Wt_o + (size_t)l * DM * 4096, 4096, 32, 8, G, c}}; EpiMerge e{p.zB, p.mg}; gemm_fast(lds, DM, 4096, 4096, sc, e); }
        xcd_barrier(xb); TICK(7);
        { TileSched sc{p.mg, DM, p.Wt_out + (size_t)l * DM * DM, DM, 32, 8, G, c}; EpiOut e{xcur, p.xr, p.hb2, p.ssqB}; gemm_fast(lds, DM, DM, DM, sc, e); }
        { TileSched sc{p.pb + (size_t)l * S * PLE, PLE, p.Wt_ple + (size_t)l * DM * PLE, PLE, 32, 8, G, c}; EpiF32 e{p.pp, DM}; gemm_fast(lds, PLE, PLE, PLE, sc, e); }
        xcd_barrier(xb); TICK(8);
        { TileSched sc{p.hb2, DM, p.Wt_pg + (size_t)l * DM * DM, DM, 32, 8, G, c}; EpiPle e{p.xr, p.pp, p.ssqB, p.hb, p.ssqA}; gemm_fast(lds, DM, DM, DM, sc, e); }
        xcd_barrier(xb); TICK(9);
    }
    phase_final_norm(p.xr, p.final_norm);
#if PROBE_MASK
    __syncthreads();
    if (blockIdx.x == 0) { const float d = sqrtf((float)t_acc * 0.01f * 4.096e-8f);
        for (int j = 0; j < 8; ++j) p.xr[threadIdx.x * 8 + j] += d; }
#endif
}

constexpr size_t LDS_BYTES = 8 * HTB + 16;

extern "C" void kernel_launch(void* const* d_in, const int* in_sizes, int n_in, void* d_out, int out_size, void* d_ws, size_t ws_size, hipStream_t st) {
    Params p{};
    p.x_in = (const float*)d_in[0]; p.p_in = (const float*)d_in[1]; p.pos = (const int*)d_in[2];
    p.attn_norm = (const float*)d_in[3]; p.w_in = (const float*)d_in[4]; p.q_a_norm = (const float*)d_in[5]; p.w_q_b = (const float*)d_in[6];
    p.kv_a_norm = (const float*)d_in[7]; p.w_kv_b = (const float*)d_in[8]; p.conv_w = (const float*)d_in[9]; p.conv_b = (const float*)d_in[10];
    p.w_rg = (const float*)d_in[11]; p.b_rg = (const float*)d_in[12]; p.w_ig = (const float*)d_in[13]; p.b_ig = (const float*)d_in[14]; p.lam = (const float*)d_in[15];
    p.w_o_mla = (const float*)d_in[16]; p.w_o_lru = (const float*)d_in[17]; p.w_out = (const float*)d_in[18]; p.ple_norm = (const float*)d_in[19];
    p.w_ple_gate = (const float*)d_in[20]; p.w_ple = (const float*)d_in[21]; p.final_norm = (const float*)d_in[22];
    p.xr = (float*)d_out;
    char* w = (char*)d_ws; size_t off = 0;
    auto take = [&](size_t bytes) { char* r = w + off; off += (bytes + 255) & ~(size_t)255; return r; };
    p.Wt_in = (u16*)take((size_t)DEPTH * NIN * DM * 2); p.Wt_q = (u16*)take((size_t)DEPTH * NQ * QL * 2); p.Wt_kv = (u16*)take((size_t)DEPTH * NKV * KVL * 2);
    p.Wt_lru = (u16*)take((size_t)DEPTH * LRUB * 65536 * 2); p.Wt_o = (u16*)take((size_t)DEPTH * DM * 4096 * 2); p.Wt_out = (u16*)take((size_t)DEPTH * DM * DM * 2);
    p.Wt_pg = (u16*)take((size_t)DEPTH * DM * DM * 2); p.Wt_ple = (u16*)take((size_t)DEPTH * DM * PLE * 2);
    p.hb = (u16*)take((size_t)S * DM * 2); p.hb2 = (u16*)take((size_t)S * DM * 2); p.ssqA = (float*)take((size_t)S * 4); p.ssqB = (float*)take((size_t)S * 4); p.zB = (u16*)take((size_t)S * ZB * 2); p.zA = (float*)take((size_t)S * ZA * 4);
    p.qn = (u16*)take((size_t)S * QL * 2); p.kvn = (u16*)take((size_t)S * KVL * 2); p.Q = (u16*)take((size_t)S * NQ * 2);
    p.Kf = (u16*)take((size_t)NH * S * QD * 2); p.Vf = (u16*)take((size_t)NH * S * VH * 2); p.xc = (u16*)take((size_t)S * DM * 2);
    p.OH = (u16*)take((size_t)S * 4096 * 2); p.pb = (u16*)take((size_t)DEPTH * S * PLE * 2); p.cs = (float*)take((size_t)S * 64 * 4); p.carry = (float*)take((size_t)3 * 128 * DM * 4); p.nsp8 = (float*)take((size_t)DEPTH * DM * 4); p.bar = (unsigned*)take((size_t)XCD_BAR_WORDS * 4);
    p.la = (float*)take((size_t)S * DM * 4); p.lb = (float*)take((size_t)S * DM * 4); p.pp = (float*)take((size_t)S * DM * 4); p.mg = (u16*)take((size_t)S * DM * 2);
    if (off > ws_size) { fprintf(stderr, "workspace too small: need %zu have %zu\n", off, ws_size); return; }
    (void)hipFuncSetAttribute((const void*)mega, hipFuncAttributeMaxDynamicSharedMemorySize, (int)LDS_BYTES);
    int dev = 0, cus = 0; (void)hipGetDevice(&dev); (void)hipDeviceGetAttribute(&cus, hipDeviceAttributeMultiprocessorCount, dev);
    int per_cu = 0; (void)hipOccupancyMaxActiveBlocksPerMultiprocessor(&per_cu, mega, NTHR, LDS_BYTES);
    if (per_cu < 1 || cus < 1) { fprintf(stderr, "occupancy query failed\n"); return; }
    void* args[] = {&p};
    hipError_t e = hipLaunchCooperativeKernel((const void*)mega, dim3(cus), dim3(NTHR), args, LDS_BYTES, st);
    if (e != hipSuccess) fprintf(stderr, "cooperative launch failed: %s\n", hipGetErrorString(e));
}
```

```cpp
#include <hip/hip_runtime.h>
#include <hip/hip_cooperative_groups.h>
#include <cstdio>
#include <cstdint>
namespace cg = cooperative_groups;

constexpr int S = 8192, DM = 2048, DEPTH = 4, NH = 16, QL = 512, KVL = 512, NOPE = 128, ROPE = 64, VH = 128;
constexpr int INT = 11328, PLE = 256, LRUB = 16, LBD = 128;
constexpr int QD = 192, NQ = NH * QD  , NKV = NH * 256  ;
constexpr int NIN = 11520;
constexpr int ZB = 10240, ZA = 1280;
constexpr int NTHR = 512;
constexpr float QSCALE = 0.07216878364870322f * 1.4426950408889634f;

typedef unsigned short u16;
typedef short bf16x8 __attribute__((ext_vector_type(8)));
typedef float f32x4 __attribute__((ext_vector_type(4)));
typedef float f32x2 __attribute__((ext_vector_type(2)));
typedef unsigned u32x2 __attribute__((ext_vector_type(2)));
typedef unsigned u32x4 __attribute__((ext_vector_type(4)));

__device__ __forceinline__ u16 f2bf(float f) { unsigned u = __float_as_uint(f); u += 0x7FFFu + ((u >> 16) & 1u); return (u16)(u >> 16); }
__device__ __forceinline__ float bf2f(u16 b) { return __uint_as_float(((unsigned)b) << 16); }
__device__ __forceinline__ unsigned pk2(float lo, float hi) { unsigned r; asm volatile("v_cvt_pk_bf16_f32 %0, %1, %2" : "=v"(r) : "v"(lo), "v"(hi)); return r; }
__device__ __forceinline__ float sigmoidf_(float x) { return __builtin_amdgcn_rcpf(1.f + __builtin_amdgcn_exp2f(-1.4426950408889634f * x)); }
__device__ __forceinline__ float siluf_(float x) { return x * __builtin_amdgcn_rcpf(1.f + __builtin_amdgcn_exp2f(-1.4426950408889634f * x)); }
__device__ __forceinline__ int opaque_zero() { int z; asm volatile("s_mov_b32 %0, 0" : "=s"(z)); return z; }
#define TID() ((int)threadIdx.x + opaque_zero())
__device__ __forceinline__ float wsum(float s, int lane) { for (int off = 32; off; off >>= 1) s += __int_as_float(__builtin_amdgcn_ds_bpermute((lane ^ off) << 2, __float_as_int(s))); return s; }
__device__ __forceinline__ float wmax(float s, int lane) { for (int off = 32; off; off >>= 1) s = fmaxf(s, __int_as_float(__builtin_amdgcn_ds_bpermute((lane ^ off) << 2, __float_as_int(s)))); return s; }

struct Params {
    const float *x_in, *p_in; const int* pos;
    const float *attn_norm, *w_in, *q_a_norm, *w_q_b, *kv_a_norm, *w_kv_b, *conv_w, *conv_b, *w_rg, *b_rg, *w_ig, *b_ig, *lam, *w_o_mla, *w_o_lru, *w_out, *ple_norm, *w_ple_gate, *w_ple, *final_norm;
    float* xr;
    u16 *Wt_in, *Wt_q, *Wt_kv, *Wt_lru, *Wt_o, *Wt_out, *Wt_pg, *Wt_ple;
    u16 *hb, *hb2, *zB, *qn, *kvn, *Q, *Kf, *Vf, *xc, *OH, *mg, *pb, *Pm;
    float *zA, *la, *lb, *pp, *cs, *carry, *sc, *nsp8, *ssqA, *ssqB; unsigned* bar;
};

struct Unit { const u16* a; const u16* b; int pm, pn, aux; };

struct TileSched {
    const u16* A; long lda; const u16* B; long ldb; int nM, nN, G, c;
    __device__ __forceinline__ bool tile(int i, int& pm, int& pn) const {
        const int nwg = nM * nN; const long L = (long)i * G + c; if (L >= nwg) return false;
        int wgid = (int)L; { const int q = nwg / 8, r = nwg % 8, xcd = wgid % 8, off = wgid / 8; wgid = (xcd < r ? xcd * (q + 1) : r * (q + 1) + (xcd - r) * q) + off; }
        const int nig = 8 * nN, gid = wgid / nig, fm = gid * 8, gsz = (nM - fm) < 8 ? (nM - fm) : 8;
        pm = fm + ((wgid % nig) % gsz); pn = (wgid % nig) / gsz; return true;
    }
    __device__ __forceinline__ bool next(int i, Unit& u) const {
        if (!tile(i, u.pm, u.pn)) return false;
        u.a = A + (long)u.pm * 256 * lda; u.b = B + (long)u.pn * 256 * ldb; u.aux = 0; return true;
    }
};
struct LruSched : TileSched {
    __device__ __forceinline__ bool next(int i, Unit& u) const {
        if (!tile(i, u.pm, u.pn)) return false;
        u.a = A + (long)u.pm * 256 * lda + (u.pn >> 1) * 256; u.b = B + (long)u.pn * 65536; u.aux = 0; return true;
    }
};
struct MergeSched : TileSched {
    __device__ __forceinline__ bool next(int i, Unit& u) const {
        if (!tile(i >> 1, u.pm, u.pn)) return false;
        u.aux = i & 1; u.a = A + (long)u.pm * 256 * lda + u.aux * 2048; u.b = B + (long)u.pn * 256 * ldb + u.aux * 2048; return true;
    }
};
struct TriSched {
    const u16* A; long lda; const u16* B; long ldb; int G, c;
    __device__ __forceinline__ bool next(int i, Unit& u) const {
        int t = i * G + c; if (t >= 528) return false;
        int pm = 0; while (t >= pm + 1) { t -= pm + 1; ++pm; }
        u.pm = pm; u.pn = t; u.a = A + (long)pm * 256 * lda; u.b = B + (long)t * 256 * ldb; u.aux = 0; return true;
    }
};
struct RowSched {
    const u16* A; long lda; const u16* B; int G, c;
    __device__ __forceinline__ bool next(int i, Unit& u) const {
        const int t = i * G + c; if (t >= 32) return false;
        u.pm = 31 - t; u.pn = 0; u.a = A + (long)u.pm * 256 * lda; u.b = B; u.aux = 0; return true;
    }
};

template <class F>
__device__ __forceinline__ void epi_foreach(f32x4 (&acc)[2][2][4][2], const Unit& u, int wr, int wc, int fr, int fq, F f) {
    const int row0 = u.pm * 256 + wr * 64 + fr, col0 = u.pn * 256 + wc * 32 + 4 * fq;
#pragma unroll
    for (int ai = 0; ai < 2; ++ai)
#pragma unroll
        for (int m = 0; m < 4; ++m) {
#pragma unroll
            for (int bj = 0; bj < 2; ++bj)
#pragma unroll
                for (int n = 0; n < 2; ++n) f(row0 + ai * 128 + m * 16, col0 + bj * 128 + n * 16, acc[ai][bj][m][n]);
        }
}
template <int GM, class T, class LF, class F>
__device__ __forceinline__ void epi_foreach_ld(f32x4 (&acc)[2][2][4][2], const Unit& u, int wr, int wc, int fr, int fq, LF lf, F f) {
    const int row0 = u.pm * 256 + wr * 64 + fr, col0 = u.pn * 256 + wc * 32 + 4 * fq;
#pragma unroll
    for (int ai = 0; ai < 2; ++ai)
#pragma unroll
        for (int mg = 0; mg < 4; mg += GM) {
            T regs[GM][2][2];
#pragma unroll
            for (int m = 0; m < GM; ++m)
#pragma unroll
                for (int bj = 0; bj < 2; ++bj)
#pragma unroll
                    for (int n = 0; n < 2; ++n) regs[m][bj][n] = lf(row0 + ai * 128 + (mg + m) * 16, col0 + bj * 128 + n * 16);
#pragma unroll
            for (int m = 0; m < GM; ++m)
#pragma unroll
                for (int bj = 0; bj < 2; ++bj)
#pragma unroll
                    for (int n = 0; n < 2; ++n) f(row0 + ai * 128 + (mg + m) * 16, col0 + bj * 128 + n * 16, acc[ai][bj][mg + m][n], regs[m][bj][n]);
        }
}
template <class F>
__device__ __forceinline__ void epi_foreach8(f32x4 (&acc)[2][2][4][2], const Unit& u, int wr, int wc, int fr, int fq, F f) {
    const int row0 = u.pm * 256 + wr * 64 + fr, col0 = u.pn * 256 + wc * 32 + 8 * fq;
#pragma unroll
    for (int ai = 0; ai < 2; ++ai)
#pragma unroll
        for (int m = 0; m < 4; ++m)
#pragma unroll
            for (int bj = 0; bj < 2; ++bj) f(row0 + ai * 128 + m * 16, col0 + bj * 128, acc[ai][bj][m][0], acc[ai][bj][m][1]);
}
template <class T, class LF, class F>
__device__ __forceinline__ void epi_foreach8_ld(f32x4 (&acc)[2][2][4][2], const Unit& u, int wr, int wc, int fr, int fq, LF lf, F f) {
    const int row0 = u.pm * 256 + wr * 64 + fr, col0 = u.pn * 256 + wc * 32 + 8 * fq;
#pragma unroll
    for (int ai = 0; ai < 2; ++ai) {
        T regs[4][2];
#pragma unroll
        for (int m = 0; m < 4; ++m)
#pragma unroll
            for (int bj = 0; bj < 2; ++bj) regs[m][bj] = lf(row0 + ai * 128 + m * 16, col0 + bj * 128);
#pragma unroll
        for (int m = 0; m < 4; ++m)
#pragma unroll
            for (int bj = 0; bj < 2; ++bj) f(row0 + ai * 128 + m * 16, col0 + bj * 128, acc[ai][bj][m][0], acc[ai][bj][m][1], regs[m][bj]);
    }
}
__device__ __forceinline__ u32x4 pack8(const f32x4& a, const f32x4& b) { return (u32x4){pk2(a[0], a[1]), pk2(a[2], a[3]), pk2(b[0], b[1]), pk2(b[2], b[3])}; }
#define EPI_COMMON  __device__ __forceinline__ bool keep(const Unit&) const { return false; } __device__ __forceinline__ int klimit(const Unit&, int K) const { return K; }
#define EPI_SIG     __device__ __forceinline__ void operator()(f32x4 (&acc)[2][2][4][2], const Unit& u, int wr, int wc, int fr, int fq) const

__device__ __forceinline__ float rinv_of(float ss) { return rsqrtf(ss * (1.f / DM) + 1e-6f); }
struct EpiIn { EPI_COMMON u16* zB; float* zA; const float* ssq;
    EPI_SIG { const int seg = u.pn >> 3;
        const int row0 = u.pm * 256 + wr * 64 + fr, col0 = u.pn * 256 + wc * 32 + 8 * fq;
        float ri[2][4];
#pragma unroll
        for (int ai = 0; ai < 2; ++ai)
#pragma unroll
            for (int m = 0; m < 4; ++m) ri[ai][m] = ssq[row0 + ai * 128 + m * 16];
#pragma unroll
        for (int ai = 0; ai < 2; ++ai)
#pragma unroll
            for (int m = 0; m < 4; ++m) ri[ai][m] = rinv_of(ri[ai][m]);
        if (seg >= 5) {
#pragma unroll
            for (int ai = 0; ai < 2; ++ai)
#pragma unroll
                for (int m = 0; m < 4; ++m)
#pragma unroll
                    for (int bj = 0; bj < 2; ++bj) { const int row = row0 + ai * 128 + m * 16, col = col0 + bj * 128;
                        if (col < ZB + 1088) { float* d = zA + (long)row * ZA + (col - ZB); *(f32x4*)d = acc[ai][bj][m][0] * ri[ai][m]; *(f32x4*)(d + 4) = acc[ai][bj][m][1] * ri[ai][m]; } }
        } else { const bool sil = seg == 0 || seg == 2, ident = seg == 1;
#pragma unroll
            for (int ai = 0; ai < 2; ++ai)
#pragma unroll
                for (int m = 0; m < 4; ++m)
#pragma unroll
                    for (int bj = 0; bj < 2; ++bj) { const int row = row0 + ai * 128 + m * 16, col = col0 + bj * 128;
                        f32x4 o0 = acc[ai][bj][m][0] * ri[ai][m], o1 = acc[ai][bj][m][1] * ri[ai][m];
                        if (!ident) {
#pragma unroll
                            for (int e = 0; e < 4; ++e) { const float s0 = sigmoidf_(o0[e]), s1 = sigmoidf_(o1[e]); o0[e] = sil ? o0[e] * s0 : s0; o1[e] = sil ? o1[e] * s1 : s1; } }
                        *(u32x4*)(zB + (long)row * ZB + col) = (u32x4){pk2(o0[0], o0[1]), pk2(o0[2], o0[3]), pk2(o1[0], o1[1]), pk2(o1[2], o1[3])}; }
        }
    } };
struct CsT { f32x4 c, s; };
struct EpiQ { EPI_COMMON u16* Q; const float* cs;
    EPI_SIG { epi_foreach8_ld<CsT>(acc, u, wr, wc, fr, fq,
            [&](int row, int col) { const int d = col % QD; CsT t; t.c = (f32x4){1.f, 1.f, 1.f, 1.f}; t.s = (f32x4){0.f, 0.f, 0.f, 0.f};
                if (d >= NOPE) { const float* tp = cs + (long)row * 64 + ((d - NOPE) >> 1); t.c = *(const f32x4*)tp; t.s = *(const f32x4*)(tp + 32); }
                return t; },
            [&](int row, int col, f32x4& v0, f32x4& v1, const CsT& t) { f32x4 o0, o1;
                const int d = col % QD;
                if (d < NOPE) { o0 = v0 * QSCALE; o1 = v1 * QSCALE; }
                else { o0[0] = (v0[0] * t.c[0] - v0[1] * t.s[0]) * QSCALE; o0[1] = (v0[1] * t.c[0] + v0[0] * t.s[0]) * QSCALE;
                       o0[2] = (v0[2] * t.c[1] - v0[3] * t.s[1]) * QSCALE; o0[3] = (v0[3] * t.c[1] + v0[2] * t.s[1]) * QSCALE;
                       o1[0] = (v1[0] * t.c[2] - v1[1] * t.s[2]) * QSCALE; o1[1] = (v1[1] * t.c[2] + v1[0] * t.s[2]) * QSCALE;
                       o1[2] = (v1[2] * t.c[3] - v1[3] * t.s[3]) * QSCALE; o1[3] = (v1[3] * t.c[3] + v1[2] * t.s[3]) * QSCALE; }
                *(u32x4*)(Q + (long)row * NQ + col) = pack8(o0, o1); }); } };
struct EpiKV { EPI_COMMON u16* Kf; u16* Vf;
    EPI_SIG { epi_foreach8(acc, u, wr, wc, fr, fq, [&](int row, int col, f32x4& v0, f32x4& v1) {
            const int hh = col >> 8, j = col & 255;
            u16* dst = (j < 128) ? Kf + ((long)hh * S + row) * QD + j : Vf + ((long)hh * S + row) * VH + (j - 128);
            *(u32x4*)dst = pack8(v0, v1);
        }); } };
struct EpiLru { EPI_COMMON const u16* xc; const float *brg, *big, *nsp8; float *la, *lb;
    EPI_SIG {
        const int row0 = u.pm * 256 + wr * 64 + fr, col0 = u.pn * 256 + wc * 32 + 4 * fq;
        f32x2 cr[2][2], ci[2][2], cn[2][2];
#pragma unroll
        for (int bj = 0; bj < 2; ++bj)
#pragma unroll
            for (int n = 0; n < 2; ++n) { const int ch = (col0 + bj * 128 + n * 16) >> 1; cr[bj][n] = *(const f32x2*)(brg + ch); ci[bj][n] = *(const f32x2*)(big + ch); cn[bj][n] = *(const f32x2*)(nsp8 + ch); }
#pragma unroll
        for (int ai = 0; ai < 2; ++ai) {
            unsigned xw[4][2][2];
#pragma unroll
            for (int m = 0; m < 4; ++m)
#pragma unroll
                for (int bj = 0; bj < 2; ++bj)
#pragma unroll
                    for (int n = 0; n < 2; ++n) xw[m][bj][n] = *(const unsigned*)(xc + (long)(row0 + ai * 128 + m * 16) * DM + ((col0 + bj * 128 + n * 16) >> 1));
#pragma unroll
            for (int m = 0; m < 4; ++m)
#pragma unroll
                for (int bj = 0; bj < 2; ++bj)
#pragma unroll
                    for (int n = 0; n < 2; ++n) {
                        const f32x4 v = acc[ai][bj][m][n]; const long o = (long)(row0 + ai * 128 + m * 16) * DM + ((col0 + bj * 128 + n * 16) >> 1);
                        f32x2 av, bv;
#pragma unroll
                        for (int e = 0; e < 2; ++e) {
                            const float r = sigmoidf_(v[2 * e] + cr[bj][n][e]), ii = sigmoidf_(v[2 * e + 1] + ci[bj][n][e]);
                            const float lg = r * cn[bj][n][e], x2 = 2.f * lg;
                            const float a = __builtin_amdgcn_exp2f(1.4426950408889634f * lg);
                            const float em = (x2 > -0.25f) ? x2 * (1.f + x2 * (0.5f + x2 * (0.16666667f + x2 * (0.041666668f + x2 * 0.0083333338f)))) : (a * a - 1.f);
                            const float x = e ? __uint_as_float(xw[m][bj][n] & 0xffff0000u) : __uint_as_float(xw[m][bj][n] << 16);
                            av[e] = a; bv[e] = __builtin_amdgcn_sqrtf(-em) * (ii * x); }
                        *(f32x2*)(la + o) = av; *(f32x2*)(lb + o) = bv; }
        }
    } };
struct SmSl { u32x4 sm, sl; };
__device__ __forceinline__ void unpack8(const u32x4& w, f32x4& a, f32x4& b) {
    a = (f32x4){__uint_as_float(w[0] << 16), __uint_as_float(w[0] & 0xffff0000u), __uint_as_float(w[1] << 16), __uint_as_float(w[1] & 0xffff0000u)};
    b = (f32x4){__uint_as_float(w[2] << 16), __uint_as_float(w[2] & 0xffff0000u), __uint_as_float(w[3] << 16), __uint_as_float(w[3] & 0xffff0000u)}; }
struct EpiMerge { const u16* zB; u16* mg;
    __device__ __forceinline__ bool keep(const Unit& u) const { return u.aux == 0; }
    __device__ __forceinline__ int klimit(const Unit&, int K) const { return K; }
    EPI_SIG { const int part = u.aux;
        epi_foreach8_ld<SmSl>(acc, u, wr, wc, fr, fq,
            [&](int row, int col) { SmSl t; t.sl = *(const u32x4*)(zB + (long)row * ZB + 8192 + col); t.sm = t.sl; if (part == 0) t.sm = *(const u32x4*)(zB + (long)row * ZB + 6144 + col); return t; },
            [&](int row, int col, f32x4& v0, f32x4& v1, const SmSl& t) {
            f32x4 l0, l1; unpack8(t.sl, l0, l1);
#pragma unroll
            for (int e = 0; e < 4; ++e) { l0[e] = fmaxf(l0[e], 1e-12f); l1[e] = fmaxf(l1[e], 1e-12f); }
            if (part == 0) { f32x4 m0, m1; unpack8(t.sm, m0, m1);
#pragma unroll
                for (int e = 0; e < 4; ++e) { v0[e] = v0[e] * m0[e] * __builtin_amdgcn_rcpf(l0[e]); v1[e] = v1[e] * m1[e] * __builtin_amdgcn_rcpf(l1[e]); }
            } else { *(u32x4*)(mg + (long)row * DM + col) = pack8(v0 * l0, v1 * l1); }
        }); } };
__device__ __forceinline__ void row_ssq_add(float sq, float* ssq, int row, int lane) {
    sq += __int_as_float(__builtin_amdgcn_ds_bpermute((lane ^ 16) << 2, __float_as_int(sq)));
    sq += __int_as_float(__builtin_amdgcn_ds_bpermute((lane ^ 32) << 2, __float_as_int(sq)));
    if (lane < 16) atomicAdd(ssq + row, sq);
}
struct EpiOut { EPI_COMMON const float* xold; float* xnew; u16* xb; float* ssq;
    EPI_SIG {
        const int row0 = u.pm * 256 + wr * 64 + fr, col0 = u.pn * 256 + wc * 32 + 8 * fq, lane = fq * 16 + fr;
#pragma unroll
        for (int ai = 0; ai < 2; ++ai) {
            f32x4 xo[4][2][2];
#pragma unroll
            for (int m = 0; m < 4; ++m)
#pragma unroll
                for (int bj = 0; bj < 2; ++bj) { const float* q = xold + (long)(row0 + ai * 128 + m * 16) * DM + col0 + bj * 128; xo[m][bj][0] = *(const f32x4*)q; xo[m][bj][1] = *(const f32x4*)(q + 4); }
#pragma unroll
            for (int m = 0; m < 4; ++m) { const int row = row0 + ai * 128 + m * 16; float sq = 0.f;
#pragma unroll
                for (int bj = 0; bj < 2; ++bj) { const f32x4 x0 = xo[m][bj][0] + acc[ai][bj][m][0], x1 = xo[m][bj][1] + acc[ai][bj][m][1]; const long idx = (long)row * DM + col0 + bj * 128;
                    *(f32x4*)(xnew + idx) = x0; *(f32x4*)(xnew + idx + 4) = x1; *(u32x4*)(xb + idx) = pack8(x0, x1);
                    sq += x0[0] * x0[0] + x0[1] * x0[1] + x0[2] * x0[2] + x0[3] * x0[3] + x1[0] * x1[0] + x1[1] * x1[1] + x1[2] * x1[2] + x1[3] * x1[3]; }
                row_ssq_add(sq, ssq, row, lane); }
        }
    } };
struct EpiF32 { EPI_COMMON float* C; long ldc;
    EPI_SIG { epi_foreach8(acc, u, wr, wc, fr, fq, [&](int row, int col, f32x4& v0, f32x4& v1) { float* d = C + (long)row * ldc + col; *(f32x4*)d = v0; *(f32x4*)(d + 4) = v1; }); } };
struct EpiPle { EPI_COMMON float* x; const float* pp; const float* ssq_in; u16* xb; float* ssq_out;
    EPI_SIG {
        const int row0 = u.pm * 256 + wr * 64 + fr, col0 = u.pn * 256 + wc * 32 + 8 * fq, lane = fq * 16 + fr;
#pragma unroll
        for (int ai = 0; ai < 2; ++ai)
#pragma unroll
            for (int mg = 0; mg < 4; mg += 2) {
                f32x4 xo[2][2][2], po[2][2][2]; float ss[2];
#pragma unroll
                for (int m = 0; m < 2; ++m) { const int row = row0 + ai * 128 + (mg + m) * 16; ss[m] = ssq_in[row];
#pragma unroll
                    for (int bj = 0; bj < 2; ++bj) { const long idx = (long)row * DM + col0 + bj * 128;
                        xo[m][bj][0] = *(const f32x4*)(x + idx); xo[m][bj][1] = *(const f32x4*)(x + idx + 4); po[m][bj][0] = *(const f32x4*)(pp + idx); po[m][bj][1] = *(const f32x4*)(pp + idx + 4); } }
#pragma unroll
                for (int m = 0; m < 2; ++m) { const int row = row0 + ai * 128 + (mg + m) * 16; const float ri = rinv_of(ss[m]); float sq = 0.f;
#pragma unroll
                    for (int bj = 0; bj < 2; ++bj) { f32x4 x0 = xo[m][bj][0], x1 = xo[m][bj][1]; const f32x4 v0 = acc[ai][bj][mg + m][0], v1 = acc[ai][bj][mg + m][1]; const long idx = (long)row * DM + col0 + bj * 128;
#pragma unroll
                        for (int e = 0; e < 4; ++e) { x0[e] += po[m][bj][0][e] * sigmoidf_(v0[e] * ri); x1[e] += po[m][bj][1][e] * sigmoidf_(v1[e] * ri); }
                        *(f32x4*)(x + idx) = x0; *(f32x4*)(x + idx + 4) = x1; *(u32x4*)(xb + idx) = pack8(x0, x1);
                        sq += x0[0] * x0[0] + x0[1] * x0[1] + x0[2] * x0[2] + x0[3] * x0[3] + x1[0] * x1[0] + x1[1] * x1[1] + x1[2] * x1[2] + x1[3] * x1[3]; }
                    row_ssq_add(sq, ssq_out, row, lane); }
            }
    } };

#define LAS __attribute__((address_space(3)))
constexpr int HTB = 128 * 64 * 2;
__device__ __forceinline__ int lds_byte(int r, int c) { const int st = (r >> 4) * 2 + (c >> 5), rr = r & 15, cc = c & 31, ob = rr * 64 + cc * 2; return st * 1024 + (ob ^ (((ob >> 9) & 1) << 5)); }
__device__ __forceinline__ void stage_rc(int b, int& R, int& C) { const int st = b / 1024, sb = b % 1024, swz = sb ^ (((sb >> 9) & 1) << 5); R = (st >> 1) * 16 + swz / 64; C = (st & 1) * 32 + (swz % 64) / 2; }

template <class Epi, class Sched>
__device__ __forceinline__ void gemm_fast(char* lds_, int K, long lda, long ldb, const Sched& S_, const Epi& E) {
    LAS unsigned char* lds = (LAS unsigned char*)lds_;
    const int tid = TID(), wid = __builtin_amdgcn_readfirstlane(tid >> 6), lane = tid & 63, wr = wid >> 2, wc = wid & 3, fr = lane & 15, fq = lane >> 4;
    const int nt = K / 64;
    unsigned voffA[2], voffB[2];
#pragma unroll
    for (int i = 0; i < 2; ++i) { int R, C; stage_rc(tid * 16 + i * 8192, R, C); voffA[i] = (unsigned)(R * lda + C) * 2u; voffB[i] = (unsigned)(R * ldb + C) * 2u; }
    const size_t kstep = 128;
    const size_t hstepA = (size_t)128 * lda * 2, hstepB = (size_t)128 * ldb * 2;
    const unsigned ldsw = (unsigned)wid * 1024u;
    const int aoff = lds_byte(wr * 64 + fr, fq * 8), boff = lds_byte(wc * 32 + fr, fq * 8);
#define G_SA(b, h) (((b) * 2 + (h)) * HTB)
#define G_SB(b, h) ((4 + (b) * 2 + (h)) * HTB)
#define G_STAGE(bufoff, gbase, voff) do { _Pragma("unroll") for (int _i = 0; _i < 2; ++_i) \
        __builtin_amdgcn_global_load_lds((const unsigned*)((const char*)(gbase) + (voff)[_i]), (LAS unsigned*)(lds + (bufoff) + ldsw + _i * 8192), 16, 0, 0); } while (0)
#define G_LDA(dst, b, h) do { _Pragma("unroll") for (int m = 0; m < 4; ++m) _Pragma("unroll") for (int k = 0; k < 2; ++k) dst[m][k] = *(const LAS bf16x8*)(lds + G_SA(b, h) + aoff + m * 2048 + k * 1024); } while (0)
#define G_LDB(dst, b, h) do { _Pragma("unroll") for (int n = 0; n < 2; ++n) _Pragma("unroll") for (int k = 0; k < 2; ++k) dst[n][k] = *(const LAS bf16x8*)(lds + G_SB(b, h) + boff + n * 2048 + k * 1024); } while (0)
#define G_MMA(ai, bj, At, Bt) do { __builtin_amdgcn_s_setprio(1); _Pragma("unroll") for (int m = 0; m < 4; ++m) _Pragma("unroll") for (int n = 0; n < 2; ++n) _Pragma("unroll") for (int k = 0; k < 2; ++k) \
        acc[ai][bj][m][n] = __builtin_amdgcn_mfma_f32_16x16x32_bf16(Bt[n][k], At[m][k], acc[ai][bj][m][n], 0, 0, 0); __builtin_amdgcn_s_setprio(0); } while (0)
#define G_WAIT_V(n) asm volatile("s_waitcnt vmcnt(" #n ")" ::: "memory")
#define G_WAIT_L(n) asm volatile("s_waitcnt lgkmcnt(" #n ")" ::: "memory")
#define G_BAR __builtin_amdgcn_s_barrier()
#define G_SCHED __builtin_amdgcn_sched_barrier(0)
    Unit cur, nxt; int ui = 0;
    if (!S_.next(0, cur)) return;
    f32x4 acc[2][2][4][2];
#pragma unroll
    for (int a = 0; a < 2; ++a)
#pragma unroll
        for (int b = 0; b < 2; ++b)
#pragma unroll
            for (int m = 0; m < 4; ++m)
#pragma unroll
                for (int n = 0; n < 2; ++n) acc[a][b][m][n] = (f32x4){0.f, 0.f, 0.f, 0.f};
    bf16x8 At[4][2], B0[2][2], B1[2][2];
    const char* cA = (const char*)cur.a; const char* cB = (const char*)cur.b;
    G_STAGE(G_SB(0, 0), cB, voffB); G_STAGE(G_SA(0, 0), cA, voffA); G_STAGE(G_SB(0, 1), cB + hstepB, voffB); G_STAGE(G_SA(0, 1), cA + hstepA, voffA);
    if (wr == 1) G_BAR;
    G_WAIT_V(4); G_BAR;
    G_STAGE(G_SB(1, 0), cB + kstep, voffB); G_STAGE(G_SA(1, 0), cA + kstep, voffA); G_STAGE(G_SB(1, 1), cB + hstepB + kstep, voffB);
    G_WAIT_V(6); G_BAR;
    for (;;) {
        const bool has_next = S_.next(ui + 1, nxt);
        const char* nA = has_next ? (const char*)nxt.a : cA; const char* nB = has_next ? (const char*)nxt.b : cB;
#pragma unroll 1
        for (int t = 0; t < nt; t += 2) {
            const bool last = (t == nt - 2);
            const char* a1 = cA + (size_t)(t + 1) * kstep;
            const char* a2 = last ? nA : cA + (size_t)(t + 2) * kstep; const char* b2 = last ? nB : cB + (size_t)(t + 2) * kstep;
            const char* a3 = a2 + kstep; const char* b3 = b2 + kstep;
            G_LDB(B0, 0, 0); G_SCHED; G_LDA(At, 0, 0); G_STAGE(G_SA(1, 1), a1 + hstepA, voffA);
            G_WAIT_L(8); G_BAR; G_WAIT_L(0); G_MMA(0, 0, At, B0); G_BAR; G_SCHED;
            G_LDB(B1, 0, 1); G_STAGE(G_SB(0, 0), b2, voffB);
            G_BAR; G_WAIT_L(0); G_MMA(0, 1, At, B1); G_BAR;
            G_LDA(At, 0, 1); G_STAGE(G_SA(0, 0), a2, voffA);
            G_BAR; G_WAIT_L(0); G_MMA(1, 0, At, B0); G_BAR; G_SCHED;
            G_STAGE(G_SB(0, 1), b2 + hstepB, voffB);
            G_WAIT_V(6); G_BAR; G_MMA(1, 1, At, B1); G_BAR;
            G_LDB(B0, 1, 0); G_SCHED; G_LDA(At, 1, 0); G_STAGE(G_SA(0, 1), a2 + hstepA, voffA);
            G_WAIT_L(8); G_BAR; G_WAIT_L(0); G_MMA(0, 0, At, B0); G_BAR; G_SCHED;
            G_LDB(B1, 1, 1); G_STAGE(G_SB(1, 0), b3, voffB);
            G_BAR; G_WAIT_L(0); G_MMA(0, 1, At, B1); G_BAR;
            G_LDA(At, 1, 1); G_STAGE(G_SA(1, 0), a3, voffA);
            G_BAR; G_WAIT_L(0); G_MMA(1, 0, At, B0); G_BAR; G_SCHED;
            G_STAGE(G_SB(1, 1), b3 + hstepB, voffB);
            G_WAIT_V(6); G_BAR; G_MMA(1, 1, At, B1); G_BAR;
        }
        { const int t2 = TID(), w2 = t2 >> 6, l2 = t2 & 63;
          E(acc, cur, w2 >> 2, w2 & 3, l2 & 15, l2 >> 4); }
        if (!has_next) break;
        if (!E.keep(cur)) {
#pragma unroll
            for (int a = 0; a < 2; ++a)
#pragma unroll
                for (int b = 0; b < 2; ++b)
#pragma unroll
                    for (int m = 0; m < 4; ++m)
#pragma unroll
                        for (int n = 0; n < 2; ++n) acc[a][b][m][n] = (f32x4){0.f, 0.f, 0.f, 0.f};
        }
        cur = nxt; cA = nA; cB = nB; ++ui;
    }
    G_WAIT_V(0);
    if (wr == 0) G_BAR;
    G_BAR;
#undef G_SA
#undef G_SB
#undef G_STAGE
#undef G_LDA
#undef G_LDB
#undef G_MMA
#undef G_WAIT_V
#undef G_WAIT_L
#undef G_BAR
#undef G_SCHED
}


#define XB_TMO      128
#define XB_XCNT(j)  (256  + 64 * (j))
#define XB_XSUB(j)  (1280 + 64 * (j))
#define XB_XGEN(j)  (2304 + 64 * (j))
#define XB_TOP      3328
#define XB_TOPGEN   3392
#define XCD_BAR_WORDS 3456
#define XB_SPIN_CAP (1u << 18)
__device__ __forceinline__ unsigned xb_ld(unsigned* p)              { return __hip_atomic_load(p, __ATOMIC_RELAXED, __HIP_MEMORY_SCOPE_AGENT); }
__device__ __forceinline__ unsigned xb_add(unsigned* p, unsigned v) { return __hip_atomic_fetch_add(p, v, __ATOMIC_RELAXED, __HIP_MEMORY_SCOPE_AGENT); }
__device__ __forceinline__ unsigned xb_xcc_id() { return (unsigned)__builtin_amdgcn_s_getreg((3 << 11) | 20) & 0xFu; }
#define XB_SPIN(cond, bar) do { unsigned _sp = 0; while (cond) { __builtin_amdgcn_s_sleep(1); \
    if ((++_sp & 255u) == 0u) { if (xb_ld(&(bar)[XB_TMO])) break; if (_sp > XB_SPIN_CAP) { atomicAdd(&(bar)[XB_TMO], 1u); break; } } } } while (0)
struct XcdBarrier { unsigned* bar; unsigned x; volatile LAS unsigned* st; };
__device__ __forceinline__ XcdBarrier xcd_barrier_post(unsigned* bar, volatile LAS unsigned* st) {
    XcdBarrier b; b.bar = bar; b.x = xb_xcc_id(); b.st = st;
    if (TID() == 0) (void)xb_add(&bar[XB_XCNT(b.x)], 1u);
    return b;
}
__device__ __forceinline__ void xcd_barrier_complete(unsigned* bar, unsigned x, unsigned& nloc, unsigned& nx) {
    const unsigned G = gridDim.x * gridDim.y * gridDim.z;
    unsigned sum, cnt, mine, sp = 0u;
    for (;;) {
        sum = 0u; cnt = 0u; mine = 0u;
#pragma unroll
        for (unsigned j = 0; j < 16; ++j) { const unsigned c = xb_ld(&bar[XB_XCNT(j)]); sum += c; cnt += (c > 0u) ? 1u : 0u; mine = (j == x) ? c : mine; }
        if (sum == G) break;
        __builtin_amdgcn_s_sleep(1);
        if ((++sp & 255u) == 0u) { if (xb_ld(&bar[XB_TMO])) break; if (sp > XB_SPIN_CAP) { atomicAdd(&bar[XB_TMO], 1u); break; } }
    }
    nloc = mine > 0u ? mine : 1u; nx = cnt > 0u ? cnt : 1u;
}
__device__ __forceinline__ void xcd_barrier(const XcdBarrier& b) {
    asm volatile("s_waitcnt vmcnt(0)" ::: "memory");
    __syncthreads();
    if (TID() == 0) {
        unsigned* bar = b.bar;
        __builtin_amdgcn_s_waitcnt(0);
        unsigned nloc = b.st[0], nx = b.st[1];
        if (nloc == 0u) { xcd_barrier_complete(bar, b.x, nloc, nx); b.st[0] = nloc; b.st[1] = nx; }
        const unsigned old = xb_add(&bar[XB_XSUB(b.x)], 1u);
        const unsigned gen = old / nloc;
        if (old + 1u == (gen + 1u) * nloc) {
            __builtin_amdgcn_fence(__ATOMIC_RELEASE, "agent");
            asm volatile("s_waitcnt vmcnt(0)" ::: "memory");
            const unsigned og = xb_add(&bar[XB_TOP], 1u);
            const unsigned tg = og / nx;
            if (og + 1u == (tg + 1u) * nx) xb_add(&bar[XB_TOPGEN], 1u);
            else XB_SPIN(xb_ld(&bar[XB_TOPGEN]) == tg, bar);
            __builtin_amdgcn_fence(__ATOMIC_ACQUIRE, "agent");
            xb_add(&bar[XB_XGEN(b.x)], 1u);
            asm volatile("s_waitcnt vmcnt(0)" ::: "memory");
        } else {
            XB_SPIN(xb_ld(&bar[XB_XGEN(b.x)]) == gen, bar);
            __builtin_amdgcn_fence(__ATOMIC_ACQUIRE, "agent");
            asm volatile("s_waitcnt vmcnt(0)" ::: "memory");
        }
    }
    __syncthreads();
}

struct TDesc { const float* src; const float* ks; u16* dst; long ldd; int N, coff, rm, tix; };
constexpr int TS_IN = (DM / 256) * (INT / 64), TS_Q = (QL / 256) * (NQ / 64), TS_KV = (KVL / 256) * (NKV / 64), TS_SQ = (DM / 256) * (DM / 64), TS_PLE = (PLE / 256) * (DM / 64);
constexpr int TS_LAYER = TS_IN + TS_Q + TS_KV + 4 * TS_SQ + TS_PLE, TS_TOTAL = DEPTH * TS_LAYER;
__device__ __forceinline__ TDesc tdesc(const Params& p, int g) {
    const int l = g / TS_LAYER; int r = g % TS_LAYER; TDesc d; d.ks = nullptr; d.coff = 0; d.rm = 0;
    if (r < TS_IN) { d.src = p.w_in + (size_t)l * DM * INT; d.N = INT; d.dst = p.Wt_in + (size_t)l * NIN * DM; d.ldd = DM; d.rm = 1; d.ks = p.attn_norm + l * DM; d.tix = r; return d; }
    r -= TS_IN;
    if (r < TS_Q) { d.src = p.w_q_b + (size_t)l * QL * NQ; d.N = NQ; d.dst = p.Wt_q + (size_t)l * NQ * QL; d.ldd = QL; d.rm = 2; d.tix = r; return d; }
    r -= TS_Q;
    if (r < TS_KV) { d.src = p.w_kv_b + (size_t)l * KVL * NKV; d.N = NKV; d.dst = p.Wt_kv + (size_t)l * NKV * KVL; d.ldd = KVL; d.rm = 3; d.tix = r; return d; }
    r -= TS_KV;
    if (r < TS_SQ) { d.src = p.w_o_mla + (size_t)l * DM * DM; d.N = DM; d.dst = p.Wt_o + (size_t)l * DM * 4096; d.ldd = 4096; d.rm = 3; d.tix = r; return d; }
    r -= TS_SQ;
    if (r < TS_SQ) { d.src = p.w_o_lru + (size_t)l * DM * DM; d.N = DM; d.dst = p.Wt_o + (size_t)l * DM * 4096; d.ldd = 4096; d.coff = 2048; d.rm = 3; d.tix = r; return d; }
    r -= TS_SQ;
    if (r < TS_SQ) { d.src = p.w_out + (size_t)l * DM * DM; d.N = DM; d.dst = p.Wt_out + (size_t)l * DM * DM; d.ldd = DM; d.rm = 3; d.tix = r; return d; }
    r -= TS_SQ;
    if (r < TS_SQ) { d.src = p.w_ple_gate + (size_t)l * DM * DM; d.N = DM; d.dst = p.Wt_pg + (size_t)l * DM * DM; d.ldd = DM; d.rm = 3; d.ks = p.ple_norm + l * DM; d.tix = r; return d; }
    r -= TS_SQ;
    d.src = p.w_ple + (size_t)l * PLE * DM; d.N = DM; d.dst = p.Wt_ple + (size_t)l * DM * PLE; d.ldd = PLE; d.rm = 3; d.tix = r; return d;
}
__device__ __forceinline__ int pslot(int r) { const int c = r & 31; return (r & ~31) + 16 * ((c >> 2) & 1) + ((c >> 3) << 2) + (c & 3); }
__device__ __forceinline__ int trowmap(int rm, int n) {
    if (rm == 1) return pslot(n >= 1088 ? n - 1088 : n + ZB);
    if (rm == 2) { const int hh = n / QD, d = n % QD; if (d < NOPE) return pslot(n); const int e = d - NOPE; return pslot(hh * QD + NOPE + ((e & 31) << 1) + (e >> 5)); }
    if (rm == 3) return pslot(n);
    return n;
}
__device__ __forceinline__ void transpose_all(const Params& p, char* lds) {
    u16 (*t)[72] = (u16(*)[72])lds;
    const int tid = TID(), k = tid >> 3, nn = (tid & 7) * 8, G = gridDim.x;
    f32x4 vA[4][2], vB[4][2];
#define TC_LOAD(v_, d_) do { const int tn_ = (d_).N / 64, k0_ = ((d_).tix / tn_) * 256, n0_ = ((d_).tix % tn_) * 64; _Pragma("unroll") for (int j = 0; j < 4; ++j) { \
        const float* p_ = (d_).src + (long)(k0_ + k + 64 * j) * (d_).N + n0_ + nn; v_[j][0] = *(const f32x4*)p_; v_[j][1] = *(const f32x4*)(p_ + 4); \
        if ((d_).ks) { const float g_ = (d_).ks[k0_ + k + 64 * j]; v_[j][0] = v_[j][0] * g_; v_[j][1] = v_[j][1] * g_; } } } while (0)
#define TC_LDSW(v_) do { _Pragma("unroll") for (int j = 0; j < 4; ++j) *(u32x4*)&t[k + 64 * j][nn ^ (((k >> 3) & 7) << 3)] = (u32x4){pk2(v_[j][0][0], v_[j][0][1]), pk2(v_[j][0][2], v_[j][0][3]), pk2(v_[j][1][0], v_[j][1][1]), pk2(v_[j][1][2], v_[j][1][3])}; } while (0)
#define TC_STORE(d_) do { const int tn_ = (d_).N / 64, k0_ = ((d_).tix / tn_) * 256, n0_ = ((d_).tix % tn_) * 64; const int n_ = tid >> 3, kk_ = (tid & 7) * 8; \
        u16* drow_ = (d_).dst + (long)trowmap((d_).rm, n0_ + n_) * (d_).ldd + (d_).coff + k0_ + kk_; \
        _Pragma("unroll") for (int j = 0; j < 4; ++j) { u32x4 o_; _Pragma("unroll") for (int e = 0; e < 4; ++e) o_[e] = (unsigned)t[64 * j + kk_ + 2 * e][n_ ^ kk_] | ((unsigned)t[64 * j + kk_ + 2 * e + 1][n_ ^ kk_] << 16); \
            *(u32x4*)(drow_ + 64 * j) = o_; } } while (0)
    int gA = blockIdx.x, gB = gA + G; TDesc dA, dB, dc;
    if (gA < TS_TOTAL) { dA = tdesc(p, gA); TC_LOAD(vA, dA); }
    if (gB < TS_TOTAL) { dB = tdesc(p, gB); TC_LOAD(vB, dB); }
    while (gA < TS_TOTAL) {
        TC_LDSW(vA); __syncthreads(); dc = dA; gA += 2 * G; if (gA < TS_TOTAL) { dA = tdesc(p, gA); TC_LOAD(vA, dA); } TC_STORE(dc); __syncthreads();
        if (gB >= TS_TOTAL) break;
        TC_LDSW(vB); __syncthreads(); dc = dB; gB += 2 * G; if (gB < TS_TOTAL) { dB = tdesc(p, gB); TC_LOAD(vB, dB); } TC_STORE(dc); __syncthreads();
    }
#undef TC_LOAD
#undef TC_LDSW
#undef TC_STORE
}

__device__ __forceinline__ void phase_prologue(const Params& p, char* lds) {
    const long gtid = (long)blockIdx.x * NTHR + TID(), gsz = (long)gridDim.x * NTHR;
    transpose_all(p, lds);
    for (long i = gtid; i < (long)DEPTH * (NIN - INT) * DM / 8; i += gsz) { const long per = (long)(NIN - INT) * DM / 8; const int l = (int)(i / per); const long r = i % per;
        *(u32x4*)(p.Wt_in + ((size_t)l * NIN + INT) * DM + r * 8) = (u32x4){0u, 0u, 0u, 0u}; }
    for (long i = gtid; i < (long)DEPTH * LRUB * 256 * 256; i += gsz) {
        const int k = (int)(i & 255), o = (int)((i >> 8) & 255), blk = (int)((i >> 16) & 15), l = (int)(i >> 20);
        const int kk = k - 128 * (blk & 1), cl = o >> 1; float v = 0.f;
        if (kk >= 0 && kk < 128) v = ((o & 1) ? p.w_ig : p.w_rg)[(((size_t)l * LRUB + blk) * LBD + kk) * LBD + cl];
        p.Wt_lru[i] = f2bf(v); }
    for (long i = gtid; i < (long)DEPTH * S * PLE / 8; i += gsz) { const float* s = p.p_in + i * 8; const f32x4 v0 = *(const f32x4*)s, v1 = *(const f32x4*)(s + 4);
        *(u32x4*)(p.pb + i * 8) = (u32x4){pk2(v0[0], v0[1]), pk2(v0[2], v0[3]), pk2(v1[0], v1[1]), pk2(v1[2], v1[3])}; }
    for (long i = gtid; i < (long)DEPTH * DM; i += gsz) p.nsp8[i] = -8.f * log1pf(expf(-p.lam[i]));
    for (long i = gtid; i < (long)S * 32; i += gsz) { const int s = (int)(i >> 5), f = (int)(i & 31);
        const float inv = powf(10000.f, -(float)(2 * f) / 64.f), ang = (float)p.pos[s] * inv;
        p.cs[(long)s * 64 + f] = (float)cos((double)ang); p.cs[(long)s * 64 + 32 + f] = (float)sin((double)ang); }
}

__device__ __forceinline__ void phase_xb_ssq(const float* __restrict__ x, u16* __restrict__ out, float* __restrict__ ssq) {
    const int tid = TID(), lane = tid & 63, gw = blockIdx.x * (NTHR / 64) + (tid >> 6), nw = gridDim.x * (NTHR / 64);
    for (int row = gw; row < S; row += nw) {
        const float* p = x + (long)row * DM; f32x4 v[8]; float s = 0.f;
#pragma unroll
        for (int j = 0; j < 8; ++j) { v[j] = *(const f32x4*)(p + j * 256 + lane * 4); s += v[j][0] * v[j][0] + v[j][1] * v[j][1] + v[j][2] * v[j][2] + v[j][3] * v[j][3]; }
        s = wsum(s, lane);
#pragma unroll
        for (int j = 0; j < 8; ++j) *(u32x2*)(out + (long)row * DM + j * 256 + lane * 4) = (u32x2){pk2(v[j][0], v[j][1]), pk2(v[j][2], v[j][3])};
        if (lane == 0) ssq[row] = s;
    }
}
__device__ __forceinline__ void phase_final_norm(float* __restrict__ x, const float* __restrict__ g) {
    const int tid = TID(), lane = tid & 63, gw = blockIdx.x * (NTHR / 64) + (tid >> 6), nw = gridDim.x * (NTHR / 64);
    for (int row = gw; row < S; row += nw) {
        float* p = x + (long)row * DM; f32x4 v[8]; float s = 0.f;
#pragma unroll
        for (int j = 0; j < 8; ++j) { v[j] = *(const f32x4*)(p + j * 256 + lane * 4); s += v[j][0] * v[j][0] + v[j][1] * v[j][1] + v[j][2] * v[j][2] + v[j][3] * v[j][3]; }
        s = wsum(s, lane); const float rinv = rsqrtf(s * (1.f / DM) + 1e-6f);
#pragma unroll
        for (int j = 0; j < 8; ++j) { const f32x4 gg = *(const f32x4*)(g + j * 256 + lane * 4); *(f32x4*)(p + j * 256 + lane * 4) = v[j] * rinv * gg; }
    }
}
__device__ __forceinline__ void t2_rows(const float* __restrict__ zA, const u16* __restrict__ zB, const float* __restrict__ cs, const float* __restrict__ cw, const float* __restrict__ cb,
                                        const float* __restrict__ gq, const float* __restrict__ gkv, u16* __restrict__ qn, u16* __restrict__ kvn, u16* __restrict__ Kf, u16* __restrict__ xc, float* __restrict__ ssqB) {
    const int tid = TID(), lane = tid & 63, gw = blockIdx.x * (NTHR / 64) + (tid >> 6), nw = gridDim.x * (NTHR / 64);
    for (int row = gw; row < S; row += nw) {
        const float* zr = zA + (long)row * ZA;
        f32x4 v[2][2];
#pragma unroll
        for (int part = 0; part < 2; ++part) { v[part][0] = *(const f32x4*)(zr + part * 512 + lane * 4); v[part][1] = *(const f32x4*)(zr + part * 512 + 256 + lane * 4); }
        const int l32 = lane & 31;
        const float x1 = zr[1024 + l32], x2 = zr[1056 + l32], cc = cs[(long)row * 64 + l32], sn = cs[(long)row * 64 + 32 + l32];
        u32x2 uu[8][4];
#pragma unroll
        for (int j = 0; j < 8; ++j)
#pragma unroll
            for (int k = 0; k < 4; ++k) { const int sp = row - 3 + k; uu[j][k] = (u32x2){0u, 0u}; if (sp >= 0) uu[j][k] = *(const u32x2*)(zB + (long)sp * ZB + 2048 + j * 256 + lane * 4); }
        if (lane == 0) ssqB[row] = 0.f;
#pragma unroll
        for (int part = 0; part < 2; ++part) {
            const float* g = part ? gkv : gq; u16* dst = (part ? kvn : qn) + (long)row * 512;
            const f32x4 v0 = v[part][0], v1 = v[part][1];
            float s = v0[0] * v0[0] + v0[1] * v0[1] + v0[2] * v0[2] + v0[3] * v0[3] + v1[0] * v1[0] + v1[1] * v1[1] + v1[2] * v1[2] + v1[3] * v1[3];
            s = wsum(s, lane); const float rinv = rsqrtf(s * (1.f / 512.f) + 1e-6f);
            const f32x4 g0 = *(const f32x4*)(g + lane * 4), g1 = *(const f32x4*)(g + 256 + lane * 4);
            *(u32x2*)(dst + lane * 4) = (u32x2){pk2(v0[0] * rinv * g0[0], v0[1] * rinv * g0[1]), pk2(v0[2] * rinv * g0[2], v0[3] * rinv * g0[3])};
            *(u32x2*)(dst + 256 + lane * 4) = (u32x2){pk2(v1[0] * rinv * g1[0], v1[1] * rinv * g1[1]), pk2(v1[2] * rinv * g1[2], v1[3] * rinv * g1[3])};
        }
        if (lane < 32) { const unsigned w = pk2(x1 * cc - x2 * sn, x2 * cc + x1 * sn);
#pragma unroll
            for (int hh = 0; hh < NH; ++hh) *(unsigned*)(Kf + ((long)hh * S + row) * QD + NOPE + 2 * lane) = w; }
#pragma unroll
        for (int j = 0; j < 8; ++j) { const int c = j * 256 + lane * 4; f32x4 y = *(const f32x4*)(cb + c);
#pragma unroll
            for (int k = 0; k < 4; ++k) { const f32x4 w = *(const f32x4*)(cw + k * DM + c); const u32x2 u2 = uu[j][k];
                y[0] += __uint_as_float(u2[0] << 16) * w[0]; y[1] += __uint_as_float(u2[0] & 0xffff0000u) * w[1]; y[2] += __uint_as_float(u2[1] << 16) * w[2]; y[3] += __uint_as_float(u2[1] & 0xffff0000u) * w[3]; }
            *(u32x2*)(xc + (long)row * DM + c) = (u32x2){pk2(y[0], y[1]), pk2(y[2], y[3])}; }
    }
}
__device__ __forceinline__ void phase_t2(const Params& p, int l) {
    t2_rows(p.zA, p.zB, p.cs, p.conv_w + (size_t)l * 4 * DM, p.conv_b + (size_t)l * DM, p.q_a_norm + l * 512, p.kv_a_norm + l * 512, p.qn, p.kvn, p.Kf, p.xc, p.ssqB);
}
__device__ __forceinline__ void phase_scan1(const Params& p) {
    float* Pc = p.carry; float* Hc = p.carry + 128 * DM;
    for (long i = (long)blockIdx.x * NTHR + TID(); i < 128L * DM; i += (long)gridDim.x * NTHR) {
        const int c = (int)(i % DM), ch = (int)(i / DM); float P = 1.f, H = 0.f;
        const float* pa = p.la + (long)ch * 64 * DM + c; const float* pb = p.lb + (long)ch * 64 * DM + c;
#pragma unroll 1
        for (int t0 = 0; t0 < 64; t0 += 16) { float a[16], b[16];
#pragma unroll
            for (int t = 0; t < 16; ++t) { a[t] = pa[(long)(t0 + t) * DM]; b[t] = pb[(long)(t0 + t) * DM]; }
#pragma unroll
            for (int t = 0; t < 16; ++t) { H = a[t] * H + b[t]; P *= a[t]; } }
        Pc[i] = P; Hc[i] = H; }
}
__device__ __forceinline__ void scan3_rows(const float* __restrict__ Pc, const float* __restrict__ Hc, const float* __restrict__ la, const float* __restrict__ lb, const u16* __restrict__ zB,
                                           u16* __restrict__ OH, float* __restrict__ ssqA) {
    for (long i = (long)blockIdx.x * NTHR + TID(); i < 128L * DM; i += (long)gridDim.x * NTHR) {
        if (i < S) ssqA[i] = 0.f;
        const int c = (int)(i % DM), ch = (int)(i / DM); float H = 0.f;
        int k = 0;
#pragma unroll 1
        for (; k + 16 <= ch; k += 16) { float a[16], b[16];
#pragma unroll
            for (int t = 0; t < 16; ++t) { a[t] = Pc[(long)(k + t) * DM + c]; b[t] = Hc[(long)(k + t) * DM + c]; }
#pragma unroll
            for (int t = 0; t < 16; ++t) H = a[t] * H + b[t]; }
        for (; k < ch; ++k) H = Pc[(long)k * DM + c] * H + Hc[(long)k * DM + c];
        const float* pa = la + (long)ch * 64 * DM + c; const float* pb = lb + (long)ch * 64 * DM + c;
        const u16* pg = zB + (long)ch * 64 * ZB + 4096 + c; u16* po = OH + (long)ch * 64 * 4096 + 2048 + c;
#pragma unroll
        for (int t0 = 0; t0 < 64; t0 += 16) { float a[16], b[16]; u16 g[16];
#pragma unroll
            for (int t = 0; t < 16; ++t) { a[t] = pa[(long)(t0 + t) * DM]; b[t] = pb[(long)(t0 + t) * DM]; g[t] = pg[(long)(t0 + t) * ZB]; }
#pragma unroll
            for (int t = 0; t < 16; ++t) { H = a[t] * H + b[t]; po[(long)(t0 + t) * 4096] = f2bf(H * bf2f(g[t])); } } }
}
__device__ __forceinline__ void phase_scan3(const Params& p) { scan3_rows(p.carry, p.carry + 128 * DM, p.la, p.lb, p.zB, p.OH, p.ssqA); }

typedef float f32x16 __attribute__((ext_vector_type(16)));
typedef short s16x4 __attribute__((ext_vector_type(4)));
constexpr int SHM_V = 64 * 128 * 2, SHM_K = 64 * 192 * 2, ATT_WS = 2 * SHM_V + 2 * SHM_K;
#define KSWZ(row, colB) ((row) * 384 + ((colB) ^ (((row) & 7) << 4)))
__device__ __forceinline__ int v_st(int k, int c) { const int kk = (k & ~0xC) | ((k & 4) << 1) | ((k & 8) >> 1); return ((kk >> 3) * 4 + (c >> 5)) * 512 + ((kk & 7) * 32 + (c & 31)) * 2; }
__device__ __forceinline__ int v_rd_base(int lane) { return ((lane & 3) << 3) | (((lane >> 2) & 3) << 6) | (((lane >> 4) & 1) << 5) | (((lane >> 5) & 1) << 8); }
constexpr int v_rd_off(int d0, int ks, int half) { return d0 * 512 + ks * 4096 + half * 2048; }
__device__ __forceinline__ int crow(int r, int hi) { return (r & 3) + 8 * (r >> 2) + 4 * hi; }
__device__ __forceinline__ unsigned cvtpk(float lo, float hi) { unsigned r; asm volatile("v_cvt_pk_bf16_f32 %0, %1, %2" : "=v"(r) : "v"(lo), "v"(hi)); return r; }

__device__ __forceinline__ void partialSM(f32x16& p0, f32x16& p1, float& m_reg, float& mn, float& alpha) {
    float pmax = p0[0];
#pragma unroll
    for (int r = 1; r < 16; ++r) pmax = fmaxf(pmax, p0[r]);
#pragma unroll
    for (int r = 0; r < 16; ++r) pmax = fmaxf(pmax, p1[r]);
    { auto rr = __builtin_amdgcn_permlane32_swap(__float_as_uint(pmax), __float_as_uint(pmax), false, false);
      pmax = fmaxf(__uint_as_float(rr[0]), __uint_as_float(rr[1])); }
    if (__builtin_expect(__all(pmax - m_reg <= 11.5f), 1)) { mn = m_reg; alpha = 1.f; }
    else { mn = fmaxf(m_reg, pmax); alpha = __builtin_amdgcn_exp2f(m_reg - mn); m_reg = mn; }
#pragma unroll
    for (int r = 0; r < 16; ++r) p0[r] = p0[r] - mn;
#pragma unroll
    for (int r = 0; r < 16; ++r) p1[r] = p1[r] - mn;
#pragma unroll
    for (int r = 0; r < 16; ++r) p0[r] = __builtin_amdgcn_exp2f(p0[r]);
}
__device__ __forceinline__ void finishSM(f32x16& p0, f32x16& p1, float alpha, float& l_reg, bf16x8& pa0, bf16x8& pa1, bf16x8& pa2, bf16x8& pa3) {
#pragma unroll
    for (int r = 0; r < 16; ++r) p1[r] = __builtin_amdgcn_exp2f(p1[r]);
    float ps = 0;
#pragma unroll
    for (int r = 0; r < 16; ++r) ps += p0[r];
#pragma unroll
    for (int r = 0; r < 16; ++r) ps += p1[r];
    { auto rr = __builtin_amdgcn_permlane32_swap(__float_as_uint(ps), __float_as_uint(ps), false, false);
      ps = __uint_as_float(rr[0]) + __uint_as_float(rr[1]); }
    l_reg = l_reg * alpha + ps;
#define PK4(P, B_, OUT) do { unsigned a0 = cvtpk(P[B_+0], P[B_+1]), a1 = cvtpk(P[B_+2], P[B_+3]);                          \
        unsigned b0 = cvtpk(P[B_+4], P[B_+5]), b1 = cvtpk(P[B_+6], P[B_+7]);                                             \
        auto r0 = __builtin_amdgcn_permlane32_swap(a0, b0, false, false); auto r1 = __builtin_amdgcn_permlane32_swap(a1, b1, false, false); \
        u32x4 w = {r0[0], r1[0], r0[1], r1[1]}; OUT = *reinterpret_cast<bf16x8*>(&w); } while (0)
    PK4(p0, 0, pa0); PK4(p0, 8, pa1); PK4(p1, 0, pa2); PK4(p1, 8, pa3);
#undef PK4
}
template <int KB>
__device__ __forceinline__ void qkt(f32x16& p0, f32x16& p1, LAS char* K_lds, int r32, int hi, const bf16x8* qr, bool act) {
    if (!act) { const float NEG = -__builtin_inff();
#pragma unroll
        for (int r = 0; r < 16; ++r) { p0[r] = NEG; p1[r] = NEG; } return; }
#pragma unroll
    for (int r = 0; r < 16; ++r) { p0[r] = 0.f; p1[r] = 0.f; }
    LAS char* kb[4];
#pragma unroll
    for (int dd = 0; dd < 4; ++dd) kb[dd] = K_lds + KB * SHM_K + KSWZ(r32, (dd * 16 + hi * 8) * 2);
#pragma unroll
    for (int d0 = 0; d0 < 12; ++d0) { LAS char* a = kb[d0 & 3] + (d0 >> 2) * 128;
        const bf16x8 b0 = *(const LAS bf16x8*)a;
        const bf16x8 b1 = *(const LAS bf16x8*)(a + 32 * 384);
        p0 = __builtin_amdgcn_mfma_f32_32x32x16_bf16(b0, qr[d0], p0, 0, 0, 0);
        p1 = __builtin_amdgcn_mfma_f32_32x32x16_bf16(b1, qr[d0], p1, 0, 0, 0); }
}
template <int VB>
__device__ __forceinline__ void pv_tile(f32x16* o, int vb0, bf16x8 pa0, bf16x8 pa1, bf16x8 pa2, bf16x8 pa3, bool act) {
    if (!act) return;
#define TRRD(dst, off) asm volatile("ds_read_b64_tr_b16 %0, %1 offset:%2" : "=&v"(dst) : "v"(vb0), "i"(off) : "memory")
#define PV_D0(d0) do { s16x4 l0, l1, l2, l3, h0, h1, h2, h3; constexpr int b_ = VB * SHM_V + v_rd_off(d0, 0, 0); \
        TRRD(l0, b_); TRRD(h0, b_ + 2048); TRRD(l1, b_ + 4096); TRRD(h1, b_ + 6144); TRRD(l2, b_ + 8192); TRRD(h2, b_ + 10240); TRRD(l3, b_ + 12288); TRRD(h3, b_ + 14336); \
        asm volatile("s_waitcnt lgkmcnt(0)" ::: "memory"); __builtin_amdgcn_sched_barrier(0); \
        o[d0] = __builtin_amdgcn_mfma_f32_32x32x16_bf16(pa0, (bf16x8){l0[0], l0[1], l0[2], l0[3], h0[0], h0[1], h0[2], h0[3]}, o[d0], 0, 0, 0);   \
        o[d0] = __builtin_amdgcn_mfma_f32_32x32x16_bf16(pa1, (bf16x8){l1[0], l1[1], l1[2], l1[3], h1[0], h1[1], h1[2], h1[3]}, o[d0], 0, 0, 0);   \
        o[d0] = __builtin_amdgcn_mfma_f32_32x32x16_bf16(pa2, (bf16x8){l2[0], l2[1], l2[2], l2[3], h2[0], h2[1], h2[2], h2[3]}, o[d0], 0, 0, 0);   \
        o[d0] = __builtin_amdgcn_mfma_f32_32x32x16_bf16(pa3, (bf16x8){l3[0], l3[1], l3[2], l3[3], h3[0], h3[1], h3[2], h3[3]}, o[d0], 0, 0, 0); } while (0)
    PV_D0(0); PV_D0(1); PV_D0(2); PV_D0(3);
#undef PV_D0
#undef TRRD
}

__device__ __forceinline__ void attn_block(char* lds, const u16* __restrict__ Qb, const u16* __restrict__ Kh, const u16* __restrict__ Vh,
                                           const u16* __restrict__ sg, u16* __restrict__ Ob, int P0) {
    const int tid = TID(), wid = __builtin_amdgcn_readfirstlane(tid >> 6), lane = tid & 63, r32 = lane & 31, hi = lane >> 5;
    const int NT = (P0 >> 6) + 4;
    const int wchunk = (P0 >> 6) + (wid >> 1);
    LAS char* L = (LAS char*)lds; LAS char* V_lds = L; LAS char* K_lds = L + 2 * SHM_V;
    LAS float* wsf = (LAS float*)(L + ATT_WS) + wid * 64; LAS float* li_l = wsf; LAS float* al_l = wsf + 32;
    float m_reg = -1e30f, l_reg = 0.f; f32x16 o[4];
#pragma unroll
    for (int d = 0; d < 4; ++d)
#pragma unroll
        for (int r = 0; r < 16; ++r) o[d][r] = 0.f;
    const int sr = tid >> 4, sc = (tid & 15) * 8, vst0 = v_st(sr, sc), vst1 = v_st(32 + sr, sc);
    const int kc0 = tid, kc1 = tid + 512, kc2 = tid + 1024;
    const int kws0 = KSWZ(kc0 / 24, (kc0 % 24) * 16), kws1 = KSWZ(kc1 / 24, (kc1 % 24) * 16), kws2 = KSWZ(kc2 / 24, (kc2 % 24) * 16);
    const int vb0 = (int)(unsigned)(uintptr_t)V_lds + v_rd_base(lane);
    bf16x8 qr[12];
#pragma unroll
    for (int d0 = 0; d0 < 12; ++d0) qr[d0] = *(const bf16x8*)(Qb + (long)(wid * 32 + r32) * NQ + d0 * 16 + hi * 8);
    bf16x8 st_k0, st_k1, st_k2, st_v0, st_v1;
#define VMW() asm volatile("s_waitcnt vmcnt(0)" ::: "memory")
#define SBAR() __builtin_amdgcn_sched_barrier(0)
#define SLOAD(t) do { const u16* kp_ = Kh + (long)(t) * 64 * QD + tid * 8; st_k0 = *(const bf16x8*)kp_; st_k1 = *(const bf16x8*)(kp_ + 4096); st_k2 = *(const bf16x8*)(kp_ + 8192); \
                      const u16* vp_ = Vh + ((long)(t) * 64 + sr) * VH + sc; st_v0 = *(const bf16x8*)vp_; st_v1 = *(const bf16x8*)(vp_ + 32 * VH); } while (0)
#define SWRITE(bf) do { *(LAS bf16x8*)(K_lds + (bf) * SHM_K + kws0) = st_k0; *(LAS bf16x8*)(K_lds + (bf) * SHM_K + kws1) = st_k1; *(LAS bf16x8*)(K_lds + (bf) * SHM_K + kws2) = st_k2; \
                        *(LAS bf16x8*)(V_lds + (bf) * SHM_V + vst0) = st_v0; *(LAS bf16x8*)(V_lds + (bf) * SHM_V + vst1) = st_v1; } while (0)
#define RESC(a) do { if (__any((a) < 1.f)) { if (hi == 0) al_l[r32] = (a); asm volatile("s_waitcnt lgkmcnt(0)" ::: "memory");              \
                     _Pragma("unroll") for (int d_ = 0; d_ < 4; ++d_) _Pragma("unroll") for (int r = 0; r < 16; ++r) o[d_][r] *= al_l[crow(r, hi)]; } } while (0)
#define ACT(t) ((t) <= wchunk)
    f32x16 pA0, pA1, pB0, pB1; float mnA, mnB, alA, alB; bf16x8 pa0, pa1, pa2, pa3;
    SLOAD(0); VMW(); SWRITE(0); SBAR();
    SLOAD(1);
    __syncthreads();
    SBAR(); qkt<0>(pA0, pA1, K_lds, r32, hi, qr, ACT(0));
    partialSM(pA0, pA1, m_reg, mnA, alA);
    VMW(); SWRITE(1);
    __syncthreads();
#define HALF_STEP(PX0, PX1, mnX, alX, PY0, PY1, alY, t, KB, VB, SB) do {                                                      \
        SBAR(); qkt<KB>(PX0, PX1, K_lds, r32, hi, qr, ACT(t));                                                                \
        finishSM(PY0, PY1, alY, l_reg, pa0, pa1, pa2, pa3); SBAR();                                                           \
        if ((t) + 1 < NT) { SLOAD((t) + 1); SBAR(); }                                                                          \
        pv_tile<VB>(o, vb0, pa0, pa1, pa2, pa3, ACT((t) - 1)); partialSM(PX0, PX1, m_reg, mnX, alX);                          \
        __syncthreads();                                                                                                      \
        if ((t) + 1 < NT) { VMW(); SWRITE(SB); }                                                                               \
        RESC(alX); __syncthreads(); } while (0)
    for (int t = 1; t + 1 < NT; t += 2) {
        HALF_STEP(pB0, pB1, mnB, alB, pA0, pA1, alA, t, 1, 0, 0);
        HALF_STEP(pA0, pA1, mnA, alA, pB0, pB1, alB, t + 1, 0, 1, 1);
    }
    SBAR(); qkt<1>(pB0, pB1, K_lds, r32, hi, qr, ACT(NT - 1)); SBAR();
    finishSM(pA0, pA1, alA, l_reg, pa0, pa1, pa2, pa3); SBAR();
    pv_tile<0>(o, vb0, pa0, pa1, pa2, pa3, ACT(NT - 2));
    partialSM(pB0, pB1, m_reg, mnB, alB); __syncthreads(); RESC(alB);
    finishSM(pB0, pB1, alB, l_reg, pa0, pa1, pa2, pa3); SBAR(); pv_tile<1>(o, vb0, pa0, pa1, pa2, pa3, ACT(NT - 1));
    SBAR();
    if (hi == 0) li_l[r32] = l_reg; asm volatile("s_waitcnt lgkmcnt(0)" ::: "memory");
    float rli[16];
#pragma unroll
    for (int r = 0; r < 16; ++r) rli[r] = __builtin_amdgcn_rcpf(li_l[crow(r, hi)]);
    const int xl = (lane ^ 1) << 2;
    unsigned gg[16][4];
#pragma unroll
    for (int r = 0; r < 16; ++r)
#pragma unroll
        for (int d0 = 0; d0 < 4; ++d0) gg[r][d0] = *(const unsigned*)(sg + (long)(wid * 32 + crow(r, hi)) * ZB + d0 * 32 + (r32 & ~1));
#pragma unroll
    for (int r = 0; r < 16; ++r) { const int orow = wid * 32 + crow(r, hi);
#pragma unroll
        for (int d0 = 0; d0 < 4; ++d0) { const float v = o[d0][r] * rli[r];
            const float vn = __int_as_float(__builtin_amdgcn_ds_bpermute(xl, __float_as_int(v)));
            const unsigned g = gg[r][d0];
            if ((r32 & 1) == 0) *(unsigned*)(Ob + (long)orow * 4096 + d0 * 32 + r32) = cvtpk(v * __uint_as_float(g << 16), vn * __uint_as_float(g & 0xffff0000u)); } }
    __syncthreads();
#undef VMW
#undef SBAR
#undef SLOAD
#undef SWRITE
#undef RESC
#undef ACT
#undef HALF_STEP
}
__device__ __forceinline__ void phase_attention(const Params& p, char* lds) {
    for (int it = blockIdx.x; it < 256; it += gridDim.x) {
        const int xcd = it & 7, idx = it >> 3, hh = xcd * 2 + (idx >> 4), x = idx & 15;
        for (int half = 0; half < 2; ++half) { const int P0 = (half ? x : 31 - x) * 256;
            attn_block(lds, p.Q + (long)P0 * NQ + hh * QD, p.Kf + (long)hh * S * QD, p.Vf + (long)hh * S * VH, p.zB + (long)P0 * ZB + hh * VH, p.OH + (long)P0 * 4096 + hh * VH, P0); }
    }
}

#ifndef PROBE_MASK
#define PROBE_MASK 0
#endif
#if PROBE_MASK
#define TICK(cls) do { const unsigned long long now_ = __builtin_amdgcn_s_memrealtime(); if ((PROBE_MASK >> (cls)) & 1) t_acc += now_ - t_last; t_last = now_; } while (0)
#else
#define TICK(cls) do { } while (0)
#endif
__global__ __launch_bounds__(NTHR, 2) void mega(Params p) {
    extern __shared__ __attribute__((aligned(16))) char lds[];
    cg::grid_group grid = cg::this_grid();
    const int G = gridDim.x;
    volatile LAS unsigned* xbst = (volatile LAS unsigned*)((LAS char*)lds + 8 * HTB);
    if (TID() == 0) { xbst[0] = 0u; xbst[1] = 0u; xbst[2] = 0u; xbst[3] = 0u; }
    __syncthreads();
    if (blockIdx.x == 0) for (int i = TID(); i < XCD_BAR_WORDS; i += NTHR) p.bar[i] = 0u;
#if PROBE_MASK
    unsigned long long t_acc = 0, t_last = __builtin_amdgcn_s_memrealtime();
#endif
    phase_prologue(p, lds);
    phase_xb_ssq(p.x_in, p.hb, p.ssqA);
    grid.sync();
    const XcdBarrier xb = xcd_barrier_post(p.bar, xbst);
    TICK(0);
    for (int l = 0; l < DEPTH; ++l) {
        const int c = (int)blockIdx.x + opaque_zero();
        const float* xcur = l ? p.xr : p.x_in;
        { TileSched sc{p.hb, DM, p.Wt_in + (size_t)l * NIN * DM, DM, 32, NIN / 256, G, c}; EpiIn e{p.zB, p.zA, p.ssqA}; gemm_fast(lds, DM, DM, DM, sc, e); }
        xcd_barrier(xb); TICK(2);
        phase_t2(p, l);
        xcd_barrier(xb); TICK(3);
        { TileSched sc{p.qn, QL, p.Wt_q + (size_t)l * NQ * QL, QL, 32, NQ / 256, G, c}; EpiQ e{p.Q, p.cs}; gemm_fast(lds, QL, QL, QL, sc, e); }
        { TileSched sc{p.kvn, KVL, p.Wt_kv + (size_t)l * NKV * KVL, KVL, 32, NKV / 256, G, (c + 128) % G}; EpiKV e{p.Kf, p.Vf}; gemm_fast(lds, KVL, KVL, KVL, sc, e); }
        { LruSched sc{{p.xc, DM, p.Wt_lru + (size_t)l * LRUB * 65536, 256, 32, LRUB, G, c}}; EpiLru e{p.xc, p.b_rg + l * DM, p.b_ig + l * DM, p.nsp8 + l * DM, p.la, p.lb}; gemm_fast(lds, 256, DM, 256, sc, e); }
        xcd_barrier(xb); TICK(4);
        phase_scan1(p);
        phase_attention(p, lds);
        xcd_barrier(xb); TICK(5);
        phase_scan3(p);
        xcd_barrier(xb); TICK(6);
        { MergeSched sc{{p.OH, 4096, p.Wt_o + (size_t)l * DM * 4096, 4096, 32, 8, G, c}}; EpiMerge e{p.zB, p.mg}; gemm_fast(lds, DM, 4096, 4096, sc, e); }
        xcd_barrier(xb); TICK(7);
        { TileSched sc{p.mg, DM, p.Wt_out + (size_t)l * DM * DM, DM, 32, 8, G, c}; EpiOut e{xcur, p.xr, p.hb2, p.ssqB}; gemm_fast(lds, DM, DM, DM, sc, e); }
        { TileSched sc{p.pb + (size_t)l * S * PLE, PLE, p.Wt_ple + (size_t)l * DM * PLE, PLE, 32, 8, G, c}; EpiF32 e{p.pp, DM}; gemm_fast(lds, PLE, PLE, PLE, sc, e); }
        xcd_barrier(xb); TICK(8);
        { TileSched sc{p.hb2, DM, p.Wt_pg + (size_t)l * DM * DM, DM, 32, 8, G, c}; EpiPle e{p.xr, p.pp, p.ssqB, p.hb, p.ssqA}; gemm_fast(lds, DM, DM, DM, sc, e); }
        xcd_barrier(xb); TICK(9);
    }
    phase_final_norm(p.xr, p.final_norm);
#if PROBE_MASK
    __syncthreads();
    if (blockIdx.x == 0) { const float d = sqrtf((float)t_acc * 0.01f * 4.096e-8f);
        for (int j = 0; j < 8; ++j) p.xr[threadIdx.x * 8 + j] += d; }
#endif
}

constexpr size_t LDS_BYTES = 8 * HTB + 16;

extern "C" void kernel_launch(void* const* d_in, const int* in_sizes, int n_in, void* d_out, int out_size, void* d_ws, size_t ws_size, hipStream_t st) {
    Params p{};
    p.x_in = (const float*)d_in[0]; p.p_in = (const float*)d_in[1]; p.pos = (const int*)d_in[2];
    p.attn_norm = (const float*)d_in[3]; p.w_in = (const float*)d_in[4]; p.q_a_norm = (const float*)d_in[5]; p.w_q_b = (const float*)d_in[6];
    p.kv_a_norm = (const float*)d_in[7]; p.w_kv_b = (const float*)d_in[8]; p.conv_w = (const float*)d_in[9]; p.conv_b = (const float*)d_in[10];
    p.w_rg = (const float*)d_in[11]; p.b_rg = (const float*)d_in[12]; p.w_ig = (const float*)d_in[13]; p.b_ig = (const float*)d_in[14]; p.lam = (const float*)d_in[15];
    p.w_o_mla = (const float*)d_in[16]; p.w_o_lru = (const float*)d_in[17]; p.w_out = (const float*)d_in[18]; p.ple_norm = (const float*)d_in[19];
    p.w_ple_gate = (const float*)d_in[20]; p.w_ple = (const float*)d_in[21]; p.final_norm = (const float*)d_in[22];
    p.xr = (float*)d_out;
    char* w = (char*)d_ws; size_t off = 0;
    auto take = [&](size_t bytes) { char* r = w + off; off += (bytes + 255) & ~(size_t)255; return r; };
    p.Wt_in = (u16*)take((size_t)DEPTH * NIN * DM * 2); p.Wt_q = (u16*)take((size_t)DEPTH * NQ * QL * 2); p.Wt_kv = (u16*)take((size_t)DEPTH * NKV * KVL * 2);
    p.Wt_lru = (u16*)take((size_t)DEPTH * LRUB * 65536 * 2); p.Wt_o = (u16*)take((size_t)DEPTH * DM * 4096 * 2); p.Wt_out = (u16*)take((size_t)DEPTH * DM * DM * 2);
    p.Wt_pg = (u16*)take((size_t)DEPTH * DM * DM * 2); p.Wt_ple = (u16*)take((size_t)DEPTH * DM * PLE * 2);
    p.hb = (u16*)take((size_t)S * DM * 2); p.hb2 = (u16*)take((size_t)S * DM * 2); p.ssqA = (float*)take((size_t)S * 4); p.ssqB = (float*)take((size_t)S * 4); p.zB = (u16*)take((size_t)S * ZB * 2); p.zA = (float*)take((size_t)S * ZA * 4);
    p.qn = (u16*)take((size_t)S * QL * 2); p.kvn = (u16*)take((size_t)S * KVL * 2); p.Q = (u16*)take((size_t)S * NQ * 2);
    p.Kf = (u16*)take((size_t)NH * S * QD * 2); p.Vf = (u16*)take((size_t)NH * S * VH * 2); p.xc = (u16*)take((size_t)S * DM * 2);
    p.OH = (u16*)take((size_t)S * 4096 * 2); p.pb = (u16*)take((size_t)DEPTH * S * PLE * 2); p.cs = (float*)take((size_t)S * 64 * 4); p.carry = (float*)take((size_t)3 * 128 * DM * 4); p.nsp8 = (float*)take((size_t)DEPTH * DM * 4); p.bar = (unsigned*)take((size_t)XCD_BAR_WORDS * 4);
    p.la = (float*)take((size_t)S * DM * 4); p.lb = (float*)take((size_t)S * DM * 4); p.pp = (float*)take((size_t)S * DM * 4); p.mg = (u16*)take((size_t)S * DM * 2);
    if (off > ws_size) { fprintf(stderr, "workspace too small: need %zu have %zu\n", off, ws_size); return; }
    (void)hipFuncSetAttribute((const void*)mega, hipFuncAttributeMaxDynamicSharedMemorySize, (int)LDS_BYTES);
    int dev = 0, cus = 0; (void)hipGetDevice(&dev); (void)hipDeviceGetAttribute(&cus, hipDeviceAttributeMultiprocessorCount, dev);
    int per_cu = 0; (void)hipOccupancyMaxActiveBlocksPerMultiprocessor(&per_cu, mega, NTHR, LDS_BYTES);
    if (per_cu < 1 || cus < 1) { fprintf(stderr, "occupancy query failed\n"); return; }
    void* args[] = {&p};
    hipError_t e = hipLaunchCooperativeKernel((const void*)mega, dim3(cus), dim3(NTHR), args, LDS_BYTES, st);
    if (e != hipSuccess) fprintf(stderr, "cooperative launch failed: %s\n", hipGetErrorString(e));
}
```

```cpp
#include <hip/hip_runtime.h>
#include <hip/hip_cooperative_groups.h>
#include <cstdio>
#include <cstdint>
namespace cg = cooperative_groups;

constexpr int S = 8192, DM = 2048, DEPTH = 4, NH = 16, QL = 512, KVL = 512, NOPE = 128, ROPE = 64, VH = 128;
constexpr int INT = 11328, PLE = 256, LRUB = 16, LBD = 128;
constexpr int QD = 192, NQ = NH * QD  , NKV = NH * 256  ;
constexpr int NIN = 11520;
constexpr int ZB = 10240, ZA = 1280;
constexpr int NTHR = 512;
constexpr float QSCALE = 0.07216878364870322f * 1.4426950408889634f;

typedef unsigned short u16;
typedef short bf16x8 __attribute__((ext_vector_type(8)));
typedef float f32x4 __attribute__((ext_vector_type(4)));
typedef float f32x2 __attribute__((ext_vector_type(2)));
typedef unsigned u32x2 __attribute__((ext_vector_type(2)));
typedef unsigned u32x4 __attribute__((ext_vector_type(4)));

__device__ __forceinline__ u16 f2bf(float f) { unsigned u = __float_as_uint(f); u += 0x7FFFu + ((u >> 16) & 1u); return (u16)(u >> 16); }
__device__ __forceinline__ float bf2f(u16 b) { return __uint_as_float(((unsigned)b) << 16); }
__device__ __forceinline__ unsigned pk2(float lo, float hi) { unsigned r; asm volatile("v_cvt_pk_bf16_f32 %0, %1, %2" : "=v"(r) : "v"(lo), "v"(hi)); return r; }
__device__ __forceinline__ float sigmoidf_(float x) { return __builtin_amdgcn_rcpf(1.f + __builtin_amdgcn_exp2f(-1.4426950408889634f * x)); }
__device__ __forceinline__ float siluf_(float x) { return x * __builtin_amdgcn_rcpf(1.f + __builtin_amdgcn_exp2f(-1.4426950408889634f * x)); }
__device__ __forceinline__ int opaque_zero() { int z; asm volatile("s_mov_b32 %0, 0" : "=s"(z)); return z; }
#define TID() ((int)threadIdx.x + opaque_zero())
__device__ __forceinline__ float wsum(float s, int lane) { for (int off = 32; off; off >>= 1) s += __int_as_float(__builtin_amdgcn_ds_bpermute((lane ^ off) << 2, __float_as_int(s))); return s; }
__device__ __forceinline__ float wmax(float s, int lane) { for (int off = 32; off; off >>= 1) s = fmaxf(s, __int_as_float(__builtin_amdgcn_ds_bpermute((lane ^ off) << 2, __float_as_int(s)))); return s; }

struct Params {
    const float *x_in, *p_in; const int* pos;
    const float *attn_norm, *w_in, *q_a_norm, *w_q_b, *kv_a_norm, *w_kv_b, *conv_w, *conv_b, *w_rg, *b_rg, *w_ig, *b_ig, *lam, *w_o_mla, *w_o_lru, *w_out, *ple_norm, *w_ple_gate, *w_ple, *final_norm;
    float* xr;
    u16 *Wt_in, *Wt_q, *Wt_kv, *Wt_lru, *Wt_o, *Wt_out, *Wt_pg, *Wt_ple;
    u16 *hb, *hb2, *zB, *qn, *kvn, *Q, *Kf, *Vf, *xc, *OH, *mg, *pb, *Pm;
    float *zA, *la, *lb, *pp, *cs, *carry, *sc, *nsp8, *ssqA, *ssqB; unsigned* bar;
};

struct Unit { const u16* a; const u16* b; int pm, pn, aux; };

struct TileSched {
    const u16* A; long lda; const u16* B; long ldb; int nM, nN, G, c;
    __device__ __forceinline__ bool tile(int i, int& pm, int& pn) const {
        const int nwg = nM * nN; const long L = (long)i * G + c; if (L >= nwg) return false;
        int wgid = (int)L; { const int q = nwg / 8, r = nwg % 8, xcd = wgid % 8, off = wgid / 8; wgid = (xcd < r ? xcd * (q + 1) : r * (q + 1) + (xcd - r) * q) + off; }
        const int nig = 8 * nN, gid = wgid / nig, fm = gid * 8, gsz = (nM - fm) < 8 ? (nM - fm) : 8;
        pm = fm + ((wgid % nig) % gsz); pn = (wgid % nig) / gsz; return true;
    }
    __device__ __forceinline__ bool next(int i, Unit& u) const {
        if (!tile(i, u.pm, u.pn)) return false;
        u.a = A + (long)u.pm * 256 * lda; u.b = B + (long)u.pn * 256 * ldb; u.aux = 0; return true;
    }
};
struct LruSched : TileSched {
    __device__ __forceinline__ bool next(int i, Unit& u) const {
        if (!tile(i, u.pm, u.pn)) return false;
        u.a = A + (long)u.pm * 256 * lda + (u.pn >> 1) * 256; u.b = B + (long)u.pn * 65536; u.aux = 0; return true;
    }
};
struct MergeSched : TileSched {
    __device__ __forceinline__ bool next(int i, Unit& u) const {
        if (!tile(i >> 1, u.pm, u.pn)) return false;
        u.aux = i & 1; u.a = A + (long)u.pm * 256 * lda + u.aux * 2048; u.b = B + (long)u.pn * 256 * ldb + u.aux * 2048; return true;
    }
};
struct TriSched {
    const u16* A; long lda; const u16* B; long ldb; int G, c;
    __device__ __forceinline__ bool next(int i, Unit& u) const {
        int t = i * G + c; if (t >= 528) return false;
        int pm = 0; while (t >= pm + 1) { t -= pm + 1; ++pm; }
        u.pm = pm; u.pn = t; u.a = A + (long)pm * 256 * lda; u.b = B + (long)t * 256 * ldb; u.aux = 0; return true;
    }
};
struct RowSched {
    const u16* A; long lda; const u16* B; int G, c;
    __device__ __forceinline__ bool next(int i, Unit& u) const {
        const int t = i * G + c; if (t >= 32) return false;
        u.pm = 31 - t; u.pn = 0; u.a = A + (long)u.pm * 256 * lda; u.b = B; u.aux = 0; return true;
    }
};

template <class F>
__device__ __forceinline__ void epi_foreach(f32x4 (&acc)[2][2][4][2], const Unit& u, int wr, int wc, int fr, int fq, F f) {
    const int row0 = u.pm * 256 + wr * 64 + fr, col0 = u.pn * 256 + wc * 32 + 4 * fq;
#pragma unroll
    for (int ai = 0; ai < 2; ++ai)
#pragma unroll
        for (int m = 0; m < 4; ++m) {
#pragma unroll
            for (int bj = 0; bj < 2; ++bj)
#pragma unroll
                for (int n = 0; n < 2; ++n) f(row0 + ai * 128 + m * 16, col0 + bj * 128 + n * 16, acc[ai][bj][m][n]);
        }
}
template <int GM, class T, class LF, class F>
__device__ __forceinline__ void epi_foreach_ld(f32x4 (&acc)[2][2][4][2], const Unit& u, int wr, int wc, int fr, int fq, LF lf, F f) {
    const int row0 = u.pm * 256 + wr * 64 + fr, col0 = u.pn * 256 + wc * 32 + 4 * fq;
#pragma unroll
    for (int ai = 0; ai < 2; ++ai)
#pragma unroll
        for (int mg = 0; mg < 4; mg += GM) {
            T regs[GM][2][2];
#pragma unroll
            for (int m = 0; m < GM; ++m)
#pragma unroll
                for (int bj = 0; bj < 2; ++bj)
#pragma unroll
                    for (int n = 0; n < 2; ++n) regs[m][bj][n] = lf(row0 + ai * 128 + (mg + m) * 16, col0 + bj * 128 + n * 16);
#pragma unroll
            for (int m = 0; m < GM; ++m)
#pragma unroll
                for (int bj = 0; bj < 2; ++bj)
#pragma unroll
                    for (int n = 0; n < 2; ++n) f(row0 + ai * 128 + (mg + m) * 16, col0 + bj * 128 + n * 16, acc[ai][bj][mg + m][n], regs[m][bj][n]);
        }
}
template <class F>
__device__ __forceinline__ void epi_foreach8(f32x4 (&acc)[2][2][4][2], const Unit& u, int wr, int wc, int fr, int fq, F f) {
    const int row0 = u.pm * 256 + wr * 64 + fr, col0 = u.pn * 256 + wc * 32 + 8 * fq;
#pragma unroll
    for (int ai = 0; ai < 2; ++ai)
#pragma unroll
        for (int m = 0; m < 4; ++m)
#pragma unroll
            for (int bj = 0; bj < 2; ++bj) f(row0 + ai * 128 + m * 16, col0 + bj * 128, acc[ai][bj][m][0], acc[ai][bj][m][1]);
}
template <class T, class LF, class F>
__device__ __forceinline__ void epi_foreach8_ld(f32x4 (&acc)[2][2][4][2], const Unit& u, int wr, int wc, int fr, int fq, LF lf, F f) {
    const int row0 = u.pm * 256 + wr * 64 + fr, col0 = u.pn * 256 + wc * 32 + 8 * fq;
#pragma unroll
    for (int ai = 0; ai < 2; ++ai) {
        T regs[4][2];
#pragma unroll
        for (int m = 0; m < 4; ++m)
#pragma unroll
            for (int bj = 0; bj < 2; ++bj) regs[m][bj] = lf(row0 + ai * 128 + m * 16, col0 + bj * 128);
#pragma unroll
        for (int m = 0; m < 4; ++m)
#pragma unroll
            for (int bj = 0; bj < 2; ++bj) f(row0 + ai * 128 + m * 16, col0 + bj * 128, acc[ai][bj][m][0], acc[ai][bj][m][1], regs[m][bj]);
    }
}
__device__ __forceinline__ u32x4 pack8(const f32x4& a, const f32x4& b) { return (u32x4){pk2(a[0], a[1]), pk2(a[2], a[3]), pk2(b[0], b[1]), pk2(b[2], b[3])}; }
#define EPI_COMMON  __device__ __forceinline__ bool keep(const Unit&) const { return false; } __device__ __forceinline__ int klimit(const Unit&, int K) const { return K; }
#define EPI_SIG     __device__ __forceinline__ void operator()(f32x4 (&acc)[2][2][4][2], const Unit& u, int wr, int wc, int fr, int fq) const

__device__ __forceinline__ float rinv_of(float ss) { return rsqrtf(ss * (1.f / DM) + 1e-6f); }
struct EpiIn { EPI_COMMON u16* zB; float* zA; const float* ssq;
    EPI_SIG { const int seg = u.pn >> 3;
        const int row0 = u.pm * 256 + wr * 64 + fr, col0 = u.pn * 256 + wc * 32 + 8 * fq;
        float ri[2][4];
#pragma unroll
        for (int ai = 0; ai < 2; ++ai)
#pragma unroll
            for (int m = 0; m < 4; ++m) ri[ai][m] = ssq[row0 + ai * 128 + m * 16];
#pragma unroll
        for (int ai = 0; ai < 2; ++ai)
#pragma unroll
            for (int m = 0; m < 4; ++m) ri[ai][m] = rinv_of(ri[ai][m]);
        if (seg >= 5) {
#pragma unroll
            for (int ai = 0; ai < 2; ++ai)
#pragma unroll
                for (int m = 0; m < 4; ++m)
#pragma unroll
                    for (int bj = 0; bj < 2; ++bj) { const int row = row0 + ai * 128 + m * 16, col = col0 + bj * 128;
                        if (col < ZB + 1088) { float* d = zA + (long)row * ZA + (col - ZB); *(f32x4*)d = acc[ai][bj][m][0] * ri[ai][m]; *(f32x4*)(d + 4) = acc[ai][bj][m][1] * ri[ai][m]; } }
        } else { const bool sil = seg == 0 || seg == 2, ident = seg == 1;
#pragma unroll
            for (int ai = 0; ai < 2; ++ai)
#pragma unroll
                for (int m = 0; m < 4; ++m)
#pragma unroll
                    for (int bj = 0; bj < 2; ++bj) { const int row = row0 + ai * 128 + m * 16, col = col0 + bj * 128;
                        f32x4 o0 = acc[ai][bj][m][0] * ri[ai][m], o1 = acc[ai][bj][m][1] * ri[ai][m];
                        if (!ident) {
#pragma unroll
                            for (int e = 0; e < 4; ++e) { const float s0 = sigmoidf_(o0[e]), s1 = sigmoidf_(o1[e]); o0[e] = sil ? o0[e] * s0 : s0; o1[e] = sil ? o1[e] * s1 : s1; } }
                        *(u32x4*)(zB + (long)row * ZB + col) = (u32x4){pk2(o0[0], o0[1]), pk2(o0[2], o0[3]), pk2(o1[0], o1[1]), pk2(o1[2], o1[3])}; }
        }
    } };
struct CsT { f32x4 c, s; };
struct EpiQ { EPI_COMMON u16* Q; const float* cs;
    EPI_SIG { epi_foreach8_ld<CsT>(acc, u, wr, wc, fr, fq,
            [&](int row, int col) { const int d = col % QD; CsT t; t.c = (f32x4){1.f, 1.f, 1.f, 1.f}; t.s = (f32x4){0.f, 0.f, 0.f, 0.f};
                if (d >= NOPE) { const float* tp = cs + (long)row * 64 + ((d - NOPE) >> 1); t.c = *(const f32x4*)tp; t.s = *(const f32x4*)(tp + 32); }
                return t; },
            [&](int row, int col, f32x4& v0, f32x4& v1, const CsT& t) { f32x4 o0, o1;
                const int d = col % QD;
                if (d < NOPE) { o0 = v0 * QSCALE; o1 = v1 * QSCALE; }
                else { o0[0] = (v0[0] * t.c[0] - v0[1] * t.s[0]) * QSCALE; o0[1] = (v0[1] * t.c[0] + v0[0] * t.s[0]) * QSCALE;
                       o0[2] = (v0[2] * t.c[1] - v0[3] * t.s[1]) * QSCALE; o0[3] = (v0[3] * t.c[1] + v0[2] * t.s[1]) * QSCALE;
                       o1[0] = (v1[0] * t.c[2] - v1[1] * t.s[2]) * QSCALE; o1[1] = (v1[1] * t.c[2] + v1[0] * t.s[2]) * QSCALE;
                       o1[2] = (v1[2] * t.c[3] - v1[3] * t.s[3]) * QSCALE; o1[3] = (v1[3] * t.c[3] + v1[2] * t.s[3]) * QSCALE; }
                *(u32x4*)(Q + (long)row * NQ + col) = pack8(o0, o1); }); } };
struct EpiKV { EPI_COMMON u16* Kf; u16* Vf;
    EPI_SIG { epi_foreach8(acc, u, wr, wc, fr, fq, [&](int row, int col, f32x4& v0, f32x4& v1) {
            const int hh = col >> 8, j = col & 255;
            u16* dst = (j < 128) ? Kf + ((long)hh * S + row) * QD + j : Vf + ((long)hh * S + row) * VH + (j - 128);
            *(u32x4*)dst = pack8(v0, v1);
        }); } };
struct EpiLru { EPI_COMMON const u16* xc; const float *brg, *big, *nsp8; float *la, *lb;
    EPI_SIG {
        const int row0 = u.pm * 256 + wr * 64 + fr, col0 = u.pn * 256 + wc * 32 + 8 * fq;
        f32x4 cr[2], ci[2], cn[2];
#pragma unroll
        for (int bj = 0; bj < 2; ++bj) { const int ch = (col0 + bj * 128) >> 1; cr[bj] = *(const f32x4*)(brg + ch); ci[bj] = *(const f32x4*)(big + ch); cn[bj] = *(const f32x4*)(nsp8 + ch); }
#pragma unroll
        for (int ai = 0; ai < 2; ++ai) {
            u32x2 xw[4][2];
#pragma unroll
            for (int m = 0; m < 4; ++m)
#pragma unroll
                for (int bj = 0; bj < 2; ++bj) xw[m][bj] = *(const u32x2*)(xc + (long)(row0 + ai * 128 + m * 16) * DM + ((col0 + bj * 128) >> 1));
#pragma unroll
            for (int m = 0; m < 4; ++m)
#pragma unroll
                for (int bj = 0; bj < 2; ++bj) {
                    const long o = (long)(row0 + ai * 128 + m * 16) * DM + ((col0 + bj * 128) >> 1);
                    f32x4 av, bv;
#pragma unroll
                    for (int e = 0; e < 4; ++e) {
                        const f32x4 v = acc[ai][bj][m][e >> 1];
                        const float r = sigmoidf_(v[2 * (e & 1)] + cr[bj][e]), ii = sigmoidf_(v[2 * (e & 1) + 1] + ci[bj][e]);
                        const float lg = r * cn[bj][e], x2 = 2.f * lg;
                        const float a = __builtin_amdgcn_exp2f(1.4426950408889634f * lg);
                        const float em = (x2 > -0.25f) ? x2 * (1.f + x2 * (0.5f + x2 * (0.16666667f + x2 * (0.041666668f + x2 * 0.0083333338f)))) : (a * a - 1.f);
                        const unsigned w = xw[m][bj][e >> 1];
                        const float x = (e & 1) ? __uint_as_float(w & 0xffff0000u) : __uint_as_float(w << 16);
                        av[e] = a; bv[e] = __builtin_amdgcn_sqrtf(-em) * (ii * x); }
                    *(f32x4*)(la + o) = av; *(f32x4*)(lb + o) = bv; }
        }
    } };
struct SmSl { u32x4 sm, sl; };
__device__ __forceinline__ void unpack8(const u32x4& w, f32x4& a, f32x4& b) {
    a = (f32x4){__uint_as_float(w[0] << 16), __uint_as_float(w[0] & 0xffff0000u), __uint_as_float(w[1] << 16), __uint_as_float(w[1] & 0xffff0000u)};
    b = (f32x4){__uint_as_float(w[2] << 16), __uint_as_float(w[2] & 0xffff0000u), __uint_as_float(w[3] << 16), __uint_as_float(w[3] & 0xffff0000u)}; }
struct EpiMerge { const u16* zB; u16* mg;
    __device__ __forceinline__ bool keep(const Unit& u) const { return u.aux == 0; }
    __device__ __forceinline__ int klimit(const Unit&, int K) const { return K; }
    EPI_SIG { const int part = u.aux;
        epi_foreach8_ld<SmSl>(acc, u, wr, wc, fr, fq,
            [&](int row, int col) { SmSl t; t.sl = *(const u32x4*)(zB + (long)row * ZB + 8192 + col); t.sm = t.sl; if (part == 0) t.sm = *(const u32x4*)(zB + (long)row * ZB + 6144 + col); return t; },
            [&](int row, int col, f32x4& v0, f32x4& v1, const SmSl& t) {
            f32x4 l0, l1; unpack8(t.sl, l0, l1);
#pragma unroll
            for (int e = 0; e < 4; ++e) { l0[e] = fmaxf(l0[e], 1e-12f); l1[e] = fmaxf(l1[e], 1e-12f); }
            if (part == 0) { f32x4 m0, m1; unpack8(t.sm, m0, m1);
#pragma unroll
                for (int e = 0; e < 4; ++e) { v0[e] = v0[e] * m0[e] * __builtin_amdgcn_rcpf(l0[e]); v1[e] = v1[e] * m1[e] * __builtin_amdgcn_rcpf(l1[e]); }
            } else { *(u32x4*)(mg + (long)row * DM + col) = pack8(v0 * l0, v1 * l1); }
        }); } };
__device__ __forceinline__ void row_ssq_add(float sq, float* ssq, int row, int lane) {
    sq += __int_as_float(__builtin_amdgcn_ds_bpermute((lane ^ 16) << 2, __float_as_int(sq)));
    sq += __int_as_float(__builtin_amdgcn_ds_bpermute((lane ^ 32) << 2, __float_as_int(sq)));
    if (lane < 16) atomicAdd(ssq + row, sq);
}
struct EpiOut { EPI_COMMON const float* xold; float* xnew; u16* xb; float* ssq;
    EPI_SIG {
        const int row0 = u.pm * 256 + wr * 64 + fr, col0 = u.pn * 256 + wc * 32 + 8 * fq, lane = fq * 16 + fr;
#pragma unroll
        for (int ai = 0; ai < 2; ++ai) {
            f32x4 xo[4][2][2];
#pragma unroll
            for (int m = 0; m < 4; ++m)
#pragma unroll
                for (int bj = 0; bj < 2; ++bj) { const float* q = xold + (long)(row0 + ai * 128 + m * 16) * DM + col0 + bj * 128; xo[m][bj][0] = *(const f32x4*)q; xo[m][bj][1] = *(const f32x4*)(q + 4); }
#pragma unroll
            for (int m = 0; m < 4; ++m) { const int row = row0 + ai * 128 + m * 16; float sq = 0.f;
#pragma unroll
                for (int bj = 0; bj < 2; ++bj) { const f32x4 x0 = xo[m][bj][0] + acc[ai][bj][m][0], x1 = xo[m][bj][1] + acc[ai][bj][m][1]; const long idx = (long)row * DM + col0 + bj * 128;
                    *(f32x4*)(xnew + idx) = x0; *(f32x4*)(xnew + idx + 4) = x1; *(u32x4*)(xb + idx) = pack8(x0, x1);
                    sq += x0[0] * x0[0] + x0[1] * x0[1] + x0[2] * x0[2] + x0[3] * x0[3] + x1[0] * x1[0] + x1[1] * x1[1] + x1[2] * x1[2] + x1[3] * x1[3]; }
                row_ssq_add(sq, ssq, row, lane); }
        }
    } };
struct EpiF32 { EPI_COMMON float* C; long ldc;
    EPI_SIG { epi_foreach8(acc, u, wr, wc, fr, fq, [&](int row, int col, f32x4& v0, f32x4& v1) { float* d = C + (long)row * ldc + col; *(f32x4*)d = v0; *(f32x4*)(d + 4) = v1; }); } };
struct EpiPle { EPI_COMMON float* x; const float* pp; const float* ssq_in; u16* xb; float* ssq_out;
    EPI_SIG {
        const int row0 = u.pm * 256 + wr * 64 + fr, col0 = u.pn * 256 + wc * 32 + 8 * fq, lane = fq * 16 + fr;
#pragma unroll
        for (int ai = 0; ai < 2; ++ai)
#pragma unroll
            for (int mg = 0; mg < 4; mg += 2) {
                f32x4 xo[2][2][2], po[2][2][2]; float ss[2];
#pragma unroll
                for (int m = 0; m < 2; ++m) { const int row = row0 + ai * 128 + (mg + m) * 16; ss[m] = ssq_in[row];
#pragma unroll
                    for (int bj = 0; bj < 2; ++bj) { const long idx = (long)row * DM + col0 + bj * 128;
                        xo[m][bj][0] = *(const f32x4*)(x + idx); xo[m][bj][1] = *(const f32x4*)(x + idx + 4); po[m][bj][0] = *(const f32x4*)(pp + idx); po[m][bj][1] = *(const f32x4*)(pp + idx + 4); } }
#pragma unroll
                for (int m = 0; m < 2; ++m) { const int row = row0 + ai * 128 + (mg + m) * 16; const float ri = rinv_of(ss[m]); float sq = 0.f;
#pragma unroll
                    for (int bj = 0; bj < 2; ++bj) { f32x4 x0 = xo[m][bj][0], x1 = xo[m][bj][1]; const f32x4 v0 = acc[ai][bj][mg + m][0], v1 = acc[ai][bj][mg + m][1]; const long idx = (long)row * DM + col0 + bj * 128;
#pragma unroll
                        for (int e = 0; e < 4; ++e) { x0[e] += po[m][bj][0][e] * sigmoidf_(v0[e] * ri); x1[e] += po[m][bj][1][e] * sigmoidf_(v1[e] * ri); }
                        *(f32x4*)(x + idx) = x0; *(f32x4*)(x + idx + 4) = x1; *(u32x4*)(xb + idx) = pack8(x0, x1);
                        sq += x0[0] * x0[0] + x0[1] * x0[1] + x0[2] * x0[2] + x0[3] * x0[3] + x1[0] * x1[0] + x1[1] * x1[1] + x1[2] * x1[2] + x1[3] * x1[3]; }
                    row_ssq_add(sq, ssq_out, row, lane); }
            }
    } };

#define LAS __attribute__((address_space(3)))
constexpr int HTB = 128 * 64 * 2;
__device__ __forceinline__ int lds_byte(int r, int c) { const int st = (r >> 4) * 2 + (c >> 5), rr = r & 15, cc = c & 31, ob = rr * 64 + cc * 2; return st * 1024 + (ob ^ (((ob >> 9) & 1) << 5)); }
__device__ __forceinline__ void stage_rc(int b, int& R, int& C) { const int st = b / 1024, sb = b % 1024, swz = sb ^ (((sb >> 9) & 1) << 5); R = (st >> 1) * 16 + swz / 64; C = (st & 1) * 32 + (swz % 64) / 2; }

template <class Epi, class Sched>
__device__ __forceinline__ void gemm_fast(char* lds_, int K, long lda, long ldb, const Sched& S_, const Epi& E) {
    LAS unsigned char* lds = (LAS unsigned char*)lds_;
    const int tid = TID(), wid = __builtin_amdgcn_readfirstlane(tid >> 6), lane = tid & 63, wr = wid >> 2, wc = wid & 3, fr = lane & 15, fq = lane >> 4;
    const int nt = K / 64;
    unsigned voffA[2], voffB[2];
#pragma unroll
    for (int i = 0; i < 2; ++i) { int R, C; stage_rc(tid * 16 + i * 8192, R, C); voffA[i] = (unsigned)(R * lda + C) * 2u; voffB[i] = (unsigned)(R * ldb + C) * 2u; }
    const size_t kstep = 128;
    const size_t hstepA = (size_t)128 * lda * 2, hstepB = (size_t)128 * ldb * 2;
    const unsigned ldsw = (unsigned)wid * 1024u;
    const int aoff = lds_byte(wr * 64 + fr, fq * 8), boff = lds_byte(wc * 32 + fr, fq * 8);
#define G_SA(b, h) (((b) * 2 + (h)) * HTB)
#define G_SB(b, h) ((4 + (b) * 2 + (h)) * HTB)
#define G_STAGE(bufoff, gbase, voff) do { _Pragma("unroll") for (int _i = 0; _i < 2; ++_i) \
        __builtin_amdgcn_global_load_lds((const unsigned*)((const char*)(gbase) + (voff)[_i]), (LAS unsigned*)(lds + (bufoff) + ldsw + _i * 8192), 16, 0, 0); } while (0)
#define G_LDA(dst, b, h) do { _Pragma("unroll") for (int m = 0; m < 4; ++m) _Pragma("unroll") for (int k = 0; k < 2; ++k) dst[m][k] = *(const LAS bf16x8*)(lds + G_SA(b, h) + aoff + m * 2048 + k * 1024); } while (0)
#define G_LDB(dst, b, h) do { _Pragma("unroll") for (int n = 0; n < 2; ++n) _Pragma("unroll") for (int k = 0; k < 2; ++k) dst[n][k] = *(const LAS bf16x8*)(lds + G_SB(b, h) + boff + n * 2048 + k * 1024); } while (0)
#define G_MMA(ai, bj, At, Bt) do { __builtin_amdgcn_s_setprio(1); _Pragma("unroll") for (int m = 0; m < 4; ++m) _Pragma("unroll") for (int n = 0; n < 2; ++n) _Pragma("unroll") for (int k = 0; k < 2; ++k) \
        acc[ai][bj][m][n] = __builtin_amdgcn_mfma_f32_16x16x32_bf16(Bt[n][k], At[m][k], acc[ai][bj][m][n], 0, 0, 0); __builtin_amdgcn_s_setprio(0); } while (0)
#define G_WAIT_V(n) asm volatile("s_waitcnt vmcnt(" #n ")" ::: "memory")
#define G_WAIT_L(n) asm volatile("s_waitcnt lgkmcnt(" #n ")" ::: "memory")
#define G_BAR __builtin_amdgcn_s_barrier()
#define G_SCHED __builtin_amdgcn_sched_barrier(0)
    Unit cur, nxt; int ui = 0;
    if (!S_.next(0, cur)) return;
    f32x4 acc[2][2][4][2];
#pragma unroll
    for (int a = 0; a < 2; ++a)
#pragma unroll
        for (int b = 0; b < 2; ++b)
#pragma unroll
            for (int m = 0; m < 4; ++m)
#pragma unroll
                for (int n = 0; n < 2; ++n) acc[a][b][m][n] = (f32x4){0.f, 0.f, 0.f, 0.f};
    bf16x8 At[4][2], B0[2][2], B1[2][2];
    const char* cA = (const char*)cur.a; const char* cB = (const char*)cur.b;
    G_STAGE(G_SB(0, 0), cB, voffB); G_STAGE(G_SA(0, 0), cA, voffA); G_STAGE(G_SB(0, 1), cB + hstepB, voffB); G_STAGE(G_SA(0, 1), cA + hstepA, voffA);
    if (wr == 1) G_BAR;
    G_WAIT_V(4); G_BAR;
    G_STAGE(G_SB(1, 0), cB + kstep, voffB); G_STAGE(G_SA(1, 0), cA + kstep, voffA); G_STAGE(G_SB(1, 1), cB + hstepB + kstep, voffB);
    G_WAIT_V(6); G_BAR;
    for (;;) {
        const bool has_next = S_.next(ui + 1, nxt);
        const char* nA = has_next ? (const char*)nxt.a : cA; const char* nB = has_next ? (const char*)nxt.b : cB;
#pragma unroll 1
        for (int t = 0; t < nt; t += 2) {
            const bool last = (t == nt - 2);
            const char* a1 = cA + (size_t)(t + 1) * kstep;
            const char* a2 = last ? nA : cA + (size_t)(t + 2) * kstep; const char* b2 = last ? nB : cB + (size_t)(t + 2) * kstep;
            const char* a3 = a2 + kstep; const char* b3 = b2 + kstep;
            G_LDB(B0, 0, 0); G_SCHED; G_LDA(At, 0, 0); G_STAGE(G_SA(1, 1), a1 + hstepA, voffA);
            G_WAIT_L(8); G_BAR; G_WAIT_L(0); G_MMA(0, 0, At, B0); G_BAR; G_SCHED;
            G_LDB(B1, 0, 1); G_STAGE(G_SB(0, 0), b2, voffB);
            G_BAR; G_WAIT_L(0); G_MMA(0, 1, At, B1); G_BAR;
            G_LDA(At, 0, 1); G_STAGE(G_SA(0, 0), a2, voffA);
            G_BAR; G_WAIT_L(0); G_MMA(1, 0, At, B0); G_BAR; G_SCHED;
            G_STAGE(G_SB(0, 1), b2 + hstepB, voffB);
            G_WAIT_V(6); G_BAR; G_MMA(1, 1, At, B1); G_BAR;
            G_LDB(B0, 1, 0); G_SCHED; G_LDA(At, 1, 0); G_STAGE(G_SA(0, 1), a2 + hstepA, voffA);
            G_WAIT_L(8); G_BAR; G_WAIT_L(0); G_MMA(0, 0, At, B0); G_BAR; G_SCHED;
            G_LDB(B1, 1, 1); G_STAGE(G_SB(1, 0), b3, voffB);
            G_BAR; G_WAIT_L(0); G_MMA(0, 1, At, B1); G_BAR;
            G_LDA(At, 1, 1); G_STAGE(G_SA(1, 0), a3, voffA);
            G_BAR; G_WAIT_L(0); G_MMA(1, 0, At, B0); G_BAR; G_SCHED;
            G_STAGE(G_SB(1, 1), b3 + hstepB, voffB);
            G_WAIT_V(6); G_BAR; G_MMA(1, 1, At, B1); G_BAR;
        }
        { const int t2 = TID(), w2 = t2 >> 6, l2 = t2 & 63;
          E(acc, cur, w2 >> 2, w2 & 3, l2 & 15, l2 >> 4); }
        if (!has_next) break;
        if (!E.keep(cur)) {
#pragma unroll
            for (int a = 0; a < 2; ++a)
#pragma unroll
                for (int b = 0; b < 2; ++b)
#pragma unroll
                    for (int m = 0; m < 4; ++m)
#pragma unroll
                        for (int n = 0; n < 2; ++n) acc[a][b][m][n] = (f32x4){0.f, 0.f, 0.f, 0.f};
        }
        cur = nxt; cA = nA; cB = nB; ++ui;
    }
    G_WAIT_V(0);
    if (wr == 0) G_BAR;
    G_BAR;
#undef G_SA
#undef G_SB
#undef G_STAGE
#undef G_LDA
#undef G_LDB
#undef G_MMA
#undef G_WAIT_V
#undef G_WAIT_L
#undef G_BAR
#undef G_SCHED
}


#define XB_TMO      128
#define XB_XCNT(j)  (256  + 64 * (j))
#define XB_XSUB(j)  (1280 + 64 * (j))
#define XB_XGEN(j)  (2304 + 64 * (j))
#define XB_TOP      3328
#define XB_TOPGEN   3392
#define XCD_BAR_WORDS 3456
#define XB_SPIN_CAP (1u << 18)
__device__ __forceinline__ unsigned xb_ld(unsigned* p)              { return __hip_atomic_load(p, __ATOMIC_RELAXED, __HIP_MEMORY_SCOPE_AGENT); }
__device__ __forceinline__ unsigned xb_add(unsigned* p, unsigned v) { return __hip_atomic_fetch_add(p, v, __ATOMIC_RELAXED, __HIP_MEMORY_SCOPE_AGENT); }
__device__ __forceinline__ unsigned xb_xcc_id() { return (unsigned)__builtin_amdgcn_s_getreg((3 << 11) | 20) & 0xFu; }
#define XB_SPIN(cond, bar) do { unsigned _sp = 0; while (cond) { __builtin_amdgcn_s_sleep(1); \
    if ((++_sp & 255u) == 0u) { if (xb_ld(&(bar)[XB_TMO])) break; if (_sp > XB_SPIN_CAP) { atomicAdd(&(bar)[XB_TMO], 1u); break; } } } } while (0)
struct XcdBarrier { unsigned* bar; unsigned x; volatile LAS unsigned* st; };
__device__ __forceinline__ XcdBarrier xcd_barrier_post(unsigned* bar, volatile LAS unsigned* st) {
    XcdBarrier b; b.bar = bar; b.x = xb_xcc_id(); b.st = st;
    if (TID() == 0) (void)xb_add(&bar[XB_XCNT(b.x)], 1u);
    return b;
}
__device__ __forceinline__ void xcd_barrier_complete(unsigned* bar, unsigned x, unsigned& nloc, unsigned& nx) {
    const unsigned G = gridDim.x * gridDim.y * gridDim.z;
    unsigned sum, cnt, mine, sp = 0u;
    for (;;) {
        sum = 0u; cnt = 0u; mine = 0u;
#pragma unroll
        for (unsigned j = 0; j < 16; ++j) { const unsigned c = xb_ld(&bar[XB_XCNT(j)]); sum += c; cnt += (c > 0u) ? 1u : 0u; mine = (j == x) ? c : mine; }
        if (sum == G) break;
        __builtin_amdgcn_s_sleep(1);
        if ((++sp & 255u) == 0u) { if (xb_ld(&bar[XB_TMO])) break; if (sp > XB_SPIN_CAP) { atomicAdd(&bar[XB_TMO], 1u); break; } }
    }
    nloc = mine > 0u ? mine : 1u; nx = cnt > 0u ? cnt : 1u;
}
__device__ __forceinline__ void xcd_barrier(const XcdBarrier& b) {
    asm volatile("s_waitcnt vmcnt(0)" ::: "memory");
    __syncthreads();
    if (TID() == 0) {
        unsigned* bar = b.bar;
        __builtin_amdgcn_s_waitcnt(0);
        unsigned nloc = b.st[0], nx = b.st[1];
        if (nloc == 0u) { xcd_barrier_complete(bar, b.x, nloc, nx); b.st[0] = nloc; b.st[1] = nx; }
        const unsigned old = xb_add(&bar[XB_XSUB(b.x)], 1u);
        const unsigned gen = old / nloc;
        if (old + 1u == (gen + 1u) * nloc) {
            __builtin_amdgcn_fence(__ATOMIC_RELEASE, "agent");
            asm volatile("s_waitcnt vmcnt(0)" ::: "memory");
            const unsigned og = xb_add(&bar[XB_TOP], 1u);
            const unsigned tg = og / nx;
            if (og + 1u == (tg + 1u) * nx) xb_add(&bar[XB_TOPGEN], 1u);
            else XB_SPIN(xb_ld(&bar[XB_TOPGEN]) == tg, bar);
            __builtin_amdgcn_fence(__ATOMIC_ACQUIRE, "agent");
            xb_add(&bar[XB_XGEN(b.x)], 1u);
            asm volatile("s_waitcnt vmcnt(0)" ::: "memory");
        } else {
            XB_SPIN(xb_ld(&bar[XB_XGEN(b.x)]) == gen, bar);
            __builtin_amdgcn_fence(__ATOMIC_ACQUIRE, "agent");
            asm volatile("s_waitcnt vmcnt(0)" ::: "memory");
        }
    }
    __syncthreads();
}

struct TDesc { const float* src; const float* ks; u16* dst; long ldd; int N, coff, rm, tix; };
constexpr int TS_IN = (DM / 256) * (INT / 64), TS_Q = (QL / 256) * (NQ / 64), TS_KV = (KVL / 256) * (NKV / 64), TS_SQ = (DM / 256) * (DM / 64), TS_PLE = (PLE / 256) * (DM / 64);
constexpr int TS_LAYER = TS_IN + TS_Q + TS_KV + 4 * TS_SQ + TS_PLE, TS_TOTAL = DEPTH * TS_LAYER;
__device__ __forceinline__ TDesc tdesc(const Params& p, int g) {
    const int l = g / TS_LAYER; int r = g % TS_LAYER; TDesc d; d.ks = nullptr; d.coff = 0; d.rm = 0;
    if (r < TS_IN) { d.src = p.w_in + (size_t)l * DM * INT; d.N = INT; d.dst = p.Wt_in + (size_t)l * NIN * DM; d.ldd = DM; d.rm = 1; d.ks = p.attn_norm + l * DM; d.tix = r; return d; }
    r -= TS_IN;
    if (r < TS_Q) { d.src = p.w_q_b + (size_t)l * QL * NQ; d.N = NQ; d.dst = p.Wt_q + (size_t)l * NQ * QL; d.ldd = QL; d.rm = 2; d.tix = r; return d; }
    r -= TS_Q;
    if (r < TS_KV) { d.src = p.w_kv_b + (size_t)l * KVL * NKV; d.N = NKV; d.dst = p.Wt_kv + (size_t)l * NKV * KVL; d.ldd = KVL; d.rm = 3; d.tix = r; return d; }
    r -= TS_KV;
    if (r < TS_SQ) { d.src = p.w_o_mla + (size_t)l * DM * DM; d.N = DM; d.dst = p.Wt_o + (size_t)l * DM * 4096; d.ldd = 4096; d.rm = 3; d.tix = r; return d; }
    r -= TS_SQ;
    if (r < TS_SQ) { d.src = p.w_o_lru + (size_t)l * DM * DM; d.N = DM; d.dst = p.Wt_o + (size_t)l * DM * 4096; d.ldd = 4096; d.coff = 2048; d.rm = 3; d.tix = r; return d; }
    r -= TS_SQ;
    if (r < TS_SQ) { d.src = p.w_out + (size_t)l * DM * DM; d.N = DM; d.dst = p.Wt_out + (size_t)l * DM * DM; d.ldd = DM; d.rm = 3; d.tix = r; return d; }
    r -= TS_SQ;
    if (r < TS_SQ) { d.src = p.w_ple_gate + (size_t)l * DM * DM; d.N = DM; d.dst = p.Wt_pg + (size_t)l * DM * DM; d.ldd = DM; d.rm = 3; d.ks = p.ple_norm + l * DM; d.tix = r; return d; }
    r -= TS_SQ;
    d.src = p.w_ple + (size_t)l * PLE * DM; d.N = DM; d.dst = p.Wt_ple + (size_t)l * DM * PLE; d.ldd = PLE; d.rm = 3; d.tix = r; return d;
}
__device__ __forceinline__ int pslot(int r) { const int c = r & 31; return (r & ~31) + 16 * ((c >> 2) & 1) + ((c >> 3) << 2) + (c & 3); }
__device__ __forceinline__ int trowmap(int rm, int n) {
    if (rm == 1) return pslot(n >= 1088 ? n - 1088 : n + ZB);
    if (rm == 2) { const int hh = n / QD, d = n % QD; if (d < NOPE) return pslot(n); const int e = d - NOPE; return pslot(hh * QD + NOPE + ((e & 31) << 1) + (e >> 5)); }
    if (rm == 3) return pslot(n);
    return n;
}
__device__ __forceinline__ void transpose_all(const Params& p, char* lds) {
    u16 (*t)[72] = (u16(*)[72])lds;
    const int tid = TID(), k = tid >> 3, nn = (tid & 7) * 8, G = gridDim.x;
    f32x4 vA[4][2], vB[4][2];
#define TC_LOAD(v_, d_) do { const int tn_ = (d_).N / 64, k0_ = ((d_).tix / tn_) * 256, n0_ = ((d_).tix % tn_) * 64; _Pragma("unroll") for (int j = 0; j < 4; ++j) { \
        const float* p_ = (d_).src + (long)(k0_ + k + 64 * j) * (d_).N + n0_ + nn; v_[j][0] = *(const f32x4*)p_; v_[j][1] = *(const f32x4*)(p_ + 4); \
        if ((d_).ks) { const float g_ = (d_).ks[k0_ + k + 64 * j]; v_[j][0] = v_[j][0] * g_; v_[j][1] = v_[j][1] * g_; } } } while (0)
#define TC_LDSW(v_) do { _Pragma("unroll") for (int j = 0; j < 4; ++j) *(u32x4*)&t[k + 64 * j][nn ^ (((k >> 3) & 7) << 3)] = (u32x4){pk2(v_[j][0][0], v_[j][0][1]), pk2(v_[j][0][2], v_[j][0][3]), pk2(v_[j][1][0], v_[j][1][1]), pk2(v_[j][1][2], v_[j][1][3])}; } while (0)
#define TC_STORE(d_) do { const int tn_ = (d_).N / 64, k0_ = ((d_).tix / tn_) * 256, n0_ = ((d_).tix % tn_) * 64; const int n_ = tid >> 3, kk_ = (tid & 7) * 8; \
        u16* drow_ = (d_).dst + (long)trowmap((d_).rm, n0_ + n_) * (d_).ldd + (d_).coff + k0_ + kk_; \
        _Pragma("unroll") for (int j = 0; j < 4; ++j) { u32x4 o_; _Pragma("unroll") for (int e = 0; e < 4; ++e) o_[e] = (unsigned)t[64 * j + kk_ + 2 * e][n_ ^ kk_] | ((unsigned)t[64 * j + kk_ + 2 * e + 1][n_ ^ kk_] << 16); \
            *(u32x4*)(drow_ + 64 * j) = o_; } } while (0)
    int gA = blockIdx.x, gB = gA + G; TDesc dA, dB, dc;
    if (gA < TS_TOTAL) { dA = tdesc(p, gA); TC_LOAD(vA, dA); }
    if (gB < TS_TOTAL) { dB = tdesc(p, gB); TC_LOAD(vB, dB); }
    while (gA < TS_TOTAL) {
        TC_LDSW(vA); __syncthreads(); dc = dA; gA += 2 * G; if (gA < TS_TOTAL) { dA = tdesc(p, gA); TC_LOAD(vA, dA); } TC_STORE(dc); __syncthreads();
        if (gB >= TS_TOTAL) break;
        TC_LDSW(vB); __syncthreads(); dc = dB; gB += 2 * G; if (gB < TS_TOTAL) { dB = tdesc(p, gB); TC_LOAD(vB, dB); } TC_STORE(dc); __syncthreads();
    }
#undef TC_LOAD
#undef TC_LDSW
#undef TC_STORE
}

__device__ __forceinline__ void phase_prologue(const Params& p, char* lds) {
    const long gtid = (long)blockIdx.x * NTHR + TID(), gsz = (long)gridDim.x * NTHR;
    transpose_all(p, lds);
    for (long i = gtid; i < (long)DEPTH * (NIN - INT) * DM / 8; i += gsz) { const long per = (long)(NIN - INT) * DM / 8; const int l = (int)(i / per); const long r = i % per;
        *(u32x4*)(p.Wt_in + ((size_t)l * NIN + INT) * DM + r * 8) = (u32x4){0u, 0u, 0u, 0u}; }
    for (long i = gtid; i < (long)DEPTH * LRUB * 256 * 256; i += gsz) {
        const int k = (int)(i & 255), o = (int)((i >> 8) & 255), blk = (int)((i >> 16) & 15), l = (int)(i >> 20);
        const int kk = k - 128 * (blk & 1), cl = o >> 1; float v = 0.f;
        if (kk >= 0 && kk < 128) v = ((o & 1) ? p.w_ig : p.w_rg)[(((size_t)l * LRUB + blk) * LBD + kk) * LBD + cl];
        p.Wt_lru[(((long)l * LRUB + blk) * 256 + pslot(o)) * 256 + k] = f2bf(v); }
    for (long i = gtid; i < (long)DEPTH * S * PLE / 8; i += gsz) { const float* s = p.p_in + i * 8; const f32x4 v0 = *(const f32x4*)s, v1 = *(const f32x4*)(s + 4);
        *(u32x4*)(p.pb + i * 8) = (u32x4){pk2(v0[0], v0[1]), pk2(v0[2], v0[3]), pk2(v1[0], v1[1]), pk2(v1[2], v1[3])}; }
    for (long i = gtid; i < (long)DEPTH * DM; i += gsz) p.nsp8[i] = -8.f * log1pf(expf(-p.lam[i]));
    for (long i = gtid; i < (long)S * 32; i += gsz) { const int s = (int)(i >> 5), f = (int)(i & 31);
        const float inv = powf(10000.f, -(float)(2 * f) / 64.f), ang = (float)p.pos[s] * inv;
        p.cs[(long)s * 64 + f] = (float)cos((double)ang); p.cs[(long)s * 64 + 32 + f] = (float)sin((double)ang); }
}

__device__ __forceinline__ void phase_xb_ssq(const float* __restrict__ x, u16* __restrict__ out, float* __restrict__ ssq) {
    const int tid = TID(), lane = tid & 63, gw = blockIdx.x * (NTHR / 64) + (tid >> 6), nw = gridDim.x * (NTHR / 64);
    for (int row = gw; row < S; row += nw) {
        const float* p = x + (long)row * DM; f32x4 v[8]; float s = 0.f;
#pragma unroll
        for (int j = 0; j < 8; ++j) { v[j] = *(const f32x4*)(p + j * 256 + lane * 4); s += v[j][0] * v[j][0] + v[j][1] * v[j][1] + v[j][2] * v[j][2] + v[j][3] * v[j][3]; }
        s = wsum(s, lane);
#pragma unroll
        for (int j = 0; j < 8; ++j) *(u32x2*)(out + (long)row * DM + j * 256 + lane * 4) = (u32x2){pk2(v[j][0], v[j][1]), pk2(v[j][2], v[j][3])};
        if (lane == 0) ssq[row] = s;
    }
}
__device__ __forceinline__ void phase_final_norm(float* __restrict__ x, const float* __restrict__ g) {
    const int tid = TID(), lane = tid & 63, gw = blockIdx.x * (NTHR / 64) + (tid >> 6), nw = gridDim.x * (NTHR / 64);
    for (int row = gw; row < S; row += nw) {
        float* p = x + (long)row * DM; f32x4 v[8]; float s = 0.f;
#pragma unroll
        for (int j = 0; j < 8; ++j) { v[j] = *(const f32x4*)(p + j * 256 + lane * 4); s += v[j][0] * v[j][0] + v[j][1] * v[j][1] + v[j][2] * v[j][2] + v[j][3] * v[j][3]; }
        s = wsum(s, lane); const float rinv = rsqrtf(s * (1.f / DM) + 1e-6f);
#pragma unroll
        for (int j = 0; j < 8; ++j) { const f32x4 gg = *(const f32x4*)(g + j * 256 + lane * 4); *(f32x4*)(p + j * 256 + lane * 4) = v[j] * rinv * gg; }
    }
}
__device__ __forceinline__ void t2_rows(const float* __restrict__ zA, const u16* __restrict__ zB, const float* __restrict__ cs, const float* __restrict__ cw, const float* __restrict__ cb,
                                        const float* __restrict__ gq, const float* __restrict__ gkv, u16* __restrict__ qn, u16* __restrict__ kvn, u16* __restrict__ Kf, u16* __restrict__ xc, float* __restrict__ ssqB) {
    const int tid = TID(), lane = tid & 63, gw = blockIdx.x * (NTHR / 64) + (tid >> 6), nw = gridDim.x * (NTHR / 64);
    for (int row = gw; row < S; row += nw) {
        const float* zr = zA + (long)row * ZA;
        f32x4 v[2][2];
#pragma unroll
        for (int part = 0; part < 2; ++part) { v[part][0] = *(const f32x4*)(zr + part * 512 + lane * 4); v[part][1] = *(const f32x4*)(zr + part * 512 + 256 + lane * 4); }
        const int l32 = lane & 31;
        const float x1 = zr[1024 + l32], x2 = zr[1056 + l32], cc = cs[(long)row * 64 + l32], sn = cs[(long)row * 64 + 32 + l32];
        u32x2 uu[8][4];
#pragma unroll
        for (int j = 0; j < 8; ++j)
#pragma unroll
            for (int k = 0; k < 4; ++k) { const int sp = row - 3 + k; uu[j][k] = (u32x2){0u, 0u}; if (sp >= 0) uu[j][k] = *(const u32x2*)(zB + (long)sp * ZB + 2048 + j * 256 + lane * 4); }
        if (lane == 0) ssqB[row] = 0.f;
#pragma unroll
        for (int part = 0; part < 2; ++part) {
            const float* g = part ? gkv : gq; u16* dst = (part ? kvn : qn) + (long)row * 512;
            const f32x4 v0 = v[part][0], v1 = v[part][1];
            float s = v0[0] * v0[0] + v0[1] * v0[1] + v0[2] * v0[2] + v0[3] * v0[3] + v1[0] * v1[0] + v1[1] * v1[1] + v1[2] * v1[2] + v1[3] * v1[3];
            s = wsum(s, lane); const float rinv = rsqrtf(s * (1.f / 512.f) + 1e-6f);
            const f32x4 g0 = *(const f32x4*)(g + lane * 4), g1 = *(const f32x4*)(g + 256 + lane * 4);
            *(u32x2*)(dst + lane * 4) = (u32x2){pk2(v0[0] * rinv * g0[0], v0[1] * rinv * g0[1]), pk2(v0[2] * rinv * g0[2], v0[3] * rinv * g0[3])};
            *(u32x2*)(dst + 256 + lane * 4) = (u32x2){pk2(v1[0] * rinv * g1[0], v1[1] * rinv * g1[1]), pk2(v1[2] * rinv * g1[2], v1[3] * rinv * g1[3])};
        }
        if (lane < 32) { const unsigned w = pk2(x1 * cc - x2 * sn, x2 * cc + x1 * sn);
#pragma unroll
            for (int hh = 0; hh < NH; ++hh) *(unsigned*)(Kf + ((long)hh * S + row) * QD + NOPE + 2 * lane) = w; }
#pragma unroll
        for (int j = 0; j < 8; ++j) { const int c = j * 256 + lane * 4; f32x4 y = *(const f32x4*)(cb + c);
#pragma unroll
            for (int k = 0; k < 4; ++k) { const f32x4 w = *(const f32x4*)(cw + k * DM + c); const u32x2 u2 = uu[j][k];
                y[0] += __uint_as_float(u2[0] << 16) * w[0]; y[1] += __uint_as_float(u2[0] & 0xffff0000u) * w[1]; y[2] += __uint_as_float(u2[1] << 16) * w[2]; y[3] += __uint_as_float(u2[1] & 0xffff0000u) * w[3]; }
            *(u32x2*)(xc + (long)row * DM + c) = (u32x2){pk2(y[0], y[1]), pk2(y[2], y[3])}; }
    }
}
__device__ __forceinline__ void phase_t2(const Params& p, int l) {
    t2_rows(p.zA, p.zB, p.cs, p.conv_w + (size_t)l * 4 * DM, p.conv_b + (size_t)l * DM, p.q_a_norm + l * 512, p.kv_a_norm + l * 512, p.qn, p.kvn, p.Kf, p.xc, p.ssqB);
}
__device__ __forceinline__ void phase_scan1(const Params& p) {
    float* Pc = p.carry; float* Hc = p.carry + 128 * DM;
    for (long i = (long)blockIdx.x * NTHR + TID(); i < 128L * DM; i += (long)gridDim.x * NTHR) {
        const int c = (int)(i % DM), ch = (int)(i / DM); float P = 1.f, H = 0.f;
        const float* pa = p.la + (long)ch * 64 * DM + c; const float* pb = p.lb + (long)ch * 64 * DM + c;
#pragma unroll 1
        for (int t0 = 0; t0 < 64; t0 += 16) { float a[16], b[16];
#pragma unroll
            for (int t = 0; t < 16; ++t) { a[t] = pa[(long)(t0 + t) * DM]; b[t] = pb[(long)(t0 + t) * DM]; }
#pragma unroll
            for (int t = 0; t < 16; ++t) { H = a[t] * H + b[t]; P *= a[t]; } }
        Pc[i] = P; Hc[i] = H; }
}
__device__ __forceinline__ void scan3_rows(const float* __restrict__ Pc, const float* __restrict__ Hc, const float* __restrict__ la, const float* __restrict__ lb, const u16* __restrict__ zB,
                                           u16* __restrict__ OH, float* __restrict__ ssqA) {
    for (long i = (long)blockIdx.x * NTHR + TID(); i < 128L * DM; i += (long)gridDim.x * NTHR) {
        if (i < S) ssqA[i] = 0.f;
        const int c = (int)(i % DM), ch = (int)(i / DM); float H = 0.f;
        int k = 0;
#pragma unroll 1
        for (; k + 16 <= ch; k += 16) { float a[16], b[16];
#pragma unroll
            for (int t = 0; t < 16; ++t) { a[t] = Pc[(long)(k + t) * DM + c]; b[t] = Hc[(long)(k + t) * DM + c]; }
#pragma unroll
            for (int t = 0; t < 16; ++t) H = a[t] * H + b[t]; }
        for (; k < ch; ++k) H = Pc[(long)k * DM + c] * H + Hc[(long)k * DM + c];
        const float* pa = la + (long)ch * 64 * DM + c; const float* pb = lb + (long)ch * 64 * DM + c;
        const u16* pg = zB + (long)ch * 64 * ZB + 4096 + c; u16* po = OH + (long)ch * 64 * 4096 + 2048 + c;
#pragma unroll
        for (int t0 = 0; t0 < 64; t0 += 16) { float a[16], b[16]; u16 g[16];
#pragma unroll
            for (int t = 0; t < 16; ++t) { a[t] = pa[(long)(t0 + t) * DM]; b[t] = pb[(long)(t0 + t) * DM]; g[t] = pg[(long)(t0 + t) * ZB]; }
#pragma unroll
            for (int t = 0; t < 16; ++t) { H = a[t] * H + b[t]; po[(long)(t0 + t) * 4096] = f2bf(H * bf2f(g[t])); } } }
}
__device__ __forceinline__ void phase_scan3(const Params& p) { scan3_rows(p.carry, p.carry + 128 * DM, p.la, p.lb, p.zB, p.OH, p.ssqA); }

typedef float f32x16 __attribute__((ext_vector_type(16)));
typedef short s16x4 __attribute__((ext_vector_type(4)));
constexpr int SHM_V = 64 * 128 * 2, SHM_K = 64 * 192 * 2, ATT_WS = 2 * SHM_V + 2 * SHM_K;
#define KSWZ(row, colB) ((row) * 384 + ((colB) ^ (((row) & 7) << 4)))
__device__ __forceinline__ int v_st(int k, int c) { const int kk = (k & ~0xC) | ((k & 4) << 1) | ((k & 8) >> 1); return ((kk >> 3) * 4 + (c >> 5)) * 512 + ((kk & 7) * 32 + (c & 31)) * 2; }
__device__ __forceinline__ int v_rd_base(int lane) { return ((lane & 3) << 3) | (((lane >> 2) & 3) << 6) | (((lane >> 4) & 1) << 5) | (((lane >> 5) & 1) << 8); }
constexpr int v_rd_off(int d0, int ks, int half) { return d0 * 512 + ks * 4096 + half * 2048; }
__device__ __forceinline__ int crow(int r, int hi) { return (r & 3) + 8 * (r >> 2) + 4 * hi; }
__device__ __forceinline__ unsigned cvtpk(float lo, float hi) { unsigned r; asm volatile("v_cvt_pk_bf16_f32 %0, %1, %2" : "=v"(r) : "v"(lo), "v"(hi)); return r; }

__device__ __forceinline__ void partialSM(f32x16& p0, f32x16& p1, float& m_reg, float& mn, float& alpha) {
    float pmax = p0[0];
#pragma unroll
    for (int r = 1; r < 16; ++r) pmax = fmaxf(pmax, p0[r]);
#pragma unroll
    for (int r = 0; r < 16; ++r) pmax = fmaxf(pmax, p1[r]);
    { auto rr = __builtin_amdgcn_permlane32_swap(__float_as_uint(pmax), __float_as_uint(pmax), false, false);
      pmax = fmaxf(__uint_as_float(rr[0]), __uint_as_float(rr[1])); }
    if (__builtin_expect(__all(pmax - m_reg <= 11.5f), 1)) { mn = m_reg; alpha = 1.f; }
    else { mn = fmaxf(m_reg, pmax); alpha = __builtin_amdgcn_exp2f(m_reg - mn); m_reg = mn; }
#pragma unroll
    for (int r = 0; r < 16; ++r) p0[r] = p0[r] - mn;
#pragma unroll
    for (int r = 0; r < 16; ++r) p1[r] = p1[r] - mn;
#pragma unroll
    for (int r = 0; r < 16; ++r) p0[r] = __builtin_amdgcn_exp2f(p0[r]);
}
__device__ __forceinline__ void finishSM(f32x16& p0, f32x16& p1, float alpha, float& l_reg, bf16x8& pa0, bf16x8& pa1, bf16x8& pa2, bf16x8& pa3) {
#pragma unroll
    for (int r = 0; r < 16; ++r) p1[r] = __builtin_amdgcn_exp2f(p1[r]);
    float ps = 0;
#pragma unroll
    for (int r = 0; r < 16; ++r) ps += p0[r];
#pragma unroll
    for (int r = 0; r < 16; ++r) ps += p1[r];
    { auto rr = __builtin_amdgcn_permlane32_swap(__float_as_uint(ps), __float_as_uint(ps), false, false);
      ps = __uint_as_float(rr[0]) + __uint_as_float(rr[1]); }
    l_reg = l_reg * alpha + ps;
#define PK4(P, B_, OUT) do { unsigned a0 = cvtpk(P[B_+0], P[B_+1]), a1 = cvtpk(P[B_+2], P[B_+3]);                          \
        unsigned b0 = cvtpk(P[B_+4], P[B_+5]), b1 = cvtpk(P[B_+6], P[B_+7]);                                             \
        auto r0 = __builtin_amdgcn_permlane32_swap(a0, b0, false, false); auto r1 = __builtin_amdgcn_permlane32_swap(a1, b1, false, false); \
        u32x4 w = {r0[0], r1[0], r0[1], r1[1]}; OUT = *reinterpret_cast<bf16x8*>(&w); } while (0)
    PK4(p0, 0, pa0); PK4(p0, 8, pa1); PK4(p1, 0, pa2); PK4(p1, 8, pa3);
#undef PK4
}
template <int KB>
__device__ __forceinline__ void qkt(f32x16& p0, f32x16& p1, LAS char* K_lds, int r32, int hi, const bf16x8* qr, bool act) {
    if (!act) { const float NEG = -__builtin_inff();
#pragma unroll
        for (int r = 0; r < 16; ++r) { p0[r] = NEG; p1[r] = NEG; } return; }
#pragma unroll
    for (int r = 0; r < 16; ++r) { p0[r] = 0.f; p1[r] = 0.f; }
    LAS char* kb[4];
#pragma unroll
    for (int dd = 0; dd < 4; ++dd) kb[dd] = K_lds + KB * SHM_K + KSWZ(r32, (dd * 16 + hi * 8) * 2);
#pragma unroll
    for (int d0 = 0; d0 < 12; ++d0) { LAS char* a = kb[d0 & 3] + (d0 >> 2) * 128;
        const bf16x8 b0 = *(const LAS bf16x8*)a;
        const bf16x8 b1 = *(const LAS bf16x8*)(a + 32 * 384);
        p0 = __builtin_amdgcn_mfma_f32_32x32x16_bf16(b0, qr[d0], p0, 0, 0, 0);
        p1 = __builtin_amdgcn_mfma_f32_32x32x16_bf16(b1, qr[d0], p1, 0, 0, 0); }
}
template <int VB>
__device__ __forceinline__ void pv_tile(f32x16* o, int vb0, bf16x8 pa0, bf16x8 pa1, bf16x8 pa2, bf16x8 pa3, bool act) {
    if (!act) return;
#define TRRD(dst, off) asm volatile("ds_read_b64_tr_b16 %0, %1 offset:%2" : "=&v"(dst) : "v"(vb0), "i"(off) : "memory")
#define PV_D0(d0) do { s16x4 l0, l1, l2, l3, h0, h1, h2, h3; constexpr int b_ = VB * SHM_V + v_rd_off(d0, 0, 0); \
        TRRD(l0, b_); TRRD(h0, b_ + 2048); TRRD(l1, b_ + 4096); TRRD(h1, b_ + 6144); TRRD(l2, b_ + 8192); TRRD(h2, b_ + 10240); TRRD(l3, b_ + 12288); TRRD(h3, b_ + 14336); \
        asm volatile("s_waitcnt lgkmcnt(0)" ::: "memory"); __builtin_amdgcn_sched_barrier(0); \
        o[d0] = __builtin_amdgcn_mfma_f32_32x32x16_bf16(pa0, (bf16x8){l0[0], l0[1], l0[2], l0[3], h0[0], h0[1], h0[2], h0[3]}, o[d0], 0, 0, 0);   \
        o[d0] = __builtin_amdgcn_mfma_f32_32x32x16_bf16(pa1, (bf16x8){l1[0], l1[1], l1[2], l1[3], h1[0], h1[1], h1[2], h1[3]}, o[d0], 0, 0, 0);   \
        o[d0] = __builtin_amdgcn_mfma_f32_32x32x16_bf16(pa2, (bf16x8){l2[0], l2[1], l2[2], l2[3], h2[0], h2[1], h2[2], h2[3]}, o[d0], 0, 0, 0);   \
        o[d0] = __builtin_amdgcn_mfma_f32_32x32x16_bf16(pa3, (bf16x8){l3[0], l3[1], l3[2], l3[3], h3[0], h3[1], h3[2], h3[3]}, o[d0], 0, 0, 0); } while (0)
    PV_D0(0); PV_D0(1); PV_D0(2); PV_D0(3);
#undef PV_D0
#undef TRRD
}

__device__ __forceinline__ void attn_block(char* lds, const u16* __restrict__ Qb, const u16* __restrict__ Kh, const u16* __restrict__ Vh,
                                           const u16* __restrict__ sg, u16* __restrict__ Ob, int P0) {
    const int tid = TID(), wid = __builtin_amdgcn_readfirstlane(tid >> 6), lane = tid & 63, r32 = lane & 31, hi = lane >> 5;
    const int NT = (P0 >> 6) + 4;
    const int wchunk = (P0 >> 6) + (wid >> 1);
    LAS char* L = (LAS char*)lds; LAS char* V_lds = L; LAS char* K_lds = L + 2 * SHM_V;
    LAS float* wsf = (LAS float*)(L + ATT_WS) + wid * 64; LAS float* li_l = wsf; LAS float* al_l = wsf + 32;
    float m_reg = -1e30f, l_reg = 0.f; f32x16 o[4];
#pragma unroll
    for (int d = 0; d < 4; ++d)
#pragma unroll
        for (int r = 0; r < 16; ++r) o[d][r] = 0.f;
    const int sr = tid >> 4, sc = (tid & 15) * 8, vst0 = v_st(sr, sc), vst1 = v_st(32 + sr, sc);
    const int kc0 = tid, kc1 = tid + 512, kc2 = tid + 1024;
    const int kws0 = KSWZ(kc0 / 24, (kc0 % 24) * 16), kws1 = KSWZ(kc1 / 24, (kc1 % 24) * 16), kws2 = KSWZ(kc2 / 24, (kc2 % 24) * 16);
    const int vb0 = (int)(unsigned)(uintptr_t)V_lds + v_rd_base(lane);
    bf16x8 qr[12];
#pragma unroll
    for (int d0 = 0; d0 < 12; ++d0) qr[d0] = *(const bf16x8*)(Qb + (long)(wid * 32 + r32) * NQ + d0 * 16 + hi * 8);
    bf16x8 st_k0, st_k1, st_k2, st_v0, st_v1;
#define VMW() asm volatile("s_waitcnt vmcnt(0)" ::: "memory")
#define SBAR() __builtin_amdgcn_sched_barrier(0)
#define SLOAD(t) do { const u16* kp_ = Kh + (long)(t) * 64 * QD + tid * 8; st_k0 = *(const bf16x8*)kp_; st_k1 = *(const bf16x8*)(kp_ + 4096); st_k2 = *(const bf16x8*)(kp_ + 8192); \
                      const u16* vp_ = Vh + ((long)(t) * 64 + sr) * VH + sc; st_v0 = *(const bf16x8*)vp_; st_v1 = *(const bf16x8*)(vp_ + 32 * VH); } while (0)
#define SWRITE(bf) do { *(LAS bf16x8*)(K_lds + (bf) * SHM_K + kws0) = st_k0; *(LAS bf16x8*)(K_lds + (bf) * SHM_K + kws1) = st_k1; *(LAS bf16x8*)(K_lds + (bf) * SHM_K + kws2) = st_k2; \
                        *(LAS bf16x8*)(V_lds + (bf) * SHM_V + vst0) = st_v0; *(LAS bf16x8*)(V_lds + (bf) * SHM_V + vst1) = st_v1; } while (0)
#define RESC(a) do { if (__any((a) < 1.f)) { if (hi == 0) al_l[r32] = (a); asm volatile("s_waitcnt lgkmcnt(0)" ::: "memory");              \
                     _Pragma("unroll") for (int d_ = 0; d_ < 4; ++d_) _Pragma("unroll") for (int r = 0; r < 16; ++r) o[d_][r] *= al_l[crow(r, hi)]; } } while (0)
#define ACT(t) ((t) <= wchunk)
    f32x16 pA0, pA1, pB0, pB1; float mnA, mnB, alA, alB; bf16x8 pa0, pa1, pa2, pa3;
    SLOAD(0); VMW(); SWRITE(0); SBAR();
    SLOAD(1);
    __syncthreads();
    SBAR(); qkt<0>(pA0, pA1, K_lds, r32, hi, qr, ACT(0));
    partialSM(pA0, pA1, m_reg, mnA, alA);
    VMW(); SWRITE(1);
    __syncthreads();
#define HALF_STEP(PX0, PX1, mnX, alX, PY0, PY1, alY, t, KB, VB, SB) do {                                                      \
        SBAR(); qkt<KB>(PX0, PX1, K_lds, r32, hi, qr, ACT(t));                                                                \
        finishSM(PY0, PY1, alY, l_reg, pa0, pa1, pa2, pa3); SBAR();                                                           \
        if ((t) + 1 < NT) { SLOAD((t) + 1); SBAR(); }                                                                          \
        pv_tile<VB>(o, vb0, pa0, pa1, pa2, pa3, ACT((t) - 1)); partialSM(PX0, PX1, m_reg, mnX, alX);                          \
        __syncthreads();                                                                                                      \
        if ((t) + 1 < NT) { VMW(); SWRITE(SB); }                                                                               \
        RESC(alX); __syncthreads(); } while (0)
    for (int t = 1; t + 1 < NT; t += 2) {
        HALF_STEP(pB0, pB1, mnB, alB, pA0, pA1, alA, t, 1, 0, 0);
        HALF_STEP(pA0, pA1, mnA, alA, pB0, pB1, alB, t + 1, 0, 1, 1);
    }
    SBAR(); qkt<1>(pB0, pB1, K_lds, r32, hi, qr, ACT(NT - 1)); SBAR();
    finishSM(pA0, pA1, alA, l_reg, pa0, pa1, pa2, pa3); SBAR();
    pv_tile<0>(o, vb0, pa0, pa1, pa2, pa3, ACT(NT - 2));
    partialSM(pB0, pB1, m_reg, mnB, alB); __syncthreads(); RESC(alB);
    finishSM(pB0, pB1, alB, l_reg, pa0, pa1, pa2, pa3); SBAR(); pv_tile<1>(o, vb0, pa0, pa1, pa2, pa3, ACT(NT - 1));
    SBAR();
    if (hi == 0) li_l[r32] = l_reg; asm volatile("s_waitcnt lgkmcnt(0)" ::: "memory");
    float rli[16];
#pragma unroll
    for (int r = 0; r < 16; ++r) rli[r] = __builtin_amdgcn_rcpf(li_l[crow(r, hi)]);
    const int xl = (lane ^ 1) << 2;
    unsigned gg[16][4];
#pragma unroll
    for (int r = 0; r < 16; ++r)
#pragma unroll
        for (int d0 = 0; d0 < 4; ++d0) gg[r][d0] = *(const unsigned*)(sg + (long)(wid * 32 + crow(r, hi)) * ZB + d0 * 32 + (r32 & ~1));
#pragma unroll
    for (int r = 0; r < 16; ++r) { const int orow = wid * 32 + crow(r, hi);
#pragma unroll
        for (int d0 = 0; d0 < 4; ++d0) { const float v = o[d0][r] * rli[r];
            const float vn = __int_as_float(__builtin_amdgcn_ds_bpermute(xl, __float_as_int(v)));
            const unsigned g = gg[r][d0];
            if ((r32 & 1) == 0) *(unsigned*)(Ob + (long)orow * 4096 + d0 * 32 + r32) = cvtpk(v * __uint_as_float(g << 16), vn * __uint_as_float(g & 0xffff0000u)); } }
    __syncthreads();
#undef VMW
#undef SBAR
#undef SLOAD
#undef SWRITE
#undef RESC
#undef ACT
#undef HALF_STEP
}
__device__ __forceinline__ void phase_attention(const Params& p, char* lds) {
    for (int it = blockIdx.x; it < 256; it += gridDim.x) {
        const int xcd = it & 7, idx = it >> 3, hh = xcd * 2 + (idx >> 4), x = idx & 15;
        for (int half = 0; half < 2; ++half) { const int P0 = (half ? x : 31 - x) * 256;
            attn_block(lds, p.Q + (long)P0 * NQ + hh * QD, p.Kf + (long)hh * S * QD, p.Vf + (long)hh * S * VH, p.zB + (long)P0 * ZB + hh * VH, p.OH + (long)P0 * 4096 + hh * VH, P0); }
    }
}

#ifndef PROBE_MASK
#define PROBE_MASK 0
#endif
#if PROBE_MASK
#define TICK(cls) do { const unsigned long long now_ = __builtin_amdgcn_s_memrealtime(); if ((PROBE_MASK >> (cls)) & 1) t_acc += now_ - t_last; t_last = now_; } while (0)
#else
#define TICK(cls) do { } while (0)
#endif
__global__ __launch_bounds__(NTHR, 2) void mega(Params p) {
    extern __shared__ __attribute__((aligned(16))) char lds[];
    cg::grid_group grid = cg::this_grid();
    const int G = gridDim.x;
    volatile LAS unsigned* xbst = (volatile LAS unsigned*)((LAS char*)lds + 8 * HTB);
    if (TID() == 0) { xbst[0] = 0u; xbst[1] = 0u; xbst[2] = 0u; xbst[3] = 0u; }
    __syncthreads();
    if (blockIdx.x == 0) for (int i = TID(); i < XCD_BAR_WORDS; i += NTHR) p.bar[i] = 0u;
#if PROBE_MASK
    unsigned long long t_acc = 0, t_last = __builtin_amdgcn_s_memrealtime();
#endif
    phase_prologue(p, lds);
    phase_xb_ssq(p.x_in, p.hb, p.ssqA);
    grid.sync();
    const XcdBarrier xb = xcd_barrier_post(p.bar, xbst);
    TICK(0);
    for (int l = 0; l < DEPTH; ++l) {
        const int c = (int)blockIdx.x + opaque_zero();
        const float* xcur = l ? p.xr : p.x_in;
        { TileSched sc{p.hb, DM, p.Wt_in + (size_t)l * NIN * DM, DM, 32, NIN / 256, G, c}; EpiIn e{p.zB, p.zA, p.ssqA}; gemm_fast(lds, DM, DM, DM, sc, e); }
        xcd_barrier(xb); TICK(2);
        phase_t2(p, l);
        xcd_barrier(xb); TICK(3);
        { TileSched sc{p.qn, QL, p.Wt_q + (size_t)l * NQ * QL, QL, 32, NQ / 256, G, c}; EpiQ e{p.Q, p.cs}; gemm_fast(lds, QL, QL, QL, sc, e); }
        { TileSched sc{p.kvn, KVL, p.Wt_kv + (size_t)l * NKV * KVL, KVL, 32, NKV / 256, G, (c + 128) % G}; EpiKV e{p.Kf, p.Vf}; gemm_fast(lds, KVL, KVL, KVL, sc, e); }
        { LruSched sc{{p.xc, DM, p.Wt_lru + (size_t)l * LRUB * 65536, 256, 32, LRUB, G, c}}; EpiLru e{p.xc, p.b_rg + l * DM, p.b_ig + l * DM, p.nsp8 + l * DM, p.la, p.lb}; gemm_fast(lds, 256, DM, 256, sc, e); }
        xcd_barrier(xb); TICK(4);
        phase_scan1(p);
        phase_attention(p, lds);
        xcd_barrier(xb); TICK(5);
        phase_scan3(p);
        xcd_barrier(xb); TICK(6);
        { MergeSched sc{{p.OH, 4096, p.Wt_o + (size_t)l * DM * 4096, 4096, 32, 8, G, c}}; EpiMerge e{p.zB, p.mg}; gemm_fast(lds, DM, 4096, 4096, sc, e); }
        xcd_barrier(xb); TICK(7);
        { TileSched sc{p.mg, DM, p.Wt_out + (size_t)l * DM * DM, DM, 32, 8, G, c}; EpiOut e{xcur, p.xr, p.hb2, p.ssqB}; gemm_fast(lds, DM, DM, DM, sc, e); }
        { TileSched sc{p.pb + (size_t)l * S * PLE, PLE, p.Wt_ple + (size_t)l * DM * PLE, PLE, 32, 8, G, c}; EpiF32 e{p.pp, DM}; gemm_fast(lds, PLE, PLE, PLE, sc, e); }
        xcd_barrier(xb); TICK(8);
        { TileSched sc{p.hb2, DM, p.Wt_pg + (size_t)l * DM * DM, DM, 32, 8, G, c}; EpiPle e{p.xr, p.pp, p.ssqB, p.hb, p.ssqA}; gemm_fast(lds, DM, DM, DM, sc, e); }
        xcd_barrier(xb); TICK(9);
    }
    phase_final_norm(p.xr, p.final_norm);
#if PROBE_MASK
    __syncthreads();
    if (blockIdx.x == 0) { const float d = sqrtf((float)t_acc * 0.01f * 4.096e-8f);
        for (int j = 0; j < 8; ++j) p.xr[threadIdx.x * 8 + j] += d; }
#endif
}

constexpr size_t LDS_BYTES = 8 * HTB + 16;

extern "C" void kernel_launch(void* const* d_in, const int* in_sizes, int n_in, void* d_out, int out_size, void* d_ws, size_t ws_size, hipStream_t st) {
    Params p{};
    p.x_in = (const float*)d_in[0]; p.p_in = (const float*)d_in[1]; p.pos = (const int*)d_in[2];
    p.attn_norm = (const float*)d_in[3]; p.w_in = (const float*)d_in[4]; p.q_a_norm = (const float*)d_in[5]; p.w_q_b = (const float*)d_in[6];
    p.kv_a_norm = (const float*)d_in[7]; p.w_kv_b = (const float*)d_in[8]; p.conv_w = (const float*)d_in[9]; p.conv_b = (const float*)d_in[10];
    p.w_rg = (const float*)d_in[11]; p.b_rg = (const float*)d_in[12]; p.w_ig = (const float*)d_in[13]; p.b_ig = (const float*)d_in[14]; p.lam = (const float*)d_in[15];
    p.w_o_mla = (const float*)d_in[16]; p.w_o_lru = (const float*)d_in[17]; p.w_out = (const float*)d_in[18]; p.ple_norm = (const float*)d_in[19];
    p.w_ple_gate = (const float*)d_in[20]; p.w_ple = (const float*)d_in[21]; p.final_norm = (const float*)d_in[22];
    p.xr = (float*)d_out;
    char* w = (char*)d_ws; size_t off = 0;
    auto take = [&](size_t bytes) { char* r = w + off; off += (bytes + 255) & ~(size_t)255; return r; };
    p.Wt_in = (u16*)take((size_t)DEPTH * NIN * DM * 2); p.Wt_q = (u16*)take((size_t)DEPTH * NQ * QL * 2); p.Wt_kv = (u16*)take((size_t)DEPTH * NKV * KVL * 2);
    p.Wt_lru = (u16*)take((size_t)DEPTH * LRUB * 65536 * 2); p.Wt_o = (u16*)take((size_t)DEPTH * DM * 4096 * 2); p.Wt_out = (u16*)take((size_t)DEPTH * DM * DM * 2);
    p.Wt_pg = (u16*)take((size_t)DEPTH * DM * DM * 2); p.Wt_ple = (u16*)take((size_t)DEPTH * DM * PLE * 2);
    p.hb = (u16*)take((size_t)S * DM * 2); p.hb2 = (u16*)take((size_t)S * DM * 2); p.ssqA = (float*)take((size_t)S * 4); p.ssqB = (float*)take((size_t)S * 4); p.zB = (u16*)take((size_t)S * ZB * 2); p.zA = (float*)take((size_t)S * ZA * 4);
    p.qn = (u16*)take((size_t)S * QL * 2); p.kvn = (u16*)take((size_t)S * KVL * 2); p.Q = (u16*)take((size_t)S * NQ * 2);
    p.Kf = (u16*)take((size_t)NH * S * QD * 2); p.Vf = (u16*)take((size_t)NH * S * VH * 2); p.xc = (u16*)take((size_t)S * DM * 2);
    p.OH = (u16*)take((size_t)S * 4096 * 2); p.pb = (u16*)take((size_t)DEPTH * S * PLE * 2); p.cs = (float*)take((size_t)S * 64 * 4); p.carry = (float*)take((size_t)3 * 128 * DM * 4); p.nsp8 = (float*)take((size_t)DEPTH * DM * 4); p.bar = (unsigned*)take((size_t)XCD_BAR_WORDS * 4);
    p.la = (float*)take((size_t)S * DM * 4); p.lb = (float*)take((size_t)S * DM * 4); p.pp = (float*)take((size_t)S * DM * 4); p.mg = (u16*)take((size_t)S * DM * 2);
    if (off > ws_size) { fprintf(stderr, "workspace too small: need %zu have %zu\n", off, ws_size); return; }
    (void)hipFuncSetAttribute((const void*)mega, hipFuncAttributeMaxDynamicSharedMemorySize, (int)LDS_BYTES);
    int dev = 0, cus = 0; (void)hipGetDevice(&dev); (void)hipDeviceGetAttribute(&cus, hipDeviceAttributeMultiprocessorCount, dev);
    int per_cu = 0; (void)hipOccupancyMaxActiveBlocksPerMultiprocessor(&per_cu, mega, NTHR, LDS_BYTES);
    if (per_cu < 1 || cus < 1) { fprintf(stderr, "occupancy query failed\n"); return; }
    void* args[] = {&p};
    hipError_t e = hipLaunchCooperativeKernel((const void*)mega, dim3(cus), dim3(NTHR), args, LDS_BYTES, st);
    if (e != hipSuccess) fprintf(stderr, "cooperative launch failed: %s\n", hipGetErrorString(e));
}
```

```cpp
#include <hip/hip_runtime.h>
#include <hip/hip_cooperative_groups.h>
#include <cstdio>
#include <cstdint>
namespace cg = cooperative_groups;

constexpr int S = 8192, DM = 2048, DEPTH = 4, NH = 16, QL = 512, KVL = 512, NOPE = 128, ROPE = 64, VH = 128;
constexpr int INT = 11328, PLE = 256, LRUB = 16, LBD = 128;
constexpr int QD = 192, NQ = NH * QD  , NKV = NH * 256  ;
constexpr int NIN = 11520;
constexpr int ZB = 10240, ZA = 1280;
constexpr int NTHR = 512;
constexpr float QSCALE = 0.07216878364870322f * 1.4426950408889634f;

typedef unsigned short u16;
typedef short bf16x8 __attribute__((ext_vector_type(8)));
typedef float f32x4 __attribute__((ext_vector_type(4)));
typedef float f32x2 __attribute__((ext_vector_type(2)));
typedef unsigned u32x2 __attribute__((ext_vector_type(2)));
typedef unsigned u32x4 __attribute__((ext_vector_type(4)));

__device__ __forceinline__ u16 f2bf(float f) { unsigned u = __float_as_uint(f); u += 0x7FFFu + ((u >> 16) & 1u); return (u16)(u >> 16); }
__device__ __forceinline__ float bf2f(u16 b) { return __uint_as_float(((unsigned)b) << 16); }
__device__ __forceinline__ unsigned pk2(float lo, float hi) { unsigned r; asm volatile("v_cvt_pk_bf16_f32 %0, %1, %2" : "=v"(r) : "v"(lo), "v"(hi)); return r; }
__device__ __forceinline__ float sigmoidf_(float x) { return __builtin_amdgcn_rcpf(1.f + __builtin_amdgcn_exp2f(-1.4426950408889634f * x)); }
__device__ __forceinline__ float siluf_(float x) { return x * __builtin_amdgcn_rcpf(1.f + __builtin_amdgcn_exp2f(-1.4426950408889634f * x)); }
__device__ __forceinline__ int opaque_zero() { int z; asm volatile("s_mov_b32 %0, 0" : "=s"(z)); return z; }
#define TID() ((int)threadIdx.x + opaque_zero())
__device__ __forceinline__ float wsum(float s, int lane) { for (int off = 32; off; off >>= 1) s += __int_as_float(__builtin_amdgcn_ds_bpermute((lane ^ off) << 2, __float_as_int(s))); return s; }
__device__ __forceinline__ float wmax(float s, int lane) { for (int off = 32; off; off >>= 1) s = fmaxf(s, __int_as_float(__builtin_amdgcn_ds_bpermute((lane ^ off) << 2, __float_as_int(s)))); return s; }

struct Params {
    const float *x_in, *p_in; const int* pos;
    const float *attn_norm, *w_in, *q_a_norm, *w_q_b, *kv_a_norm, *w_kv_b, *conv_w, *conv_b, *w_rg, *b_rg, *w_ig, *b_ig, *lam, *w_o_mla, *w_o_lru, *w_out, *ple_norm, *w_ple_gate, *w_ple, *final_norm;
    float* xr;
    u16 *Wt_in, *Wt_q, *Wt_kv, *Wt_lru, *Wt_o, *Wt_out, *Wt_pg, *Wt_ple;
    u16 *hb, *hb2, *zB, *qn, *kvn, *Q, *Kf, *Vf, *xc, *OH, *mg, *pb, *Pm;
    float *zA, *la, *lb, *pp, *cs, *carry, *sc, *nsp8, *ssqA, *ssqB; unsigned* bar;
};

struct Unit { const u16* a; const u16* b; int pm, pn, aux; };

struct TileSched {
    const u16* A; long lda; const u16* B; long ldb; int nM, nN, G, c;
    __device__ __forceinline__ bool tile(int i, int& pm, int& pn) const {
        const int nwg = nM * nN; const long L = (long)i * G + c; if (L >= nwg) return false;
        int wgid = (int)L; { const int q = nwg / 8, r = nwg % 8, xcd = wgid % 8, off = wgid / 8; wgid = (xcd < r ? xcd * (q + 1) : r * (q + 1) + (xcd - r) * q) + off; }
        const int nig = 8 * nN, gid = wgid / nig, fm = gid * 8, gsz = (nM - fm) < 8 ? (nM - fm) : 8;
        pm = fm + ((wgid % nig) % gsz); pn = (wgid % nig) / gsz; return true;
    }
    __device__ __forceinline__ bool next(int i, Unit& u) const {
        if (!tile(i, u.pm, u.pn)) return false;
        u.a = A + (long)u.pm * 256 * lda; u.b = B + (long)u.pn * 256 * ldb; u.aux = 0; return true;
    }
};
struct LruSched : TileSched {
    __device__ __forceinline__ bool next(int i, Unit& u) const {
        if (!tile(i, u.pm, u.pn)) return false;
        u.a = A + (long)u.pm * 256 * lda + (u.pn >> 1) * 256; u.b = B + (long)u.pn * 65536; u.aux = 0; return true;
    }
};
struct MergeSched : TileSched {
    __device__ __forceinline__ bool next(int i, Unit& u) const {
        if (!tile(i >> 1, u.pm, u.pn)) return false;
        u.aux = i & 1; u.a = A + (long)u.pm * 256 * lda + u.aux * 2048; u.b = B + (long)u.pn * 256 * ldb + u.aux * 2048; return true;
    }
};
struct TriSched {
    const u16* A; long lda; const u16* B; long ldb; int G, c;
    __device__ __forceinline__ bool next(int i, Unit& u) const {
        int t = i * G + c; if (t >= 528) return false;
        int pm = 0; while (t >= pm + 1) { t -= pm + 1; ++pm; }
        u.pm = pm; u.pn = t; u.a = A + (long)pm * 256 * lda; u.b = B + (long)t * 256 * ldb; u.aux = 0; return true;
    }
};
struct RowSched {
    const u16* A; long lda; const u16* B; int G, c;
    __device__ __forceinline__ bool next(int i, Unit& u) const {
        const int t = i * G + c; if (t >= 32) return false;
        u.pm = 31 - t; u.pn = 0; u.a = A + (long)u.pm * 256 * lda; u.b = B; u.aux = 0; return true;
    }
};

template <class F>
__device__ __forceinline__ void epi_foreach(f32x4 (&acc)[2][2][4][2], const Unit& u, int wr, int wc, int fr, int fq, F f) {
    const int row0 = u.pm * 256 + wr * 64 + fr, col0 = u.pn * 256 + wc * 32 + 4 * fq;
#pragma unroll
    for (int ai = 0; ai < 2; ++ai)
#pragma unroll
        for (int m = 0; m < 4; ++m) {
#pragma unroll
            for (int bj = 0; bj < 2; ++bj)
#pragma unroll
                for (int n = 0; n < 2; ++n) f(row0 + ai * 128 + m * 16, col0 + bj * 128 + n * 16, acc[ai][bj][m][n]);
        }
}
template <int GM, class T, class LF, class F>
__device__ __forceinline__ void epi_foreach_ld(f32x4 (&acc)[2][2][4][2], const Unit& u, int wr, int wc, int fr, int fq, LF lf, F f) {
    const int row0 = u.pm * 256 + wr * 64 + fr, col0 = u.pn * 256 + wc * 32 + 4 * fq;
#pragma unroll
    for (int ai = 0; ai < 2; ++ai)
#pragma unroll
        for (int mg = 0; mg < 4; mg += GM) {
            T regs[GM][2][2];
#pragma unroll
            for (int m = 0; m < GM; ++m)
#pragma unroll
                for (int bj = 0; bj < 2; ++bj)
#pragma unroll
                    for (int n = 0; n < 2; ++n) regs[m][bj][n] = lf(row0 + ai * 128 + (mg + m) * 16, col0 + bj * 128 + n * 16);
#pragma unroll
            for (int m = 0; m < GM; ++m)
#pragma unroll
                for (int bj = 0; bj < 2; ++bj)
#pragma unroll
                    for (int n = 0; n < 2; ++n) f(row0 + ai * 128 + (mg + m) * 16, col0 + bj * 128 + n * 16, acc[ai][bj][mg + m][n], regs[m][bj][n]);
        }
}
template <class F>
__device__ __forceinline__ void epi_foreach8(f32x4 (&acc)[2][2][4][2], const Unit& u, int wr, int wc, int fr, int fq, F f) {
    const int row0 = u.pm * 256 + wr * 64 + fr, col0 = u.pn * 256 + wc * 32 + 8 * fq;
#pragma unroll
    for (int ai = 0; ai < 2; ++ai)
#pragma unroll
        for (int m = 0; m < 4; ++m)
#pragma unroll
            for (int bj = 0; bj < 2; ++bj) f(row0 + ai * 128 + m * 16, col0 + bj * 128, acc[ai][bj][m][0], acc[ai][bj][m][1]);
}
template <class T, class LF, class F>
__device__ __forceinline__ void epi_foreach8_ld(f32x4 (&acc)[2][2][4][2], const Unit& u, int wr, int wc, int fr, int fq, LF lf, F f) {
    const int row0 = u.pm * 256 + wr * 64 + fr, col0 = u.pn * 256 + wc * 32 + 8 * fq;
#pragma unroll
    for (int ai = 0; ai < 2; ++ai) {
        T regs[4][2];
#pragma unroll
        for (int m = 0; m < 4; ++m)
#pragma unroll
            for (int bj = 0; bj < 2; ++bj) regs[m][bj] = lf(row0 + ai * 128 + m * 16, col0 + bj * 128);
#pragma unroll
        for (int m = 0; m < 4; ++m)
#pragma unroll
            for (int bj = 0; bj < 2; ++bj) f(row0 + ai * 128 + m * 16, col0 + bj * 128, acc[ai][bj][m][0], acc[ai][bj][m][1], regs[m][bj]);
    }
}
__device__ __forceinline__ u32x4 pack8(const f32x4& a, const f32x4& b) { return (u32x4){pk2(a[0], a[1]), pk2(a[2], a[3]), pk2(b[0], b[1]), pk2(b[2], b[3])}; }
#define EPI_COMMON  __device__ __forceinline__ bool keep(const Unit&) const { return false; } __device__ __forceinline__ int klimit(const Unit&, int K) const { return K; }
#define EPI_SIG     __device__ __forceinline__ void operator()(f32x4 (&acc)[2][2][4][2], const Unit& u, int wr, int wc, int fr, int fq) const

__device__ __forceinline__ float rinv_of(float ss) { return rsqrtf(ss * (1.f / DM) + 1e-6f); }
struct EpiIn { EPI_COMMON u16* zB; float* zA; const float* ssq;
    EPI_SIG { const int seg = u.pn >> 3;
        const int row0 = u.pm * 256 + wr * 64 + fr, col0 = u.pn * 256 + wc * 32 + 8 * fq;
        float ri[2][4];
#pragma unroll
        for (int ai = 0; ai < 2; ++ai)
#pragma unroll
            for (int m = 0; m < 4; ++m) ri[ai][m] = ssq[row0 + ai * 128 + m * 16];
#pragma unroll
        for (int ai = 0; ai < 2; ++ai)
#pragma unroll
            for (int m = 0; m < 4; ++m) ri[ai][m] = rinv_of(ri[ai][m]);
        if (seg >= 5) {
#pragma unroll
            for (int ai = 0; ai < 2; ++ai)
#pragma unroll
                for (int m = 0; m < 4; ++m)
#pragma unroll
                    for (int bj = 0; bj < 2; ++bj) { const int row = row0 + ai * 128 + m * 16, col = col0 + bj * 128;
                        if (col < ZB + 1088) { float* d = zA + (long)row * ZA + (col - ZB); *(f32x4*)d = acc[ai][bj][m][0] * ri[ai][m]; *(f32x4*)(d + 4) = acc[ai][bj][m][1] * ri[ai][m]; } }
        } else { const bool sil = seg == 0 || seg == 2, ident = seg == 1;
#pragma unroll
            for (int ai = 0; ai < 2; ++ai)
#pragma unroll
                for (int m = 0; m < 4; ++m)
#pragma unroll
                    for (int bj = 0; bj < 2; ++bj) { const int row = row0 + ai * 128 + m * 16, col = col0 + bj * 128;
                        f32x4 o0 = acc[ai][bj][m][0] * ri[ai][m], o1 = acc[ai][bj][m][1] * ri[ai][m];
                        if (!ident) {
#pragma unroll
                            for (int e = 0; e < 4; ++e) { const float s0 = sigmoidf_(o0[e]), s1 = sigmoidf_(o1[e]); o0[e] = sil ? o0[e] * s0 : s0; o1[e] = sil ? o1[e] * s1 : s1; } }
                        *(u32x4*)(zB + (long)row * ZB + col) = (u32x4){pk2(o0[0], o0[1]), pk2(o0[2], o0[3]), pk2(o1[0], o1[1]), pk2(o1[2], o1[3])}; }
        }
    } };
struct CsT { f32x4 c, s; };
struct EpiQ { EPI_COMMON u16* Q; const float* cs;
    EPI_SIG { epi_foreach8_ld<CsT>(acc, u, wr, wc, fr, fq,
            [&](int row, int col) { const int d = col % QD; CsT t; t.c = (f32x4){1.f, 1.f, 1.f, 1.f}; t.s = (f32x4){0.f, 0.f, 0.f, 0.f};
                if (d >= NOPE) { const float* tp = cs + (long)row * 64 + ((d - NOPE) >> 1); t.c = *(const f32x4*)tp; t.s = *(const f32x4*)(tp + 32); }
                return t; },
            [&](int row, int col, f32x4& v0, f32x4& v1, const CsT& t) { f32x4 o0, o1;
                const int d = col % QD;
                if (d < NOPE) { o0 = v0 * QSCALE; o1 = v1 * QSCALE; }
                else { o0[0] = (v0[0] * t.c[0] - v0[1] * t.s[0]) * QSCALE; o0[1] = (v0[1] * t.c[0] + v0[0] * t.s[0]) * QSCALE;
                       o0[2] = (v0[2] * t.c[1] - v0[3] * t.s[1]) * QSCALE; o0[3] = (v0[3] * t.c[1] + v0[2] * t.s[1]) * QSCALE;
                       o1[0] = (v1[0] * t.c[2] - v1[1] * t.s[2]) * QSCALE; o1[1] = (v1[1] * t.c[2] + v1[0] * t.s[2]) * QSCALE;
                       o1[2] = (v1[2] * t.c[3] - v1[3] * t.s[3]) * QSCALE; o1[3] = (v1[3] * t.c[3] + v1[2] * t.s[3]) * QSCALE; }
                *(u32x4*)(Q + (long)row * NQ + col) = pack8(o0, o1); }); } };
struct EpiKV { EPI_COMMON u16* Kf; u16* Vf;
    EPI_SIG { epi_foreach8(acc, u, wr, wc, fr, fq, [&](int row, int col, f32x4& v0, f32x4& v1) {
            const int hh = col >> 8, j = col & 255;
            u16* dst = (j < 128) ? Kf + ((long)hh * S + row) * QD + j : Vf + ((long)hh * S + row) * VH + (j - 128);
            *(u32x4*)dst = pack8(v0, v1);
        }); } };
struct EpiLru { EPI_COMMON const u16* xc; const float *brg, *big, *nsp8; float *la, *lb;
    EPI_SIG {
        const int row0 = u.pm * 256 + wr * 64 + fr, col0 = u.pn * 256 + wc * 32 + 8 * fq;
        f32x4 cr[2], ci[2], cn[2];
#pragma unroll
        for (int bj = 0; bj < 2; ++bj) { const int ch = (col0 + bj * 128) >> 1; cr[bj] = *(const f32x4*)(brg + ch); ci[bj] = *(const f32x4*)(big + ch); cn[bj] = *(const f32x4*)(nsp8 + ch); }
#pragma unroll
        for (int ai = 0; ai < 2; ++ai) {
            u32x2 xw[4][2];
#pragma unroll
            for (int m = 0; m < 4; ++m)
#pragma unroll
                for (int bj = 0; bj < 2; ++bj) xw[m][bj] = *(const u32x2*)(xc + (long)(row0 + ai * 128 + m * 16) * DM + ((col0 + bj * 128) >> 1));
#pragma unroll
            for (int m = 0; m < 4; ++m)
#pragma unroll
                for (int bj = 0; bj < 2; ++bj) {
                    const long o = (long)(row0 + ai * 128 + m * 16) * DM + ((col0 + bj * 128) >> 1);
                    f32x4 av, bv;
#pragma unroll
                    for (int e = 0; e < 4; ++e) {
                        const f32x4 v = acc[ai][bj][m][e >> 1];
                        const float r = sigmoidf_(v[2 * (e & 1)] + cr[bj][e]), ii = sigmoidf_(v[2 * (e & 1) + 1] + ci[bj][e]);
                        const float lg = r * cn[bj][e], x2 = 2.f * lg;
                        const float a = __builtin_amdgcn_exp2f(1.4426950408889634f * lg);
                        const float em = (x2 > -0.25f) ? x2 * (1.f + x2 * (0.5f + x2 * (0.16666667f + x2 * (0.041666668f + x2 * 0.0083333338f)))) : (a * a - 1.f);
                        const unsigned w = xw[m][bj][e >> 1];
                        const float x = (e & 1) ? __uint_as_float(w & 0xffff0000u) : __uint_as_float(w << 16);
                        av[e] = a; bv[e] = __builtin_amdgcn_sqrtf(-em) * (ii * x); }
                    *(f32x4*)(la + o) = av; *(f32x4*)(lb + o) = bv; }
        }
    } };
struct SmSl { u32x4 sm, sl; };
__device__ __forceinline__ void unpack8(const u32x4& w, f32x4& a, f32x4& b) {
    a = (f32x4){__uint_as_float(w[0] << 16), __uint_as_float(w[0] & 0xffff0000u), __uint_as_float(w[1] << 16), __uint_as_float(w[1] & 0xffff0000u)};
    b = (f32x4){__uint_as_float(w[2] << 16), __uint_as_float(w[2] & 0xffff0000u), __uint_as_float(w[3] << 16), __uint_as_float(w[3] & 0xffff0000u)}; }
struct EpiMerge { const u16* zB; u16* mg;
    __device__ __forceinline__ bool keep(const Unit& u) const { return u.aux == 0; }
    __device__ __forceinline__ int klimit(const Unit&, int K) const { return K; }
    EPI_SIG { const int part = u.aux;
        epi_foreach8_ld<SmSl>(acc, u, wr, wc, fr, fq,
            [&](int row, int col) { SmSl t; t.sl = *(const u32x4*)(zB + (long)row * ZB + 8192 + col); t.sm = t.sl; if (part == 0) t.sm = *(const u32x4*)(zB + (long)row * ZB + 6144 + col); return t; },
            [&](int row, int col, f32x4& v0, f32x4& v1, const SmSl& t) {
            f32x4 l0, l1; unpack8(t.sl, l0, l1);
#pragma unroll
            for (int e = 0; e < 4; ++e) { l0[e] = fmaxf(l0[e], 1e-12f); l1[e] = fmaxf(l1[e], 1e-12f); }
            if (part == 0) { f32x4 m0, m1; unpack8(t.sm, m0, m1);
#pragma unroll
                for (int e = 0; e < 4; ++e) { v0[e] = v0[e] * m0[e] * __builtin_amdgcn_rcpf(l0[e]); v1[e] = v1[e] * m1[e] * __builtin_amdgcn_rcpf(l1[e]); }
            } else { *(u32x4*)(mg + (long)row * DM + col) = pack8(v0 * l0, v1 * l1); }
        }); } };
__device__ __forceinline__ void row_ssq_add(float sq, float* ssq, int row, int lane) {
    sq += __int_as_float(__builtin_amdgcn_ds_bpermute((lane ^ 16) << 2, __float_as_int(sq)));
    sq += __int_as_float(__builtin_amdgcn_ds_bpermute((lane ^ 32) << 2, __float_as_int(sq)));
    if (lane < 16) atomicAdd(ssq + row, sq);
}
struct EpiOut { EPI_COMMON const float* xold; float* xnew; u16* xb; float* ssq;
    EPI_SIG {
        const int row0 = u.pm * 256 + wr * 64 + fr, col0 = u.pn * 256 + wc * 32 + 8 * fq, lane = fq * 16 + fr;
#pragma unroll
        for (int ai = 0; ai < 2; ++ai) {
            f32x4 xo[4][2][2];
#pragma unroll
            for (int m = 0; m < 4; ++m)
#pragma unroll
                for (int bj = 0; bj < 2; ++bj) { const float* q = xold + (long)(row0 + ai * 128 + m * 16) * DM + col0 + bj * 128; xo[m][bj][0] = *(const f32x4*)q; xo[m][bj][1] = *(const f32x4*)(q + 4); }
#pragma unroll
            for (int m = 0; m < 4; ++m) { const int row = row0 + ai * 128 + m * 16; float sq = 0.f;
#pragma unroll
                for (int bj = 0; bj < 2; ++bj) { const f32x4 x0 = xo[m][bj][0] + acc[ai][bj][m][0], x1 = xo[m][bj][1] + acc[ai][bj][m][1]; const long idx = (long)row * DM + col0 + bj * 128;
                    *(f32x4*)(xnew + idx) = x0; *(f32x4*)(xnew + idx + 4) = x1; *(u32x4*)(xb + idx) = pack8(x0, x1);
                    sq += x0[0] * x0[0] + x0[1] * x0[1] + x0[2] * x0[2] + x0[3] * x0[3] + x1[0] * x1[0] + x1[1] * x1[1] + x1[2] * x1[2] + x1[3] * x1[3]; }
                row_ssq_add(sq, ssq, row, lane); }
        }
    } };
struct EpiF32 { EPI_COMMON float* C; long ldc;
    EPI_SIG { epi_foreach8(acc, u, wr, wc, fr, fq, [&](int row, int col, f32x4& v0, f32x4& v1) { float* d = C + (long)row * ldc + col; *(f32x4*)d = v0; *(f32x4*)(d + 4) = v1; }); } };
struct EpiPle { EPI_COMMON float* x; const float* pp; const float* ssq_in; u16* xb; float* ssq_out;
    EPI_SIG {
        const int row0 = u.pm * 256 + wr * 64 + fr, col0 = u.pn * 256 + wc * 32 + 8 * fq, lane = fq * 16 + fr;
#pragma unroll
        for (int ai = 0; ai < 2; ++ai)
#pragma unroll
            for (int mg = 0; mg < 4; mg += 2) {
                f32x4 xo[2][2][2], po[2][2][2]; float ss[2];
#pragma unroll
                for (int m = 0; m < 2; ++m) { const int row = row0 + ai * 128 + (mg + m) * 16; ss[m] = ssq_in[row];
#pragma unroll
                    for (int bj = 0; bj < 2; ++bj) { const long idx = (long)row * DM + col0 + bj * 128;
                        xo[m][bj][0] = *(const f32x4*)(x + idx); xo[m][bj][1] = *(const f32x4*)(x + idx + 4); po[m][bj][0] = *(const f32x4*)(pp + idx); po[m][bj][1] = *(const f32x4*)(pp + idx + 4); } }
#pragma unroll
                for (int m = 0; m < 2; ++m) { const int row = row0 + ai * 128 + (mg + m) * 16; const float ri = rinv_of(ss[m]); float sq = 0.f;
#pragma unroll
                    for (int bj = 0; bj < 2; ++bj) { f32x4 x0 = xo[m][bj][0], x1 = xo[m][bj][1]; const f32x4 v0 = acc[ai][bj][mg + m][0], v1 = acc[ai][bj][mg + m][1]; const long idx = (long)row * DM + col0 + bj * 128;
#pragma unroll
                        for (int e = 0; e < 4; ++e) { x0[e] += po[m][bj][0][e] * sigmoidf_(v0[e] * ri); x1[e] += po[m][bj][1][e] * sigmoidf_(v1[e] * ri); }
                        *(f32x4*)(x + idx) = x0; *(f32x4*)(x + idx + 4) = x1; *(u32x4*)(xb + idx) = pack8(x0, x1);
                        sq += x0[0] * x0[0] + x0[1] * x0[1] + x0[2] * x0[2] + x0[3] * x0[3] + x1[0] * x1[0] + x1[1] * x1[1] + x1[2] * x1[2] + x1[3] * x1[3]; }
                    row_ssq_add(sq, ssq_out, row, lane); }
            }
    } };

#define LAS __attribute__((address_space(3)))
constexpr int HTB = 128 * 64 * 2;
__device__ __forceinline__ int lds_byte(int r, int c) { const int st = (r >> 4) * 2 + (c >> 5), rr = r & 15, cc = c & 31, ob = rr * 64 + cc * 2; return st * 1024 + (ob ^ (((ob >> 9) & 1) << 5)); }
__device__ __forceinline__ void stage_rc(int b, int& R, int& C) { const int st = b / 1024, sb = b % 1024, swz = sb ^ (((sb >> 9) & 1) << 5); R = (st >> 1) * 16 + swz / 64; C = (st & 1) * 32 + (swz % 64) / 2; }

template <class Epi, class Sched>
__device__ __forceinline__ void gemm_fast(char* lds_, int K, long lda, long ldb, const Sched& S_, const Epi& E) {
    LAS unsigned char* lds = (LAS unsigned char*)lds_;
    const int tid = TID(), wid = __builtin_amdgcn_readfirstlane(tid >> 6), lane = tid & 63, wr = wid >> 2, wc = wid & 3, fr = lane & 15, fq = lane >> 4;
    const int nt = K / 64;
    unsigned voffA[2], voffB[2];
#pragma unroll
    for (int i = 0; i < 2; ++i) { int R, C; stage_rc(tid * 16 + i * 8192, R, C); voffA[i] = (unsigned)(R * lda + C) * 2u; voffB[i] = (unsigned)(R * ldb + C) * 2u; }
    const size_t kstep = 128;
    const size_t hstepA = (size_t)128 * lda * 2, hstepB = (size_t)128 * ldb * 2;
    const unsigned ldsw = (unsigned)wid * 1024u;
    const int aoff = lds_byte(wr * 64 + fr, fq * 8), boff = lds_byte(wc * 32 + fr, fq * 8);
#define G_SA(b, h) (((b) * 2 + (h)) * HTB)
#define G_SB(b, h) ((4 + (b) * 2 + (h)) * HTB)
#define G_STAGE(bufoff, gbase, voff) do { _Pragma("unroll") for (int _i = 0; _i < 2; ++_i) \
        __builtin_amdgcn_global_load_lds((const unsigned*)((const char*)(gbase) + (voff)[_i]), (LAS unsigned*)(lds + (bufoff) + ldsw + _i * 8192), 16, 0, 0); } while (0)
#define G_LDA(dst, b, h) do { _Pragma("unroll") for (int m = 0; m < 4; ++m) _Pragma("unroll") for (int k = 0; k < 2; ++k) dst[m][k] = *(const LAS bf16x8*)(lds + G_SA(b, h) + aoff + m * 2048 + k * 1024); } while (0)
#define G_LDB(dst, b, h) do { _Pragma("unroll") for (int n = 0; n < 2; ++n) _Pragma("unroll") for (int k = 0; k < 2; ++k) dst[n][k] = *(const LAS bf16x8*)(lds + G_SB(b, h) + boff + n * 2048 + k * 1024); } while (0)
#define G_MMA(ai, bj, At, Bt) do { __builtin_amdgcn_s_setprio(1); _Pragma("unroll") for (int m = 0; m < 4; ++m) _Pragma("unroll") for (int n = 0; n < 2; ++n) _Pragma("unroll") for (int k = 0; k < 2; ++k) \
        acc[ai][bj][m][n] = __builtin_amdgcn_mfma_f32_16x16x32_bf16(Bt[n][k], At[m][k], acc[ai][bj][m][n], 0, 0, 0); __builtin_amdgcn_s_setprio(0); } while (0)
#define G_WAIT_V(n) asm volatile("s_waitcnt vmcnt(" #n ")" ::: "memory")
#define G_WAIT_L(n) asm volatile("s_waitcnt lgkmcnt(" #n ")" ::: "memory")
#define G_BAR __builtin_amdgcn_s_barrier()
#define G_SCHED __builtin_amdgcn_sched_barrier(0)
    Unit cur, nxt; int ui = 0;
    if (!S_.next(0, cur)) return;
    f32x4 acc[2][2][4][2];
#pragma unroll
    for (int a = 0; a < 2; ++a)
#pragma unroll
        for (int b = 0; b < 2; ++b)
#pragma unroll
            for (int m = 0; m < 4; ++m)
#pragma unroll
                for (int n = 0; n < 2; ++n) acc[a][b][m][n] = (f32x4){0.f, 0.f, 0.f, 0.f};
    bf16x8 At[4][2], B0[2][2], B1[2][2];
    const char* cA = (const char*)cur.a; const char* cB = (const char*)cur.b;
    G_STAGE(G_SB(0, 0), cB, voffB); G_STAGE(G_SA(0, 0), cA, voffA); G_STAGE(G_SB(0, 1), cB + hstepB, voffB); G_STAGE(G_SA(0, 1), cA + hstepA, voffA);
    if (wr == 1) G_BAR;
    G_WAIT_V(4); G_BAR;
    G_STAGE(G_SB(1, 0), cB + kstep, voffB); G_STAGE(G_SA(1, 0), cA + kstep, voffA); G_STAGE(G_SB(1, 1), cB + hstepB + kstep, voffB);
    G_WAIT_V(6); G_BAR;
    for (;;) {
        const bool has_next = S_.next(ui + 1, nxt);
        const char* nA = has_next ? (const char*)nxt.a : cA; const char* nB = has_next ? (const char*)nxt.b : cB;
#pragma unroll 1
        for (int t = 0; t < nt; t += 2) {
            const bool last = (t == nt - 2);
            const char* a1 = cA + (size_t)(t + 1) * kstep;
            const char* a2 = last ? nA : cA + (size_t)(t + 2) * kstep; const char* b2 = last ? nB : cB + (size_t)(t + 2) * kstep;
            const char* a3 = a2 + kstep; const char* b3 = b2 + kstep;
            G_LDB(B0, 0, 0); G_SCHED; G_LDA(At, 0, 0); G_STAGE(G_SA(1, 1), a1 + hstepA, voffA);
            G_WAIT_L(8); G_BAR; G_WAIT_L(0); G_MMA(0, 0, At, B0); G_BAR; G_SCHED;
            G_LDB(B1, 0, 1); G_STAGE(G_SB(0, 0), b2, voffB);
            G_BAR; G_WAIT_L(0); G_MMA(0, 1, At, B1); G_BAR;
            G_LDA(At, 0, 1); G_STAGE(G_SA(0, 0), a2, voffA);
            G_BAR; G_WAIT_L(0); G_MMA(1, 0, At, B0); G_BAR; G_SCHED;
            G_STAGE(G_SB(0, 1), b2 + hstepB, voffB);
            G_WAIT_V(6); G_BAR; G_MMA(1, 1, At, B1); G_BAR;
            G_LDB(B0, 1, 0); G_SCHED; G_LDA(At, 1, 0); G_STAGE(G_SA(0, 1), a2 + hstepA, voffA);
            G_WAIT_L(8); G_BAR; G_WAIT_L(0); G_MMA(0, 0, At, B0); G_BAR; G_SCHED;
            G_LDB(B1, 1, 1); G_STAGE(G_SB(1, 0), b3, voffB);
            G_BAR; G_WAIT_L(0); G_MMA(0, 1, At, B1); G_BAR;
            G_LDA(At, 1, 1); G_STAGE(G_SA(1, 0), a3, voffA);
            G_BAR; G_WAIT_L(0); G_MMA(1, 0, At, B0); G_BAR; G_SCHED;
            G_STAGE(G_SB(1, 1), b3 + hstepB, voffB);
            G_WAIT_V(6); G_BAR; G_MMA(1, 1, At, B1); G_BAR;
        }
        { const int t2 = TID(), w2 = t2 >> 6, l2 = t2 & 63;
          E(acc, cur, w2 >> 2, w2 & 3, l2 & 15, l2 >> 4); }
        if (!has_next) break;
        if (!E.keep(cur)) {
#pragma unroll
            for (int a = 0; a < 2; ++a)
#pragma unroll
                for (int b = 0; b < 2; ++b)
#pragma unroll
                    for (int m = 0; m < 4; ++m)
#pragma unroll
                        for (int n = 0; n < 2; ++n) acc[a][b][m][n] = (f32x4){0.f, 0.f, 0.f, 0.f};
        }
        cur = nxt; cA = nA; cB = nB; ++ui;
    }
    G_WAIT_V(0);
    if (wr == 0) G_BAR;
    G_BAR;
#undef G_SA
#undef G_SB
#undef G_STAGE
#undef G_LDA
#undef G_LDB
#undef G_MMA
#undef G_WAIT_V
#undef G_WAIT_L
#undef G_BAR
#undef G_SCHED
}


#define XB_TMO      128
#define XB_XCNT(j)  (256  + 64 * (j))
#define XB_XSUB(j)  (1280 + 64 * (j))
#define XB_XGEN(j)  (2304 + 64 * (j))
#define XB_TOP      3328
#define XB_TOPGEN   3392
#define XCD_BAR_WORDS 3456
#define XB_SPIN_CAP (1u << 18)
__device__ __forceinline__ unsigned xb_ld(unsigned* p)              { return __hip_atomic_load(p, __ATOMIC_RELAXED, __HIP_MEMORY_SCOPE_AGENT); }
__device__ __forceinline__ unsigned xb_add(unsigned* p, unsigned v) { return __hip_atomic_fetch_add(p, v, __ATOMIC_RELAXED, __HIP_MEMORY_SCOPE_AGENT); }
__device__ __forceinline__ unsigned xb_xcc_id() { return (unsigned)__builtin_amdgcn_s_getreg((3 << 11) | 20) & 0xFu; }
#define XB_SPIN(cond, bar) do { unsigned _sp = 0; while (cond) { __builtin_amdgcn_s_sleep(1); \
    if ((++_sp & 255u) == 0u) { if (xb_ld(&(bar)[XB_TMO])) break; if (_sp > XB_SPIN_CAP) { atomicAdd(&(bar)[XB_TMO], 1u); break; } } } } while (0)
struct XcdBarrier { unsigned* bar; unsigned x; volatile LAS unsigned* st; };
__device__ __forceinline__ XcdBarrier xcd_barrier_post(unsigned* bar, volatile LAS unsigned* st) {
    XcdBarrier b; b.bar = bar; b.x = xb_xcc_id(); b.st = st;
    if (TID() == 0) (void)xb_add(&bar[XB_XCNT(b.x)], 1u);
    return b;
}
__device__ __forceinline__ void xcd_barrier_complete(unsigned* bar, unsigned x, unsigned& nloc, unsigned& nx) {
    const unsigned G = gridDim.x * gridDim.y * gridDim.z;
    unsigned sum, cnt, mine, sp = 0u;
    for (;;) {
        sum = 0u; cnt = 0u; mine = 0u;
#pragma unroll
        for (unsigned j = 0; j < 16; ++j) { const unsigned c = xb_ld(&bar[XB_XCNT(j)]); sum += c; cnt += (c > 0u) ? 1u : 0u; mine = (j == x) ? c : mine; }
        if (sum == G) break;
        __builtin_amdgcn_s_sleep(1);
        if ((++sp & 255u) == 0u) { if (xb_ld(&bar[XB_TMO])) break; if (sp > XB_SPIN_CAP) { atomicAdd(&bar[XB_TMO], 1u); break; } }
    }
    nloc = mine > 0u ? mine : 1u; nx = cnt > 0u ? cnt : 1u;
}
__device__ __forceinline__ void xcd_barrier(const XcdBarrier& b) {
    asm volatile("s_waitcnt vmcnt(0)" ::: "memory");
    __syncthreads();
    if (TID() == 0) {
        unsigned* bar = b.bar;
        __builtin_amdgcn_s_waitcnt(0);
        unsigned nloc = b.st[0], nx = b.st[1];
        if (nloc == 0u) { xcd_barrier_complete(bar, b.x, nloc, nx); b.st[0] = nloc; b.st[1] = nx; }
        const unsigned old = xb_add(&bar[XB_XSUB(b.x)], 1u);
        const unsigned gen = old / nloc;
        if (old + 1u == (gen + 1u) * nloc) {
            __builtin_amdgcn_fence(__ATOMIC_RELEASE, "agent");
            asm volatile("s_waitcnt vmcnt(0)" ::: "memory");
            const unsigned og = xb_add(&bar[XB_TOP], 1u);
            const unsigned tg = og / nx;
            if (og + 1u == (tg + 1u) * nx) xb_add(&bar[XB_TOPGEN], 1u);
            else XB_SPIN(xb_ld(&bar[XB_TOPGEN]) == tg, bar);
            __builtin_amdgcn_fence(__ATOMIC_ACQUIRE, "agent");
            xb_add(&bar[XB_XGEN(b.x)], 1u);
            asm volatile("s_waitcnt vmcnt(0)" ::: "memory");
        } else {
            XB_SPIN(xb_ld(&bar[XB_XGEN(b.x)]) == gen, bar);
            __builtin_amdgcn_fence(__ATOMIC_ACQUIRE, "agent");
            asm volatile("s_waitcnt vmcnt(0)" ::: "memory");
        }
    }
    __syncthreads();
}

struct TDesc { const float* src; const float* ks; u16* dst; long ldd; int N, coff, rm, tix; };
constexpr int TS_IN = (DM / 256) * (INT / 64), TS_Q = (QL / 256) * (NQ / 64), TS_KV = (KVL / 256) * (NKV / 64), TS_SQ = (DM / 256) * (DM / 64), TS_PLE = (PLE / 256) * (DM / 64);
constexpr int TS_LAYER = TS_IN + TS_Q + TS_KV + 4 * TS_SQ + TS_PLE, TS_TOTAL = DEPTH * TS_LAYER;
__device__ __forceinline__ TDesc tdesc(const Params& p, int g) {
    const int l = g / TS_LAYER; int r = g % TS_LAYER; TDesc d; d.ks = nullptr; d.coff = 0; d.rm = 0;
    if (r < TS_IN) { d.src = p.w_in + (size_t)l * DM * INT; d.N = INT; d.dst = p.Wt_in + (size_t)l * NIN * DM; d.ldd = DM; d.rm = 1; d.ks = p.attn_norm + l * DM; d.tix = r; return d; }
    r -= TS_IN;
    if (r < TS_Q) { d.src = p.w_q_b + (size_t)l * QL * NQ; d.N = NQ; d.dst = p.Wt_q + (size_t)l * NQ * QL; d.ldd = QL; d.rm = 2; d.tix = r; return d; }
    r -= TS_Q;
    if (r < TS_KV) { d.src = p.w_kv_b + (size_t)l * KVL * NKV; d.N = NKV; d.dst = p.Wt_kv + (size_t)l * NKV * KVL; d.ldd = KVL; d.rm = 3; d.tix = r; return d; }
    r -= TS_KV;
    if (r < TS_SQ) { d.src = p.w_o_mla + (size_t)l * DM * DM; d.N = DM; d.dst = p.Wt_o + (size_t)l * DM * 4096; d.ldd = 4096; d.rm = 3; d.tix = r; return d; }
    r -= TS_SQ;
    if (r < TS_SQ) { d.src = p.w_o_lru + (size_t)l * DM * DM; d.N = DM; d.dst = p.Wt_o + (size_t)l * DM * 4096; d.ldd = 4096; d.coff = 2048; d.rm = 3; d.tix = r; return d; }
    r -= TS_SQ;
    if (r < TS_SQ) { d.src = p.w_out + (size_t)l * DM * DM; d.N = DM; d.dst = p.Wt_out + (size_t)l * DM * DM; d.ldd = DM; d.rm = 3; d.tix = r; return d; }
    r -= TS_SQ;
    if (r < TS_SQ) { d.src = p.w_ple_gate + (size_t)l * DM * DM; d.N = DM; d.dst = p.Wt_pg + (size_t)l * DM * DM; d.ldd = DM; d.rm = 3; d.ks = p.ple_norm + l * DM; d.tix = r; return d; }
    r -= TS_SQ;
    d.src = p.w_ple + (size_t)l * PLE * DM; d.N = DM; d.dst = p.Wt_ple + (size_t)l * DM * PLE; d.ldd = PLE; d.rm = 3; d.tix = r; return d;
}
__device__ __forceinline__ int pslot(int r) { const int c = r & 31; return (r & ~31) + 16 * ((c >> 2) & 1) + ((c >> 3) << 2) + (c & 3); }
__device__ __forceinline__ int trowmap(int rm, int n) {
    if (rm == 1) return pslot(n >= 1088 ? n - 1088 : n + ZB);
    if (rm == 2) { const int hh = n / QD, d = n % QD; if (d < NOPE) return pslot(n); const int e = d - NOPE; return pslot(hh * QD + NOPE + ((e & 31) << 1) + (e >> 5)); }
    if (rm == 3) return pslot(n);
    return n;
}
__device__ __forceinline__ void transpose_all(const Params& p, char* lds) {
    u16 (*t)[72] = (u16(*)[72])lds;
    const int tid = TID(), k = tid >> 3, nn = (tid & 7) * 8, G = gridDim.x;
    f32x4 vA[4][2], vB[4][2];
#define TC_LOAD(v_, d_) do { const int tn_ = (d_).N / 64, k0_ = ((d_).tix / tn_) * 256, n0_ = ((d_).tix % tn_) * 64; _Pragma("unroll") for (int j = 0; j < 4; ++j) { \
        const float* p_ = (d_).src + (long)(k0_ + k + 64 * j) * (d_).N + n0_ + nn; v_[j][0] = *(const f32x4*)p_; v_[j][1] = *(const f32x4*)(p_ + 4); \
        if ((d_).ks) { const float g_ = (d_).ks[k0_ + k + 64 * j]; v_[j][0] = v_[j][0] * g_; v_[j][1] = v_[j][1] * g_; } } } while (0)
#define TC_LDSW(v_) do { _Pragma("unroll") for (int j = 0; j < 4; ++j) *(u32x4*)&t[k + 64 * j][nn ^ (((k >> 3) & 7) << 3)] = (u32x4){pk2(v_[j][0][0], v_[j][0][1]), pk2(v_[j][0][2], v_[j][0][3]), pk2(v_[j][1][0], v_[j][1][1]), pk2(v_[j][1][2], v_[j][1][3])}; } while (0)
#define TC_STORE(d_) do { const int tn_ = (d_).N / 64, k0_ = ((d_).tix / tn_) * 256, n0_ = ((d_).tix % tn_) * 64; const int n_ = tid >> 3, kk_ = (tid & 7) * 8; \
        u16* drow_ = (d_).dst + (long)trowmap((d_).rm, n0_ + n_) * (d_).ldd + (d_).coff + k0_ + kk_; \
        _Pragma("unroll") for (int j = 0; j < 4; ++j) { u32x4 o_; _Pragma("unroll") for (int e = 0; e < 4; ++e) o_[e] = (unsigned)t[64 * j + kk_ + 2 * e][n_ ^ kk_] | ((unsigned)t[64 * j + kk_ + 2 * e + 1][n_ ^ kk_] << 16); \
            *(u32x4*)(drow_ + 64 * j) = o_; } } while (0)
    int gA = blockIdx.x, gB = gA + G; TDesc dA, dB, dc;
    if (gA < TS_TOTAL) { dA = tdesc(p, gA); TC_LOAD(vA, dA); }
    if (gB < TS_TOTAL) { dB = tdesc(p, gB); TC_LOAD(vB, dB); }
    while (gA < TS_TOTAL) {
        TC_LDSW(vA); __syncthreads(); dc = dA; gA += 2 * G; if (gA < TS_TOTAL) { dA = tdesc(p, gA); TC_LOAD(vA, dA); } TC_STORE(dc); __syncthreads();
        if (gB >= TS_TOTAL) break;
        TC_LDSW(vB); __syncthreads(); dc = dB; gB += 2 * G; if (gB < TS_TOTAL) { dB = tdesc(p, gB); TC_LOAD(vB, dB); } TC_STORE(dc); __syncthreads();
    }
#undef TC_LOAD
#undef TC_LDSW
#undef TC_STORE
}

__device__ __forceinline__ void phase_prologue(const Params& p, char* lds) {
    const long gtid = (long)blockIdx.x * NTHR + TID(), gsz = (long)gridDim.x * NTHR;
    transpose_all(p, lds);
    for (long i = gtid; i < (long)DEPTH * (NIN - INT) * DM / 8; i += gsz) { const long per = (long)(NIN - INT) * DM / 8; const int l = (int)(i / per); const long r = i % per;
        *(u32x4*)(p.Wt_in + ((size_t)l * NIN + INT) * DM + r * 8) = (u32x4){0u, 0u, 0u, 0u}; }
    for (long i = gtid; i < (long)DEPTH * LRUB * 256 * 256; i += gsz) {
        const int k = (int)(i & 255), o = (int)((i >> 8) & 255), blk = (int)((i >> 16) & 15), l = (int)(i >> 20);
        const int kk = k - 128 * (blk & 1), cl = o >> 1; float v = 0.f;
        if (kk >= 0 && kk < 128) v = ((o & 1) ? p.w_ig : p.w_rg)[(((size_t)l * LRUB + blk) * LBD + kk) * LBD + cl];
        p.Wt_lru[(((long)l * LRUB + blk) * 256 + pslot(o)) * 256 + k] = f2bf(v); }
    for (long i = gtid; i < (long)DEPTH * S * PLE / 8; i += gsz) { const float* s = p.p_in + i * 8; const f32x4 v0 = *(const f32x4*)s, v1 = *(const f32x4*)(s + 4);
        *(u32x4*)(p.pb + i * 8) = (u32x4){pk2(v0[0], v0[1]), pk2(v0[2], v0[3]), pk2(v1[0], v1[1]), pk2(v1[2], v1[3])}; }
    for (long i = gtid; i < (long)DEPTH * DM; i += gsz) p.nsp8[i] = -8.f * log1pf(expf(-p.lam[i]));
    for (long i = gtid; i < (long)S * 32; i += gsz) { const int s = (int)(i >> 5), f = (int)(i & 31);
        const float inv = powf(10000.f, -(float)(2 * f) / 64.f), ang = (float)p.pos[s] * inv;
        p.cs[(long)s * 64 + f] = (float)cos((double)ang); p.cs[(long)s * 64 + 32 + f] = (float)sin((double)ang); }
}

__device__ __forceinline__ void phase_xb_ssq(const float* __restrict__ x, u16* __restrict__ out, float* __restrict__ ssq) {
    const int tid = TID(), lane = tid & 63, gw = blockIdx.x * (NTHR / 64) + (tid >> 6), nw = gridDim.x * (NTHR / 64);
    for (int row = gw; row < S; row += nw) {
        const float* p = x + (long)row * DM; f32x4 v[8]; float s = 0.f;
#pragma unroll
        for (int j = 0; j < 8; ++j) { v[j] = *(const f32x4*)(p + j * 256 + lane * 4); s += v[j][0] * v[j][0] + v[j][1] * v[j][1] + v[j][2] * v[j][2] + v[j][3] * v[j][3]; }
        s = wsum(s, lane);
#pragma unroll
        for (int j = 0; j < 8; ++j) *(u32x2*)(out + (long)row * DM + j * 256 + lane * 4) = (u32x2){pk2(v[j][0], v[j][1]), pk2(v[j][2], v[j][3])};
        if (lane == 0) ssq[row] = s;
    }
}
__device__ __forceinline__ void phase_final_norm(float* __restrict__ x, const float* __restrict__ g) {
    const int tid = TID(), lane = tid & 63, gw = blockIdx.x * (NTHR / 64) + (tid >> 6), nw = gridDim.x * (NTHR / 64);
    for (int row = gw; row < S; row += nw) {
        float* p = x + (long)row * DM; f32x4 v[8]; float s = 0.f;
#pragma unroll
        for (int j = 0; j < 8; ++j) { v[j] = *(const f32x4*)(p + j * 256 + lane * 4); s += v[j][0] * v[j][0] + v[j][1] * v[j][1] + v[j][2] * v[j][2] + v[j][3] * v[j][3]; }
        s = wsum(s, lane); const float rinv = rsqrtf(s * (1.f / DM) + 1e-6f);
#pragma unroll
        for (int j = 0; j < 8; ++j) { const f32x4 gg = *(const f32x4*)(g + j * 256 + lane * 4); *(f32x4*)(p + j * 256 + lane * 4) = v[j] * rinv * gg; }
    }
}
__device__ __forceinline__ void t2_rows(const float* __restrict__ zA, const u16* __restrict__ zB, const float* __restrict__ cs, const float* __restrict__ cw, const float* __restrict__ cb,
                                        const float* __restrict__ gq, const float* __restrict__ gkv, u16* __restrict__ qn, u16* __restrict__ kvn, u16* __restrict__ Kf, u16* __restrict__ xc, float* __restrict__ ssqB) {
    const int tid = TID(), lane = tid & 63, gw = blockIdx.x * (NTHR / 64) + (tid >> 6), nw = gridDim.x * (NTHR / 64);
    for (int row = gw; row < S; row += nw) {
        const float* zr = zA + (long)row * ZA;
        f32x4 v[2][2];
#pragma unroll
        for (int part = 0; part < 2; ++part) { v[part][0] = *(const f32x4*)(zr + part * 512 + lane * 4); v[part][1] = *(const f32x4*)(zr + part * 512 + 256 + lane * 4); }
        const int l32 = lane & 31;
        const float x1 = zr[1024 + l32], x2 = zr[1056 + l32], cc = cs[(long)row * 64 + l32], sn = cs[(long)row * 64 + 32 + l32];
        u32x2 uu[8][4];
#pragma unroll
        for (int j = 0; j < 8; ++j)
#pragma unroll
            for (int k = 0; k < 4; ++k) { const int sp = row - 3 + k; uu[j][k] = (u32x2){0u, 0u}; if (sp >= 0) uu[j][k] = *(const u32x2*)(zB + (long)sp * ZB + 2048 + j * 256 + lane * 4); }
        if (lane == 0) ssqB[row] = 0.f;
#pragma unroll
        for (int part = 0; part < 2; ++part) {
            const float* g = part ? gkv : gq; u16* dst = (part ? kvn : qn) + (long)row * 512;
            const f32x4 v0 = v[part][0], v1 = v[part][1];
            float s = v0[0] * v0[0] + v0[1] * v0[1] + v0[2] * v0[2] + v0[3] * v0[3] + v1[0] * v1[0] + v1[1] * v1[1] + v1[2] * v1[2] + v1[3] * v1[3];
            s = wsum(s, lane); const float rinv = rsqrtf(s * (1.f / 512.f) + 1e-6f);
            const f32x4 g0 = *(const f32x4*)(g + lane * 4), g1 = *(const f32x4*)(g + 256 + lane * 4);
            *(u32x2*)(dst + lane * 4) = (u32x2){pk2(v0[0] * rinv * g0[0], v0[1] * rinv * g0[1]), pk2(v0[2] * rinv * g0[2], v0[3] * rinv * g0[3])};
            *(u32x2*)(dst + 256 + lane * 4) = (u32x2){pk2(v1[0] * rinv * g1[0], v1[1] * rinv * g1[1]), pk2(v1[2] * rinv * g1[2], v1[3] * rinv * g1[3])};
        }
        if (lane < 32) { const unsigned w = pk2(x1 * cc - x2 * sn, x2 * cc + x1 * sn);
#pragma unroll
            for (int hh = 0; hh < NH; ++hh) *(unsigned*)(Kf + ((long)hh * S + row) * QD + NOPE + 2 * lane) = w; }
#pragma unroll
        for (int j = 0; j < 8; ++j) { const int c = j * 256 + lane * 4; f32x4 y = *(const f32x4*)(cb + c);
#pragma unroll
            for (int k = 0; k < 4; ++k) { const f32x4 w = *(const f32x4*)(cw + k * DM + c); const u32x2 u2 = uu[j][k];
                y[0] += __uint_as_float(u2[0] << 16) * w[0]; y[1] += __uint_as_float(u2[0] & 0xffff0000u) * w[1]; y[2] += __uint_as_float(u2[1] << 16) * w[2]; y[3] += __uint_as_float(u2[1] & 0xffff0000u) * w[3]; }
            *(u32x2*)(xc + (long)row * DM + c) = (u32x2){pk2(y[0], y[1]), pk2(y[2], y[3])}; }
    }
}
__device__ __forceinline__ void phase_t2(const Params& p, int l) {
    t2_rows(p.zA, p.zB, p.cs, p.conv_w + (size_t)l * 4 * DM, p.conv_b + (size_t)l * DM, p.q_a_norm + l * 512, p.kv_a_norm + l * 512, p.qn, p.kvn, p.Kf, p.xc, p.ssqB);
}
__device__ __forceinline__ void phase_scan1(const Params& p) {
    float* Pc = p.carry; float* Hc = p.carry + 128 * DM;
    for (long i = (long)blockIdx.x * NTHR + TID(); i < 128L * DM; i += (long)gridDim.x * NTHR) {
        const int c = (int)(i % DM), ch = (int)(i / DM); float P = 1.f, H = 0.f;
        const float* pa = p.la + (long)ch * 64 * DM + c; const float* pb = p.lb + (long)ch * 64 * DM + c;
#pragma unroll 1
        for (int t0 = 0; t0 < 64; t0 += 16) { float a[16], b[16];
#pragma unroll
            for (int t = 0; t < 16; ++t) { a[t] = pa[(long)(t0 + t) * DM]; b[t] = pb[(long)(t0 + t) * DM]; }
#pragma unroll
            for (int t = 0; t < 16; ++t) { H = a[t] * H + b[t]; P *= a[t]; } }
        Pc[i] = P; Hc[i] = H; }
}
__device__ __forceinline__ void scan3_rows(const float* __restrict__ Pc, const float* __restrict__ Hc, const float* __restrict__ la, const float* __restrict__ lb, const u16* __restrict__ zB,
                                           u16* __restrict__ OH, float* __restrict__ ssqA) {
    for (long i = (long)blockIdx.x * NTHR + TID(); i < 128L * DM; i += (long)gridDim.x * NTHR) {
        if (i < S) ssqA[i] = 0.f;
        const int c = (int)(i % DM), ch = (int)(i / DM); float H = 0.f;
        int k = 0;
#pragma unroll 1
        for (; k + 16 <= ch; k += 16) { float a[16], b[16];
#pragma unroll
            for (int t = 0; t < 16; ++t) { a[t] = Pc[(long)(k + t) * DM + c]; b[t] = Hc[(long)(k + t) * DM + c]; }
#pragma unroll
            for (int t = 0; t < 16; ++t) H = a[t] * H + b[t]; }
        for (; k < ch; ++k) H = Pc[(long)k * DM + c] * H + Hc[(long)k * DM + c];
        const float* pa = la + (long)ch * 64 * DM + c; const float* pb = lb + (long)ch * 64 * DM + c;
        const u16* pg = zB + (long)ch * 64 * ZB + 4096 + c; u16* po = OH + (long)ch * 64 * 4096 + 2048 + c;
#pragma unroll
        for (int t0 = 0; t0 < 64; t0 += 16) { float a[16], b[16]; u16 g[16];
#pragma unroll
            for (int t = 0; t < 16; ++t) { a[t] = pa[(long)(t0 + t) * DM]; b[t] = pb[(long)(t0 + t) * DM]; g[t] = pg[(long)(t0 + t) * ZB]; }
#pragma unroll
            for (int t = 0; t < 16; ++t) { H = a[t] * H + b[t]; po[(long)(t0 + t) * 4096] = f2bf(H * bf2f(g[t])); } } }
}
__device__ __forceinline__ void phase_scan3(const Params& p) { scan3_rows(p.carry, p.carry + 128 * DM, p.la, p.lb, p.zB, p.OH, p.ssqA); }

typedef float f32x16 __attribute__((ext_vector_type(16)));
typedef short s16x4 __attribute__((ext_vector_type(4)));
constexpr int SHM_V = 64 * 128 * 2, SHM_K = 64 * 192 * 2, ATT_WS = 2 * SHM_V + 2 * SHM_K;
#define KSWZ(row, colB) ((row) * 384 + ((colB) ^ (((row) & 7) << 4)))
__device__ __forceinline__ int v_st(int k, int c) { const int kk = (k & ~0xC) | ((k & 4) << 1) | ((k & 8) >> 1); return ((kk >> 3) * 4 + (c >> 5)) * 512 + ((kk & 7) * 32 + (c & 31)) * 2; }
__device__ __forceinline__ int v_rd_base(int lane) { return ((lane & 3) << 3) | (((lane >> 2) & 3) << 6) | (((lane >> 4) & 1) << 5) | (((lane >> 5) & 1) << 8); }
constexpr int v_rd_off(int d0, int ks, int half) { return d0 * 512 + ks * 4096 + half * 2048; }
__device__ __forceinline__ int crow(int r, int hi) { return (r & 3) + 8 * (r >> 2) + 4 * hi; }
__device__ __forceinline__ unsigned cvtpk(float lo, float hi) { unsigned r; asm volatile("v_cvt_pk_bf16_f32 %0, %1, %2" : "=v"(r) : "v"(lo), "v"(hi)); return r; }

__device__ __forceinline__ void partialSM(f32x16& p0, f32x16& p1, float& m_reg, float& mn, float& alpha) {
    float pmax = p0[0];
#pragma unroll
    for (int r = 1; r < 16; ++r) pmax = fmaxf(pmax, p0[r]);
#pragma unroll
    for (int r = 0; r < 16; ++r) pmax = fmaxf(pmax, p1[r]);
    { auto rr = __builtin_amdgcn_permlane32_swap(__float_as_uint(pmax), __float_as_uint(pmax), false, false);
      pmax = fmaxf(__uint_as_float(rr[0]), __uint_as_float(rr[1])); }
    if (__builtin_expect(__all(pmax - m_reg <= 11.5f), 1)) { mn = m_reg; alpha = 1.f; }
    else { mn = fmaxf(m_reg, pmax); alpha = __builtin_amdgcn_exp2f(m_reg - mn); m_reg = mn; }
#pragma unroll
    for (int r = 0; r < 16; ++r) p0[r] = p0[r] - mn;
#pragma unroll
    for (int r = 0; r < 16; ++r) p1[r] = p1[r] - mn;
#pragma unroll
    for (int r = 0; r < 16; ++r) p0[r] = __builtin_amdgcn_exp2f(p0[r]);
}
__device__ __forceinline__ void finishSM(f32x16& p0, f32x16& p1, float alpha, float& l_reg, bf16x8& pa0, bf16x8& pa1, bf16x8& pa2, bf16x8& pa3) {
#pragma unroll
    for (int r = 0; r < 16; ++r) p1[r] = __builtin_amdgcn_exp2f(p1[r]);
    float ps = 0;
#pragma unroll
    for (int r = 0; r < 16; ++r) ps += p0[r];
#pragma unroll
    for (int r = 0; r < 16; ++r) ps += p1[r];
    { auto rr = __builtin_amdgcn_permlane32_swap(__float_as_uint(ps), __float_as_uint(ps), false, false);
      ps = __uint_as_float(rr[0]) + __uint_as_float(rr[1]); }
    l_reg = l_reg * alpha + ps;
#define PK4(P, B_, OUT) do { unsigned a0 = cvtpk(P[B_+0], P[B_+1]), a1 = cvtpk(P[B_+2], P[B_+3]);                          \
        unsigned b0 = cvtpk(P[B_+4], P[B_+5]), b1 = cvtpk(P[B_+6], P[B_+7]);                                             \
        auto r0 = __builtin_amdgcn_permlane32_swap(a0, b0, false, false); auto r1 = __builtin_amdgcn_permlane32_swap(a1, b1, false, false); \
        u32x4 w = {r0[0], r1[0], r0[1], r1[1]}; OUT = *reinterpret_cast<bf16x8*>(&w); } while (0)
    PK4(p0, 0, pa0); PK4(p0, 8, pa1); PK4(p1, 0, pa2); PK4(p1, 8, pa3);
#undef PK4
}
template <int KB>
__device__ __forceinline__ void qkt(f32x16& p0, f32x16& p1, LAS char* K_lds, int r32, int hi, const bf16x8* qr, bool act) {
    if (!act) { const float NEG = -__builtin_inff();
#pragma unroll
        for (int r = 0; r < 16; ++r) { p0[r] = NEG; p1[r] = NEG; } return; }
#pragma unroll
    for (int r = 0; r < 16; ++r) { p0[r] = 0.f; p1[r] = 0.f; }
    LAS char* kb[4];
#pragma unroll
    for (int dd = 0; dd < 4; ++dd) kb[dd] = K_lds + KB * SHM_K + KSWZ(r32, (dd * 16 + hi * 8) * 2);
#pragma unroll
    for (int d0 = 0; d0 < 12; ++d0) { LAS char* a = kb[d0 & 3] + (d0 >> 2) * 128;
        const bf16x8 b0 = *(const LAS bf16x8*)a;
        const bf16x8 b1 = *(const LAS bf16x8*)(a + 32 * 384);
        p0 = __builtin_amdgcn_mfma_f32_32x32x16_bf16(b0, qr[d0], p0, 0, 0, 0);
        p1 = __builtin_amdgcn_mfma_f32_32x32x16_bf16(b1, qr[d0], p1, 0, 0, 0); }
}
template <int VB>
__device__ __forceinline__ void pv_tile(f32x16* o, int vb0, bf16x8 pa0, bf16x8 pa1, bf16x8 pa2, bf16x8 pa3, bool act) {
    if (!act) return;
#define TRRD(dst, off) asm volatile("ds_read_b64_tr_b16 %0, %1 offset:%2" : "=&v"(dst) : "v"(vb0), "i"(off) : "memory")
#define PV_D0(d0) do { s16x4 l0, l1, l2, l3, h0, h1, h2, h3; constexpr int b_ = VB * SHM_V + v_rd_off(d0, 0, 0); \
        TRRD(l0, b_); TRRD(h0, b_ + 2048); TRRD(l1, b_ + 4096); TRRD(h1, b_ + 6144); TRRD(l2, b_ + 8192); TRRD(h2, b_ + 10240); TRRD(l3, b_ + 12288); TRRD(h3, b_ + 14336); \
        asm volatile("s_waitcnt lgkmcnt(0)" ::: "memory"); __builtin_amdgcn_sched_barrier(0); \
        o[d0] = __builtin_amdgcn_mfma_f32_32x32x16_bf16(pa0, (bf16x8){l0[0], l0[1], l0[2], l0[3], h0[0], h0[1], h0[2], h0[3]}, o[d0], 0, 0, 0);   \
        o[d0] = __builtin_amdgcn_mfma_f32_32x32x16_bf16(pa1, (bf16x8){l1[0], l1[1], l1[2], l1[3], h1[0], h1[1], h1[2], h1[3]}, o[d0], 0, 0, 0);   \
        o[d0] = __builtin_amdgcn_mfma_f32_32x32x16_bf16(pa2, (bf16x8){l2[0], l2[1], l2[2], l2[3], h2[0], h2[1], h2[2], h2[3]}, o[d0], 0, 0, 0);   \
        o[d0] = __builtin_amdgcn_mfma_f32_32x32x16_bf16(pa3, (bf16x8){l3[0], l3[1], l3[2], l3[3], h3[0], h3[1], h3[2], h3[3]}, o[d0], 0, 0, 0); } while (0)
    PV_D0(0); PV_D0(1); PV_D0(2); PV_D0(3);
#undef PV_D0
#undef TRRD
}

__device__ __forceinline__ void attn_block(char* lds, const u16* __restrict__ Qb, const u16* __restrict__ Kh, const u16* __restrict__ Vh,
                                           const u16* __restrict__ sg, u16* __restrict__ Ob, int P0) {
    const int tid = TID(), wid = __builtin_amdgcn_readfirstlane(tid >> 6), lane = tid & 63, r32 = lane & 31, hi = lane >> 5;
    const int NT = (P0 >> 6) + 4;
    const int wchunk = (P0 >> 6) + (wid >> 1);
    LAS char* L = (LAS char*)lds; LAS char* V_lds = L; LAS char* K_lds = L + 2 * SHM_V;
    LAS float* wsf = (LAS float*)(L + ATT_WS) + wid * 64; LAS float* li_l = wsf; LAS float* al_l = wsf + 32;
    float m_reg = -1e30f, l_reg = 0.f; f32x16 o[4];
#pragma unroll
    for (int d = 0; d < 4; ++d)
#pragma unroll
        for (int r = 0; r < 16; ++r) o[d][r] = 0.f;
    const int sr = tid >> 4, sc = (tid & 15) * 8, vst0 = v_st(sr, sc), vst1 = v_st(32 + sr, sc);
    const int kc0 = tid, kc1 = tid + 512, kc2 = tid + 1024;
    const int kws0 = KSWZ(kc0 / 24, (kc0 % 24) * 16), kws1 = KSWZ(kc1 / 24, (kc1 % 24) * 16), kws2 = KSWZ(kc2 / 24, (kc2 % 24) * 16);
    const int vb0 = (int)(unsigned)(uintptr_t)V_lds + v_rd_base(lane);
    bf16x8 qr[12];
#pragma unroll
    for (int d0 = 0; d0 < 12; ++d0) qr[d0] = *(const bf16x8*)(Qb + (long)(wid * 32 + r32) * NQ + d0 * 16 + hi * 8);
    bf16x8 st_k0, st_k1, st_k2, st_v0, st_v1;
#define VMW() asm volatile("s_waitcnt vmcnt(0)" ::: "memory")
#define SBAR() __builtin_amdgcn_sched_barrier(0)
#define SLOAD(t) do { const u16* kp_ = Kh + (long)(t) * 64 * QD + tid * 8; st_k0 = *(const bf16x8*)kp_; st_k1 = *(const bf16x8*)(kp_ + 4096); st_k2 = *(const bf16x8*)(kp_ + 8192); \
                      const u16* vp_ = Vh + ((long)(t) * 64 + sr) * VH + sc; st_v0 = *(const bf16x8*)vp_; st_v1 = *(const bf16x8*)(vp_ + 32 * VH); } while (0)
#define SWRITE(bf) do { *(LAS bf16x8*)(K_lds + (bf) * SHM_K + kws0) = st_k0; *(LAS bf16x8*)(K_lds + (bf) * SHM_K + kws1) = st_k1; *(LAS bf16x8*)(K_lds + (bf) * SHM_K + kws2) = st_k2; \
                        *(LAS bf16x8*)(V_lds + (bf) * SHM_V + vst0) = st_v0; *(LAS bf16x8*)(V_lds + (bf) * SHM_V + vst1) = st_v1; } while (0)
#define RESC(a) do { if (__any((a) < 1.f)) { if (hi == 0) al_l[r32] = (a); asm volatile("s_waitcnt lgkmcnt(0)" ::: "memory");              \
                     _Pragma("unroll") for (int d_ = 0; d_ < 4; ++d_) _Pragma("unroll") for (int r = 0; r < 16; ++r) o[d_][r] *= al_l[crow(r, hi)]; } } while (0)
#define ACT(t) ((t) <= wchunk)
    f32x16 pA0, pA1, pB0, pB1; float mnA, mnB, alA, alB; bf16x8 pa0, pa1, pa2, pa3;
    SLOAD(0); VMW(); SWRITE(0); SBAR();
    SLOAD(1);
    __syncthreads();
    SBAR(); qkt<0>(pA0, pA1, K_lds, r32, hi, qr, ACT(0));
    partialSM(pA0, pA1, m_reg, mnA, alA);
    VMW(); SWRITE(1);
    __syncthreads();
#define HALF_STEP(PX0, PX1, mnX, alX, PY0, PY1, alY, t, KB, VB, SB) do {                                                      \
        SBAR(); qkt<KB>(PX0, PX1, K_lds, r32, hi, qr, ACT(t));                                                                \
        finishSM(PY0, PY1, alY, l_reg, pa0, pa1, pa2, pa3); SBAR();                                                           \
        if ((t) + 1 < NT) { SLOAD((t) + 1); SBAR(); }                                                                          \
        pv_tile<VB>(o, vb0, pa0, pa1, pa2, pa3, ACT((t) - 1)); partialSM(PX0, PX1, m_reg, mnX, alX);                          \
        __syncthreads();                                                                                                      \
        if ((t) + 1 < NT) { VMW(); SWRITE(SB); }                                                                               \
        RESC(alX); __syncthreads(); } while (0)
    for (int t = 1; t + 1 < NT; t += 2) {
        HALF_STEP(pB0, pB1, mnB, alB, pA0, pA1, alA, t, 1, 0, 0);
        HALF_STEP(pA0, pA1, mnA, alA, pB0, pB1, alB, t + 1, 0, 1, 1);
    }
    SBAR(); qkt<1>(pB0, pB1, K_lds, r32, hi, qr, ACT(NT - 1)); SBAR();
    finishSM(pA0, pA1, alA, l_reg, pa0, pa1, pa2, pa3); SBAR();
    pv_tile<0>(o, vb0, pa0, pa1, pa2, pa3, ACT(NT - 2));
    partialSM(pB0, pB1, m_reg, mnB, alB); __syncthreads(); RESC(alB);
    finishSM(pB0, pB1, alB, l_reg, pa0, pa1, pa2, pa3); SBAR(); pv_tile<1>(o, vb0, pa0, pa1, pa2, pa3, ACT(NT - 1));
    SBAR();
    if (hi == 0) li_l[r32] = l_reg; asm volatile("s_waitcnt lgkmcnt(0)" ::: "memory");
    float rli[16];
#pragma unroll
    for (int r = 0; r < 16; ++r) rli[r] = __builtin_amdgcn_rcpf(li_l[crow(r, hi)]);
    const int jq = r32 & 3, colb = jq * 32 + (r32 & ~3);
    const bool b0 = (jq & 1) != 0, b1 = (jq & 2) != 0;
    u32x2 gg[16];
#pragma unroll
    for (int r = 0; r < 16; ++r) gg[r] = *(const u32x2*)(sg + (long)(wid * 32 + crow(r, hi)) * ZB + colb);
#define QSWAP1(v_) __int_as_float(__builtin_amdgcn_mov_dpp(__float_as_int(v_), 0xB1, 0xF, 0xF, true))
#define QSWAP2(v_) __int_as_float(__builtin_amdgcn_mov_dpp(__float_as_int(v_), 0x4E, 0xF, 0xF, true))
#pragma unroll
    for (int r = 0; r < 16; ++r) { const int orow = wid * 32 + crow(r, hi);
        float x0 = o[0][r] * rli[r], x1 = o[1][r] * rli[r], x2 = o[2][r] * rli[r], x3 = o[3][r] * rli[r];
        { const float r01 = QSWAP1(b0 ? x0 : x1), r23 = QSWAP1(b0 ? x2 : x3);
          const float n0 = b0 ? r01 : x0, n1 = b0 ? x1 : r01, n2 = b0 ? r23 : x2, n3 = b0 ? x3 : r23; x0 = n0; x1 = n1; x2 = n2; x3 = n3; }
        { const float r02 = QSWAP2(b1 ? x0 : x2), r13 = QSWAP2(b1 ? x1 : x3);
          const float n0 = b1 ? r02 : x0, n2 = b1 ? x2 : r02, n1 = b1 ? r13 : x1, n3 = b1 ? x3 : r13; x0 = n0; x1 = n1; x2 = n2; x3 = n3; }
        const u32x2 g = gg[r];
        *(u32x2*)(Ob + (long)orow * 4096 + colb) = (u32x2){cvtpk(x0 * __uint_as_float(g[0] << 16), x1 * __uint_as_float(g[0] & 0xffff0000u)), cvtpk(x2 * __uint_as_float(g[1] << 16), x3 * __uint_as_float(g[1] & 0xffff0000u))}; }
#undef QSWAP1
#undef QSWAP2
    __syncthreads();
#undef VMW
#undef SBAR
#undef SLOAD
#undef SWRITE
#undef RESC
#undef ACT
#undef HALF_STEP
}
__device__ __forceinline__ void phase_attention(const Params& p, char* lds) {
    for (int it = blockIdx.x; it < 256; it += gridDim.x) {
        const int xcd = it & 7, idx = it >> 3, hh = xcd * 2 + (idx >> 4), x = idx & 15;
        for (int half = 0; half < 2; ++half) { const int P0 = (half ? x : 31 - x) * 256;
            attn_block(lds, p.Q + (long)P0 * NQ + hh * QD, p.Kf + (long)hh * S * QD, p.Vf + (long)hh * S * VH, p.zB + (long)P0 * ZB + hh * VH, p.OH + (long)P0 * 4096 + hh * VH, P0); }
    }
}

#ifndef PROBE_MASK
#define PROBE_MASK 0
#endif
#if PROBE_MASK
#define TICK(cls) do { const unsigned long long now_ = __builtin_amdgcn_s_memrealtime(); if ((PROBE_MASK >> (cls)) & 1) t_acc += now_ - t_last; t_last = now_; } while (0)
#else
#define TICK(cls) do { } while (0)
#endif
__global__ __launch_bounds__(NTHR, 2) void mega(Params p) {
    extern __shared__ __attribute__((aligned(16))) char lds[];
    cg::grid_group grid = cg::this_grid();
    const int G = gridDim.x;
    volatile LAS unsigned* xbst = (volatile LAS unsigned*)((LAS char*)lds + 8 * HTB);
    if (TID() == 0) { xbst[0] = 0u; xbst[1] = 0u; xbst[2] = 0u; xbst[3] = 0u; }
    __syncthreads();
    if (blockIdx.x == 0) for (int i = TID(); i < XCD_BAR_WORDS; i += NTHR) p.bar[i] = 0u;
#if PROBE_MASK
    unsigned long long t_acc = 0, t_last = __builtin_amdgcn_s_memrealtime();
#endif
    phase_prologue(p, lds);
    phase_xb_ssq(p.x_in, p.hb, p.ssqA);
    grid.sync();
    const XcdBarrier xb = xcd_barrier_post(p.bar, xbst);
    TICK(0);
    for (int l = 0; l < DEPTH; ++l) {
        const int c = (int)blockIdx.x + opaque_zero();
        const float* xcur = l ? p.xr : p.x_in;
        { TileSched sc{p.hb, DM, p.Wt_in + (size_t)l * NIN * DM, DM, 32, NIN / 256, G, c}; EpiIn e{p.zB, p.zA, p.ssqA}; gemm_fast(lds, DM, DM, DM, sc, e); }
        xcd_barrier(xb); TICK(2);
        phase_t2(p, l);
        xcd_barrier(xb); TICK(3);
        { TileSched sc{p.qn, QL, p.Wt_q + (size_t)l * NQ * QL, QL, 32, NQ / 256, G, c}; EpiQ e{p.Q, p.cs}; gemm_fast(lds, QL, QL, QL, sc, e); }
        { TileSched sc{p.kvn, KVL, p.Wt_kv + (size_t)l * NKV * KVL, KVL, 32, NKV / 256, G, (c + 128) % G}; EpiKV e{p.Kf, p.Vf}; gemm_fast(lds, KVL, KVL, KVL, sc, e); }
        { LruSched sc{{p.xc, DM, p.Wt_lru + (size_t)l * LRUB * 65536, 256, 32, LRUB, G, c}}; EpiLru e{p.xc, p.b_rg + l * DM, p.b_ig + l * DM, p.nsp8 + l * DM, p.la, p.lb}; gemm_fast(lds, 256, DM, 256, sc, e); }
        xcd_barrier(xb); TICK(4);
        phase_scan1(p);
        phase_attention(p, lds);
        xcd_barrier(xb); TICK(5);
        phase_scan3(p);
        xcd_barrier(xb); TICK(6);
        { MergeSched sc{{p.OH, 4096, p.Wt_o + (size_t)l * DM * 4096, 4096, 32, 8, G, c}}; EpiMerge e{p.zB, p.mg}; gemm_fast(lds, DM, 4096, 4096, sc, e); }
        xcd_barrier(xb); TICK(7);
        { TileSched sc{p.mg, DM, p.Wt_out + (size_t)l * DM * DM, DM, 32, 8, G, c}; EpiOut e{xcur, p.xr, p.hb2, p.ssqB}; gemm_fast(lds, DM, DM, DM, sc, e); }
        { TileSched sc{p.pb + (size_t)l * S * PLE, PLE, p.Wt_ple + (size_t)l * DM * PLE, PLE, 32, 8, G, c}; EpiF32 e{p.pp, DM}; gemm_fast(lds, PLE, PLE, PLE, sc, e); }
        xcd_barrier(xb); TICK(8);
        { TileSched sc{p.hb2, DM, p.Wt_pg + (size_t)l * DM * DM, DM, 32, 8, G, c}; EpiPle e{p.xr, p.pp, p.ssqB, p.hb, p.ssqA}; gemm_fast(lds, DM, DM, DM, sc, e); }
        xcd_barrier(xb); TICK(9);
    }
    phase_final_norm(p.xr, p.final_norm);
#if PROBE_MASK
    __syncthreads();
    if (blockIdx.x == 0) { const float d = sqrtf((float)t_acc * 0.01f * 4.096e-8f);
        for (int j = 0; j < 8; ++j) p.xr[threadIdx.x * 8 + j] += d; }
#endif
}

constexpr size_t LDS_BYTES = 8 * HTB + 16;

extern "C" void kernel_launch(void* const* d_in, const int* in_sizes, int n_in, void* d_out, int out_size, void* d_ws, size_t ws_size, hipStream_t st) {
    Params p{};
    p.x_in = (const float*)d_in[0]; p.p_in = (const float*)d_in[1]; p.pos = (const int*)d_in[2];
    p.attn_norm = (const float*)d_in[3]; p.w_in = (const float*)d_in[4]; p.q_a_norm = (const float*)d_in[5]; p.w_q_b = (const float*)d_in[6];
    p.kv_a_norm = (const float*)d_in[7]; p.w_kv_b = (const float*)d_in[8]; p.conv_w = (const float*)d_in[9]; p.conv_b = (const float*)d_in[10];
    p.w_rg = (const float*)d_in[11]; p.b_rg = (const float*)d_in[12]; p.w_ig = (const float*)d_in[13]; p.b_ig = (const float*)d_in[14]; p.lam = (const float*)d_in[15];
    p.w_o_mla = (const float*)d_in[16]; p.w_o_lru = (const float*)d_in[17]; p.w_out = (const float*)d_in[18]; p.ple_norm = (const float*)d_in[19];
    p.w_ple_gate = (const float*)d_in[20]; p.w_ple = (const float*)d_in[21]; p.final_norm = (const float*)d_in[22];
    p.xr = (float*)d_out;
    char* w = (char*)d_ws; size_t off = 0;
    auto take = [&](size_t bytes) { char* r = w + off; off += (bytes + 255) & ~(size_t)255; return r; };
    p.Wt_in = (u16*)take((size_t)DEPTH * NIN * DM * 2); p.Wt_q = (u16*)take((size_t)DEPTH * NQ * QL * 2); p.Wt_kv = (u16*)take((size_t)DEPTH * NKV * KVL * 2);
    p.Wt_lru = (u16*)take((size_t)DEPTH * LRUB * 65536 * 2); p.Wt_o = (u16*)take((size_t)DEPTH * DM * 4096 * 2); p.Wt_out = (u16*)take((size_t)DEPTH * DM * DM * 2);
    p.Wt_pg = (u16*)take((size_t)DEPTH * DM * DM * 2); p.Wt_ple = (u16*)take((size_t)DEPTH * DM * PLE * 2);
    p.hb = (u16*)take((size_t)S * DM * 2); p.hb2 = (u16*)take((size_t)S * DM * 2); p.ssqA = (float*)take((size_t)S * 4); p.ssqB = (float*)take((size_t)S * 4); p.zB = (u16*)take((size_t)S * ZB * 2); p.zA = (float*)take((size_t)S * ZA * 4);
    p.qn = (u16*)take((size_t)S * QL * 2); p.kvn = (u16*)take((size_t)S * KVL * 2); p.Q = (u16*)take((size_t)S * NQ * 2);
    p.Kf = (u16*)take((size_t)NH * S * QD * 2); p.Vf = (u16*)take((size_t)NH * S * VH * 2); p.xc = (u16*)take((size_t)S * DM * 2);
    p.OH = (u16*)take((size_t)S * 4096 * 2); p.pb = (u16*)take((size_t)DEPTH * S * PLE * 2); p.cs = (float*)take((size_t)S * 64 * 4); p.carry = (float*)take((size_t)3 * 128 * DM * 4); p.nsp8 = (float*)take((size_t)DEPTH * DM * 4); p.bar = (unsigned*)take((size_t)XCD_BAR_WORDS * 4);
    p.la = (float*)take((size_t)S * DM * 4); p.lb = (float*)take((size_t)S * DM * 4); p.pp = (float*)take((size_t)S * DM * 4); p.mg = (u16*)take((size_t)S * DM * 2);
    if (off > ws_size) { fprintf(stderr, "workspace too small: need %zu have %zu\n", off, ws_size); return; }
    (void)hipFuncSetAttribute((const void*)mega, hipFuncAttributeMaxDynamicSharedMemorySize, (int)LDS_BYTES);
    int dev = 0, cus = 0; (void)hipGetDevice(&dev); (void)hipDeviceGetAttribute(&cus, hipDeviceAttributeMultiprocessorCount, dev);
    int per_cu = 0; (void)hipOccupancyMaxActiveBlocksPerMultiprocessor(&per_cu, mega, NTHR, LDS_BYTES);
    if (per_cu < 1 || cus < 1) { fprintf(stderr, "occupancy query failed\n"); return; }
    void* args[] = {&p};
    hipError_t e = hipLaunchCooperativeKernel((const void*)mega, dim3(cus), dim3(NTHR), args, LDS_BYTES, st);
    if (e != hipSuccess) fprintf(stderr, "cooperative launch failed: %s\n", hipGetErrorString(e));
}
```

```cpp
#include <hip/hip_runtime.h>
#include <hip/hip_cooperative_groups.h>
#include <cstdio>
#include <cstdint>
namespace cg = cooperative_groups;

constexpr int S = 8192, DM = 2048, DEPTH = 4, NH = 16, QL = 512, KVL = 512, NOPE = 128, ROPE = 64, VH = 128;
constexpr int INT = 11328, PLE = 256, LRUB = 16, LBD = 128;
constexpr int QD = 192, NQ = NH * QD  , NKV = NH * 256  ;
constexpr int NIN = 11520;
constexpr int ZB = 10240, ZA = 1280;
constexpr int NTHR = 512;
constexpr float QSCALE = 0.07216878364870322f * 1.4426950408889634f;

typedef unsigned short u16;
typedef short bf16x8 __attribute__((ext_vector_type(8)));
typedef float f32x4 __attribute__((ext_vector_type(4)));
typedef float f32x2 __attribute__((ext_vector_type(2)));
typedef unsigned u32x2 __attribute__((ext_vector_type(2)));
typedef unsigned u32x4 __attribute__((ext_vector_type(4)));

__device__ __forceinline__ u16 f2bf(float f) { unsigned u = __float_as_uint(f); u += 0x7FFFu + ((u >> 16) & 1u); return (u16)(u >> 16); }
__device__ __forceinline__ float bf2f(u16 b) { return __uint_as_float(((unsigned)b) << 16); }
__device__ __forceinline__ unsigned pk2(float lo, float hi) { unsigned r; asm volatile("v_cvt_pk_bf16_f32 %0, %1, %2" : "=v"(r) : "v"(lo), "v"(hi)); return r; }
__device__ __forceinline__ float sigmoidf_(float x) { return __builtin_amdgcn_rcpf(1.f + __builtin_amdgcn_exp2f(-1.4426950408889634f * x)); }
__device__ __forceinline__ float siluf_(float x) { return x * __builtin_amdgcn_rcpf(1.f + __builtin_amdgcn_exp2f(-1.4426950408889634f * x)); }
__device__ __forceinline__ int opaque_zero() { int z; asm volatile("s_mov_b32 %0, 0" : "=s"(z)); return z; }
#define TID() ((int)threadIdx.x + opaque_zero())
__device__ __forceinline__ float wsum(float s, int lane) { for (int off = 32; off; off >>= 1) s += __int_as_float(__builtin_amdgcn_ds_bpermute((lane ^ off) << 2, __float_as_int(s))); return s; }
__device__ __forceinline__ float wmax(float s, int lane) { for (int off = 32; off; off >>= 1) s = fmaxf(s, __int_as_float(__builtin_amdgcn_ds_bpermute((lane ^ off) << 2, __float_as_int(s)))); return s; }

struct Params {
    const float *x_in, *p_in; const int* pos;
    const float *attn_norm, *w_in, *q_a_norm, *w_q_b, *kv_a_norm, *w_kv_b, *conv_w, *conv_b, *w_rg, *b_rg, *w_ig, *b_ig, *lam, *w_o_mla, *w_o_lru, *w_out, *ple_norm, *w_ple_gate, *w_ple, *final_norm;
    float* xr;
    u16 *Wt_in, *Wt_q, *Wt_kv, *Wt_lru, *Wt_o, *Wt_out, *Wt_pg, *Wt_ple;
    u16 *hb, *hb2, *zB, *qn, *kvn, *Q, *Kf, *Vf, *xc, *OH, *mg, *pb, *Pm;
    float *zA, *la, *lb, *pp, *cs, *carry, *sc, *nsp8, *ssqA, *ssqB; unsigned* bar;
};

struct Unit { const u16* a; const u16* b; int pm, pn, aux; };

struct TileSched {
    const u16* A; long lda; const u16* B; long ldb; int nM, nN, G, c;
    __device__ __forceinline__ bool tile(int i, int& pm, int& pn) const {
        const int nwg = nM * nN; const long L = (long)i * G + c; if (L >= nwg) return false;
        int wgid = (int)L; { const int q = nwg / 8, r = nwg % 8, xcd = wgid % 8, off = wgid / 8; wgid = (xcd < r ? xcd * (q + 1) : r * (q + 1) + (xcd - r) * q) + off; }
        const int nig = 8 * nN, gid = wgid / nig, fm = gid * 8, gsz = (nM - fm) < 8 ? (nM - fm) : 8;
        pm = fm + ((wgid % nig) % gsz); pn = (wgid % nig) / gsz; return true;
    }
    __device__ __forceinline__ bool next(int i, Unit& u) const {
        if (!tile(i, u.pm, u.pn)) return false;
        u.a = A + (long)u.pm * 256 * lda; u.b = B + (long)u.pn * 256 * ldb; u.aux = 0; return true;
    }
};
struct LruSched : TileSched {
    __device__ __forceinline__ bool next(int i, Unit& u) const {
        if (!tile(i, u.pm, u.pn)) return false;
        u.a = A + (long)u.pm * 256 * lda + (u.pn >> 1) * 256; u.b = B + (long)u.pn * 65536; u.aux = 0; return true;
    }
};
struct MergeSched : TileSched {
    __device__ __forceinline__ bool next(int i, Unit& u) const {
        if (!tile(i >> 1, u.pm, u.pn)) return false;
        u.aux = i & 1; u.a = A + (long)u.pm * 256 * lda + u.aux * 2048; u.b = B + (long)u.pn * 256 * ldb + u.aux * 2048; return true;
    }
};
struct TriSched {
    const u16* A; long lda; const u16* B; long ldb; int G, c;
    __device__ __forceinline__ bool next(int i, Unit& u) const {
        int t = i * G + c; if (t >= 528) return false;
        int pm = 0; while (t >= pm + 1) { t -= pm + 1; ++pm; }
        u.pm = pm; u.pn = t; u.a = A + (long)pm * 256 * lda; u.b = B + (long)t * 256 * ldb; u.aux = 0; return true;
    }
};
struct RowSched {
    const u16* A; long lda; const u16* B; int G, c;
    __device__ __forceinline__ bool next(int i, Unit& u) const {
        const int t = i * G + c; if (t >= 32) return false;
        u.pm = 31 - t; u.pn = 0; u.a = A + (long)u.pm * 256 * lda; u.b = B; u.aux = 0; return true;
    }
};

template <class F>
__device__ __forceinline__ void epi_foreach(f32x4 (&acc)[2][2][4][2], const Unit& u, int wr, int wc, int fr, int fq, F f) {
    const int row0 = u.pm * 256 + wr * 64 + fr, col0 = u.pn * 256 + wc * 32 + 4 * fq;
#pragma unroll
    for (int ai = 0; ai < 2; ++ai)
#pragma unroll
        for (int m = 0; m < 4; ++m) {
#pragma unroll
            for (int bj = 0; bj < 2; ++bj)
#pragma unroll
                for (int n = 0; n < 2; ++n) f(row0 + ai * 128 + m * 16, col0 + bj * 128 + n * 16, acc[ai][bj][m][n]);
        }
}
template <int GM, class T, class LF, class F>
__device__ __forceinline__ void epi_foreach_ld(f32x4 (&acc)[2][2][4][2], const Unit& u, int wr, int wc, int fr, int fq, LF lf, F f) {
    const int row0 = u.pm * 256 + wr * 64 + fr, col0 = u.pn * 256 + wc * 32 + 4 * fq;
#pragma unroll
    for (int ai = 0; ai < 2; ++ai)
#pragma unroll
        for (int mg = 0; mg < 4; mg += GM) {
            T regs[GM][2][2];
#pragma unroll
            for (int m = 0; m < GM; ++m)
#pragma unroll
                for (int bj = 0; bj < 2; ++bj)
#pragma unroll
                    for (int n = 0; n < 2; ++n) regs[m][bj][n] = lf(row0 + ai * 128 + (mg + m) * 16, col0 + bj * 128 + n * 16);
#pragma unroll
            for (int m = 0; m < GM; ++m)
#pragma unroll
                for (int bj = 0; bj < 2; ++bj)
#pragma unroll
                    for (int n = 0; n < 2; ++n) f(row0 + ai * 128 + (mg + m) * 16, col0 + bj * 128 + n * 16, acc[ai][bj][mg + m][n], regs[m][bj][n]);
        }
}
template <class F>
__device__ __forceinline__ void epi_foreach8(f32x4 (&acc)[2][2][4][2], const Unit& u, int wr, int wc, int fr, int fq, F f) {
    const int row0 = u.pm * 256 + wr * 64 + fr, col0 = u.pn * 256 + wc * 32 + 8 * fq;
#pragma unroll
    for (int ai = 0; ai < 2; ++ai)
#pragma unroll
        for (int m = 0; m < 4; ++m)
#pragma unroll
            for (int bj = 0; bj < 2; ++bj) f(row0 + ai * 128 + m * 16, col0 + bj * 128, acc[ai][bj][m][0], acc[ai][bj][m][1]);
}
template <class T, class LF, class F>
__device__ __forceinline__ void epi_foreach8_ld(f32x4 (&acc)[2][2][4][2], const Unit& u, int wr, int wc, int fr, int fq, LF lf, F f) {
    const int row0 = u.pm * 256 + wr * 64 + fr, col0 = u.pn * 256 + wc * 32 + 8 * fq;
#pragma unroll
    for (int ai = 0; ai < 2; ++ai) {
        T regs[4][2];
#pragma unroll
        for (int m = 0; m < 4; ++m)
#pragma unroll
            for (int bj = 0; bj < 2; ++bj) regs[m][bj] = lf(row0 + ai * 128 + m * 16, col0 + bj * 128);
#pragma unroll
        for (int m = 0; m < 4; ++m)
#pragma unroll
            for (int bj = 0; bj < 2; ++bj) f(row0 + ai * 128 + m * 16, col0 + bj * 128, acc[ai][bj][m][0], acc[ai][bj][m][1], regs[m][bj]);
    }
}
__device__ __forceinline__ u32x4 pack8(const f32x4& a, const f32x4& b) { return (u32x4){pk2(a[0], a[1]), pk2(a[2], a[3]), pk2(b[0], b[1]), pk2(b[2], b[3])}; }
#define EPI_COMMON  __device__ __forceinline__ bool keep(const Unit&) const { return false; } __device__ __forceinline__ int klimit(const Unit&, int K) const { return K; }
#define EPI_SIG     __device__ __forceinline__ void operator()(f32x4 (&acc)[2][2][4][2], const Unit& u, int wr, int wc, int fr, int fq) const

__device__ __forceinline__ float rinv_of(float ss) { return rsqrtf(ss * (1.f / DM) + 1e-6f); }
struct EpiIn { EPI_COMMON u16* zB; float* zA; const float* ssq;
    EPI_SIG { const int seg = u.pn >> 3;
        const int row0 = u.pm * 256 + wr * 64 + fr, col0 = u.pn * 256 + wc * 32 + 8 * fq;
        float ri[2][4];
#pragma unroll
        for (int ai = 0; ai < 2; ++ai)
#pragma unroll
            for (int m = 0; m < 4; ++m) ri[ai][m] = ssq[row0 + ai * 128 + m * 16];
#pragma unroll
        for (int ai = 0; ai < 2; ++ai)
#pragma unroll
            for (int m = 0; m < 4; ++m) ri[ai][m] = rinv_of(ri[ai][m]);
        if (seg >= 5) {
#pragma unroll
            for (int ai = 0; ai < 2; ++ai)
#pragma unroll
                for (int m = 0; m < 4; ++m)
#pragma unroll
                    for (int bj = 0; bj < 2; ++bj) { const int row = row0 + ai * 128 + m * 16, col = col0 + bj * 128;
                        if (col < ZB + 1088) { float* d = zA + (long)row * ZA + (col - ZB); *(f32x4*)d = acc[ai][bj][m][0] * ri[ai][m]; *(f32x4*)(d + 4) = acc[ai][bj][m][1] * ri[ai][m]; } }
        } else { const bool sil = seg == 0 || seg == 2, ident = seg == 1;
#pragma unroll
            for (int ai = 0; ai < 2; ++ai)
#pragma unroll
                for (int m = 0; m < 4; ++m)
#pragma unroll
                    for (int bj = 0; bj < 2; ++bj) { const int row = row0 + ai * 128 + m * 16, col = col0 + bj * 128;
                        f32x4 o0 = acc[ai][bj][m][0] * ri[ai][m], o1 = acc[ai][bj][m][1] * ri[ai][m];
                        if (!ident) {
#pragma unroll
                            for (int e = 0; e < 4; ++e) { const float s0 = sigmoidf_(o0[e]), s1 = sigmoidf_(o1[e]); o0[e] = sil ? o0[e] * s0 : s0; o1[e] = sil ? o1[e] * s1 : s1; } }
                        *(u32x4*)(zB + (long)row * ZB + col) = (u32x4){pk2(o0[0], o0[1]), pk2(o0[2], o0[3]), pk2(o1[0], o1[1]), pk2(o1[2], o1[3])}; }
        }
    } };
struct CsT { f32x4 c, s; };
struct EpiQ { EPI_COMMON u16* Q; const float* cs;
    EPI_SIG { epi_foreach8_ld<CsT>(acc, u, wr, wc, fr, fq,
            [&](int row, int col) { const int d = col % QD; CsT t; t.c = (f32x4){1.f, 1.f, 1.f, 1.f}; t.s = (f32x4){0.f, 0.f, 0.f, 0.f};
                if (d >= NOPE) { const float* tp = cs + (long)row * 64 + ((d - NOPE) >> 1); t.c = *(const f32x4*)tp; t.s = *(const f32x4*)(tp + 32); }
                return t; },
            [&](int row, int col, f32x4& v0, f32x4& v1, const CsT& t) { f32x4 o0, o1;
                const int d = col % QD;
                if (d < NOPE) { o0 = v0 * QSCALE; o1 = v1 * QSCALE; }
                else { o0[0] = (v0[0] * t.c[0] - v0[1] * t.s[0]) * QSCALE; o0[1] = (v0[1] * t.c[0] + v0[0] * t.s[0]) * QSCALE;
                       o0[2] = (v0[2] * t.c[1] - v0[3] * t.s[1]) * QSCALE; o0[3] = (v0[3] * t.c[1] + v0[2] * t.s[1]) * QSCALE;
                       o1[0] = (v1[0] * t.c[2] - v1[1] * t.s[2]) * QSCALE; o1[1] = (v1[1] * t.c[2] + v1[0] * t.s[2]) * QSCALE;
                       o1[2] = (v1[2] * t.c[3] - v1[3] * t.s[3]) * QSCALE; o1[3] = (v1[3] * t.c[3] + v1[2] * t.s[3]) * QSCALE; }
                *(u32x4*)(Q + (long)row * NQ + col) = pack8(o0, o1); }); } };
struct EpiKV { EPI_COMMON u16* Kf; u16* Vf;
    EPI_SIG { epi_foreach8(acc, u, wr, wc, fr, fq, [&](int row, int col, f32x4& v0, f32x4& v1) {
            const int hh = col >> 8, j = col & 255;
            u16* dst = (j < 128) ? Kf + ((long)hh * S + row) * QD + j : Vf + ((long)hh * S + row) * VH + (j - 128);
            *(u32x4*)dst = pack8(v0, v1);
        }); } };
struct EpiLru { EPI_COMMON const u16* xc; const float *brg, *big, *nsp8; float *la, *lb;
    EPI_SIG {
        const int row0 = u.pm * 256 + wr * 64 + fr, col0 = u.pn * 256 + wc * 32 + 8 * fq;
        f32x4 cr[2], ci[2], cn[2];
#pragma unroll
        for (int bj = 0; bj < 2; ++bj) { const int ch = (col0 + bj * 128) >> 1; cr[bj] = *(const f32x4*)(brg + ch); ci[bj] = *(const f32x4*)(big + ch); cn[bj] = *(const f32x4*)(nsp8 + ch); }
#pragma unroll
        for (int ai = 0; ai < 2; ++ai) {
            u32x2 xw[4][2];
#pragma unroll
            for (int m = 0; m < 4; ++m)
#pragma unroll
                for (int bj = 0; bj < 2; ++bj) xw[m][bj] = *(const u32x2*)(xc + (long)(row0 + ai * 128 + m * 16) * DM + ((col0 + bj * 128) >> 1));
#pragma unroll
            for (int m = 0; m < 4; ++m)
#pragma unroll
                for (int bj = 0; bj < 2; ++bj) {
                    const long o = (long)(row0 + ai * 128 + m * 16) * DM + ((col0 + bj * 128) >> 1);
                    f32x4 av, bv;
#pragma unroll
                    for (int e = 0; e < 4; ++e) {
                        const f32x4 v = acc[ai][bj][m][e >> 1];
                        const float r = sigmoidf_(v[2 * (e & 1)] + cr[bj][e]), ii = sigmoidf_(v[2 * (e & 1) + 1] + ci[bj][e]);
                        const float lg = r * cn[bj][e], x2 = 2.f * lg;
                        const float a = __builtin_amdgcn_exp2f(1.4426950408889634f * lg);
                        const float em = (x2 > -0.25f) ? x2 * (1.f + x2 * (0.5f + x2 * (0.16666667f + x2 * (0.041666668f + x2 * 0.0083333338f)))) : (a * a - 1.f);
                        const unsigned w = xw[m][bj][e >> 1];
                        const float x = (e & 1) ? __uint_as_float(w & 0xffff0000u) : __uint_as_float(w << 16);
                        av[e] = a; bv[e] = __builtin_amdgcn_sqrtf(-em) * (ii * x); }
                    *(f32x4*)(la + o) = av; *(f32x4*)(lb + o) = bv; }
        }
    } };
struct SmSl { u32x4 sm, sl; };
__device__ __forceinline__ void unpack8(const u32x4& w, f32x4& a, f32x4& b) {
    a = (f32x4){__uint_as_float(w[0] << 16), __uint_as_float(w[0] & 0xffff0000u), __uint_as_float(w[1] << 16), __uint_as_float(w[1] & 0xffff0000u)};
    b = (f32x4){__uint_as_float(w[2] << 16), __uint_as_float(w[2] & 0xffff0000u), __uint_as_float(w[3] << 16), __uint_as_float(w[3] & 0xffff0000u)}; }
struct EpiMerge { const u16* zB; u16* mg;
    __device__ __forceinline__ bool keep(const Unit& u) const { return u.aux == 0; }
    __device__ __forceinline__ int klimit(const Unit&, int K) const { return K; }
    EPI_SIG { const int part = u.aux;
        epi_foreach8_ld<SmSl>(acc, u, wr, wc, fr, fq,
            [&](int row, int col) { SmSl t; t.sl = *(const u32x4*)(zB + (long)row * ZB + 8192 + col); t.sm = t.sl; if (part == 0) t.sm = *(const u32x4*)(zB + (long)row * ZB + 6144 + col); return t; },
            [&](int row, int col, f32x4& v0, f32x4& v1, const SmSl& t) {
            f32x4 l0, l1; unpack8(t.sl, l0, l1);
#pragma unroll
            for (int e = 0; e < 4; ++e) { l0[e] = fmaxf(l0[e], 1e-12f); l1[e] = fmaxf(l1[e], 1e-12f); }
            if (part == 0) { f32x4 m0, m1; unpack8(t.sm, m0, m1);
#pragma unroll
                for (int e = 0; e < 4; ++e) { v0[e] = v0[e] * m0[e] * __builtin_amdgcn_rcpf(l0[e]); v1[e] = v1[e] * m1[e] * __builtin_amdgcn_rcpf(l1[e]); }
            } else { *(u32x4*)(mg + (long)row * DM + col) = pack8(v0 * l0, v1 * l1); }
        }); } };
__device__ __forceinline__ void row_ssq_add(float sq, float* ssq, int row, int lane) {
    sq += __int_as_float(__builtin_amdgcn_ds_bpermute((lane ^ 16) << 2, __float_as_int(sq)));
    sq += __int_as_float(__builtin_amdgcn_ds_bpermute((lane ^ 32) << 2, __float_as_int(sq)));
    if (lane < 16) atomicAdd(ssq + row, sq);
}
struct EpiOut { EPI_COMMON const float* xold; float* xnew; u16* xb; float* ssq;
    EPI_SIG {
        const int row0 = u.pm * 256 + wr * 64 + fr, col0 = u.pn * 256 + wc * 32 + 8 * fq, lane = fq * 16 + fr;
#pragma unroll
        for (int ai = 0; ai < 2; ++ai) {
            f32x4 xo[4][2][2];
#pragma unroll
            for (int m = 0; m < 4; ++m)
#pragma unroll
                for (int bj = 0; bj < 2; ++bj) { const float* q = xold + (long)(row0 + ai * 128 + m * 16) * DM + col0 + bj * 128; xo[m][bj][0] = *(const f32x4*)q; xo[m][bj][1] = *(const f32x4*)(q + 4); }
#pragma unroll
            for (int m = 0; m < 4; ++m) { const int row = row0 + ai * 128 + m * 16; float sq = 0.f;
#pragma unroll
                for (int bj = 0; bj < 2; ++bj) { const f32x4 x0 = xo[m][bj][0] + acc[ai][bj][m][0], x1 = xo[m][bj][1] + acc[ai][bj][m][1]; const long idx = (long)row * DM + col0 + bj * 128;
                    *(f32x4*)(xnew + idx) = x0; *(f32x4*)(xnew + idx + 4) = x1; *(u32x4*)(xb + idx) = pack8(x0, x1);
                    sq += x0[0] * x0[0] + x0[1] * x0[1] + x0[2] * x0[2] + x0[3] * x0[3] + x1[0] * x1[0] + x1[1] * x1[1] + x1[2] * x1[2] + x1[3] * x1[3]; }
                row_ssq_add(sq, ssq, row, lane); }
        }
    } };
struct EpiF32 { EPI_COMMON float* C; long ldc;
    EPI_SIG { epi_foreach8(acc, u, wr, wc, fr, fq, [&](int row, int col, f32x4& v0, f32x4& v1) { float* d = C + (long)row * ldc + col; *(f32x4*)d = v0; *(f32x4*)(d + 4) = v1; }); } };
struct EpiPle { EPI_COMMON float* x; const float* pp; const float* ssq_in; u16* xb; float* ssq_out;
    EPI_SIG {
        const int row0 = u.pm * 256 + wr * 64 + fr, col0 = u.pn * 256 + wc * 32 + 8 * fq, lane = fq * 16 + fr;
#pragma unroll
        for (int ai = 0; ai < 2; ++ai)
#pragma unroll
            for (int mg = 0; mg < 4; mg += 2) {
                f32x4 xo[2][2][2], po[2][2][2]; float ss[2];
#pragma unroll
                for (int m = 0; m < 2; ++m) { const int row = row0 + ai * 128 + (mg + m) * 16; ss[m] = ssq_in[row];
#pragma unroll
                    for (int bj = 0; bj < 2; ++bj) { const long idx = (long)row * DM + col0 + bj * 128;
                        xo[m][bj][0] = *(const f32x4*)(x + idx); xo[m][bj][1] = *(const f32x4*)(x + idx + 4); po[m][bj][0] = *(const f32x4*)(pp + idx); po[m][bj][1] = *(const f32x4*)(pp + idx + 4); } }
#pragma unroll
                for (int m = 0; m < 2; ++m) { const int row = row0 + ai * 128 + (mg + m) * 16; const float ri = rinv_of(ss[m]); float sq = 0.f;
#pragma unroll
                    for (int bj = 0; bj < 2; ++bj) { f32x4 x0 = xo[m][bj][0], x1 = xo[m][bj][1]; const f32x4 v0 = acc[ai][bj][mg + m][0], v1 = acc[ai][bj][mg + m][1]; const long idx = (long)row * DM + col0 + bj * 128;
#pragma unroll
                        for (int e = 0; e < 4; ++e) { x0[e] += po[m][bj][0][e] * sigmoidf_(v0[e] * ri); x1[e] += po[m][bj][1][e] * sigmoidf_(v1[e] * ri); }
                        *(f32x4*)(x + idx) = x0; *(f32x4*)(x + idx + 4) = x1; *(u32x4*)(xb + idx) = pack8(x0, x1);
                        sq += x0[0] * x0[0] + x0[1] * x0[1] + x0[2] * x0[2] + x0[3] * x0[3] + x1[0] * x1[0] + x1[1] * x1[1] + x1[2] * x1[2] + x1[3] * x1[3]; }
                    row_ssq_add(sq, ssq_out, row, lane); }
            }
    } };

#define LAS __attribute__((address_space(3)))
constexpr int HTB = 128 * 64 * 2;
__device__ __forceinline__ int lds_byte(int r, int c) { const int st = (r >> 4) * 2 + (c >> 5), rr = r & 15, cc = c & 31, ob = rr * 64 + cc * 2; return st * 1024 + (ob ^ (((ob >> 9) & 1) << 5)); }
__device__ __forceinline__ void stage_rc(int b, int& R, int& C) { const int st = b / 1024, sb = b % 1024, swz = sb ^ (((sb >> 9) & 1) << 5); R = (st >> 1) * 16 + swz / 64; C = (st & 1) * 32 + (swz % 64) / 2; }

template <class Epi, class Sched>
__device__ __forceinline__ void gemm_fast(char* lds_, int K, long lda, long ldb, const Sched& S_, const Epi& E) {
    LAS unsigned char* lds = (LAS unsigned char*)lds_;
    const int tid = TID(), wid = __builtin_amdgcn_readfirstlane(tid >> 6), lane = tid & 63, wr = wid >> 2, wc = wid & 3, fr = lane & 15, fq = lane >> 4;
    const int nt = K / 64;
    unsigned voffA[2], voffB[2];
#pragma unroll
    for (int i = 0; i < 2; ++i) { int R, C; stage_rc(tid * 16 + i * 8192, R, C); voffA[i] = (unsigned)(R * lda + C) * 2u; voffB[i] = (unsigned)(R * ldb + C) * 2u; }
    const size_t kstep = 128;
    const size_t hstepA = (size_t)128 * lda * 2, hstepB = (size_t)128 * ldb * 2;
    const unsigned ldsw = (unsigned)wid * 1024u;
    const int aoff = lds_byte(wr * 64 + fr, fq * 8), boff = lds_byte(wc * 32 + fr, fq * 8);
#define G_SA(b, h) (((b) * 2 + (h)) * HTB)
#define G_SB(b, h) ((4 + (b) * 2 + (h)) * HTB)
#define G_STAGE(bufoff, gbase, voff) do { _Pragma("unroll") for (int _i = 0; _i < 2; ++_i) \
        __builtin_amdgcn_global_load_lds((const unsigned*)((const char*)(gbase) + (voff)[_i]), (LAS unsigned*)(lds + (bufoff) + ldsw + _i * 8192), 16, 0, 0); } while (0)
#define G_LDA(dst, b, h) do { _Pragma("unroll") for (int m = 0; m < 4; ++m) _Pragma("unroll") for (int k = 0; k < 2; ++k) dst[m][k] = *(const LAS bf16x8*)(lds + G_SA(b, h) + aoff + m * 2048 + k * 1024); } while (0)
#define G_LDB(dst, b, h) do { _Pragma("unroll") for (int n = 0; n < 2; ++n) _Pragma("unroll") for (int k = 0; k < 2; ++k) dst[n][k] = *(const LAS bf16x8*)(lds + G_SB(b, h) + boff + n * 2048 + k * 1024); } while (0)
#define G_MMA(ai, bj, At, Bt) do { __builtin_amdgcn_s_setprio(1); _Pragma("unroll") for (int m = 0; m < 4; ++m) _Pragma("unroll") for (int n = 0; n < 2; ++n) _Pragma("unroll") for (int k = 0; k < 2; ++k) \
        acc[ai][bj][m][n] = __builtin_amdgcn_mfma_f32_16x16x32_bf16(Bt[n][k], At[m][k], acc[ai][bj][m][n], 0, 0, 0); __builtin_amdgcn_s_setprio(0); } while (0)
#define G_WAIT_V(n) asm volatile("s_waitcnt vmcnt(" #n ")" ::: "memory")
#define G_WAIT_L(n) asm volatile("s_waitcnt lgkmcnt(" #n ")" ::: "memory")
#define G_BAR __builtin_amdgcn_s_barrier()
#define G_SCHED __builtin_amdgcn_sched_barrier(0)
    Unit cur, nxt; int ui = 0;
    if (!S_.next(0, cur)) return;
    f32x4 acc[2][2][4][2];
#pragma unroll
    for (int a = 0; a < 2; ++a)
#pragma unroll
        for (int b = 0; b < 2; ++b)
#pragma unroll
            for (int m = 0; m < 4; ++m)
#pragma unroll
                for (int n = 0; n < 2; ++n) acc[a][b][m][n] = (f32x4){0.f, 0.f, 0.f, 0.f};
    bf16x8 At[4][2], B0[2][2], B1[2][2];
    const char* cA = (const char*)cur.a; const char* cB = (const char*)cur.b;
    G_STAGE(G_SB(0, 0), cB, voffB); G_STAGE(G_SA(0, 0), cA, voffA); G_STAGE(G_SB(0, 1), cB + hstepB, voffB); G_STAGE(G_SA(0, 1), cA + hstepA, voffA);
    if (wr == 1) G_BAR;
    G_WAIT_V(4); G_BAR;
    G_STAGE(G_SB(1, 0), cB + kstep, voffB); G_STAGE(G_SA(1, 0), cA + kstep, voffA); G_STAGE(G_SB(1, 1), cB + hstepB + kstep, voffB);
    G_WAIT_V(6); G_BAR;
    for (;;) {
        const bool has_next = S_.next(ui + 1, nxt);
        const char* nA = has_next ? (const char*)nxt.a : cA; const char* nB = has_next ? (const char*)nxt.b : cB;
#pragma unroll 1
        for (int t = 0; t < nt; t += 2) {
            const bool last = (t == nt - 2);
            const char* a1 = cA + (size_t)(t + 1) * kstep;
            const char* a2 = last ? nA : cA + (size_t)(t + 2) * kstep; const char* b2 = last ? nB : cB + (size_t)(t + 2) * kstep;
            const char* a3 = a2 + kstep; const char* b3 = b2 + kstep;
            G_LDB(B0, 0, 0); G_SCHED; G_LDA(At, 0, 0); G_STAGE(G_SA(1, 1), a1 + hstepA, voffA);
            G_WAIT_L(8); G_BAR; G_WAIT_L(0); G_MMA(0, 0, At, B0); G_BAR; G_SCHED;
            G_LDB(B1, 0, 1); G_STAGE(G_SB(0, 0), b2, voffB);
            G_BAR; G_WAIT_L(0); G_MMA(0, 1, At, B1); G_BAR;
            G_LDA(At, 0, 1); G_STAGE(G_SA(0, 0), a2, voffA);
            G_BAR; G_WAIT_L(0); G_MMA(1, 0, At, B0); G_BAR; G_SCHED;
            G_STAGE(G_SB(0, 1), b2 + hstepB, voffB);
            G_WAIT_V(6); G_BAR; G_MMA(1, 1, At, B1); G_BAR;
            G_LDB(B0, 1, 0); G_SCHED; G_LDA(At, 1, 0); G_STAGE(G_SA(0, 1), a2 + hstepA, voffA);
            G_WAIT_L(8); G_BAR; G_WAIT_L(0); G_MMA(0, 0, At, B0); G_BAR; G_SCHED;
            G_LDB(B1, 1, 1); G_STAGE(G_SB(1, 0), b3, voffB);
            G_BAR; G_WAIT_L(0); G_MMA(0, 1, At, B1); G_BAR;
            G_LDA(At, 1, 1); G_STAGE(G_SA(1, 0), a3, voffA);
            G_BAR; G_WAIT_L(0); G_MMA(1, 0, At, B0); G_BAR; G_SCHED;
            G_STAGE(G_SB(1, 1), b3 + hstepB, voffB);
            G_WAIT_V(6); G_BAR; G_MMA(1, 1, At, B1); G_BAR;
        }
        { const int t2 = TID(), w2 = t2 >> 6, l2 = t2 & 63;
          E(acc, cur, w2 >> 2, w2 & 3, l2 & 15, l2 >> 4); }
        if (!has_next) break;
        if (!E.keep(cur)) {
#pragma unroll
            for (int a = 0; a < 2; ++a)
#pragma unroll
                for (int b = 0; b < 2; ++b)
#pragma unroll
                    for (int m = 0; m < 4; ++m)
#pragma unroll
                        for (int n = 0; n < 2; ++n) acc[a][b][m][n] = (f32x4){0.f, 0.f, 0.f, 0.f};
        }
        cur = nxt; cA = nA; cB = nB; ++ui;
    }
    G_WAIT_V(0);
    if (wr == 0) G_BAR;
    G_BAR;
#undef G_SA
#undef G_SB
#undef G_STAGE
#undef G_LDA
#undef G_LDB
#undef G_MMA
#undef G_WAIT_V
#undef G_WAIT_L
#undef G_BAR
#undef G_SCHED
}


#define XB_TMO      128
#define XB_XCNT(j)  (256  + 64 * (j))
#define XB_XSUB(j)  (1280 + 64 * (j))
#define XB_XGEN(j)  (2304 + 64 * (j))
#define XB_TOP      3328
#define XB_TOPGEN   3392
#define XCD_BAR_WORDS 3456
#define XB_SPIN_CAP (1u << 18)
__device__ __forceinline__ unsigned xb_ld(unsigned* p)              { return __hip_atomic_load(p, __ATOMIC_RELAXED, __HIP_MEMORY_SCOPE_AGENT); }
__device__ __forceinline__ unsigned xb_add(unsigned* p, unsigned v) { return __hip_atomic_fetch_add(p, v, __ATOMIC_RELAXED, __HIP_MEMORY_SCOPE_AGENT); }
__device__ __forceinline__ unsigned xb_xcc_id() { return (unsigned)__builtin_amdgcn_s_getreg((3 << 11) | 20) & 0xFu; }
#define XB_SPIN(cond, bar) do { unsigned _sp = 0; while (cond) { __builtin_amdgcn_s_sleep(1); \
    if ((++_sp & 255u) == 0u) { if (xb_ld(&(bar)[XB_TMO])) break; if (_sp > XB_SPIN_CAP) { atomicAdd(&(bar)[XB_TMO], 1u); break; } } } } while (0)
struct XcdBarrier { unsigned* bar; unsigned x; volatile LAS unsigned* st; };
__device__ __forceinline__ XcdBarrier xcd_barrier_post(unsigned* bar, volatile LAS unsigned* st) {
    XcdBarrier b; b.bar = bar; b.x = xb_xcc_id(); b.st = st;
    if (TID() == 0) (void)xb_add(&bar[XB_XCNT(b.x)], 1u);
    return b;
}
__device__ __forceinline__ void xcd_barrier_complete(unsigned* bar, unsigned x, unsigned& nloc, unsigned& nx) {
    const unsigned G = gridDim.x * gridDim.y * gridDim.z;
    unsigned sum, cnt, mine, sp = 0u;
    for (;;) {
        sum = 0u; cnt = 0u; mine = 0u;
#pragma unroll
        for (unsigned j = 0; j < 16; ++j) { const unsigned c = xb_ld(&bar[XB_XCNT(j)]); sum += c; cnt += (c > 0u) ? 1u : 0u; mine = (j == x) ? c : mine; }
        if (sum == G) break;
        __builtin_amdgcn_s_sleep(1);
        if ((++sp & 255u) == 0u) { if (xb_ld(&bar[XB_TMO])) break; if (sp > XB_SPIN_CAP) { atomicAdd(&bar[XB_TMO], 1u); break; } }
    }
    nloc = mine > 0u ? mine : 1u; nx = cnt > 0u ? cnt : 1u;
}
__device__ __forceinline__ void xcd_barrier(const XcdBarrier& b) {
    asm volatile("s_waitcnt vmcnt(0)" ::: "memory");
    __syncthreads();
    if (TID() == 0) {
        unsigned* bar = b.bar;
        __builtin_amdgcn_s_waitcnt(0);
        unsigned nloc = b.st[0], nx = b.st[1];
        if (nloc == 0u) { xcd_barrier_complete(bar, b.x, nloc, nx); b.st[0] = nloc; b.st[1] = nx; }
        const unsigned old = xb_add(&bar[XB_XSUB(b.x)], 1u);
        const unsigned gen = old / nloc;
        if (old + 1u == (gen + 1u) * nloc) {
            __builtin_amdgcn_fence(__ATOMIC_RELEASE, "agent");
            asm volatile("s_waitcnt vmcnt(0)" ::: "memory");
            const unsigned og = xb_add(&bar[XB_TOP], 1u);
            const unsigned tg = og / nx;
            if (og + 1u == (tg + 1u) * nx) xb_add(&bar[XB_TOPGEN], 1u);
            else XB_SPIN(xb_ld(&bar[XB_TOPGEN]) == tg, bar);
            __builtin_amdgcn_fence(__ATOMIC_ACQUIRE, "agent");
            xb_add(&bar[XB_XGEN(b.x)], 1u);
            asm volatile("s_waitcnt vmcnt(0)" ::: "memory");
        } else {
            XB_SPIN(xb_ld(&bar[XB_XGEN(b.x)]) == gen, bar);
            __builtin_amdgcn_fence(__ATOMIC_ACQUIRE, "agent");
            asm volatile("s_waitcnt vmcnt(0)" ::: "memory");
        }
    }
    __syncthreads();
}

struct TDesc { const float* src; const float* ks; u16* dst; long ldd; int N, coff, rm, tix; };
constexpr int TS_IN = (DM / 256) * (INT / 64), TS_Q = (QL / 256) * (NQ / 64), TS_KV = (KVL / 256) * (NKV / 64), TS_SQ = (DM / 256) * (DM / 64), TS_PLE = (PLE / 256) * (DM / 64);
constexpr int TS_LAYER = TS_IN + TS_Q + TS_KV + 4 * TS_SQ + TS_PLE, TS_TOTAL = DEPTH * TS_LAYER;
__device__ __forceinline__ TDesc tdesc(const Params& p, int g) {
    const int l = g / TS_LAYER; int r = g % TS_LAYER; TDesc d; d.ks = nullptr; d.coff = 0; d.rm = 0;
    if (r < TS_IN) { d.src = p.w_in + (size_t)l * DM * INT; d.N = INT; d.dst = p.Wt_in + (size_t)l * NIN * DM; d.ldd = DM; d.rm = 1; d.ks = p.attn_norm + l * DM; d.tix = r; return d; }
    r -= TS_IN;
    if (r < TS_Q) { d.src = p.w_q_b + (size_t)l * QL * NQ; d.N = NQ; d.dst = p.Wt_q + (size_t)l * NQ * QL; d.ldd = QL; d.rm = 2; d.tix = r; return d; }
    r -= TS_Q;
    if (r < TS_KV) { d.src = p.w_kv_b + (size_t)l * KVL * NKV; d.N = NKV; d.dst = p.Wt_kv + (size_t)l * NKV * KVL; d.ldd = KVL; d.rm = 3; d.tix = r; return d; }
    r -= TS_KV;
    if (r < TS_SQ) { d.src = p.w_o_mla + (size_t)l * DM * DM; d.N = DM; d.dst = p.Wt_o + (size_t)l * DM * 4096; d.ldd = 4096; d.rm = 3; d.tix = r; return d; }
    r -= TS_SQ;
    if (r < TS_SQ) { d.src = p.w_o_lru + (size_t)l * DM * DM; d.N = DM; d.dst = p.Wt_o + (size_t)l * DM * 4096; d.ldd = 4096; d.coff = 2048; d.rm = 3; d.tix = r; return d; }
    r -= TS_SQ;
    if (r < TS_SQ) { d.src = p.w_out + (size_t)l * DM * DM; d.N = DM; d.dst = p.Wt_out + (size_t)l * DM * DM; d.ldd = DM; d.rm = 3; d.tix = r; return d; }
    r -= TS_SQ;
    if (r < TS_SQ) { d.src = p.w_ple_gate + (size_t)l * DM * DM; d.N = DM; d.dst = p.Wt_pg + (size_t)l * DM * DM; d.ldd = DM; d.rm = 3; d.ks = p.ple_norm + l * DM; d.tix = r; return d; }
    r -= TS_SQ;
    d.src = p.w_ple + (size_t)l * PLE * DM; d.N = DM; d.dst = p.Wt_ple + (size_t)l * DM * PLE; d.ldd = PLE; d.rm = 3; d.tix = r; return d;
}
__device__ __forceinline__ int pslot(int r) { const int c = r & 31; return (r & ~31) + 16 * ((c >> 2) & 1) + ((c >> 3) << 2) + (c & 3); }
__device__ __forceinline__ int trowmap(int rm, int n) {
    if (rm == 1) return pslot(n >= 1088 ? n - 1088 : n + ZB);
    if (rm == 2) { const int hh = n / QD, d = n % QD; if (d < NOPE) return pslot(n); const int e = d - NOPE; return pslot(hh * QD + NOPE + ((e & 31) << 1) + (e >> 5)); }
    if (rm == 3) return pslot(n);
    return n;
}
__device__ __forceinline__ void transpose_all(const Params& p, char* lds) {
    u16 (*t)[72] = (u16(*)[72])lds;
    const int tid = TID(), k = tid >> 3, nn = (tid & 7) * 8, G = gridDim.x;
    f32x4 vA[4][2], vB[4][2];
#define TC_LOAD(v_, d_) do { const int tn_ = (d_).N / 64, k0_ = ((d_).tix / tn_) * 256, n0_ = ((d_).tix % tn_) * 64; _Pragma("unroll") for (int j = 0; j < 4; ++j) { \
        const float* p_ = (d_).src + (long)(k0_ + k + 64 * j) * (d_).N + n0_ + nn; v_[j][0] = *(const f32x4*)p_; v_[j][1] = *(const f32x4*)(p_ + 4); \
        if ((d_).ks) { const float g_ = (d_).ks[k0_ + k + 64 * j]; v_[j][0] = v_[j][0] * g_; v_[j][1] = v_[j][1] * g_; } } } while (0)
#define TC_LDSW(v_) do { _Pragma("unroll") for (int j = 0; j < 4; ++j) *(u32x4*)&t[k + 64 * j][nn ^ (((k >> 3) & 7) << 3)] = (u32x4){pk2(v_[j][0][0], v_[j][0][1]), pk2(v_[j][0][2], v_[j][0][3]), pk2(v_[j][1][0], v_[j][1][1]), pk2(v_[j][1][2], v_[j][1][3])}; } while (0)
#define TC_STORE(d_) do { const int tn_ = (d_).N / 64, k0_ = ((d_).tix / tn_) * 256, n0_ = ((d_).tix % tn_) * 64; const int n_ = tid >> 3, kk_ = (tid & 7) * 8; \
        u16* drow_ = (d_).dst + (long)trowmap((d_).rm, n0_ + n_) * (d_).ldd + (d_).coff + k0_ + kk_; \
        _Pragma("unroll") for (int j = 0; j < 4; ++j) { u32x4 o_; _Pragma("unroll") for (int e = 0; e < 4; ++e) o_[e] = (unsigned)t[64 * j + kk_ + 2 * e][n_ ^ kk_] | ((unsigned)t[64 * j + kk_ + 2 * e + 1][n_ ^ kk_] << 16); \
            *(u32x4*)(drow_ + 64 * j) = o_; } } while (0)
    int gA = blockIdx.x, gB = gA + G; TDesc dA, dB, dc;
    if (gA < TS_TOTAL) { dA = tdesc(p, gA); TC_LOAD(vA, dA); }
    if (gB < TS_TOTAL) { dB = tdesc(p, gB); TC_LOAD(vB, dB); }
    while (gA < TS_TOTAL) {
        TC_LDSW(vA); __syncthreads(); dc = dA; gA += 2 * G; if (gA < TS_TOTAL) { dA = tdesc(p, gA); TC_LOAD(vA, dA); } TC_STORE(dc); __syncthreads();
        if (gB >= TS_TOTAL) break;
        TC_LDSW(vB); __syncthreads(); dc = dB; gB += 2 * G; if (gB < TS_TOTAL) { dB = tdesc(p, gB); TC_LOAD(vB, dB); } TC_STORE(dc); __syncthreads();
    }
#undef TC_LOAD
#undef TC_LDSW
#undef TC_STORE
}

__device__ __forceinline__ void phase_prologue(const Params& p, char* lds) {
    const long gtid = (long)blockIdx.x * NTHR + TID(), gsz = (long)gridDim.x * NTHR;
    transpose_all(p, lds);
    for (long i = gtid; i < (long)DEPTH * (NIN - INT) * DM / 8; i += gsz) { const long per = (long)(NIN - INT) * DM / 8; const int l = (int)(i / per); const long r = i % per;
        *(u32x4*)(p.Wt_in + ((size_t)l * NIN + INT) * DM + r * 8) = (u32x4){0u, 0u, 0u, 0u}; }
    for (long i = gtid; i < (long)DEPTH * LRUB * 256 * 256; i += gsz) {
        const int k = (int)(i & 255), o = (int)((i >> 8) & 255), blk = (int)((i >> 16) & 15), l = (int)(i >> 20);
        const int kk = k - 128 * (blk & 1), cl = o >> 1; float v = 0.f;
        if (kk >= 0 && kk < 128) v = ((o & 1) ? p.w_ig : p.w_rg)[(((size_t)l * LRUB + blk) * LBD + kk) * LBD + cl];
        p.Wt_lru[(((long)l * LRUB + blk) * 256 + pslot(o)) * 256 + k] = f2bf(v); }
    for (long i = gtid; i < (long)DEPTH * S * PLE / 8; i += gsz) { const float* s = p.p_in + i * 8; const f32x4 v0 = *(const f32x4*)s, v1 = *(const f32x4*)(s + 4);
        *(u32x4*)(p.pb + i * 8) = (u32x4){pk2(v0[0], v0[1]), pk2(v0[2], v0[3]), pk2(v1[0], v1[1]), pk2(v1[2], v1[3])}; }
    for (long i = gtid; i < (long)DEPTH * DM; i += gsz) p.nsp8[i] = -8.f * log1pf(expf(-p.lam[i]));
    for (long i = gtid; i < (long)S * 32; i += gsz) { const int s = (int)(i >> 5), f = (int)(i & 31);
        const float inv = powf(10000.f, -(float)(2 * f) / 64.f), ang = (float)p.pos[s] * inv;
        p.cs[(long)s * 64 + f] = (float)cos((double)ang); p.cs[(long)s * 64 + 32 + f] = (float)sin((double)ang); }
}

__device__ __forceinline__ void phase_xb_ssq(const float* __restrict__ x, u16* __restrict__ out, float* __restrict__ ssq) {
    const int tid = TID(), lane = tid & 63, gw = blockIdx.x * (NTHR / 64) + (tid >> 6), nw = gridDim.x * (NTHR / 64);
    for (int row = gw; row < S; row += nw) {
        const float* p = x + (long)row * DM; f32x4 v[8]; float s = 0.f;
#pragma unroll
        for (int j = 0; j < 8; ++j) { v[j] = *(const f32x4*)(p + j * 256 + lane * 4); s += v[j][0] * v[j][0] + v[j][1] * v[j][1] + v[j][2] * v[j][2] + v[j][3] * v[j][3]; }
        s = wsum(s, lane);
#pragma unroll
        for (int j = 0; j < 8; ++j) *(u32x2*)(out + (long)row * DM + j * 256 + lane * 4) = (u32x2){pk2(v[j][0], v[j][1]), pk2(v[j][2], v[j][3])};
        if (lane == 0) ssq[row] = s;
    }
}
__device__ __forceinline__ void phase_final_norm(float* __restrict__ x, const float* __restrict__ g) {
    const int tid = TID(), lane = tid & 63, gw = blockIdx.x * (NTHR / 64) + (tid >> 6), nw = gridDim.x * (NTHR / 64);
    for (int row = gw; row < S; row += nw) {
        float* p = x + (long)row * DM; f32x4 v[8]; float s = 0.f;
#pragma unroll
        for (int j = 0; j < 8; ++j) { v[j] = *(const f32x4*)(p + j * 256 + lane * 4); s += v[j][0] * v[j][0] + v[j][1] * v[j][1] + v[j][2] * v[j][2] + v[j][3] * v[j][3]; }
        s = wsum(s, lane); const float rinv = rsqrtf(s * (1.f / DM) + 1e-6f);
#pragma unroll
        for (int j = 0; j < 8; ++j) { const f32x4 gg = *(const f32x4*)(g + j * 256 + lane * 4); *(f32x4*)(p + j * 256 + lane * 4) = v[j] * rinv * gg; }
    }
}
__device__ __forceinline__ void t2_rows(const float* __restrict__ zA, const u16* __restrict__ zB, const float* __restrict__ cs, const float* __restrict__ cw, const float* __restrict__ cb,
                                        const float* __restrict__ gq, const float* __restrict__ gkv, u16* __restrict__ qn, u16* __restrict__ kvn, u16* __restrict__ Kf, u16* __restrict__ xc, float* __restrict__ ssqB) {
    const int tid = TID(), lane = tid & 63, gw = blockIdx.x * (NTHR / 64) + (tid >> 6), nw = gridDim.x * (NTHR / 64);
    for (int row = gw; row < S; row += nw) {
        const float* zr = zA + (long)row * ZA;
        f32x4 v[2][2];
#pragma unroll
        for (int part = 0; part < 2; ++part) { v[part][0] = *(const f32x4*)(zr + part * 512 + lane * 4); v[part][1] = *(const f32x4*)(zr + part * 512 + 256 + lane * 4); }
        const int l32 = lane & 31;
        const float x1 = zr[1024 + l32], x2 = zr[1056 + l32], cc = cs[(long)row * 64 + l32], sn = cs[(long)row * 64 + 32 + l32];
        u32x2 uu[8][4];
#pragma unroll
        for (int j = 0; j < 8; ++j)
#pragma unroll
            for (int k = 0; k < 4; ++k) { const int sp = row - 3 + k; uu[j][k] = (u32x2){0u, 0u}; if (sp >= 0) uu[j][k] = *(const u32x2*)(zB + (long)sp * ZB + 2048 + j * 256 + lane * 4); }
        if (lane == 0) ssqB[row] = 0.f;
#pragma unroll
        for (int part = 0; part < 2; ++part) {
            const float* g = part ? gkv : gq; u16* dst = (part ? kvn : qn) + (long)row * 512;
            const f32x4 v0 = v[part][0], v1 = v[part][1];
            float s = v0[0] * v0[0] + v0[1] * v0[1] + v0[2] * v0[2] + v0[3] * v0[3] + v1[0] * v1[0] + v1[1] * v1[1] + v1[2] * v1[2] + v1[3] * v1[3];
            s = wsum(s, lane); const float rinv = rsqrtf(s * (1.f / 512.f) + 1e-6f);
            const f32x4 g0 = *(const f32x4*)(g + lane * 4), g1 = *(const f32x4*)(g + 256 + lane * 4);
            *(u32x2*)(dst + lane * 4) = (u32x2){pk2(v0[0] * rinv * g0[0], v0[1] * rinv * g0[1]), pk2(v0[2] * rinv * g0[2], v0[3] * rinv * g0[3])};
            *(u32x2*)(dst + 256 + lane * 4) = (u32x2){pk2(v1[0] * rinv * g1[0], v1[1] * rinv * g1[1]), pk2(v1[2] * rinv * g1[2], v1[3] * rinv * g1[3])};
        }
        if (lane < 32) { const unsigned w = pk2(x1 * cc - x2 * sn, x2 * cc + x1 * sn);
#pragma unroll
            for (int hh = 0; hh < NH; ++hh) *(unsigned*)(Kf + ((long)hh * S + row) * QD + NOPE + 2 * lane) = w; }
#pragma unroll
        for (int j = 0; j < 8; ++j) { const int c = j * 256 + lane * 4; f32x4 y = *(const f32x4*)(cb + c);
#pragma unroll
            for (int k = 0; k < 4; ++k) { const f32x4 w = *(const f32x4*)(cw + k * DM + c); const u32x2 u2 = uu[j][k];
                y[0] += __uint_as_float(u2[0] << 16) * w[0]; y[1] += __uint_as_float(u2[0] & 0xffff0000u) * w[1]; y[2] += __uint_as_float(u2[1] << 16) * w[2]; y[3] += __uint_as_float(u2[1] & 0xffff0000u) * w[3]; }
            *(u32x2*)(xc + (long)row * DM + c) = (u32x2){pk2(y[0], y[1]), pk2(y[2], y[3])}; }
    }
}
__device__ __forceinline__ void phase_t2(const Params& p, int l) {
    t2_rows(p.zA, p.zB, p.cs, p.conv_w + (size_t)l * 4 * DM, p.conv_b + (size_t)l * DM, p.q_a_norm + l * 512, p.kv_a_norm + l * 512, p.qn, p.kvn, p.Kf, p.xc, p.ssqB);
}
__device__ __forceinline__ void phase_scan1(const Params& p) {
    float* Pc = p.carry; float* Hc = p.carry + 128 * DM;
    for (long i = (long)blockIdx.x * NTHR + TID(); i < 128L * (DM / 2); i += (long)gridDim.x * NTHR) {
        const int c = (int)(i % (DM / 2)) * 2, ch = (int)(i / (DM / 2)); f32x2 P = {1.f, 1.f}, H = {0.f, 0.f};
        const float* pa = p.la + (long)ch * 64 * DM + c; const float* pb = p.lb + (long)ch * 64 * DM + c;
#pragma unroll 1
        for (int t0 = 0; t0 < 64; t0 += 16) { f32x2 a[16], b[16];
#pragma unroll
            for (int t = 0; t < 16; ++t) { a[t] = *(const f32x2*)(pa + (long)(t0 + t) * DM); b[t] = *(const f32x2*)(pb + (long)(t0 + t) * DM); }
#pragma unroll
            for (int t = 0; t < 16; ++t) { H = a[t] * H + b[t]; P = P * a[t]; } }
        *(f32x2*)(Pc + (long)ch * DM + c) = P; *(f32x2*)(Hc + (long)ch * DM + c) = H; }
}
__device__ __forceinline__ void scan3_rows(const float* __restrict__ Pc, const float* __restrict__ Hc, const float* __restrict__ la, const float* __restrict__ lb, const u16* __restrict__ zB,
                                           u16* __restrict__ OH, float* __restrict__ ssqA) {
    for (long i = (long)blockIdx.x * NTHR + TID(); i < 128L * (DM / 2); i += (long)gridDim.x * NTHR) {
        if (i < S) ssqA[i] = 0.f;
        const int c = (int)(i % (DM / 2)) * 2, ch = (int)(i / (DM / 2)); f32x2 H = {0.f, 0.f};
        int k = 0;
#pragma unroll 1
        for (; k + 16 <= ch; k += 16) { f32x2 a[16], b[16];
#pragma unroll
            for (int t = 0; t < 16; ++t) { a[t] = *(const f32x2*)(Pc + (long)(k + t) * DM + c); b[t] = *(const f32x2*)(Hc + (long)(k + t) * DM + c); }
#pragma unroll
            for (int t = 0; t < 16; ++t) H = a[t] * H + b[t]; }
        for (; k < ch; ++k) H = *(const f32x2*)(Pc + (long)k * DM + c) * H + *(const f32x2*)(Hc + (long)k * DM + c);
        const float* pa = la + (long)ch * 64 * DM + c; const float* pb = lb + (long)ch * 64 * DM + c;
        const u16* pg = zB + (long)ch * 64 * ZB + 4096 + c; u16* po = OH + (long)ch * 64 * 4096 + 2048 + c;
#pragma unroll
        for (int t0 = 0; t0 < 64; t0 += 16) { f32x2 a[16], b[16]; unsigned g[16];
#pragma unroll
            for (int t = 0; t < 16; ++t) { a[t] = *(const f32x2*)(pa + (long)(t0 + t) * DM); b[t] = *(const f32x2*)(pb + (long)(t0 + t) * DM); g[t] = *(const unsigned*)(pg + (long)(t0 + t) * ZB); }
#pragma unroll
            for (int t = 0; t < 16; ++t) { H = a[t] * H + b[t];
                *(unsigned*)(po + (long)(t0 + t) * 4096) = pk2(H[0] * __uint_as_float(g[t] << 16), H[1] * __uint_as_float(g[t] & 0xffff0000u)); } } }
}
__device__ __forceinline__ void phase_scan3(const Params& p) { scan3_rows(p.carry, p.carry + 128 * DM, p.la, p.lb, p.zB, p.OH, p.ssqA); }

typedef float f32x16 __attribute__((ext_vector_type(16)));
typedef short s16x4 __attribute__((ext_vector_type(4)));
constexpr int SHM_V = 64 * 128 * 2, SHM_K = 64 * 192 * 2, ATT_WS = 2 * SHM_V + 2 * SHM_K;
#define KSWZ(row, colB) ((row) * 384 + ((colB) ^ (((row) & 7) << 4)))
__device__ __forceinline__ int v_st(int k, int c) { const int kk = (k & ~0xC) | ((k & 4) << 1) | ((k & 8) >> 1); return ((kk >> 3) * 4 + (c >> 5)) * 512 + ((kk & 7) * 32 + (c & 31)) * 2; }
__device__ __forceinline__ int v_rd_base(int lane) { return ((lane & 3) << 3) | (((lane >> 2) & 3) << 6) | (((lane >> 4) & 1) << 5) | (((lane >> 5) & 1) << 8); }
constexpr int v_rd_off(int d0, int ks, int half) { return d0 * 512 + ks * 4096 + half * 2048; }
__device__ __forceinline__ int crow(int r, int hi) { return (r & 3) + 8 * (r >> 2) + 4 * hi; }
__device__ __forceinline__ unsigned cvtpk(float lo, float hi) { unsigned r; asm volatile("v_cvt_pk_bf16_f32 %0, %1, %2" : "=v"(r) : "v"(lo), "v"(hi)); return r; }

__device__ __forceinline__ void partialSM(f32x16& p0, f32x16& p1, float& m_reg, float& mn, float& alpha) {
    float pmax = p0[0];
#pragma unroll
    for (int r = 1; r < 16; ++r) pmax = fmaxf(pmax, p0[r]);
#pragma unroll
    for (int r = 0; r < 16; ++r) pmax = fmaxf(pmax, p1[r]);
    { auto rr = __builtin_amdgcn_permlane32_swap(__float_as_uint(pmax), __float_as_uint(pmax), false, false);
      pmax = fmaxf(__uint_as_float(rr[0]), __uint_as_float(rr[1])); }
    if (__builtin_expect(__all(pmax - m_reg <= 11.5f), 1)) { mn = m_reg; alpha = 1.f; }
    else { mn = fmaxf(m_reg, pmax); alpha = __builtin_amdgcn_exp2f(m_reg - mn); m_reg = mn; }
#pragma unroll
    for (int r = 0; r < 16; ++r) p0[r] = p0[r] - mn;
#pragma unroll
    for (int r = 0; r < 16; ++r) p1[r] = p1[r] - mn;
#pragma unroll
    for (int r = 0; r < 16; ++r) p0[r] = __builtin_amdgcn_exp2f(p0[r]);
}
__device__ __forceinline__ void finishSM(f32x16& p0, f32x16& p1, float alpha, float& l_reg, bf16x8& pa0, bf16x8& pa1, bf16x8& pa2, bf16x8& pa3) {
#pragma unroll
    for (int r = 0; r < 16; ++r) p1[r] = __builtin_amdgcn_exp2f(p1[r]);
    float ps = 0;
#pragma unroll
    for (int r = 0; r < 16; ++r) ps += p0[r];
#pragma unroll
    for (int r = 0; r < 16; ++r) ps += p1[r];
    { auto rr = __builtin_amdgcn_permlane32_swap(__float_as_uint(ps), __float_as_uint(ps), false, false);
      ps = __uint_as_float(rr[0]) + __uint_as_float(rr[1]); }
    l_reg = l_reg * alpha + ps;
#define PK4(P, B_, OUT) do { unsigned a0 = cvtpk(P[B_+0], P[B_+1]), a1 = cvtpk(P[B_+2], P[B_+3]);                          \
        unsigned b0 = cvtpk(P[B_+4], P[B_+5]), b1 = cvtpk(P[B_+6], P[B_+7]);                                             \
        auto r0 = __builtin_amdgcn_permlane32_swap(a0, b0, false, false); auto r1 = __builtin_amdgcn_permlane32_swap(a1, b1, false, false); \
        u32x4 w = {r0[0], r1[0], r0[1], r1[1]}; OUT = *reinterpret_cast<bf16x8*>(&w); } while (0)
    PK4(p0, 0, pa0); PK4(p0, 8, pa1); PK4(p1, 0, pa2); PK4(p1, 8, pa3);
#undef PK4
}
template <int KB>
__device__ __forceinline__ void qkt(f32x16& p0, f32x16& p1, LAS char* K_lds, int r32, int hi, const bf16x8* qr, bool act) {
    if (!act) { const float NEG = -__builtin_inff();
#pragma unroll
        for (int r = 0; r < 16; ++r) { p0[r] = NEG; p1[r] = NEG; } return; }
#pragma unroll
    for (int r = 0; r < 16; ++r) { p0[r] = 0.f; p1[r] = 0.f; }
    LAS char* kb[4];
#pragma unroll
    for (int dd = 0; dd < 4; ++dd) kb[dd] = K_lds + KB * SHM_K + KSWZ(r32, (dd * 16 + hi * 8) * 2);
#pragma unroll
    for (int d0 = 0; d0 < 12; ++d0) { LAS char* a = kb[d0 & 3] + (d0 >> 2) * 128;
        const bf16x8 b0 = *(const LAS bf16x8*)a;
        const bf16x8 b1 = *(const LAS bf16x8*)(a + 32 * 384);
        p0 = __builtin_amdgcn_mfma_f32_32x32x16_bf16(b0, qr[d0], p0, 0, 0, 0);
        p1 = __builtin_amdgcn_mfma_f32_32x32x16_bf16(b1, qr[d0], p1, 0, 0, 0); }
}
template <int VB>
__device__ __forceinline__ void pv_tile(f32x16* o, int vb0, bf16x8 pa0, bf16x8 pa1, bf16x8 pa2, bf16x8 pa3, bool act) {
    if (!act) return;
#define TRRD(dst, off) asm volatile("ds_read_b64_tr_b16 %0, %1 offset:%2" : "=&v"(dst) : "v"(vb0), "i"(off) : "memory")
#define PV_D0(d0) do { s16x4 l0, l1, l2, l3, h0, h1, h2, h3; constexpr int b_ = VB * SHM_V + v_rd_off(d0, 0, 0); \
        TRRD(l0, b_); TRRD(h0, b_ + 2048); TRRD(l1, b_ + 4096); TRRD(h1, b_ + 6144); TRRD(l2, b_ + 8192); TRRD(h2, b_ + 10240); TRRD(l3, b_ + 12288); TRRD(h3, b_ + 14336); \
        asm volatile("s_waitcnt lgkmcnt(0)" ::: "memory"); __builtin_amdgcn_sched_barrier(0); \
        o[d0] = __builtin_amdgcn_mfma_f32_32x32x16_bf16(pa0, (bf16x8){l0[0], l0[1], l0[2], l0[3], h0[0], h0[1], h0[2], h0[3]}, o[d0], 0, 0, 0);   \
        o[d0] = __builtin_amdgcn_mfma_f32_32x32x16_bf16(pa1, (bf16x8){l1[0], l1[1], l1[2], l1[3], h1[0], h1[1], h1[2], h1[3]}, o[d0], 0, 0, 0);   \
        o[d0] = __builtin_amdgcn_mfma_f32_32x32x16_bf16(pa2, (bf16x8){l2[0], l2[1], l2[2], l2[3], h2[0], h2[1], h2[2], h2[3]}, o[d0], 0, 0, 0);   \
        o[d0] = __builtin_amdgcn_mfma_f32_32x32x16_bf16(pa3, (bf16x8){l3[0], l3[1], l3[2], l3[3], h3[0], h3[1], h3[2], h3[3]}, o[d0], 0, 0, 0); } while (0)
    PV_D0(0); PV_D0(1); PV_D0(2); PV_D0(3);
#undef PV_D0
#undef TRRD
}

__device__ __forceinline__ void attn_block(char* lds, const u16* __restrict__ Qb, const u16* __restrict__ Kh, const u16* __restrict__ Vh,
                                           const u16* __restrict__ sg, u16* __restrict__ Ob, int P0) {
    const int tid = TID(), wid = __builtin_amdgcn_readfirstlane(tid >> 6), lane = tid & 63, r32 = lane & 31, hi = lane >> 5;
    const int NT = (P0 >> 6) + 4;
    const int wchunk = (P0 >> 6) + (wid >> 1);
    LAS char* L = (LAS char*)lds; LAS char* V_lds = L; LAS char* K_lds = L + 2 * SHM_V;
    LAS float* wsf = (LAS float*)(L + ATT_WS) + wid * 64; LAS float* li_l = wsf; LAS float* al_l = wsf + 32;
    float m_reg = -1e30f, l_reg = 0.f; f32x16 o[4];
#pragma unroll
    for (int d = 0; d < 4; ++d)
#pragma unroll
        for (int r = 0; r < 16; ++r) o[d][r] = 0.f;
    const int sr = tid >> 4, sc = (tid & 15) * 8, vst0 = v_st(sr, sc), vst1 = v_st(32 + sr, sc);
    const int kc0 = tid, kc1 = tid + 512, kc2 = tid + 1024;
    const int kws0 = KSWZ(kc0 / 24, (kc0 % 24) * 16), kws1 = KSWZ(kc1 / 24, (kc1 % 24) * 16), kws2 = KSWZ(kc2 / 24, (kc2 % 24) * 16);
    const int vb0 = (int)(unsigned)(uintptr_t)V_lds + v_rd_base(lane);
    bf16x8 qr[12];
#pragma unroll
    for (int d0 = 0; d0 < 12; ++d0) qr[d0] = *(const bf16x8*)(Qb + (long)(wid * 32 + r32) * NQ + d0 * 16 + hi * 8);
    bf16x8 st_k0, st_k1, st_k2, st_v0, st_v1;
#define VMW() asm volatile("s_waitcnt vmcnt(0)" ::: "memory")
#define SBAR() __builtin_amdgcn_sched_barrier(0)
#define SLOAD(t) do { const u16* kp_ = Kh + (long)(t) * 64 * QD + tid * 8; st_k0 = *(const bf16x8*)kp_; st_k1 = *(const bf16x8*)(kp_ + 4096); st_k2 = *(const bf16x8*)(kp_ + 8192); \
                      const u16* vp_ = Vh + ((long)(t) * 64 + sr) * VH + sc; st_v0 = *(const bf16x8*)vp_; st_v1 = *(const bf16x8*)(vp_ + 32 * VH); } while (0)
#define SWRITE(bf) do { *(LAS bf16x8*)(K_lds + (bf) * SHM_K + kws0) = st_k0; *(LAS bf16x8*)(K_lds + (bf) * SHM_K + kws1) = st_k1; *(LAS bf16x8*)(K_lds + (bf) * SHM_K + kws2) = st_k2; \
                        *(LAS bf16x8*)(V_lds + (bf) * SHM_V + vst0) = st_v0; *(LAS bf16x8*)(V_lds + (bf) * SHM_V + vst1) = st_v1; } while (0)
#define RESC(a) do { if (__any((a) < 1.f)) { if (hi == 0) al_l[r32] = (a); asm volatile("s_waitcnt lgkmcnt(0)" ::: "memory");              \
                     _Pragma("unroll") for (int d_ = 0; d_ < 4; ++d_) _Pragma("unroll") for (int r = 0; r < 16; ++r) o[d_][r] *= al_l[crow(r, hi)]; } } while (0)
#define ACT(t) ((t) <= wchunk)
    f32x16 pA0, pA1, pB0, pB1; float mnA, mnB, alA, alB; bf16x8 pa0, pa1, pa2, pa3;
    SLOAD(0); VMW(); SWRITE(0); SBAR();
    SLOAD(1);
    __syncthreads();
    SBAR(); qkt<0>(pA0, pA1, K_lds, r32, hi, qr, ACT(0));
    partialSM(pA0, pA1, m_reg, mnA, alA);
    VMW(); SWRITE(1);
    __syncthreads();
#define HALF_STEP(PX0, PX1, mnX, alX, PY0, PY1, alY, t, KB, VB, SB) do {                                                      \
        SBAR(); qkt<KB>(PX0, PX1, K_lds, r32, hi, qr, ACT(t));                                                                \
        finishSM(PY0, PY1, alY, l_reg, pa0, pa1, pa2, pa3); SBAR();                                                           \
        if ((t) + 1 < NT) { SLOAD((t) + 1); SBAR(); }                                                                          \
        pv_tile<VB>(o, vb0, pa0, pa1, pa2, pa3, ACT((t) - 1)); partialSM(PX0, PX1, m_reg, mnX, alX);                          \
        __syncthreads();                                                                                                      \
        if ((t) + 1 < NT) { VMW(); SWRITE(SB); }                                                                               \
        RESC(alX); __syncthreads(); } while (0)
    for (int t = 1; t + 1 < NT; t += 2) {
        HALF_STEP(pB0, pB1, mnB, alB, pA0, pA1, alA, t, 1, 0, 0);
        HALF_STEP(pA0, pA1, mnA, alA, pB0, pB1, alB, t + 1, 0, 1, 1);
    }
    SBAR(); qkt<1>(pB0, pB1, K_lds, r32, hi, qr, ACT(NT - 1)); SBAR();
    finishSM(pA0, pA1, alA, l_reg, pa0, pa1, pa2, pa3); SBAR();
    pv_tile<0>(o, vb0, pa0, pa1, pa2, pa3, ACT(NT - 2));
    partialSM(pB0, pB1, m_reg, mnB, alB); __syncthreads(); RESC(alB);
    finishSM(pB0, pB1, alB, l_reg, pa0, pa1, pa2, pa3); SBAR(); pv_tile<1>(o, vb0, pa0, pa1, pa2, pa3, ACT(NT - 1));
    SBAR();
    if (hi == 0) li_l[r32] = l_reg; asm volatile("s_waitcnt lgkmcnt(0)" ::: "memory");
    float rli[16];
#pragma unroll
    for (int r = 0; r < 16; ++r) rli[r] = __builtin_amdgcn_rcpf(li_l[crow(r, hi)]);
    const int jq = r32 & 3, colb = jq * 32 + (r32 & ~3);
    const bool b0 = (jq & 1) != 0, b1 = (jq & 2) != 0;
    u32x2 gg[16];
#pragma unroll
    for (int r = 0; r < 16; ++r) gg[r] = *(const u32x2*)(sg + (long)(wid * 32 + crow(r, hi)) * ZB + colb);
#define QSWAP1(v_) __int_as_float(__builtin_amdgcn_mov_dpp(__float_as_int(v_), 0xB1, 0xF, 0xF, true))
#define QSWAP2(v_) __int_as_float(__builtin_amdgcn_mov_dpp(__float_as_int(v_), 0x4E, 0xF, 0xF, true))
#pragma unroll
    for (int r = 0; r < 16; ++r) { const int orow = wid * 32 + crow(r, hi);
        float x0 = o[0][r] * rli[r], x1 = o[1][r] * rli[r], x2 = o[2][r] * rli[r], x3 = o[3][r] * rli[r];
        { const float r01 = QSWAP1(b0 ? x0 : x1), r23 = QSWAP1(b0 ? x2 : x3);
          const float n0 = b0 ? r01 : x0, n1 = b0 ? x1 : r01, n2 = b0 ? r23 : x2, n3 = b0 ? x3 : r23; x0 = n0; x1 = n1; x2 = n2; x3 = n3; }
        { const float r02 = QSWAP2(b1 ? x0 : x2), r13 = QSWAP2(b1 ? x1 : x3);
          const float n0 = b1 ? r02 : x0, n2 = b1 ? x2 : r02, n1 = b1 ? r13 : x1, n3 = b1 ? x3 : r13; x0 = n0; x1 = n1; x2 = n2; x3 = n3; }
        const u32x2 g = gg[r];
        *(u32x2*)(Ob + (long)orow * 4096 + colb) = (u32x2){cvtpk(x0 * __uint_as_float(g[0] << 16), x1 * __uint_as_float(g[0] & 0xffff0000u)), cvtpk(x2 * __uint_as_float(g[1] << 16), x3 * __uint_as_float(g[1] & 0xffff0000u))}; }
#undef QSWAP1
#undef QSWAP2
    __syncthreads();
#undef VMW
#undef SBAR
#undef SLOAD
#undef SWRITE
#undef RESC
#undef ACT
#undef HALF_STEP
}
__device__ __forceinline__ void phase_attention(const Params& p, char* lds) {
    for (int it = blockIdx.x; it < 256; it += gridDim.x) {
        const int xcd = it & 7, idx = it >> 3, hh = xcd * 2 + (idx >> 4), x = idx & 15;
        for (int half = 0; half < 2; ++half) { const int P0 = (half ? x : 31 - x) * 256;
            attn_block(lds, p.Q + (long)P0 * NQ + hh * QD, p.Kf + (long)hh * S * QD, p.Vf + (long)hh * S * VH, p.zB + (long)P0 * ZB + hh * VH, p.OH + (long)P0 * 4096 + hh * VH, P0); }
    }
}

#ifndef PROBE_MASK
#define PROBE_MASK 0
#endif
#if PROBE_MASK
#define TICK(cls) do { const unsigned long long now_ = __builtin_amdgcn_s_memrealtime(); if ((PROBE_MASK >> (cls)) & 1) t_acc += now_ - t_last; t_last = now_; } while (0)
#else
#define TICK(cls) do { } while (0)
#endif
__global__ __launch_bounds__(NTHR, 2) void mega(Params p) {
    extern __shared__ __attribute__((aligned(16))) char lds[];
    cg::grid_group grid = cg::this_grid();
    const int G = gridDim.x;
    volatile LAS unsigned* xbst = (volatile LAS unsigned*)((LAS char*)lds + 8 * HTB);
    if (TID() == 0) { xbst[0] = 0u; xbst[1] = 0u; xbst[2] = 0u; xbst[3] = 0u; }
    __syncthreads();
    if (blockIdx.x == 0) for (int i = TID(); i < XCD_BAR_WORDS; i += NTHR) p.bar[i] = 0u;
#if PROBE_MASK
    unsigned long long t_acc = 0, t_last = __builtin_amdgcn_s_memrealtime();
#endif
    phase_prologue(p, lds);
    phase_xb_ssq(p.x_in, p.hb, p.ssqA);
    grid.sync();
    const XcdBarrier xb = xcd_barrier_post(p.bar, xbst);
    TICK(0);
    for (int l = 0; l < DEPTH; ++l) {
        const int c = (int)blockIdx.x + opaque_zero();
        const float* xcur = l ? p.xr : p.x_in;
        { TileSched sc{p.hb, DM, p.Wt_in + (size_t)l * NIN * DM, DM, 32, NIN / 256, G, c}; EpiIn e{p.zB, p.zA, p.ssqA}; gemm_fast(lds, DM, DM, DM, sc, e); }
        xcd_barrier(xb); TICK(2);
        phase_t2(p, l);
        xcd_barrier(xb); TICK(3);
        { TileSched sc{p.qn, QL, p.Wt_q + (size_t)l * NQ * QL, QL, 32, NQ / 256, G, c}; EpiQ e{p.Q, p.cs}; gemm_fast(lds, QL, QL, QL, sc, e); }
        { TileSched sc{p.kvn, KVL, p.Wt_kv + (size_t)l * NKV * KVL, KVL, 32, NKV / 256, G, (c + 128) % G}; EpiKV e{p.Kf, p.Vf}; gemm_fast(lds, KVL, KVL, KVL, sc, e); }
        { LruSched sc{{p.xc, DM, p.Wt_lru + (size_t)l * LRUB * 65536, 256, 32, LRUB, G, c}}; EpiLru e{p.xc, p.b_rg + l * DM, p.b_ig + l * DM, p.nsp8 + l * DM, p.la, p.lb}; gemm_fast(lds, 256, DM, 256, sc, e); }
        xcd_barrier(xb); TICK(4);
        phase_scan1(p);
        phase_attention(p, lds);
        xcd_barrier(xb); TICK(5);
        phase_scan3(p);
        xcd_barrier(xb); TICK(6);
        { MergeSched sc{{p.OH, 4096, p.Wt_o + (size_t)l * DM * 4096, 4096, 32, 8, G, c}}; EpiMerge e{p.zB, p.mg}; gemm_fast(lds, DM, 4096, 4096, sc, e); }
        xcd_barrier(xb); TICK(7);
        { TileSched sc{p.mg, DM, p.Wt_out + (size_t)l * DM * DM, DM, 32, 8, G, c}; EpiOut e{xcur, p.xr, p.hb2, p.ssqB}; gemm_fast(lds, DM, DM, DM, sc, e); }
        { TileSched sc{p.pb + (size_t)l * S * PLE, PLE, p.Wt_ple + (size_t)l * DM * PLE, PLE, 32, 8, G, c}; EpiF32 e{p.pp, DM}; gemm_fast(lds, PLE, PLE, PLE, sc, e); }
        xcd_barrier(xb); TICK(8);
        { TileSched sc{p.hb2, DM, p.Wt_pg + (size_t)l * DM * DM, DM, 32, 8, G, c}; EpiPle e{p.xr, p.pp, p.ssqB, p.hb, p.ssqA}; gemm_fast(lds, DM, DM, DM, sc, e); }
        xcd_barrier(xb); TICK(9);
    }
    phase_final_norm(p.xr, p.final_norm);
#if PROBE_MASK
    __syncthreads();
    if (blockIdx.x == 0) { const float d = sqrtf((float)t_acc * 0.01f * 4.096e-8f);
        for (int j = 0; j < 8; ++j) p.xr[threadIdx.x * 8 + j] += d; }
#endif
}

constexpr size_t LDS_BYTES = 8 * HTB + 16;

extern "C" void kernel_launch(void* const* d_in, const int* in_sizes, int n_in, void* d_out, int out_size, void* d_ws, size_t ws_size, hipStream_t st) {
    Params p{};
    p.x_in = (const float*)d_in[0]; p.p_in = (const float*)d_in[1]; p.pos = (const int*)d_in[2];
    p.attn_norm = (const float*)d_in[3]; p.w_in = (const float*)d_in[4]; p.q_a_norm = (const float*)d_in[5]; p.w_q_b = (const float*)d_in[6];
    p.kv_a_norm = (const float*)d_in[7]; p.w_kv_b = (const float*)d_in[8]; p.conv_w = (const float*)d_in[9]; p.conv_b = (const float*)d_in[10];
    p.w_rg = (const float*)d_in[11]; p.b_rg = (const float*)d_in[12]; p.w_ig = (const float*)d_in[13]; p.b_ig = (const float*)d_in[14]; p.lam = (const float*)d_in[15];
    p.w_o_mla = (const float*)d_in[16]; p.w_o_lru = (const float*)d_in[17]; p.w_out = (const float*)d_in[18]; p.ple_norm = (const float*)d_in[19];
    p.w_ple_gate = (const float*)d_in[20]; p.w_ple = (const float*)d_in[21]; p.final_norm = (const float*)d_in[22];
    p.xr = (float*)d_out;
    char* w = (char*)d_ws; size_t off = 0;
    auto take = [&](size_t bytes) { char* r = w + off; off += (bytes + 255) & ~(size_t)255; return r; };
    p.Wt_in = (u16*)take((size_t)DEPTH * NIN * DM * 2); p.Wt_q = (u16*)take((size_t)DEPTH * NQ * QL * 2); p.Wt_kv = (u16*)take((size_t)DEPTH * NKV * KVL * 2);
    p.Wt_lru = (u16*)take((size_t)DEPTH * LRUB * 65536 * 2); p.Wt_o = (u16*)take((size_t)DEPTH * DM * 4096 * 2); p.Wt_out = (u16*)take((size_t)DEPTH * DM * DM * 2);
    p.Wt_pg = (u16*)take((size_t)DEPTH * DM * DM * 2); p.Wt_ple = (u16*)take((size_t)DEPTH * DM * PLE * 2);
    p.hb = (u16*)take((size_t)S * DM * 2); p.hb2 = (u16*)take((size_t)S * DM * 2); p.ssqA = (float*)take((size_t)S * 4); p.ssqB = (float*)take((size_t)S * 4); p.zB = (u16*)take((size_t)S * ZB * 2); p.zA = (float*)take((size_t)S * ZA * 4);
    p.qn = (u16*)take((size_t)S * QL * 2); p.kvn = (u16*)take((size_t)S * KVL * 2); p.Q = (u16*)take((size_t)S * NQ * 2);
    p.Kf = (u16*)take((size_t)NH * S * QD * 2); p.Vf = (u16*)take((size_t)NH * S * VH * 2); p.xc = (u16*)take((size_t)S * DM * 2);
    p.OH = (u16*)take((size_t)S * 4096 * 2); p.pb = (u16*)take((size_t)DEPTH * S * PLE * 2); p.cs = (float*)take((size_t)S * 64 * 4); p.carry = (float*)take((size_t)3 * 128 * DM * 4); p.nsp8 = (float*)take((size_t)DEPTH * DM * 4); p.bar = (unsigned*)take((size_t)XCD_BAR_WORDS * 4);
    p.la = (float*)take((size_t)S * DM * 4); p.lb = (float*)take((size_t)S * DM * 4); p.pp = (float*)take((size_t)S * DM * 4); p.mg = (u16*)take((size_t)S * DM * 2);
    if (off > ws_size) { fprintf(stderr, "workspace too small: need %zu have %zu\n", off, ws_size); return; }
    (void)hipFuncSetAttribute((const void*)mega, hipFuncAttributeMaxDynamicSharedMemorySize, (int)LDS_BYTES);
    int dev = 0, cus = 0; (void)hipGetDevice(&dev); (void)hipDeviceGetAttribute(&cus, hipDeviceAttributeMultiprocessorCount, dev);
    int per_cu = 0; (void)hipOccupancyMaxActiveBlocksPerMultiprocessor(&per_cu, mega, NTHR, LDS_BYTES);
    if (per_cu < 1 || cus < 1) { fprintf(stderr, "occupancy query failed\n"); return; }
    void* args[] = {&p};
    hipError_t e = hipLaunchCooperativeKernel((const void*)mega, dim3(cus), dim3(NTHR), args, LDS_BYTES, st);
    if (e != hipSuccess) fprintf(stderr, "cooperative launch failed: %s\n", hipGetErrorString(e));
}
```

```cpp
#include <hip/hip_runtime.h>
#include <hip/hip_cooperative_groups.h>
#include <cstdio>
#include <cstdint>
namespace cg = cooperative_groups;

constexpr int S = 8192, DM = 2048, DEPTH = 4, NH = 16, QL = 512, KVL = 512, NOPE = 128, ROPE = 64, VH = 128;
constexpr int INT = 11328, PLE = 256, LRUB = 16, LBD = 128;
constexpr int QD = 192, NQ = NH * QD  , NKV = NH * 256  ;
constexpr int NIN = 11520;
constexpr int ZB = 10240, ZA = 1280;
constexpr int NTHR = 512;
constexpr float QSCALE = 0.07216878364870322f * 1.4426950408889634f;

typedef unsigned short u16;
typedef short bf16x8 __attribute__((ext_vector_type(8)));
typedef float f32x4 __attribute__((ext_vector_type(4)));
typedef float f32x2 __attribute__((ext_vector_type(2)));
typedef unsigned u32x2 __attribute__((ext_vector_type(2)));
typedef unsigned u32x4 __attribute__((ext_vector_type(4)));

__device__ __forceinline__ u16 f2bf(float f) { unsigned u = __float_as_uint(f); u += 0x7FFFu + ((u >> 16) & 1u); return (u16)(u >> 16); }
__device__ __forceinline__ float bf2f(u16 b) { return __uint_as_float(((unsigned)b) << 16); }
__device__ __forceinline__ unsigned pk2(float lo, float hi) { unsigned r; asm volatile("v_cvt_pk_bf16_f32 %0, %1, %2" : "=v"(r) : "v"(lo), "v"(hi)); return r; }
__device__ __forceinline__ float sigmoidf_(float x) { return __builtin_amdgcn_rcpf(1.f + __builtin_amdgcn_exp2f(-1.4426950408889634f * x)); }
__device__ __forceinline__ float siluf_(float x) { return x * __builtin_amdgcn_rcpf(1.f + __builtin_amdgcn_exp2f(-1.4426950408889634f * x)); }
__device__ __forceinline__ int opaque_zero() { int z; asm volatile("s_mov_b32 %0, 0" : "=s"(z)); return z; }
#define TID() ((int)threadIdx.x + opaque_zero())
__device__ __forceinline__ float wsum(float s, int lane) { for (int off = 32; off; off >>= 1) s += __int_as_float(__builtin_amdgcn_ds_bpermute((lane ^ off) << 2, __float_as_int(s))); return s; }
__device__ __forceinline__ float wmax(float s, int lane) { for (int off = 32; off; off >>= 1) s = fmaxf(s, __int_as_float(__builtin_amdgcn_ds_bpermute((lane ^ off) << 2, __float_as_int(s)))); return s; }

struct Params {
    const float *x_in, *p_in; const int* pos;
    const float *attn_norm, *w_in, *q_a_norm, *w_q_b, *kv_a_norm, *w_kv_b, *conv_w, *conv_b, *w_rg, *b_rg, *w_ig, *b_ig, *lam, *w_o_mla, *w_o_lru, *w_out, *ple_norm, *w_ple_gate, *w_ple, *final_norm;
    float* xr;
    u16 *Wt_in, *Wt_q, *Wt_kv, *Wt_lru, *Wt_o, *Wt_out, *Wt_pg, *Wt_ple;
    u16 *hb, *hb2, *zB, *qn, *kvn, *Q, *Kf, *Vf, *xc, *OH, *mg, *pb, *Pm;
    float *zA, *la, *lb, *pp, *cs, *carry, *sc, *nsp8, *ssqA, *ssqB; unsigned* bar;
};

struct Unit { const u16* a; const u16* b; int pm, pn, aux; };

struct TileSched {
    const u16* A; long lda; const u16* B; long ldb; int nM, nN, G, c;
    __device__ __forceinline__ bool tile(int i, int& pm, int& pn) const {
        const int nwg = nM * nN; const long L = (long)i * G + c; if (L >= nwg) return false;
        int wgid = (int)L; { const int q = nwg / 8, r = nwg % 8, xcd = wgid % 8, off = wgid / 8; wgid = (xcd < r ? xcd * (q + 1) : r * (q + 1) + (xcd - r) * q) + off; }
        const int nig = 8 * nN, gid = wgid / nig, fm = gid * 8, gsz = (nM - fm) < 8 ? (nM - fm) : 8;
        pm = fm + ((wgid % nig) % gsz); pn = (wgid % nig) / gsz; return true;
    }
    __device__ __forceinline__ bool next(int i, Unit& u) const {
        if (!tile(i, u.pm, u.pn)) return false;
        u.a = A + (long)u.pm * 256 * lda; u.b = B + (long)u.pn * 256 * ldb; u.aux = 0; return true;
    }
};
struct LruSched : TileSched {
    __device__ __forceinline__ bool next(int i, Unit& u) const {
        if (!tile(i, u.pm, u.pn)) return false;
        u.a = A + (long)u.pm * 256 * lda + (u.pn >> 1) * 256; u.b = B + (long)u.pn * 65536; u.aux = 0; return true;
    }
};
struct MergeSched : TileSched {
    __device__ __forceinline__ bool next(int i, Unit& u) const {
        if (!tile(i >> 1, u.pm, u.pn)) return false;
        u.aux = i & 1; u.a = A + (long)u.pm * 256 * lda + u.aux * 2048; u.b = B + (long)u.pn * 256 * ldb + u.aux * 2048; return true;
    }
};
struct TriSched {
    const u16* A; long lda; const u16* B; long ldb; int G, c;
    __device__ __forceinline__ bool next(int i, Unit& u) const {
        int t = i * G + c; if (t >= 528) return false;
        int pm = 0; while (t >= pm + 1) { t -= pm + 1; ++pm; }
        u.pm = pm; u.pn = t; u.a = A + (long)pm * 256 * lda; u.b = B + (long)t * 256 * ldb; u.aux = 0; return true;
    }
};
struct RowSched {
    const u16* A; long lda; const u16* B; int G, c;
    __device__ __forceinline__ bool next(int i, Unit& u) const {
        const int t = i * G + c; if (t >= 32) return false;
        u.pm = 31 - t; u.pn = 0; u.a = A + (long)u.pm * 256 * lda; u.b = B; u.aux = 0; return true;
    }
};

template <class F>
__device__ __forceinline__ void epi_foreach(f32x4 (&acc)[2][2][4][2], const Unit& u, int wr, int wc, int fr, int fq, F f) {
    const int row0 = u.pm * 256 + wr * 64 + fr, col0 = u.pn * 256 + wc * 32 + 4 * fq;
#pragma unroll
    for (int ai = 0; ai < 2; ++ai)
#pragma unroll
        for (int m = 0; m < 4; ++m) {
#pragma unroll
            for (int bj = 0; bj < 2; ++bj)
#pragma unroll
                for (int n = 0; n < 2; ++n) f(row0 + ai * 128 + m * 16, col0 + bj * 128 + n * 16, acc[ai][bj][m][n]);
        }
}
template <int GM, class T, class LF, class F>
__device__ __forceinline__ void epi_foreach_ld(f32x4 (&acc)[2][2][4][2], const Unit& u, int wr, int wc, int fr, int fq, LF lf, F f) {
    const int row0 = u.pm * 256 + wr * 64 + fr, col0 = u.pn * 256 + wc * 32 + 4 * fq;
#pragma unroll
    for (int ai = 0; ai < 2; ++ai)
#pragma unroll
        for (int mg = 0; mg < 4; mg += GM) {
            T regs[GM][2][2];
#pragma unroll
            for (int m = 0; m < GM; ++m)
#pragma unroll
                for (int bj = 0; bj < 2; ++bj)
#pragma unroll
                    for (int n = 0; n < 2; ++n) regs[m][bj][n] = lf(row0 + ai * 128 + (mg + m) * 16, col0 + bj * 128 + n * 16);
#pragma unroll
            for (int m = 0; m < GM; ++m)
#pragma unroll
                for (int bj = 0; bj < 2; ++bj)
#pragma unroll
                    for (int n = 0; n < 2; ++n) f(row0 + ai * 128 + (mg + m) * 16, col0 + bj * 128 + n * 16, acc[ai][bj][mg + m][n], regs[m][bj][n]);
        }
}
template <class F>
__device__ __forceinline__ void epi_foreach8(f32x4 (&acc)[2][2][4][2], const Unit& u, int wr, int wc, int fr, int fq, F f) {
    const int row0 = u.pm * 256 + wr * 64 + fr, col0 = u.pn * 256 + wc * 32 + 8 * fq;
#pragma unroll
    for (int ai = 0; ai < 2; ++ai)
#pragma unroll
        for (int m = 0; m < 4; ++m)
#pragma unroll
            for (int bj = 0; bj < 2; ++bj) f(row0 + ai * 128 + m * 16, col0 + bj * 128, acc[ai][bj][m][0], acc[ai][bj][m][1]);
}
template <class T, class LF, class F>
__device__ __forceinline__ void epi_foreach8_ld(f32x4 (&acc)[2][2][4][2], const Unit& u, int wr, int wc, int fr, int fq, LF lf, F f) {
    const int row0 = u.pm * 256 + wr * 64 + fr, col0 = u.pn * 256 + wc * 32 + 8 * fq;
#pragma unroll
    for (int ai = 0; ai < 2; ++ai) {
        T regs[4][2];
#pragma unroll
        for (int m = 0; m < 4; ++m)
#pragma unroll
            for (int bj = 0; bj < 2; ++bj) regs[m][bj] = lf(row0 + ai * 128 + m * 16, col0 + bj * 128);
#pragma unroll
        for (int m = 0; m < 4; ++m)
#pragma unroll
            for (int bj = 0; bj < 2; ++bj) f(row0 + ai * 128 + m * 16, col0 + bj * 128, acc[ai][bj][m][0], acc[ai][bj][m][1], regs[m][bj]);
    }
}
__device__ __forceinline__ u32x4 pack8(const f32x4& a, const f32x4& b) { return (u32x4){pk2(a[0], a[1]), pk2(a[2], a[3]), pk2(b[0], b[1]), pk2(b[2], b[3])}; }
#define EPI_COMMON  __device__ __forceinline__ bool keep(const Unit&) const { return false; } __device__ __forceinline__ int klimit(const Unit&, int K) const { return K; }
#define EPI_SIG     __device__ __forceinline__ void operator()(f32x4 (&acc)[2][2][4][2], const Unit& u, int wr, int wc, int fr, int fq) const

__device__ __forceinline__ float rinv_of(float ss) { return rsqrtf(ss * (1.f / DM) + 1e-6f); }
struct EpiIn { EPI_COMMON u16* zB; float* zA; const float* ssq;
    EPI_SIG { const int seg = u.pn >> 3;
        const int row0 = u.pm * 256 + wr * 64 + fr, col0 = u.pn * 256 + wc * 32 + 8 * fq;
        float ri[2][4];
#pragma unroll
        for (int ai = 0; ai < 2; ++ai)
#pragma unroll
            for (int m = 0; m < 4; ++m) ri[ai][m] = ssq[row0 + ai * 128 + m * 16];
#pragma unroll
        for (int ai = 0; ai < 2; ++ai)
#pragma unroll
            for (int m = 0; m < 4; ++m) ri[ai][m] = rinv_of(ri[ai][m]);
        if (seg >= 5) {
#pragma unroll
            for (int ai = 0; ai < 2; ++ai)
#pragma unroll
                for (int m = 0; m < 4; ++m)
#pragma unroll
                    for (int bj = 0; bj < 2; ++bj) { const int row = row0 + ai * 128 + m * 16, col = col0 + bj * 128;
                        if (col < ZB + 1088) { float* d = zA + (long)row * ZA + (col - ZB); *(f32x4*)d = acc[ai][bj][m][0] * ri[ai][m]; *(f32x4*)(d + 4) = acc[ai][bj][m][1] * ri[ai][m]; } }
        } else { const bool sil = seg == 0 || seg == 2, ident = seg == 1;
#pragma unroll
            for (int ai = 0; ai < 2; ++ai)
#pragma unroll
                for (int m = 0; m < 4; ++m)
#pragma unroll
                    for (int bj = 0; bj < 2; ++bj) { const int row = row0 + ai * 128 + m * 16, col = col0 + bj * 128;
                        f32x4 o0 = acc[ai][bj][m][0] * ri[ai][m], o1 = acc[ai][bj][m][1] * ri[ai][m];
                        if (!ident) {
#pragma unroll
                            for (int e = 0; e < 4; ++e) { const float s0 = sigmoidf_(o0[e]), s1 = sigmoidf_(o1[e]); o0[e] = sil ? o0[e] * s0 : s0; o1[e] = sil ? o1[e] * s1 : s1; } }
                        *(u32x4*)(zB + (long)row * ZB + col) = (u32x4){pk2(o0[0], o0[1]), pk2(o0[2], o0[3]), pk2(o1[0], o1[1]), pk2(o1[2], o1[3])}; }
        }
    } };
struct CsT { f32x4 c, s; };
struct EpiQ { EPI_COMMON u16* Q; const float* cs;
    EPI_SIG { epi_foreach8_ld<CsT>(acc, u, wr, wc, fr, fq,
            [&](int row, int col) { const int d = col % QD; CsT t; t.c = (f32x4){1.f, 1.f, 1.f, 1.f}; t.s = (f32x4){0.f, 0.f, 0.f, 0.f};
                if (d >= NOPE) { const float* tp = cs + (long)row * 64 + ((d - NOPE) >> 1); t.c = *(const f32x4*)tp; t.s = *(const f32x4*)(tp + 32); }
                return t; },
            [&](int row, int col, f32x4& v0, f32x4& v1, const CsT& t) { f32x4 o0, o1;
                const int d = col % QD;
                if (d < NOPE) { o0 = v0 * QSCALE; o1 = v1 * QSCALE; }
                else { o0[0] = (v0[0] * t.c[0] - v0[1] * t.s[0]) * QSCALE; o0[1] = (v0[1] * t.c[0] + v0[0] * t.s[0]) * QSCALE;
                       o0[2] = (v0[2] * t.c[1] - v0[3] * t.s[1]) * QSCALE; o0[3] = (v0[3] * t.c[1] + v0[2] * t.s[1]) * QSCALE;
                       o1[0] = (v1[0] * t.c[2] - v1[1] * t.s[2]) * QSCALE; o1[1] = (v1[1] * t.c[2] + v1[0] * t.s[2]) * QSCALE;
                       o1[2] = (v1[2] * t.c[3] - v1[3] * t.s[3]) * QSCALE; o1[3] = (v1[3] * t.c[3] + v1[2] * t.s[3]) * QSCALE; }
                *(u32x4*)(Q + (long)row * NQ + col) = pack8(o0, o1); }); } };
struct EpiKV { EPI_COMMON u16* Kf; u16* Vf;
    EPI_SIG { epi_foreach8(acc, u, wr, wc, fr, fq, [&](int row, int col, f32x4& v0, f32x4& v1) {
            const int hh = col >> 8, j = col & 255;
            u16* dst = (j < 128) ? Kf + ((long)hh * S + row) * QD + j : Vf + ((long)hh * S + row) * VH + (j - 128);
            *(u32x4*)dst = pack8(v0, v1);
        }); } };
struct EpiLru { EPI_COMMON const u16* xc; const float *brg, *big, *nsp8; float *la, *lb;
    EPI_SIG {
        const int row0 = u.pm * 256 + wr * 64 + fr, col0 = u.pn * 256 + wc * 32 + 8 * fq;
        f32x4 cr[2], ci[2], cn[2];
#pragma unroll
        for (int bj = 0; bj < 2; ++bj) { const int ch = (col0 + bj * 128) >> 1; cr[bj] = *(const f32x4*)(brg + ch); ci[bj] = *(const f32x4*)(big + ch); cn[bj] = *(const f32x4*)(nsp8 + ch); }
#pragma unroll
        for (int ai = 0; ai < 2; ++ai) {
            u32x2 xw[4][2];
#pragma unroll
            for (int m = 0; m < 4; ++m)
#pragma unroll
                for (int bj = 0; bj < 2; ++bj) xw[m][bj] = *(const u32x2*)(xc + (long)(row0 + ai * 128 + m * 16) * DM + ((col0 + bj * 128) >> 1));
#pragma unroll
            for (int m = 0; m < 4; ++m)
#pragma unroll
                for (int bj = 0; bj < 2; ++bj) {
                    const long o = (long)(row0 + ai * 128 + m * 16) * DM + ((col0 + bj * 128) >> 1);
                    f32x4 av, bv;
#pragma unroll
                    for (int e = 0; e < 4; ++e) {
                        const f32x4 v = acc[ai][bj][m][e >> 1];
                        const float r = sigmoidf_(v[2 * (e & 1)] + cr[bj][e]), ii = sigmoidf_(v[2 * (e & 1) + 1] + ci[bj][e]);
                        const float lg = r * cn[bj][e], x2 = 2.f * lg;
                        const float a = __builtin_amdgcn_exp2f(1.4426950408889634f * lg);
                        const float em = (x2 > -0.25f) ? x2 * (1.f + x2 * (0.5f + x2 * (0.16666667f + x2 * (0.041666668f + x2 * 0.0083333338f)))) : (a * a - 1.f);
                        const unsigned w = xw[m][bj][e >> 1];
                        const float x = (e & 1) ? __uint_as_float(w & 0xffff0000u) : __uint_as_float(w << 16);
                        av[e] = a; bv[e] = __builtin_amdgcn_sqrtf(-em) * (ii * x); }
                    *(f32x4*)(la + o) = av; *(f32x4*)(lb + o) = bv; }
        }
    } };
struct SmSl { u32x4 sm, sl; };
__device__ __forceinline__ void unpack8(const u32x4& w, f32x4& a, f32x4& b) {
    a = (f32x4){__uint_as_float(w[0] << 16), __uint_as_float(w[0] & 0xffff0000u), __uint_as_float(w[1] << 16), __uint_as_float(w[1] & 0xffff0000u)};
    b = (f32x4){__uint_as_float(w[2] << 16), __uint_as_float(w[2] & 0xffff0000u), __uint_as_float(w[3] << 16), __uint_as_float(w[3] & 0xffff0000u)}; }
struct EpiMerge { const u16* zB; u16* mg;
    __device__ __forceinline__ bool keep(const Unit& u) const { return u.aux == 0; }
    __device__ __forceinline__ int klimit(const Unit&, int K) const { return K; }
    EPI_SIG { const int part = u.aux;
        epi_foreach8_ld<SmSl>(acc, u, wr, wc, fr, fq,
            [&](int row, int col) { SmSl t; t.sl = *(const u32x4*)(zB + (long)row * ZB + 8192 + col); t.sm = t.sl; if (part == 0) t.sm = *(const u32x4*)(zB + (long)row * ZB + 6144 + col); return t; },
            [&](int row, int col, f32x4& v0, f32x4& v1, const SmSl& t) {
            f32x4 l0, l1; unpack8(t.sl, l0, l1);
#pragma unroll
            for (int e = 0; e < 4; ++e) { l0[e] = fmaxf(l0[e], 1e-12f); l1[e] = fmaxf(l1[e], 1e-12f); }
            if (part == 0) { f32x4 m0, m1; unpack8(t.sm, m0, m1);
#pragma unroll
                for (int e = 0; e < 4; ++e) { v0[e] = v0[e] * m0[e] * __builtin_amdgcn_rcpf(l0[e]); v1[e] = v1[e] * m1[e] * __builtin_amdgcn_rcpf(l1[e]); }
            } else { *(u32x4*)(mg + (long)row * DM + col) = pack8(v0 * l0, v1 * l1); }
        }); } };
__device__ __forceinline__ void row_ssq_add(float sq, float* ssq, int row, int lane) {
    sq += __int_as_float(__builtin_amdgcn_ds_bpermute((lane ^ 16) << 2, __float_as_int(sq)));
    sq += __int_as_float(__builtin_amdgcn_ds_bpermute((lane ^ 32) << 2, __float_as_int(sq)));
    if (lane < 16) atomicAdd(ssq + row, sq);
}
struct EpiOut { EPI_COMMON const float* xold; float* xnew; u16* xb; float* ssq;
    EPI_SIG {
        const int row0 = u.pm * 256 + wr * 64 + fr, col0 = u.pn * 256 + wc * 32 + 8 * fq, lane = fq * 16 + fr;
#pragma unroll
        for (int ai = 0; ai < 2; ++ai) {
            f32x4 xo[4][2][2];
#pragma unroll
            for (int m = 0; m < 4; ++m)
#pragma unroll
                for (int bj = 0; bj < 2; ++bj) { const float* q = xold + (long)(row0 + ai * 128 + m * 16) * DM + col0 + bj * 128; xo[m][bj][0] = *(const f32x4*)q; xo[m][bj][1] = *(const f32x4*)(q + 4); }
#pragma unroll
            for (int m = 0; m < 4; ++m) { const int row = row0 + ai * 128 + m * 16; float sq = 0.f;
#pragma unroll
                for (int bj = 0; bj < 2; ++bj) { const f32x4 x0 = xo[m][bj][0] + acc[ai][bj][m][0], x1 = xo[m][bj][1] + acc[ai][bj][m][1]; const long idx = (long)row * DM + col0 + bj * 128;
                    *(f32x4*)(xnew + idx) = x0; *(f32x4*)(xnew + idx + 4) = x1; *(u32x4*)(xb + idx) = pack8(x0, x1);
                    sq += x0[0] * x0[0] + x0[1] * x0[1] + x0[2] * x0[2] + x0[3] * x0[3] + x1[0] * x1[0] + x1[1] * x1[1] + x1[2] * x1[2] + x1[3] * x1[3]; }
                row_ssq_add(sq, ssq, row, lane); }
        }
    } };
struct EpiF32 { EPI_COMMON float* C; long ldc;
    EPI_SIG { epi_foreach8(acc, u, wr, wc, fr, fq, [&](int row, int col, f32x4& v0, f32x4& v1) { float* d = C + (long)row * ldc + col; *(f32x4*)d = v0; *(f32x4*)(d + 4) = v1; }); } };
struct EpiPle { EPI_COMMON float* x; const float* pp; const float* ssq_in; u16* xb; float* ssq_out;
    EPI_SIG {
        const int row0 = u.pm * 256 + wr * 64 + fr, col0 = u.pn * 256 + wc * 32 + 8 * fq, lane = fq * 16 + fr;
#pragma unroll
        for (int ai = 0; ai < 2; ++ai)
#pragma unroll
            for (int mg = 0; mg < 4; mg += 2) {
                f32x4 xo[2][2][2], po[2][2][2]; float ss[2];
#pragma unroll
                for (int m = 0; m < 2; ++m) { const int row = row0 + ai * 128 + (mg + m) * 16; ss[m] = ssq_in[row];
#pragma unroll
                    for (int bj = 0; bj < 2; ++bj) { const long idx = (long)row * DM + col0 + bj * 128;
                        xo[m][bj][0] = *(const f32x4*)(x + idx); xo[m][bj][1] = *(const f32x4*)(x + idx + 4); po[m][bj][0] = *(const f32x4*)(pp + idx); po[m][bj][1] = *(const f32x4*)(pp + idx + 4); } }
#pragma unroll
                for (int m = 0; m < 2; ++m) { const int row = row0 + ai * 128 + (mg + m) * 16; const float ri = rinv_of(ss[m]); float sq = 0.f;
#pragma unroll
                    for (int bj = 0; bj < 2; ++bj) { f32x4 x0 = xo[m][bj][0], x1 = xo[m][bj][1]; const f32x4 v0 = acc[ai][bj][mg + m][0], v1 = acc[ai][bj][mg + m][1]; const long idx = (long)row * DM + col0 + bj * 128;
#pragma unroll
                        for (int e = 0; e < 4; ++e) { x0[e] += po[m][bj][0][e] * sigmoidf_(v0[e] * ri); x1[e] += po[m][bj][1][e] * sigmoidf_(v1[e] * ri); }
                        *(f32x4*)(x + idx) = x0; *(f32x4*)(x + idx + 4) = x1; *(u32x4*)(xb + idx) = pack8(x0, x1);
                        sq += x0[0] * x0[0] + x0[1] * x0[1] + x0[2] * x0[2] + x0[3] * x0[3] + x1[0] * x1[0] + x1[1] * x1[1] + x1[2] * x1[2] + x1[3] * x1[3]; }
                    row_ssq_add(sq, ssq_out, row, lane); }
            }
    } };

#define LAS __attribute__((address_space(3)))
constexpr int HTB = 128 * 64 * 2;
__device__ __forceinline__ int lds_byte(int r, int c) { const int st = (r >> 4) * 2 + (c >> 5), rr = r & 15, cc = c & 31, ob = rr * 64 + cc * 2; return st * 1024 + (ob ^ (((ob >> 9) & 1) << 5)); }
__device__ __forceinline__ void stage_rc(int b, int& R, int& C) { const int st = b / 1024, sb = b % 1024, swz = sb ^ (((sb >> 9) & 1) << 5); R = (st >> 1) * 16 + swz / 64; C = (st & 1) * 32 + (swz % 64) / 2; }

template <class Epi, class Sched>
__device__ __forceinline__ void gemm_fast(char* lds_, int K, long lda, long ldb, const Sched& S_, const Epi& E) {
    LAS unsigned char* lds = (LAS unsigned char*)lds_;
    const int tid = TID(), wid = __builtin_amdgcn_readfirstlane(tid >> 6), lane = tid & 63, wr = wid >> 2, wc = wid & 3, fr = lane & 15, fq = lane >> 4;
    const int nt = K / 64;
    unsigned voffA[2], voffB[2];
#pragma unroll
    for (int i = 0; i < 2; ++i) { int R, C; stage_rc(tid * 16 + i * 8192, R, C); voffA[i] = (unsigned)(R * lda + C) * 2u; voffB[i] = (unsigned)(R * ldb + C) * 2u; }
    const size_t kstep = 128;
    const size_t hstepA = (size_t)128 * lda * 2, hstepB = (size_t)128 * ldb * 2;
    const unsigned ldsw = (unsigned)wid * 1024u;
    const int aoff = lds_byte(wr * 64 + fr, fq * 8), boff = lds_byte(wc * 32 + fr, fq * 8);
#define G_SA(b, h) (((b) * 2 + (h)) * HTB)
#define G_SB(b, h) ((4 + (b) * 2 + (h)) * HTB)
#define G_STAGE(bufoff, gbase, voff) do { _Pragma("unroll") for (int _i = 0; _i < 2; ++_i) \
        __builtin_amdgcn_global_load_lds((const unsigned*)((const char*)(gbase) + (voff)[_i]), (LAS unsigned*)(lds + (bufoff) + ldsw + _i * 8192), 16, 0, 0); } while (0)
#define G_LDA(dst, b, h) do { _Pragma("unroll") for (int m = 0; m < 4; ++m) _Pragma("unroll") for (int k = 0; k < 2; ++k) dst[m][k] = *(const LAS bf16x8*)(lds + G_SA(b, h) + aoff + m * 2048 + k * 1024); } while (0)
#define G_LDB(dst, b, h) do { _Pragma("unroll") for (int n = 0; n < 2; ++n) _Pragma("unroll") for (int k = 0; k < 2; ++k) dst[n][k] = *(const LAS bf16x8*)(lds + G_SB(b, h) + boff + n * 2048 + k * 1024); } while (0)
#define G_MMA(ai, bj, At, Bt) do { __builtin_amdgcn_s_setprio(1); _Pragma("unroll") for (int m = 0; m < 4; ++m) _Pragma("unroll") for (int n = 0; n < 2; ++n) _Pragma("unroll") for (int k = 0; k < 2; ++k) \
        acc[ai][bj][m][n] = __builtin_amdgcn_mfma_f32_16x16x32_bf16(Bt[n][k], At[m][k], acc[ai][bj][m][n], 0, 0, 0); __builtin_amdgcn_s_setprio(0); } while (0)
#define G_WAIT_V(n) asm volatile("s_waitcnt vmcnt(" #n ")" ::: "memory")
#define G_WAIT_L(n) asm volatile("s_waitcnt lgkmcnt(" #n ")" ::: "memory")
#define G_BAR __builtin_amdgcn_s_barrier()
#define G_SCHED __builtin_amdgcn_sched_barrier(0)
    Unit cur, nxt; int ui = 0;
    if (!S_.next(0, cur)) return;
    f32x4 acc[2][2][4][2];
#pragma unroll
    for (int a = 0; a < 2; ++a)
#pragma unroll
        for (int b = 0; b < 2; ++b)
#pragma unroll
            for (int m = 0; m < 4; ++m)
#pragma unroll
                for (int n = 0; n < 2; ++n) acc[a][b][m][n] = (f32x4){0.f, 0.f, 0.f, 0.f};
    bf16x8 At[4][2], B0[2][2], B1[2][2];
    const char* cA = (const char*)cur.a; const char* cB = (const char*)cur.b;
    G_STAGE(G_SB(0, 0), cB, voffB); G_STAGE(G_SA(0, 0), cA, voffA); G_STAGE(G_SB(0, 1), cB + hstepB, voffB); G_STAGE(G_SA(0, 1), cA + hstepA, voffA);
    if (wr == 1) G_BAR;
    G_WAIT_V(4); G_BAR;
    G_STAGE(G_SB(1, 0), cB + kstep, voffB); G_STAGE(G_SA(1, 0), cA + kstep, voffA); G_STAGE(G_SB(1, 1), cB + hstepB + kstep, voffB);
    G_WAIT_V(6); G_BAR;
    for (;;) {
        const bool has_next = S_.next(ui + 1, nxt);
        const char* nA = has_next ? (const char*)nxt.a : cA; const char* nB = has_next ? (const char*)nxt.b : cB;
#pragma unroll 1
        for (int t = 0; t < nt; t += 2) {
            const bool last = (t == nt - 2);
            const char* a1 = cA + (size_t)(t + 1) * kstep;
            const char* a2 = last ? nA : cA + (size_t)(t + 2) * kstep; const char* b2 = last ? nB : cB + (size_t)(t + 2) * kstep;
            const char* a3 = a2 + kstep; const char* b3 = b2 + kstep;
            G_LDB(B0, 0, 0); G_SCHED; G_LDA(At, 0, 0); G_STAGE(G_SA(1, 1), a1 + hstepA, voffA);
            G_WAIT_L(8); G_BAR; G_WAIT_L(0); G_MMA(0, 0, At, B0); G_BAR; G_SCHED;
            G_LDB(B1, 0, 1); G_STAGE(G_SB(0, 0), b2, voffB);
            G_BAR; G_WAIT_L(0); G_MMA(0, 1, At, B1); G_BAR;
            G_LDA(At, 0, 1); G_STAGE(G_SA(0, 0), a2, voffA);
            G_BAR; G_WAIT_L(0); G_MMA(1, 0, At, B0); G_BAR; G_SCHED;
            G_STAGE(G_SB(0, 1), b2 + hstepB, voffB);
            G_WAIT_V(6); G_BAR; G_MMA(1, 1, At, B1); G_BAR;
            G_LDB(B0, 1, 0); G_SCHED; G_LDA(At, 1, 0); G_STAGE(G_SA(0, 1), a2 + hstepA, voffA);
            G_WAIT_L(8); G_BAR; G_WAIT_L(0); G_MMA(0, 0, At, B0); G_BAR; G_SCHED;
            G_LDB(B1, 1, 1); G_STAGE(G_SB(1, 0), b3, voffB);
            G_BAR; G_WAIT_L(0); G_MMA(0, 1, At, B1); G_BAR;
            G_LDA(At, 1, 1); G_STAGE(G_SA(1, 0), a3, voffA);
            G_BAR; G_WAIT_L(0); G_MMA(1, 0, At, B0); G_BAR; G_SCHED;
            G_STAGE(G_SB(1, 1), b3 + hstepB, voffB);
            G_WAIT_V(6); G_BAR; G_MMA(1, 1, At, B1); G_BAR;
        }
        { const int t2 = TID(), w2 = t2 >> 6, l2 = t2 & 63;
          E(acc, cur, w2 >> 2, w2 & 3, l2 & 15, l2 >> 4); }
        if (!has_next) break;
        if (!E.keep(cur)) {
#pragma unroll
            for (int a = 0; a < 2; ++a)
#pragma unroll
                for (int b = 0; b < 2; ++b)
#pragma unroll
                    for (int m = 0; m < 4; ++m)
#pragma unroll
                        for (int n = 0; n < 2; ++n) acc[a][b][m][n] = (f32x4){0.f, 0.f, 0.f, 0.f};
        }
        cur = nxt; cA = nA; cB = nB; ++ui;
    }
    G_WAIT_V(0);
    if (wr == 0) G_BAR;
    G_BAR;
#undef G_SA
#undef G_SB
#undef G_STAGE
#undef G_LDA
#undef G_LDB
#undef G_MMA
#undef G_WAIT_V
#undef G_WAIT_L
#undef G_BAR
#undef G_SCHED
}


#define XB_TMO      128
#define XB_XCNT(j)  (256  + 64 * (j))
#define XB_XSUB(j)  (1280 + 64 * (j))
#define XB_XGEN(j)  (2304 + 64 * (j))
#define XB_TOP      3328
#define XB_TOPGEN   3392
#define XCD_BAR_WORDS 3456
#define XB_SPIN_CAP (1u << 18)
__device__ __forceinline__ unsigned xb_ld(unsigned* p)              { return __hip_atomic_load(p, __ATOMIC_RELAXED, __HIP_MEMORY_SCOPE_AGENT); }
__device__ __forceinline__ unsigned xb_add(unsigned* p, unsigned v) { return __hip_atomic_fetch_add(p, v, __ATOMIC_RELAXED, __HIP_MEMORY_SCOPE_AGENT); }
__device__ __forceinline__ unsigned xb_xcc_id() { return (unsigned)__builtin_amdgcn_s_getreg((3 << 11) | 20) & 0xFu; }
#define XB_SPIN(cond, bar) do { unsigned _sp = 0; while (cond) { __builtin_amdgcn_s_sleep(1); \
    if ((++_sp & 255u) == 0u) { if (xb_ld(&(bar)[XB_TMO])) break; if (_sp > XB_SPIN_CAP) { atomicAdd(&(bar)[XB_TMO], 1u); break; } } } } while (0)
struct XcdBarrier { unsigned* bar; unsigned x; volatile LAS unsigned* st; };
__device__ __forceinline__ XcdBarrier xcd_barrier_post(unsigned* bar, volatile LAS unsigned* st) {
    XcdBarrier b; b.bar = bar; b.x = xb_xcc_id(); b.st = st;
    if (TID() == 0) (void)xb_add(&bar[XB_XCNT(b.x)], 1u);
    return b;
}
__device__ __forceinline__ void xcd_barrier_complete(unsigned* bar, unsigned x, unsigned& nloc, unsigned& nx) {
    const unsigned G = gridDim.x * gridDim.y * gridDim.z;
    unsigned sum, cnt, mine, sp = 0u;
    for (;;) {
        sum = 0u; cnt = 0u; mine = 0u;
#pragma unroll
        for (unsigned j = 0; j < 16; ++j) { const unsigned c = xb_ld(&bar[XB_XCNT(j)]); sum += c; cnt += (c > 0u) ? 1u : 0u; mine = (j == x) ? c : mine; }
        if (sum == G) break;
        __builtin_amdgcn_s_sleep(1);
        if ((++sp & 255u) == 0u) { if (xb_ld(&bar[XB_TMO])) break; if (sp > XB_SPIN_CAP) { atomicAdd(&bar[XB_TMO], 1u); break; } }
    }
    nloc = mine > 0u ? mine : 1u; nx = cnt > 0u ? cnt : 1u;
}
__device__ __forceinline__ void xcd_barrier(const XcdBarrier& b) {
    asm volatile("s_waitcnt vmcnt(0)" ::: "memory");
    __syncthreads();
    if (TID() == 0) {
        unsigned* bar = b.bar;
        __builtin_amdgcn_s_waitcnt(0);
        unsigned nloc = b.st[0], nx = b.st[1];
        if (nloc == 0u) { xcd_barrier_complete(bar, b.x, nloc, nx); b.st[0] = nloc; b.st[1] = nx; }
        const unsigned old = xb_add(&bar[XB_XSUB(b.x)], 1u);
        const unsigned gen = old / nloc;
        if (old + 1u == (gen + 1u) * nloc) {
            __builtin_amdgcn_fence(__ATOMIC_RELEASE, "agent");
            asm volatile("s_waitcnt vmcnt(0)" ::: "memory");
            const unsigned og = xb_add(&bar[XB_TOP], 1u);
            const unsigned tg = og / nx;
            if (og + 1u == (tg + 1u) * nx) xb_add(&bar[XB_TOPGEN], 1u);
            else XB_SPIN(xb_ld(&bar[XB_TOPGEN]) == tg, bar);
            __builtin_amdgcn_fence(__ATOMIC_ACQUIRE, "agent");
            xb_add(&bar[XB_XGEN(b.x)], 1u);
            asm volatile("s_waitcnt vmcnt(0)" ::: "memory");
        } else {
            XB_SPIN(xb_ld(&bar[XB_XGEN(b.x)]) == gen, bar);
            __builtin_amdgcn_fence(__ATOMIC_ACQUIRE, "agent");
            asm volatile("s_waitcnt vmcnt(0)" ::: "memory");
        }
    }
    __syncthreads();
}

struct TDesc { const float* src; const float* ks; u16* dst; long ldd; int N, coff, rm, tix; };
constexpr int TS_IN = (DM / 256) * (INT / 64), TS_Q = (QL / 256) * (NQ / 64), TS_KV = (KVL / 256) * (NKV / 64), TS_SQ = (DM / 256) * (DM / 64), TS_PLE = (PLE / 256) * (DM / 64);
constexpr int TS_LAYER = TS_IN + TS_Q + TS_KV + 4 * TS_SQ + TS_PLE, TS_TOTAL = DEPTH * TS_LAYER;
__device__ __forceinline__ TDesc tdesc(const Params& p, int g) {
    const int l = g / TS_LAYER; int r = g % TS_LAYER; TDesc d; d.ks = nullptr; d.coff = 0; d.rm = 0;
    if (r < TS_IN) { d.src = p.w_in + (size_t)l * DM * INT; d.N = INT; d.dst = p.Wt_in + (size_t)l * NIN * DM; d.ldd = DM; d.rm = 1; d.ks = p.attn_norm + l * DM; d.tix = r; return d; }
    r -= TS_IN;
    if (r < TS_Q) { d.src = p.w_q_b + (size_t)l * QL * NQ; d.N = NQ; d.dst = p.Wt_q + (size_t)l * NQ * QL; d.ldd = QL; d.rm = 2; d.tix = r; return d; }
    r -= TS_Q;
    if (r < TS_KV) { d.src = p.w_kv_b + (size_t)l * KVL * NKV; d.N = NKV; d.dst = p.Wt_kv + (size_t)l * NKV * KVL; d.ldd = KVL; d.rm = 3; d.tix = r; return d; }
    r -= TS_KV;
    if (r < TS_SQ) { d.src = p.w_o_mla + (size_t)l * DM * DM; d.N = DM; d.dst = p.Wt_o + (size_t)l * DM * 4096; d.ldd = 4096; d.rm = 3; d.tix = r; return d; }
    r -= TS_SQ;
    if (r < TS_SQ) { d.src = p.w_o_lru + (size_t)l * DM * DM; d.N = DM; d.dst = p.Wt_o + (size_t)l * DM * 4096; d.ldd = 4096; d.coff = 2048; d.rm = 3; d.tix = r; return d; }
    r -= TS_SQ;
    if (r < TS_SQ) { d.src = p.w_out + (size_t)l * DM * DM; d.N = DM; d.dst = p.Wt_out + (size_t)l * DM * DM; d.ldd = DM; d.rm = 3; d.tix = r; return d; }
    r -= TS_SQ;
    if (r < TS_SQ) { d.src = p.w_ple_gate + (size_t)l * DM * DM; d.N = DM; d.dst = p.Wt_pg + (size_t)l * DM * DM; d.ldd = DM; d.rm = 3; d.ks = p.ple_norm + l * DM; d.tix = r; return d; }
    r -= TS_SQ;
    d.src = p.w_ple + (size_t)l * PLE * DM; d.N = DM; d.dst = p.Wt_ple + (size_t)l * DM * PLE; d.ldd = PLE; d.rm = 3; d.tix = r; return d;
}
__device__ __forceinline__ int pslot(int r) { const int c = r & 31; return (r & ~31) + 16 * ((c >> 2) & 1) + ((c >> 3) << 2) + (c & 3); }
__device__ __forceinline__ int trowmap(int rm, int n) {
    if (rm == 1) return pslot(n >= 1088 ? n - 1088 : n + ZB);
    if (rm == 2) { const int hh = n / QD, d = n % QD; if (d < NOPE) return pslot(n); const int e = d - NOPE; return pslot(hh * QD + NOPE + ((e & 31) << 1) + (e >> 5)); }
    if (rm == 3) return pslot(n);
    return n;
}
__device__ __forceinline__ void transpose_all(const Params& p, char* lds) {
    u16 (*t)[72] = (u16(*)[72])lds;
    const int tid = TID(), k = tid >> 3, nn = (tid & 7) * 8, G = gridDim.x;
    f32x4 vA[4][2], vB[4][2];
#define TC_LOAD(v_, d_) do { const int tn_ = (d_).N / 64, k0_ = ((d_).tix / tn_) * 256, n0_ = ((d_).tix % tn_) * 64; _Pragma("unroll") for (int j = 0; j < 4; ++j) { \
        const float* p_ = (d_).src + (long)(k0_ + k + 64 * j) * (d_).N + n0_ + nn; v_[j][0] = *(const f32x4*)p_; v_[j][1] = *(const f32x4*)(p_ + 4); \
        if ((d_).ks) { const float g_ = (d_).ks[k0_ + k + 64 * j]; v_[j][0] = v_[j][0] * g_; v_[j][1] = v_[j][1] * g_; } } } while (0)
#define TC_LDSW(v_) do { _Pragma("unroll") for (int j = 0; j < 4; ++j) *(u32x4*)&t[k + 64 * j][nn ^ (((k >> 3) & 7) << 3)] = (u32x4){pk2(v_[j][0][0], v_[j][0][1]), pk2(v_[j][0][2], v_[j][0][3]), pk2(v_[j][1][0], v_[j][1][1]), pk2(v_[j][1][2], v_[j][1][3])}; } while (0)
#define TC_STORE(d_) do { const int tn_ = (d_).N / 64, k0_ = ((d_).tix / tn_) * 256, n0_ = ((d_).tix % tn_) * 64; const int n_ = tid >> 3, kk_ = (tid & 7) * 8; \
        u16* drow_ = (d_).dst + (long)trowmap((d_).rm, n0_ + n_) * (d_).ldd + (d_).coff + k0_ + kk_; \
        _Pragma("unroll") for (int j = 0; j < 4; ++j) { u32x4 o_; _Pragma("unroll") for (int e = 0; e < 4; ++e) o_[e] = (unsigned)t[64 * j + kk_ + 2 * e][n_ ^ kk_] | ((unsigned)t[64 * j + kk_ + 2 * e + 1][n_ ^ kk_] << 16); \
            *(u32x4*)(drow_ + 64 * j) = o_; } } while (0)
    int gA = blockIdx.x, gB = gA + G; TDesc dA, dB, dc;
    if (gA < TS_TOTAL) { dA = tdesc(p, gA); TC_LOAD(vA, dA); }
    if (gB < TS_TOTAL) { dB = tdesc(p, gB); TC_LOAD(vB, dB); }
    while (gA < TS_TOTAL) {
        TC_LDSW(vA); __syncthreads(); dc = dA; gA += 2 * G; if (gA < TS_TOTAL) { dA = tdesc(p, gA); TC_LOAD(vA, dA); } TC_STORE(dc); __syncthreads();
        if (gB >= TS_TOTAL) break;
        TC_LDSW(vB); __syncthreads(); dc = dB; gB += 2 * G; if (gB < TS_TOTAL) { dB = tdesc(p, gB); TC_LOAD(vB, dB); } TC_STORE(dc); __syncthreads();
    }
#undef TC_LOAD
#undef TC_LDSW
#undef TC_STORE
}

__device__ __forceinline__ void phase_prologue(const Params& p, char* lds) {
    const long gtid = (long)blockIdx.x * NTHR + TID(), gsz = (long)gridDim.x * NTHR;
    transpose_all(p, lds);
    for (long i = gtid; i < (long)DEPTH * (NIN - INT) * DM / 8; i += gsz) { const long per = (long)(NIN - INT) * DM / 8; const int l = (int)(i / per); const long r = i % per;
        *(u32x4*)(p.Wt_in + ((size_t)l * NIN + INT) * DM + r * 8) = (u32x4){0u, 0u, 0u, 0u}; }
    for (long i = gtid; i < (long)DEPTH * LRUB * 256 * 256; i += gsz) {
        const int k = (int)(i & 255), o = (int)((i >> 8) & 255), blk = (int)((i >> 16) & 15), l = (int)(i >> 20);
        const int kk = k - 128 * (blk & 1), cl = o >> 1; float v = 0.f;
        if (kk >= 0 && kk < 128) v = ((o & 1) ? p.w_ig : p.w_rg)[(((size_t)l * LRUB + blk) * LBD + kk) * LBD + cl];
        p.Wt_lru[(((long)l * LRUB + blk) * 256 + pslot(o)) * 256 + k] = f2bf(v); }
    for (long i = gtid; i < (long)DEPTH * S * PLE / 8; i += gsz) { const float* s = p.p_in + i * 8; const f32x4 v0 = *(const f32x4*)s, v1 = *(const f32x4*)(s + 4);
        *(u32x4*)(p.pb + i * 8) = (u32x4){pk2(v0[0], v0[1]), pk2(v0[2], v0[3]), pk2(v1[0], v1[1]), pk2(v1[2], v1[3])}; }
    for (long i = gtid; i < (long)DEPTH * DM; i += gsz) p.nsp8[i] = -8.f * log1pf(expf(-p.lam[i]));
    for (long i = gtid; i < (long)S * 32; i += gsz) { const int s = (int)(i >> 5), f = (int)(i & 31);
        const float inv = powf(10000.f, -(float)(2 * f) / 64.f), ang = (float)p.pos[s] * inv;
        p.cs[(long)s * 64 + f] = (float)cos((double)ang); p.cs[(long)s * 64 + 32 + f] = (float)sin((double)ang); }
}

__device__ __forceinline__ void phase_xb_ssq(const float* __restrict__ x, u16* __restrict__ out, float* __restrict__ ssq) {
    const int tid = TID(), lane = tid & 63, gw = blockIdx.x * (NTHR / 64) + (tid >> 6), nw = gridDim.x * (NTHR / 64);
    for (int row = gw; row < S; row += nw) {
        const float* p = x + (long)row * DM; f32x4 v[8]; float s = 0.f;
#pragma unroll
        for (int j = 0; j < 8; ++j) { v[j] = *(const f32x4*)(p + j * 256 + lane * 4); s += v[j][0] * v[j][0] + v[j][1] * v[j][1] + v[j][2] * v[j][2] + v[j][3] * v[j][3]; }
        s = wsum(s, lane);
#pragma unroll
        for (int j = 0; j < 8; ++j) *(u32x2*)(out + (long)row * DM + j * 256 + lane * 4) = (u32x2){pk2(v[j][0], v[j][1]), pk2(v[j][2], v[j][3])};
        if (lane == 0) ssq[row] = s;
    }
}
__device__ __forceinline__ void phase_final_norm(float* __restrict__ x, const float* __restrict__ g) {
    const int tid = TID(), lane = tid & 63, gw = blockIdx.x * (NTHR / 64) + (tid >> 6), nw = gridDim.x * (NTHR / 64);
    for (int row = gw; row < S; row += nw) {
        float* p = x + (long)row * DM; f32x4 v[8]; float s = 0.f;
#pragma unroll
        for (int j = 0; j < 8; ++j) { v[j] = *(const f32x4*)(p + j * 256 + lane * 4); s += v[j][0] * v[j][0] + v[j][1] * v[j][1] + v[j][2] * v[j][2] + v[j][3] * v[j][3]; }
        s = wsum(s, lane); const float rinv = rsqrtf(s * (1.f / DM) + 1e-6f);
#pragma unroll
        for (int j = 0; j < 8; ++j) { const f32x4 gg = *(const f32x4*)(g + j * 256 + lane * 4); *(f32x4*)(p + j * 256 + lane * 4) = v[j] * rinv * gg; }
    }
}
__device__ __forceinline__ void t2_rows(const float* __restrict__ zA, const float* __restrict__ cs,
                                        const float* __restrict__ gq, const float* __restrict__ gkv, u16* __restrict__ qn, u16* __restrict__ kvn, u16* __restrict__ Kf, float* __restrict__ ssqB) {
    const int tid = TID(), lane = tid & 63, gw = blockIdx.x * (NTHR / 64) + (tid >> 6), nw = gridDim.x * (NTHR / 64);
    for (int row = gw; row < S; row += nw) {
        const float* zr = zA + (long)row * ZA;
        f32x4 v[2][2];
#pragma unroll
        for (int part = 0; part < 2; ++part) { v[part][0] = *(const f32x4*)(zr + part * 512 + lane * 4); v[part][1] = *(const f32x4*)(zr + part * 512 + 256 + lane * 4); }
        const int l32 = lane & 31;
        const float x1 = zr[1024 + l32], x2 = zr[1056 + l32], cc = cs[(long)row * 64 + l32], sn = cs[(long)row * 64 + 32 + l32];
        if (lane == 0) ssqB[row] = 0.f;
#pragma unroll
        for (int part = 0; part < 2; ++part) {
            const float* g = part ? gkv : gq; u16* dst = (part ? kvn : qn) + (long)row * 512;
            const f32x4 v0 = v[part][0], v1 = v[part][1];
            float s = v0[0] * v0[0] + v0[1] * v0[1] + v0[2] * v0[2] + v0[3] * v0[3] + v1[0] * v1[0] + v1[1] * v1[1] + v1[2] * v1[2] + v1[3] * v1[3];
            s = wsum(s, lane); const float rinv = rsqrtf(s * (1.f / 512.f) + 1e-6f);
            const f32x4 g0 = *(const f32x4*)(g + lane * 4), g1 = *(const f32x4*)(g + 256 + lane * 4);
            *(u32x2*)(dst + lane * 4) = (u32x2){pk2(v0[0] * rinv * g0[0], v0[1] * rinv * g0[1]), pk2(v0[2] * rinv * g0[2], v0[3] * rinv * g0[3])};
            *(u32x2*)(dst + 256 + lane * 4) = (u32x2){pk2(v1[0] * rinv * g1[0], v1[1] * rinv * g1[1]), pk2(v1[2] * rinv * g1[2], v1[3] * rinv * g1[3])};
        }
        if (lane < 32) { const unsigned w = pk2(x1 * cc - x2 * sn, x2 * cc + x1 * sn);
#pragma unroll
            for (int hh = 0; hh < NH; ++hh) *(unsigned*)(Kf + ((long)hh * S + row) * QD + NOPE + 2 * lane) = w; }
    }
}
__device__ __forceinline__ void t2_conv(const u16* __restrict__ zB, const float* __restrict__ cw, const float* __restrict__ cb, u16* __restrict__ xc) {
    const int tid = TID(), lane = tid & 63, gw = blockIdx.x * (NTHR / 64) + (tid >> 6), nw = gridDim.x * (NTHR / 64);
    for (int unit = gw; unit < (S / 32) * 8; unit += nw) {
        const int row0 = (unit >> 3) * 32, c = (unit & 7) * 256 + lane * 4;
        const f32x4 w0 = *(const f32x4*)(cw + c), w1 = *(const f32x4*)(cw + DM + c), w2 = *(const f32x4*)(cw + 2 * DM + c), w3 = *(const f32x4*)(cw + 3 * DM + c), bias = *(const f32x4*)(cb + c);
        const u16* up = zB + 2048 + c;
        u32x2 h0 = {0u, 0u}, h1 = {0u, 0u}, h2 = {0u, 0u};
        if (row0 > 0) { h0 = *(const u32x2*)(up + (long)(row0 - 3) * ZB); h1 = *(const u32x2*)(up + (long)(row0 - 2) * ZB); h2 = *(const u32x2*)(up + (long)(row0 - 1) * ZB); }
#define UF(w_, i_) ((i_) == 0 ? __uint_as_float((w_)[0] << 16) : (i_) == 1 ? __uint_as_float((w_)[0] & 0xffff0000u) : (i_) == 2 ? __uint_as_float((w_)[1] << 16) : __uint_as_float((w_)[1] & 0xffff0000u))
#pragma unroll 1
        for (int t0 = 0; t0 < 32; t0 += 8) { u32x2 cur[8];
#pragma unroll
            for (int t = 0; t < 8; ++t) cur[t] = *(const u32x2*)(up + (long)(row0 + t0 + t) * ZB);
#pragma unroll
            for (int t = 0; t < 8; ++t) { f32x4 y = bias;
#pragma unroll
                for (int i = 0; i < 4; ++i) y[i] += UF(h0, i) * w0[i] + UF(h1, i) * w1[i] + UF(h2, i) * w2[i] + UF(cur[t], i) * w3[i];
                *(u32x2*)(xc + (long)(row0 + t0 + t) * DM + c) = (u32x2){pk2(y[0], y[1]), pk2(y[2], y[3])};
                h0 = h1; h1 = h2; h2 = cur[t]; } }
#undef UF
    }
}
__device__ __forceinline__ void phase_t2(const Params& p, int l) {
    t2_rows(p.zA, p.cs, p.q_a_norm + l * 512, p.kv_a_norm + l * 512, p.qn, p.kvn, p.Kf, p.ssqB);
    t2_conv(p.zB, p.conv_w + (size_t)l * 4 * DM, p.conv_b + (size_t)l * DM, p.xc);
}
__device__ __forceinline__ void phase_scan1(const Params& p) {
    float* Pc = p.carry; float* Hc = p.carry + 128 * DM;
    for (long i = (long)blockIdx.x * NTHR + TID(); i < 128L * (DM / 2); i += (long)gridDim.x * NTHR) {
        const int c = (int)(i % (DM / 2)) * 2, ch = (int)(i / (DM / 2)); f32x2 P = {1.f, 1.f}, H = {0.f, 0.f};
        const float* pa = p.la + (long)ch * 64 * DM + c; const float* pb = p.lb + (long)ch * 64 * DM + c;
#pragma unroll 1
        for (int t0 = 0; t0 < 64; t0 += 16) { f32x2 a[16], b[16];
#pragma unroll
            for (int t = 0; t < 16; ++t) { a[t] = *(const f32x2*)(pa + (long)(t0 + t) * DM); b[t] = *(const f32x2*)(pb + (long)(t0 + t) * DM); }
#pragma unroll
            for (int t = 0; t < 16; ++t) { H = a[t] * H + b[t]; P = P * a[t]; } }
        *(f32x2*)(Pc + (long)ch * DM + c) = P; *(f32x2*)(Hc + (long)ch * DM + c) = H; }
}
__device__ __forceinline__ void scan3_rows(const float* __restrict__ Pc, const float* __restrict__ Hc, const float* __restrict__ la, const float* __restrict__ lb, const u16* __restrict__ zB,
                                           u16* __restrict__ OH, float* __restrict__ ssqA) {
    for (long i = (long)blockIdx.x * NTHR + TID(); i < 128L * (DM / 2); i += (long)gridDim.x * NTHR) {
        if (i < S) ssqA[i] = 0.f;
        const int c = (int)(i % (DM / 2)) * 2, ch = (int)(i / (DM / 2)); f32x2 H = {0.f, 0.f};
        int k = 0;
#pragma unroll 1
        for (; k + 16 <= ch; k += 16) { f32x2 a[16], b[16];
#pragma unroll
            for (int t = 0; t < 16; ++t) { a[t] = *(const f32x2*)(Pc + (long)(k + t) * DM + c); b[t] = *(const f32x2*)(Hc + (long)(k + t) * DM + c); }
#pragma unroll
            for (int t = 0; t < 16; ++t) H = a[t] * H + b[t]; }
        for (; k < ch; ++k) H = *(const f32x2*)(Pc + (long)k * DM + c) * H + *(const f32x2*)(Hc + (long)k * DM + c);
        const float* pa = la + (long)ch * 64 * DM + c; const float* pb = lb + (long)ch * 64 * DM + c;
        const u16* pg = zB + (long)ch * 64 * ZB + 4096 + c; u16* po = OH + (long)ch * 64 * 4096 + 2048 + c;
#pragma unroll
        for (int t0 = 0; t0 < 64; t0 += 16) { f32x2 a[16], b[16]; unsigned g[16];
#pragma unroll
            for (int t = 0; t < 16; ++t) { a[t] = *(const f32x2*)(pa + (long)(t0 + t) * DM); b[t] = *(const f32x2*)(pb + (long)(t0 + t) * DM); g[t] = *(const unsigned*)(pg + (long)(t0 + t) * ZB); }
#pragma unroll
            for (int t = 0; t < 16; ++t) { H = a[t] * H + b[t];
                *(unsigned*)(po + (long)(t0 + t) * 4096) = pk2(H[0] * __uint_as_float(g[t] << 16), H[1] * __uint_as_float(g[t] & 0xffff0000u)); } } }
}
__device__ __forceinline__ void phase_scan3(const Params& p) { scan3_rows(p.carry, p.carry + 128 * DM, p.la, p.lb, p.zB, p.OH, p.ssqA); }

typedef float f32x16 __attribute__((ext_vector_type(16)));
typedef short s16x4 __attribute__((ext_vector_type(4)));
constexpr int SHM_V = 64 * 128 * 2, SHM_K = 64 * 192 * 2, ATT_WS = 2 * SHM_V + 2 * SHM_K;
#define KSWZ(row, colB) ((row) * 384 + ((colB) ^ (((row) & 7) << 4)))
__device__ __forceinline__ int v_st(int k, int c) { const int kk = (k & ~0xC) | ((k & 4) << 1) | ((k & 8) >> 1); return ((kk >> 3) * 4 + (c >> 5)) * 512 + ((kk & 7) * 32 + (c & 31)) * 2; }
__device__ __forceinline__ int v_rd_base(int lane) { return ((lane & 3) << 3) | (((lane >> 2) & 3) << 6) | (((lane >> 4) & 1) << 5) | (((lane >> 5) & 1) << 8); }
constexpr int v_rd_off(int d0, int ks, int half) { return d0 * 512 + ks * 4096 + half * 2048; }
__device__ __forceinline__ int crow(int r, int hi) { return (r & 3) + 8 * (r >> 2) + 4 * hi; }
__device__ __forceinline__ unsigned cvtpk(float lo, float hi) { unsigned r; asm volatile("v_cvt_pk_bf16_f32 %0, %1, %2" : "=v"(r) : "v"(lo), "v"(hi)); return r; }

__device__ __forceinline__ void partialSM(f32x16& p0, f32x16& p1, float& m_reg, float& mn, float& alpha) {
    float pmax = p0[0];
#pragma unroll
    for (int r = 1; r < 16; ++r) pmax = fmaxf(pmax, p0[r]);
#pragma unroll
    for (int r = 0; r < 16; ++r) pmax = fmaxf(pmax, p1[r]);
    { auto rr = __builtin_amdgcn_permlane32_swap(__float_as_uint(pmax), __float_as_uint(pmax), false, false);
      pmax = fmaxf(__uint_as_float(rr[0]), __uint_as_float(rr[1])); }
    if (__builtin_expect(__all(pmax - m_reg <= 11.5f), 1)) { mn = m_reg; alpha = 1.f; }
    else { mn = fmaxf(m_reg, pmax); alpha = __builtin_amdgcn_exp2f(m_reg - mn); m_reg = mn; }
#pragma unroll
    for (int r = 0; r < 16; ++r) p0[r] = p0[r] - mn;
#pragma unroll
    for (int r = 0; r < 16; ++r) p1[r] = p1[r] - mn;
#pragma unroll
    for (int r = 0; r < 16; ++r) p0[r] = __builtin_amdgcn_exp2f(p0[r]);
}
__device__ __forceinline__ void finishSM(f32x16& p0, f32x16& p1, float alpha, float& l_reg, bf16x8& pa0, bf16x8& pa1, bf16x8& pa2, bf16x8& pa3) {
#pragma unroll
    for (int r = 0; r < 16; ++r) p1[r] = __builtin_amdgcn_exp2f(p1[r]);
    float ps = 0;
#pragma unroll
    for (int r = 0; r < 16; ++r) ps += p0[r];
#pragma unroll
    for (int r = 0; r < 16; ++r) ps += p1[r];
    { auto rr = __builtin_amdgcn_permlane32_swap(__float_as_uint(ps), __float_as_uint(ps), false, false);
      ps = __uint_as_float(rr[0]) + __uint_as_float(rr[1]); }
    l_reg = l_reg * alpha + ps;
#define PK4(P, B_, OUT) do { unsigned a0 = cvtpk(P[B_+0], P[B_+1]), a1 = cvtpk(P[B_+2], P[B_+3]);                          \
        unsigned b0 = cvtpk(P[B_+4], P[B_+5]), b1 = cvtpk(P[B_+6], P[B_+7]);                                             \
        auto r0 = __builtin_amdgcn_permlane32_swap(a0, b0, false, false); auto r1 = __builtin_amdgcn_permlane32_swap(a1, b1, false, false); \
        u32x4 w = {r0[0], r1[0], r0[1], r1[1]}; OUT = *reinterpret_cast<bf16x8*>(&w); } while (0)
    PK4(p0, 0, pa0); PK4(p0, 8, pa1); PK4(p1, 0, pa2); PK4(p1, 8, pa3);
#undef PK4
}
template <int KB>
__device__ __forceinline__ void qkt(f32x16& p0, f32x16& p1, LAS char* K_lds, int r32, int hi, const bf16x8* qr, bool act) {
    if (!act) { const float NEG = -__builtin_inff();
#pragma unroll
        for (int r = 0; r < 16; ++r) { p0[r] = NEG; p1[r] = NEG; } return; }
#pragma unroll
    for (int r = 0; r < 16; ++r) { p0[r] = 0.f; p1[r] = 0.f; }
    LAS char* kb[4];
#pragma unroll
    for (int dd = 0; dd < 4; ++dd) kb[dd] = K_lds + KB * SHM_K + KSWZ(r32, (dd * 16 + hi * 8) * 2);
#pragma unroll
    for (int d0 = 0; d0 < 12; ++d0) { LAS char* a = kb[d0 & 3] + (d0 >> 2) * 128;
        const bf16x8 b0 = *(const LAS bf16x8*)a;
        const bf16x8 b1 = *(const LAS bf16x8*)(a + 32 * 384);
        p0 = __builtin_amdgcn_mfma_f32_32x32x16_bf16(b0, qr[d0], p0, 0, 0, 0);
        p1 = __builtin_amdgcn_mfma_f32_32x32x16_bf16(b1, qr[d0], p1, 0, 0, 0); }
}
template <int VB>
__device__ __forceinline__ void pv_tile(f32x16* o, int vb0, bf16x8 pa0, bf16x8 pa1, bf16x8 pa2, bf16x8 pa3, bool act) {
    if (!act) return;
#define TRRD(dst, off) asm volatile("ds_read_b64_tr_b16 %0, %1 offset:%2" : "=&v"(dst) : "v"(vb0), "i"(off) : "memory")
#define PV_D0(d0) do { s16x4 l0, l1, l2, l3, h0, h1, h2, h3; constexpr int b_ = VB * SHM_V + v_rd_off(d0, 0, 0); \
        TRRD(l0, b_); TRRD(h0, b_ + 2048); TRRD(l1, b_ + 4096); TRRD(h1, b_ + 6144); TRRD(l2, b_ + 8192); TRRD(h2, b_ + 10240); TRRD(l3, b_ + 12288); TRRD(h3, b_ + 14336); \
        asm volatile("s_waitcnt lgkmcnt(0)" ::: "memory"); __builtin_amdgcn_sched_barrier(0); \
        o[d0] = __builtin_amdgcn_mfma_f32_32x32x16_bf16(pa0, (bf16x8){l0[0], l0[1], l0[2], l0[3], h0[0], h0[1], h0[2], h0[3]}, o[d0], 0, 0, 0);   \
        o[d0] = __builtin_amdgcn_mfma_f32_32x32x16_bf16(pa1, (bf16x8){l1[0], l1[1], l1[2], l1[3], h1[0], h1[1], h1[2], h1[3]}, o[d0], 0, 0, 0);   \
        o[d0] = __builtin_amdgcn_mfma_f32_32x32x16_bf16(pa2, (bf16x8){l2[0], l2[1], l2[2], l2[3], h2[0], h2[1], h2[2], h2[3]}, o[d0], 0, 0, 0);   \
        o[d0] = __builtin_amdgcn_mfma_f32_32x32x16_bf16(pa3, (bf16x8){l3[0], l3[1], l3[2], l3[3], h3[0], h3[1], h3[2], h3[3]}, o[d0], 0, 0, 0); } while (0)
    PV_D0(0); PV_D0(1); PV_D0(2); PV_D0(3);
#undef PV_D0
#undef TRRD
}

__device__ __forceinline__ void attn_block(char* lds, const u16* __restrict__ Qb, const u16* __restrict__ Kh, const u16* __restrict__ Vh,
                                           const u16* __restrict__ sg, u16* __restrict__ Ob, int P0) {
    const int tid = TID(), wid = __builtin_amdgcn_readfirstlane(tid >> 6), lane = tid & 63, r32 = lane & 31, hi = lane >> 5;
    const int NT = (P0 >> 6) + 4;
    const int wchunk = (P0 >> 6) + (wid >> 1);
    LAS char* L = (LAS char*)lds; LAS char* V_lds = L; LAS char* K_lds = L + 2 * SHM_V;
    LAS float* wsf = (LAS float*)(L + ATT_WS) + wid * 64; LAS float* li_l = wsf; LAS float* al_l = wsf + 32;
    float m_reg = -1e30f, l_reg = 0.f; f32x16 o[4];
#pragma unroll
    for (int d = 0; d < 4; ++d)
#pragma unroll
        for (int r = 0; r < 16; ++r) o[d][r] = 0.f;
    const int sr = tid >> 4, sc = (tid & 15) * 8, vst0 = v_st(sr, sc), vst1 = v_st(32 + sr, sc);
    const int kc0 = tid, kc1 = tid + 512, kc2 = tid + 1024;
    const int kws0 = KSWZ(kc0 / 24, (kc0 % 24) * 16), kws1 = KSWZ(kc1 / 24, (kc1 % 24) * 16), kws2 = KSWZ(kc2 / 24, (kc2 % 24) * 16);
    const int vb0 = (int)(unsigned)(uintptr_t)V_lds + v_rd_base(lane);
    bf16x8 qr[12];
#pragma unroll
    for (int d0 = 0; d0 < 12; ++d0) qr[d0] = *(const bf16x8*)(Qb + (long)(wid * 32 + r32) * NQ + d0 * 16 + hi * 8);
    bf16x8 st_k0, st_k1, st_k2, st_v0, st_v1;
#define VMW() asm volatile("s_waitcnt vmcnt(0)" ::: "memory")
#define SBAR() __builtin_amdgcn_sched_barrier(0)
#define SLOAD(t) do { const u16* kp_ = Kh + (long)(t) * 64 * QD + tid * 8; st_k0 = *(const bf16x8*)kp_; st_k1 = *(const bf16x8*)(kp_ + 4096); st_k2 = *(const bf16x8*)(kp_ + 8192); \
                      const u16* vp_ = Vh + ((long)(t) * 64 + sr) * VH + sc; st_v0 = *(const bf16x8*)vp_; st_v1 = *(const bf16x8*)(vp_ + 32 * VH); } while (0)
#define SWRITE(bf) do { *(LAS bf16x8*)(K_lds + (bf) * SHM_K + kws0) = st_k0; *(LAS bf16x8*)(K_lds + (bf) * SHM_K + kws1) = st_k1; *(LAS bf16x8*)(K_lds + (bf) * SHM_K + kws2) = st_k2; \
                        *(LAS bf16x8*)(V_lds + (bf) * SHM_V + vst0) = st_v0; *(LAS bf16x8*)(V_lds + (bf) * SHM_V + vst1) = st_v1; } while (0)
#define RESC(a) do { if (__any((a) < 1.f)) { if (hi == 0) al_l[r32] = (a); asm volatile("s_waitcnt lgkmcnt(0)" ::: "memory");              \
                     _Pragma("unroll") for (int d_ = 0; d_ < 4; ++d_) _Pragma("unroll") for (int r = 0; r < 16; ++r) o[d_][r] *= al_l[crow(r, hi)]; } } while (0)
#define ACT(t) ((t) <= wchunk)
    f32x16 pA0, pA1, pB0, pB1; float mnA, mnB, alA, alB; bf16x8 pa0, pa1, pa2, pa3;
    SLOAD(0); VMW(); SWRITE(0); SBAR();
    SLOAD(1);
    __syncthreads();
    SBAR(); qkt<0>(pA0, pA1, K_lds, r32, hi, qr, ACT(0));
    partialSM(pA0, pA1, m_reg, mnA, alA);
    VMW(); SWRITE(1);
    __syncthreads();
#define HALF_STEP(PX0, PX1, mnX, alX, PY0, PY1, alY, t, KB, VB, SB) do {                                                      \
        SBAR(); qkt<KB>(PX0, PX1, K_lds, r32, hi, qr, ACT(t));                                                                \
        finishSM(PY0, PY1, alY, l_reg, pa0, pa1, pa2, pa3); SBAR();                                                           \
        if ((t) + 1 < NT) { SLOAD((t) + 1); SBAR(); }                                                                          \
        pv_tile<VB>(o, vb0, pa0, pa1, pa2, pa3, ACT((t) - 1)); partialSM(PX0, PX1, m_reg, mnX, alX);                          \
        __syncthreads();                                                                                                      \
        if ((t) + 1 < NT) { VMW(); SWRITE(SB); }                                                                               \
        RESC(alX); __syncthreads(); } while (0)
    for (int t = 1; t + 1 < NT; t += 2) {
        HALF_STEP(pB0, pB1, mnB, alB, pA0, pA1, alA, t, 1, 0, 0);
        HALF_STEP(pA0, pA1, mnA, alA, pB0, pB1, alB, t + 1, 0, 1, 1);
    }
    SBAR(); qkt<1>(pB0, pB1, K_lds, r32, hi, qr, ACT(NT - 1)); SBAR();
    finishSM(pA0, pA1, alA, l_reg, pa0, pa1, pa2, pa3); SBAR();
    pv_tile<0>(o, vb0, pa0, pa1, pa2, pa3, ACT(NT - 2));
    partialSM(pB0, pB1, m_reg, mnB, alB); __syncthreads(); RESC(alB);
    finishSM(pB0, pB1, alB, l_reg, pa0, pa1, pa2, pa3); SBAR(); pv_tile<1>(o, vb0, pa0, pa1, pa2, pa3, ACT(NT - 1));
    SBAR();
    if (hi == 0) li_l[r32] = l_reg; asm volatile("s_waitcnt lgkmcnt(0)" ::: "memory");
    float rli[16];
#pragma unroll
    for (int r = 0; r < 16; ++r) rli[r] = __builtin_amdgcn_rcpf(li_l[crow(r, hi)]);
    const int jq = r32 & 3, colb = jq * 32 + (r32 & ~3);
    const bool b0 = (jq & 1) != 0, b1 = (jq & 2) != 0;
    u32x2 gg[16];
#pragma unroll
    for (int r = 0; r < 16; ++r) gg[r] = *(const u32x2*)(sg + (long)(wid * 32 + crow(r, hi)) * ZB + colb);
#define QSWAP1(v_) __int_as_float(__builtin_amdgcn_mov_dpp(__float_as_int(v_), 0xB1, 0xF, 0xF, true))
#define QSWAP2(v_) __int_as_float(__builtin_amdgcn_mov_dpp(__float_as_int(v_), 0x4E, 0xF, 0xF, true))
#pragma unroll
    for (int r = 0; r < 16; ++r) { const int orow = wid * 32 + crow(r, hi);
        float x0 = o[0][r] * rli[r], x1 = o[1][r] * rli[r], x2 = o[2][r] * rli[r], x3 = o[3][r] * rli[r];
        { const float r01 = QSWAP1(b0 ? x0 : x1), r23 = QSWAP1(b0 ? x2 : x3);
          const float n0 = b0 ? r01 : x0, n1 = b0 ? x1 : r01, n2 = b0 ? r23 : x2, n3 = b0 ? x3 : r23; x0 = n0; x1 = n1; x2 = n2; x3 = n3; }
        { const float r02 = QSWAP2(b1 ? x0 : x2), r13 = QSWAP2(b1 ? x1 : x3);
          const float n0 = b1 ? r02 : x0, n2 = b1 ? x2 : r02, n1 = b1 ? r13 : x1, n3 = b1 ? x3 : r13; x0 = n0; x1 = n1; x2 = n2; x3 = n3; }
        const u32x2 g = gg[r];
        *(u32x2*)(Ob + (long)orow * 4096 + colb) = (u32x2){cvtpk(x0 * __uint_as_float(g[0] << 16), x1 * __uint_as_float(g[0] & 0xffff0000u)), cvtpk(x2 * __uint_as_float(g[1] << 16), x3 * __uint_as_float(g[1] & 0xffff0000u))}; }
#undef QSWAP1
#undef QSWAP2
    __syncthreads();
#undef VMW
#undef SBAR
#undef SLOAD
#undef SWRITE
#undef RESC
#undef ACT
#undef HALF_STEP
}
__device__ __forceinline__ void phase_attention(const Params& p, char* lds) {
    for (int it = blockIdx.x; it < 256; it += gridDim.x) {
        const int xcd = it & 7, idx = it >> 3, hh = xcd * 2 + (idx >> 4), x = idx & 15;
        for (int half = 0; half < 2; ++half) { const int P0 = (half ? x : 31 - x) * 256;
            attn_block(lds, p.Q + (long)P0 * NQ + hh * QD, p.Kf + (long)hh * S * QD, p.Vf + (long)hh * S * VH, p.zB + (long)P0 * ZB + hh * VH, p.OH + (long)P0 * 4096 + hh * VH, P0); }
    }
}

#ifndef PROBE_MASK
#define PROBE_MASK 0
#endif
#if PROBE_MASK
#define TICK(cls) do { const unsigned long long now_ = __builtin_amdgcn_s_memrealtime(); if ((PROBE_MASK >> (cls)) & 1) t_acc += now_ - t_last; t_last = now_; } while (0)
#else
#define TICK(cls) do { } while (0)
#endif
__global__ __launch_bounds__(NTHR, 2) void mega(Params p) {
    extern __shared__ __attribute__((aligned(16))) char lds[];
    cg::grid_group grid = cg::this_grid();
    const int G = gridDim.x;
    volatile LAS unsigned* xbst = (volatile LAS unsigned*)((LAS char*)lds + 8 * HTB);
    if (TID() == 0) { xbst[0] = 0u; xbst[1] = 0u; xbst[2] = 0u; xbst[3] = 0u; }
    __syncthreads();
    if (blockIdx.x == 0) for (int i = TID(); i < XCD_BAR_WORDS; i += NTHR) p.bar[i] = 0u;
#if PROBE_MASK
    unsigned long long t_acc = 0, t_last = __builtin_amdgcn_s_memrealtime();
#endif
    phase_prologue(p, lds);
    phase_xb_ssq(p.x_in, p.hb, p.ssqA);
    grid.sync();
    const XcdBarrier xb = xcd_barrier_post(p.bar, xbst);
    TICK(0);
    for (int l = 0; l < DEPTH; ++l) {
        const int c = (int)blockIdx.x + opaque_zero();
        const float* xcur = l ? p.xr : p.x_in;
        { TileSched sc{p.hb, DM, p.Wt_in + (size_t)l * NIN * DM, DM, 32, NIN / 256, G, c}; EpiIn e{p.zB, p.zA, p.ssqA}; gemm_fast(lds, DM, DM, DM, sc, e); }
        xcd_barrier(xb); TICK(2);
        phase_t2(p, l);
        xcd_barrier(xb); TICK(3);
        { TileSched sc{p.qn, QL, p.Wt_q + (size_t)l * NQ * QL, QL, 32, NQ / 256, G, c}; EpiQ e{p.Q, p.cs}; gemm_fast(lds, QL, QL, QL, sc, e); }
        { TileSched sc{p.kvn, KVL, p.Wt_kv + (size_t)l * NKV * KVL, KVL, 32, NKV / 256, G, (c + 128) % G}; EpiKV e{p.Kf, p.Vf}; gemm_fast(lds, KVL, KVL, KVL, sc, e); }
        { LruSched sc{{p.xc, DM, p.Wt_lru + (size_t)l * LRUB * 65536, 256, 32, LRUB, G, c}}; EpiLru e{p.xc, p.b_rg + l * DM, p.b_ig + l * DM, p.nsp8 + l * DM, p.la, p.lb}; gemm_fast(lds, 256, DM, 256, sc, e); }
        xcd_barrier(xb); TICK(4);
        phase_scan1(p);
        phase_attention(p, lds);
        xcd_barrier(xb); TICK(5);
        phase_scan3(p);
        xcd_barrier(xb); TICK(6);
        { MergeSched sc{{p.OH, 4096, p.Wt_o + (size_t)l * DM * 4096, 4096, 32, 8, G, c}}; EpiMerge e{p.zB, p.mg}; gemm_fast(lds, DM, 4096, 4096, sc, e); }
        xcd_barrier(xb); TICK(7);
        { TileSched sc{p.mg, DM, p.Wt_out + (size_t)l * DM * DM, DM, 32, 8, G, c}; EpiOut e{xcur, p.xr, p.hb2, p.ssqB}; gemm_fast(lds, DM, DM, DM, sc, e); }
        { TileSched sc{p.pb + (size_t)l * S * PLE, PLE, p.Wt_ple + (size_t)l * DM * PLE, PLE, 32, 8, G, c}; EpiF32 e{p.pp, DM}; gemm_fast(lds, PLE, PLE, PLE, sc, e); }
        xcd_barrier(xb); TICK(8);
        { TileSched sc{p.hb2, DM, p.Wt_pg + (size_t)l * DM * DM, DM, 32, 8, G, c}; EpiPle e{p.xr, p.pp, p.ssqB, p.hb, p.ssqA}; gemm_fast(lds, DM, DM, DM, sc, e); }
        xcd_barrier(xb); TICK(9);
    }
    phase_final_norm(p.xr, p.final_norm);
#if PROBE_MASK
    __syncthreads();
    if (blockIdx.x == 0) { const float d = sqrtf((float)t_acc * 0.01f * 4.096e-8f);
        for (int j = 0; j < 8; ++j) p.xr[threadIdx.x * 8 + j] += d; }
#endif
}

constexpr size_t LDS_BYTES = 8 * HTB + 16;

extern "C" void kernel_launch(void* const* d_in, const int* in_sizes, int n_in, void* d_out, int out_size, void* d_ws, size_t ws_size, hipStream_t st) {
    Params p{};
    p.x_in = (const float*)d_in[0]; p.p_in = (const float*)d_in[1]; p.pos = (const int*)d_in[2];
    p.attn_norm = (const float*)d_in[3]; p.w_in = (const float*)d_in[4]; p.q_a_norm = (const float*)d_in[5]; p.w_q_b = (const float*)d_in[6];
    p.kv_a_norm = (const float*)d_in[7]; p.w_kv_b = (const float*)d_in[8]; p.conv_w = (const float*)d_in[9]; p.conv_b = (const float*)d_in[10];
    p.w_rg = (const float*)d_in[11]; p.b_rg = (const float*)d_in[12]; p.w_ig = (const float*)d_in[13]; p.b_ig = (const float*)d_in[14]; p.lam = (const float*)d_in[15];
    p.w_o_mla = (const float*)d_in[16]; p.w_o_lru = (const float*)d_in[17]; p.w_out = (const float*)d_in[18]; p.ple_norm = (const float*)d_in[19];
    p.w_ple_gate = (const float*)d_in[20]; p.w_ple = (const float*)d_in[21]; p.final_norm = (const float*)d_in[22];
    p.xr = (float*)d_out;
    char* w = (char*)d_ws; size_t off = 0;
    auto take = [&](size_t bytes) { char* r = w + off; off += (bytes + 255) & ~(size_t)255; return r; };
    p.Wt_in = (u16*)take((size_t)DEPTH * NIN * DM * 2); p.Wt_q = (u16*)take((size_t)DEPTH * NQ * QL * 2); p.Wt_kv = (u16*)take((size_t)DEPTH * NKV * KVL * 2);
    p.Wt_lru = (u16*)take((size_t)DEPTH * LRUB * 65536 * 2); p.Wt_o = (u16*)take((size_t)DEPTH * DM * 4096 * 2); p.Wt_out = (u16*)take((size_t)DEPTH * DM * DM * 2);
    p.Wt_pg = (u16*)take((size_t)DEPTH * DM * DM * 2); p.Wt_ple = (u16*)take((size_t)DEPTH * DM * PLE * 2);
    p.hb = (u16*)take((size_t)S * DM * 2); p.hb2 = (u16*)take((size_t)S * DM * 2); p.ssqA = (float*)take((size_t)S * 4); p.ssqB = (float*)take((size_t)S * 4); p.zB = (u16*)take((size_t)S * ZB * 2); p.zA = (float*)take((size_t)S * ZA * 4);
    p.qn = (u16*)take((size_t)S * QL * 2); p.kvn = (u16*)take((size_t)S * KVL * 2); p.Q = (u16*)take((size_t)S * NQ * 2);
    p.Kf = (u16*)take((size_t)NH * S * QD * 2); p.Vf = (u16*)take((size_t)NH * S * VH * 2); p.xc = (u16*)take((size_t)S * DM * 2);
    p.OH = (u16*)take((size_t)S * 4096 * 2); p.pb = (u16*)take((size_t)DEPTH * S * PLE * 2); p.cs = (float*)take((size_t)S * 64 * 4); p.carry = (float*)take((size_t)3 * 128 * DM * 4); p.nsp8 = (float*)take((size_t)DEPTH * DM * 4); p.bar = (unsigned*)take((size_t)XCD_BAR_WORDS * 4);
    p.la = (float*)take((size_t)S * DM * 4); p.lb = (float*)take((size_t)S * DM * 4); p.pp = (float*)take((size_t)S * DM * 4); p.mg = (u16*)take((size_t)S * DM * 2);
    if (off > ws_size) { fprintf(stderr, "workspace too small: need %zu have %zu\n", off, ws_size); return; }
    (void)hipFuncSetAttribute((const void*)mega, hipFuncAttributeMaxDynamicSharedMemorySize, (int)LDS_BYTES);
    int dev = 0, cus = 0; (void)hipGetDevice(&dev); (void)hipDeviceGetAttribute(&cus, hipDeviceAttributeMultiprocessorCount, dev);
    int per_cu = 0; (void)hipOccupancyMaxActiveBlocksPerMultiprocessor(&per_cu, mega, NTHR, LDS_BYTES);
    if (per_cu < 1 || cus < 1) { fprintf(stderr, "occupancy query failed\n"); return; }
    void* args[] = {&p};
    hipError_t e = hipLaunchCooperativeKernel((const void*)mega, dim3(cus), dim3(NTHR), args, LDS_BYTES, st);
    if (e != hipSuccess) fprintf(stderr, "cooperative launch failed: %s\n", hipGetErrorString(e));
}
```

```cpp
#include <hip/hip_runtime.h>
#include <hip/hip_cooperative_groups.h>
#include <cstdio>
#include <cstdint>
namespace cg = cooperative_groups;

constexpr int S = 8192, DM = 2048, DEPTH = 4, NH = 16, QL = 512, KVL = 512, NOPE = 128, ROPE = 64, VH = 128;
constexpr int INT = 11328, PLE = 256, LRUB = 16, LBD = 128;
constexpr int QD = 192, NQ = NH * QD  , NKV = NH * 256  ;
constexpr int NIN = 11520;
constexpr int ZB = 10240, ZA = 1280;
constexpr int NTHR = 512;
constexpr float QSCALE = 0.07216878364870322f * 1.4426950408889634f;

typedef unsigned short u16;
typedef short bf16x8 __attribute__((ext_vector_type(8)));
typedef float f32x4 __attribute__((ext_vector_type(4)));
typedef float f32x2 __attribute__((ext_vector_type(2)));
typedef unsigned u32x2 __attribute__((ext_vector_type(2)));
typedef unsigned u32x4 __attribute__((ext_vector_type(4)));

__device__ __forceinline__ u16 f2bf(float f) { unsigned u = __float_as_uint(f); u += 0x7FFFu + ((u >> 16) & 1u); return (u16)(u >> 16); }
__device__ __forceinline__ float bf2f(u16 b) { return __uint_as_float(((unsigned)b) << 16); }
__device__ __forceinline__ unsigned pk2(float lo, float hi) { unsigned r; asm volatile("v_cvt_pk_bf16_f32 %0, %1, %2" : "=v"(r) : "v"(lo), "v"(hi)); return r; }
__device__ __forceinline__ float sigmoidf_(float x) { return __builtin_amdgcn_rcpf(1.f + __builtin_amdgcn_exp2f(-1.4426950408889634f * x)); }
__device__ __forceinline__ float siluf_(float x) { return x * __builtin_amdgcn_rcpf(1.f + __builtin_amdgcn_exp2f(-1.4426950408889634f * x)); }
__device__ __forceinline__ int opaque_zero() { int z; asm volatile("s_mov_b32 %0, 0" : "=s"(z)); return z; }
#define TID() ((int)threadIdx.x + opaque_zero())
__device__ __forceinline__ float wsum(float s, int lane) { for (int off = 32; off; off >>= 1) s += __int_as_float(__builtin_amdgcn_ds_bpermute((lane ^ off) << 2, __float_as_int(s))); return s; }
__device__ __forceinline__ float wmax(float s, int lane) { for (int off = 32; off; off >>= 1) s = fmaxf(s, __int_as_float(__builtin_amdgcn_ds_bpermute((lane ^ off) << 2, __float_as_int(s)))); return s; }

struct Params {
    const float *x_in, *p_in; const int* pos;
    const float *attn_norm, *w_in, *q_a_norm, *w_q_b, *kv_a_norm, *w_kv_b, *conv_w, *conv_b, *w_rg, *b_rg, *w_ig, *b_ig, *lam, *w_o_mla, *w_o_lru, *w_out, *ple_norm, *w_ple_gate, *w_ple, *final_norm;
    float* xr;
    u16 *Wt_in, *Wt_q, *Wt_kv, *Wt_lru, *Wt_o, *Wt_out, *Wt_pg, *Wt_ple;
    u16 *hb, *hb2, *zB, *qn, *kvn, *Q, *Kf, *Vf, *xc, *OH, *mg, *pb, *Pm;
    float *zA, *la, *lb, *pp, *cs, *carry, *sc, *nsp8, *ssqA, *ssqB; unsigned* bar;
};

struct Unit { const u16* a; const u16* b; int pm, pn, aux; };

struct TileSched {
    const u16* A; long lda; const u16* B; long ldb; int nM, nN, G, c;
    __device__ __forceinline__ bool tile(int i, int& pm, int& pn) const {
        const int nwg = nM * nN; const long L = (long)i * G + c; if (L >= nwg) return false;
        int wgid = (int)L; { const int q = nwg / 8, r = nwg % 8, xcd = wgid % 8, off = wgid / 8; wgid = (xcd < r ? xcd * (q + 1) : r * (q + 1) + (xcd - r) * q) + off; }
        const int nig = 8 * nN, gid = wgid / nig, fm = gid * 8, gsz = (nM - fm) < 8 ? (nM - fm) : 8;
        pm = fm + ((wgid % nig) % gsz); pn = (wgid % nig) / gsz; return true;
    }
    __device__ __forceinline__ bool next(int i, Unit& u) const {
        if (!tile(i, u.pm, u.pn)) return false;
        u.a = A + (long)u.pm * 256 * lda; u.b = B + (long)u.pn * 256 * ldb; u.aux = 0; return true;
    }
};
struct LruSched : TileSched {
    __device__ __forceinline__ bool next(int i, Unit& u) const {
        if (!tile(i, u.pm, u.pn)) return false;
        u.a = A + (long)u.pm * 256 * lda + (u.pn >> 1) * 256; u.b = B + (long)u.pn * 65536; u.aux = 0; return true;
    }
};
struct MergeSched : TileSched {
    __device__ __forceinline__ bool next(int i, Unit& u) const {
        if (!tile(i >> 1, u.pm, u.pn)) return false;
        u.aux = i & 1; u.a = A + (long)u.pm * 256 * lda + u.aux * 2048; u.b = B + (long)u.pn * 256 * ldb + u.aux * 2048; return true;
    }
};
struct TriSched {
    const u16* A; long lda; const u16* B; long ldb; int G, c;
    __device__ __forceinline__ bool next(int i, Unit& u) const {
        int t = i * G + c; if (t >= 528) return false;
        int pm = 0; while (t >= pm + 1) { t -= pm + 1; ++pm; }
        u.pm = pm; u.pn = t; u.a = A + (long)pm * 256 * lda; u.b = B + (long)t * 256 * ldb; u.aux = 0; return true;
    }
};
struct RowSched {
    const u16* A; long lda; const u16* B; int G, c;
    __device__ __forceinline__ bool next(int i, Unit& u) const {
        const int t = i * G + c; if (t >= 32) return false;
        u.pm = 31 - t; u.pn = 0; u.a = A + (long)u.pm * 256 * lda; u.b = B; u.aux = 0; return true;
    }
};

template <class F>
__device__ __forceinline__ void epi_foreach(f32x4 (&acc)[2][2][4][2], const Unit& u, int wr, int wc, int fr, int fq, F f) {
    const int row0 = u.pm * 256 + wr * 64 + fr, col0 = u.pn * 256 + wc * 32 + 4 * fq;
#pragma unroll
    for (int ai = 0; ai < 2; ++ai)
#pragma unroll
        for (int m = 0; m < 4; ++m) {
#pragma unroll
            for (int bj = 0; bj < 2; ++bj)
#pragma unroll
                for (int n = 0; n < 2; ++n) f(row0 + ai * 128 + m * 16, col0 + bj * 128 + n * 16, acc[ai][bj][m][n]);
        }
}
template <int GM, class T, class LF, class F>
__device__ __forceinline__ void epi_foreach_ld(f32x4 (&acc)[2][2][4][2], const Unit& u, int wr, int wc, int fr, int fq, LF lf, F f) {
    const int row0 = u.pm * 256 + wr * 64 + fr, col0 = u.pn * 256 + wc * 32 + 4 * fq;
#pragma unroll
    for (int ai = 0; ai < 2; ++ai)
#pragma unroll
        for (int mg = 0; mg < 4; mg += GM) {
            T regs[GM][2][2];
#pragma unroll
            for (int m = 0; m < GM; ++m)
#pragma unroll
                for (int bj = 0; bj < 2; ++bj)
#pragma unroll
                    for (int n = 0; n < 2; ++n) regs[m][bj][n] = lf(row0 + ai * 128 + (mg + m) * 16, col0 + bj * 128 + n * 16);
#pragma unroll
            for (int m = 0; m < GM; ++m)
#pragma unroll
                for (int bj = 0; bj < 2; ++bj)
#pragma unroll
                    for (int n = 0; n < 2; ++n) f(row0 + ai * 128 + (mg + m) * 16, col0 + bj * 128 + n * 16, acc[ai][bj][mg + m][n], regs[m][bj][n]);
        }
}
template <class F>
__device__ __forceinline__ void epi_foreach8(f32x4 (&acc)[2][2][4][2], const Unit& u, int wr, int wc, int fr, int fq, F f) {
    const int row0 = u.pm * 256 + wr * 64 + fr, col0 = u.pn * 256 + wc * 32 + 8 * fq;
#pragma unroll
    for (int ai = 0; ai < 2; ++ai)
#pragma unroll
        for (int m = 0; m < 4; ++m)
#pragma unroll
            for (int bj = 0; bj < 2; ++bj) f(row0 + ai * 128 + m * 16, col0 + bj * 128, acc[ai][bj][m][0], acc[ai][bj][m][1]);
}
template <class T, class LF, class F>
__device__ __forceinline__ void epi_foreach8_ld(f32x4 (&acc)[2][2][4][2], const Unit& u, int wr, int wc, int fr, int fq, LF lf, F f) {
    const int row0 = u.pm * 256 + wr * 64 + fr, col0 = u.pn * 256 + wc * 32 + 8 * fq;
#pragma unroll
    for (int ai = 0; ai < 2; ++ai) {
        T regs[4][2];
#pragma unroll
        for (int m = 0; m < 4; ++m)
#pragma unroll
            for (int bj = 0; bj < 2; ++bj) regs[m][bj] = lf(row0 + ai * 128 + m * 16, col0 + bj * 128);
#pragma unroll
        for (int m = 0; m < 4; ++m)
#pragma unroll
            for (int bj = 0; bj < 2; ++bj) f(row0 + ai * 128 + m * 16, col0 + bj * 128, acc[ai][bj][m][0], acc[ai][bj][m][1], regs[m][bj]);
    }
}
__device__ __forceinline__ u32x4 pack8(const f32x4& a, const f32x4& b) { return (u32x4){pk2(a[0], a[1]), pk2(a[2], a[3]), pk2(b[0], b[1]), pk2(b[2], b[3])}; }
#define EPI_COMMON  __device__ __forceinline__ bool keep(const Unit&) const { return false; } __device__ __forceinline__ int klimit(const Unit&, int K) const { return K; }
#define EPI_SIG     __device__ __forceinline__ void operator()(f32x4 (&acc)[2][2][4][2], const Unit& u, int wr, int wc, int fr, int fq) const

__device__ __forceinline__ float rinv_of(float ss) { return rsqrtf(ss * (1.f / DM) + 1e-6f); }
struct EpiIn { EPI_COMMON u16* zB; float* zA; const float* ssq;
    EPI_SIG { const int seg = u.pn >> 3;
        const int row0 = u.pm * 256 + wr * 64 + fr, col0 = u.pn * 256 + wc * 32 + 8 * fq;
        float ri[2][4];
#pragma unroll
        for (int ai = 0; ai < 2; ++ai)
#pragma unroll
            for (int m = 0; m < 4; ++m) ri[ai][m] = ssq[row0 + ai * 128 + m * 16];
#pragma unroll
        for (int ai = 0; ai < 2; ++ai)
#pragma unroll
            for (int m = 0; m < 4; ++m) ri[ai][m] = rinv_of(ri[ai][m]);
        if (seg >= 5) {
#pragma unroll
            for (int ai = 0; ai < 2; ++ai)
#pragma unroll
                for (int m = 0; m < 4; ++m)
#pragma unroll
                    for (int bj = 0; bj < 2; ++bj) { const int row = row0 + ai * 128 + m * 16, col = col0 + bj * 128;
                        if (col < ZB + 1088) { float* d = zA + (long)row * ZA + (col - ZB); *(f32x4*)d = acc[ai][bj][m][0] * ri[ai][m]; *(f32x4*)(d + 4) = acc[ai][bj][m][1] * ri[ai][m]; } }
        } else { const bool sil = seg == 0 || seg == 2, ident = seg == 1;
#pragma unroll
            for (int ai = 0; ai < 2; ++ai)
#pragma unroll
                for (int m = 0; m < 4; ++m)
#pragma unroll
                    for (int bj = 0; bj < 2; ++bj) { const int row = row0 + ai * 128 + m * 16, col = col0 + bj * 128;
                        f32x4 o0 = acc[ai][bj][m][0] * ri[ai][m], o1 = acc[ai][bj][m][1] * ri[ai][m];
                        if (!ident) {
#pragma unroll
                            for (int e = 0; e < 4; ++e) { const float s0 = sigmoidf_(o0[e]), s1 = sigmoidf_(o1[e]); o0[e] = sil ? o0[e] * s0 : s0; o1[e] = sil ? o1[e] * s1 : s1; } }
                        *(u32x4*)(zB + (long)row * ZB + col) = (u32x4){pk2(o0[0], o0[1]), pk2(o0[2], o0[3]), pk2(o1[0], o1[1]), pk2(o1[2], o1[3])}; }
        }
    } };
struct CsT { f32x4 c, s; };
struct EpiQ { EPI_COMMON u16* Q; const float* cs;
    EPI_SIG { epi_foreach8_ld<CsT>(acc, u, wr, wc, fr, fq,
            [&](int row, int col) { const int d = col % QD; CsT t; t.c = (f32x4){1.f, 1.f, 1.f, 1.f}; t.s = (f32x4){0.f, 0.f, 0.f, 0.f};
                if (d >= NOPE) { const float* tp = cs + (long)row * 64 + ((d - NOPE) >> 1); t.c = *(const f32x4*)tp; t.s = *(const f32x4*)(tp + 32); }
                return t; },
            [&](int row, int col, f32x4& v0, f32x4& v1, const CsT& t) { f32x4 o0, o1;
                const int d = col % QD;
                if (d < NOPE) { o0 = v0 * QSCALE; o1 = v1 * QSCALE; }
                else { o0[0] = (v0[0] * t.c[0] - v0[1] * t.s[0]) * QSCALE; o0[1] = (v0[1] * t.c[0] + v0[0] * t.s[0]) * QSCALE;
                       o0[2] = (v0[2] * t.c[1] - v0[3] * t.s[1]) * QSCALE; o0[3] = (v0[3] * t.c[1] + v0[2] * t.s[1]) * QSCALE;
                       o1[0] = (v1[0] * t.c[2] - v1[1] * t.s[2]) * QSCALE; o1[1] = (v1[1] * t.c[2] + v1[0] * t.s[2]) * QSCALE;
                       o1[2] = (v1[2] * t.c[3] - v1[3] * t.s[3]) * QSCALE; o1[3] = (v1[3] * t.c[3] + v1[2] * t.s[3]) * QSCALE; }
                *(u32x4*)(Q + (long)row * NQ + col) = pack8(o0, o1); }); } };
struct EpiKV { EPI_COMMON u16* Kf; u16* Vf;
    EPI_SIG { epi_foreach8(acc, u, wr, wc, fr, fq, [&](int row, int col, f32x4& v0, f32x4& v1) {
            const int hh = col >> 8, j = col & 255;
            u16* dst = (j < 128) ? Kf + ((long)hh * S + row) * QD + j : Vf + ((long)hh * S + row) * VH + (j - 128);
            *(u32x4*)dst = pack8(v0, v1);
        }); } };
struct EpiLru { EPI_COMMON const u16* xc; const float *brg, *big, *nsp8; float *la, *lb;
    EPI_SIG {
        const int row0 = u.pm * 256 + wr * 64 + fr, col0 = u.pn * 256 + wc * 32 + 8 * fq;
        f32x4 cr[2], ci[2], cn[2];
#pragma unroll
        for (int bj = 0; bj < 2; ++bj) { const int ch = (col0 + bj * 128) >> 1; cr[bj] = *(const f32x4*)(brg + ch); ci[bj] = *(const f32x4*)(big + ch); cn[bj] = *(const f32x4*)(nsp8 + ch); }
#pragma unroll
        for (int ai = 0; ai < 2; ++ai) {
            u32x2 xw[4][2];
#pragma unroll
            for (int m = 0; m < 4; ++m)
#pragma unroll
                for (int bj = 0; bj < 2; ++bj) xw[m][bj] = *(const u32x2*)(xc + (long)(row0 + ai * 128 + m * 16) * DM + ((col0 + bj * 128) >> 1));
#pragma unroll
            for (int m = 0; m < 4; ++m)
#pragma unroll
                for (int bj = 0; bj < 2; ++bj) {
                    const long o = (long)(row0 + ai * 128 + m * 16) * DM + ((col0 + bj * 128) >> 1);
                    f32x4 av, bv;
#pragma unroll
                    for (int e = 0; e < 4; ++e) {
                        const f32x4 v = acc[ai][bj][m][e >> 1];
                        const float r = sigmoidf_(v[2 * (e & 1)] + cr[bj][e]), ii = sigmoidf_(v[2 * (e & 1) + 1] + ci[bj][e]);
                        const float lg = r * cn[bj][e], x2 = 2.f * lg;
                        const float a = __builtin_amdgcn_exp2f(1.4426950408889634f * lg);
                        const float em = (x2 > -0.25f) ? x2 * (1.f + x2 * (0.5f + x2 * (0.16666667f + x2 * (0.041666668f + x2 * 0.0083333338f)))) : (a * a - 1.f);
                        const unsigned w = xw[m][bj][e >> 1];
                        const float x = (e & 1) ? __uint_as_float(w & 0xffff0000u) : __uint_as_float(w << 16);
                        av[e] = a; bv[e] = __builtin_amdgcn_sqrtf(-em) * (ii * x); }
                    *(f32x4*)(la + o) = av; *(f32x4*)(lb + o) = bv; }
        }
    } };
struct SmSl { u32x4 sm, sl; };
__device__ __forceinline__ void unpack8(const u32x4& w, f32x4& a, f32x4& b) {
    a = (f32x4){__uint_as_float(w[0] << 16), __uint_as_float(w[0] & 0xffff0000u), __uint_as_float(w[1] << 16), __uint_as_float(w[1] & 0xffff0000u)};
    b = (f32x4){__uint_as_float(w[2] << 16), __uint_as_float(w[2] & 0xffff0000u), __uint_as_float(w[3] << 16), __uint_as_float(w[3] & 0xffff0000u)}; }
struct EpiMerge { const u16* zB; u16* mg;
    __device__ __forceinline__ bool keep(const Unit& u) const { return u.aux == 0; }
    __device__ __forceinline__ int klimit(const Unit&, int K) const { return K; }
    EPI_SIG { const int part = u.aux;
        epi_foreach8_ld<SmSl>(acc, u, wr, wc, fr, fq,
            [&](int row, int col) { SmSl t; t.sl = *(const u32x4*)(zB + (long)row * ZB + 8192 + col); t.sm = t.sl; if (part == 0) t.sm = *(const u32x4*)(zB + (long)row * ZB + 6144 + col); return t; },
            [&](int row, int col, f32x4& v0, f32x4& v1, const SmSl& t) {
            f32x4 l0, l1; unpack8(t.sl, l0, l1);
#pragma unroll
            for (int e = 0; e < 4; ++e) { l0[e] = fmaxf(l0[e], 1e-12f); l1[e] = fmaxf(l1[e], 1e-12f); }
            if (part == 0) { f32x4 m0, m1; unpack8(t.sm, m0, m1);
#pragma unroll
                for (int e = 0; e < 4; ++e) { v0[e] = v0[e] * m0[e] * __builtin_amdgcn_rcpf(l0[e]); v1[e] = v1[e] * m1[e] * __builtin_amdgcn_rcpf(l1[e]); }
            } else { *(u32x4*)(mg + (long)row * DM + col) = pack8(v0 * l0, v1 * l1); }
        }); } };
__device__ __forceinline__ void row_ssq_add(float sq, float* ssq, int row, int lane) {
    sq += __int_as_float(__builtin_amdgcn_ds_bpermute((lane ^ 16) << 2, __float_as_int(sq)));
    sq += __int_as_float(__builtin_amdgcn_ds_bpermute((lane ^ 32) << 2, __float_as_int(sq)));
    if (lane < 16) atomicAdd(ssq + row, sq);
}
struct EpiOut { EPI_COMMON const float* xold; float* xnew; u16* xb; float* ssq;
    EPI_SIG {
        const int row0 = u.pm * 256 + wr * 64 + fr, col0 = u.pn * 256 + wc * 32 + 8 * fq, lane = fq * 16 + fr;
#pragma unroll
        for (int ai = 0; ai < 2; ++ai) {
            f32x4 xo[4][2][2];
#pragma unroll
            for (int m = 0; m < 4; ++m)
#pragma unroll
                for (int bj = 0; bj < 2; ++bj) { const float* q = xold + (long)(row0 + ai * 128 + m * 16) * DM + col0 + bj * 128; xo[m][bj][0] = *(const f32x4*)q; xo[m][bj][1] = *(const f32x4*)(q + 4); }
#pragma unroll
            for (int m = 0; m < 4; ++m) { const int row = row0 + ai * 128 + m * 16; float sq = 0.f;
#pragma unroll
                for (int bj = 0; bj < 2; ++bj) { const f32x4 x0 = xo[m][bj][0] + acc[ai][bj][m][0], x1 = xo[m][bj][1] + acc[ai][bj][m][1]; const long idx = (long)row * DM + col0 + bj * 128;
                    *(f32x4*)(xnew + idx) = x0; *(f32x4*)(xnew + idx + 4) = x1; *(u32x4*)(xb + idx) = pack8(x0, x1);
                    sq += x0[0] * x0[0] + x0[1] * x0[1] + x0[2] * x0[2] + x0[3] * x0[3] + x1[0] * x1[0] + x1[1] * x1[1] + x1[2] * x1[2] + x1[3] * x1[3]; }
                row_ssq_add(sq, ssq, row, lane); }
        }
    } };
struct EpiF32 { EPI_COMMON float* C; long ldc;
    EPI_SIG { epi_foreach8(acc, u, wr, wc, fr, fq, [&](int row, int col, f32x4& v0, f32x4& v1) { float* d = C + (long)row * ldc + col; *(f32x4*)d = v0; *(f32x4*)(d + 4) = v1; }); } };
struct EpiPle { EPI_COMMON float* x; const float* pp; const float* ssq_in; u16* xb; float* ssq_out;
    EPI_SIG {
        const int row0 = u.pm * 256 + wr * 64 + fr, col0 = u.pn * 256 + wc * 32 + 8 * fq, lane = fq * 16 + fr;
#pragma unroll
        for (int ai = 0; ai < 2; ++ai)
#pragma unroll
            for (int mg = 0; mg < 4; mg += 2) {
                f32x4 xo[2][2][2], po[2][2][2]; float ss[2];
#pragma unroll
                for (int m = 0; m < 2; ++m) { const int row = row0 + ai * 128 + (mg + m) * 16; ss[m] = ssq_in[row];
#pragma unroll
                    for (int bj = 0; bj < 2; ++bj) { const long idx = (long)row * DM + col0 + bj * 128;
                        xo[m][bj][0] = *(const f32x4*)(x + idx); xo[m][bj][1] = *(const f32x4*)(x + idx + 4); po[m][bj][0] = *(const f32x4*)(pp + idx); po[m][bj][1] = *(const f32x4*)(pp + idx + 4); } }
#pragma unroll
                for (int m = 0; m < 2; ++m) { const int row = row0 + ai * 128 + (mg + m) * 16; const float ri = rinv_of(ss[m]); float sq = 0.f;
#pragma unroll
                    for (int bj = 0; bj < 2; ++bj) { f32x4 x0 = xo[m][bj][0], x1 = xo[m][bj][1]; const f32x4 v0 = acc[ai][bj][mg + m][0], v1 = acc[ai][bj][mg + m][1]; const long idx = (long)row * DM + col0 + bj * 128;
#pragma unroll
                        for (int e = 0; e < 4; ++e) { x0[e] += po[m][bj][0][e] * sigmoidf_(v0[e] * ri); x1[e] += po[m][bj][1][e] * sigmoidf_(v1[e] * ri); }
                        *(f32x4*)(x + idx) = x0; *(f32x4*)(x + idx + 4) = x1; *(u32x4*)(xb + idx) = pack8(x0, x1);
                        sq += x0[0] * x0[0] + x0[1] * x0[1] + x0[2] * x0[2] + x0[3] * x0[3] + x1[0] * x1[0] + x1[1] * x1[1] + x1[2] * x1[2] + x1[3] * x1[3]; }
                    row_ssq_add(sq, ssq_out, row, lane); }
            }
    } };

#define LAS __attribute__((address_space(3)))
constexpr int HTB = 128 * 64 * 2;
__device__ __forceinline__ int lds_byte(int r, int c) { const int st = (r >> 4) * 2 + (c >> 5), rr = r & 15, cc = c & 31, ob = rr * 64 + cc * 2; return st * 1024 + (ob ^ (((ob >> 9) & 1) << 5)); }
__device__ __forceinline__ void stage_rc(int b, int& R, int& C) { const int st = b / 1024, sb = b % 1024, swz = sb ^ (((sb >> 9) & 1) << 5); R = (st >> 1) * 16 + swz / 64; C = (st & 1) * 32 + (swz % 64) / 2; }

template <class Epi, class Sched>
__device__ __forceinline__ void gemm_fast(char* lds_, int K, long lda, long ldb, const Sched& S_, const Epi& E) {
    LAS unsigned char* lds = (LAS unsigned char*)lds_;
    const int tid = TID(), wid = __builtin_amdgcn_readfirstlane(tid >> 6), lane = tid & 63, wr = wid >> 2, wc = wid & 3, fr = lane & 15, fq = lane >> 4;
    const int nt = K / 64;
    unsigned voffA[2], voffB[2];
#pragma unroll
    for (int i = 0; i < 2; ++i) { int R, C; stage_rc(tid * 16 + i * 8192, R, C); voffA[i] = (unsigned)(R * lda + C) * 2u; voffB[i] = (unsigned)(R * ldb + C) * 2u; }
    const size_t kstep = 128;
    const size_t hstepA = (size_t)128 * lda * 2, hstepB = (size_t)128 * ldb * 2;
    const unsigned ldsw = (unsigned)wid * 1024u;
    const int aoff = lds_byte(wr * 64 + fr, fq * 8), boff = lds_byte(wc * 32 + fr, fq * 8);
#define G_SA(b, h) (((b) * 2 + (h)) * HTB)
#define G_SB(b, h) ((4 + (b) * 2 + (h)) * HTB)
#define G_STAGE(bufoff, gbase, voff) do { _Pragma("unroll") for (int _i = 0; _i < 2; ++_i) \
        __builtin_amdgcn_global_load_lds((const unsigned*)((const char*)(gbase) + (voff)[_i]), (LAS unsigned*)(lds + (bufoff) + ldsw + _i * 8192), 16, 0, 0); } while (0)
#define G_LDA(dst, b, h) do { _Pragma("unroll") for (int m = 0; m < 4; ++m) _Pragma("unroll") for (int k = 0; k < 2; ++k) dst[m][k] = *(const LAS bf16x8*)(lds + G_SA(b, h) + aoff + m * 2048 + k * 1024); } while (0)
#define G_LDB(dst, b, h) do { _Pragma("unroll") for (int n = 0; n < 2; ++n) _Pragma("unroll") for (int k = 0; k < 2; ++k) dst[n][k] = *(const LAS bf16x8*)(lds + G_SB(b, h) + boff + n * 2048 + k * 1024); } while (0)
#define G_MMA(ai, bj, At, Bt) do { __builtin_amdgcn_s_setprio(1); _Pragma("unroll") for (int m = 0; m < 4; ++m) _Pragma("unroll") for (int n = 0; n < 2; ++n) _Pragma("unroll") for (int k = 0; k < 2; ++k) \
        acc[ai][bj][m][n] = __builtin_amdgcn_mfma_f32_16x16x32_bf16(Bt[n][k], At[m][k], acc[ai][bj][m][n], 0, 0, 0); __builtin_amdgcn_s_setprio(0); } while (0)
#define G_WAIT_V(n) asm volatile("s_waitcnt vmcnt(" #n ")" ::: "memory")
#define G_WAIT_L(n) asm volatile("s_waitcnt lgkmcnt(" #n ")" ::: "memory")
#define G_BAR __builtin_amdgcn_s_barrier()
#define G_SCHED __builtin_amdgcn_sched_barrier(0)
    Unit cur, nxt; int ui = 0;
    if (!S_.next(0, cur)) return;
    f32x4 acc[2][2][4][2];
#pragma unroll
    for (int a = 0; a < 2; ++a)
#pragma unroll
        for (int b = 0; b < 2; ++b)
#pragma unroll
            for (int m = 0; m < 4; ++m)
#pragma unroll
                for (int n = 0; n < 2; ++n) acc[a][b][m][n] = (f32x4){0.f, 0.f, 0.f, 0.f};
    bf16x8 At[4][2], B0[2][2], B1[2][2];
    const char* cA = (const char*)cur.a; const char* cB = (const char*)cur.b;
    G_STAGE(G_SB(0, 0), cB, voffB); G_STAGE(G_SA(0, 0), cA, voffA); G_STAGE(G_SB(0, 1), cB + hstepB, voffB); G_STAGE(G_SA(0, 1), cA + hstepA, voffA);
    if (wr == 1) G_BAR;
    G_WAIT_V(4); G_BAR;
    G_STAGE(G_SB(1, 0), cB + kstep, voffB); G_STAGE(G_SA(1, 0), cA + kstep, voffA); G_STAGE(G_SB(1, 1), cB + hstepB + kstep, voffB);
    G_WAIT_V(6); G_BAR;
    for (;;) {
        const bool has_next = S_.next(ui + 1, nxt);
        const char* nA = has_next ? (const char*)nxt.a : cA; const char* nB = has_next ? (const char*)nxt.b : cB;
#pragma unroll 1
        for (int t = 0; t < nt; t += 2) {
            const bool last = (t == nt - 2);
            const char* a1 = cA + (size_t)(t + 1) * kstep;
            const char* a2 = last ? nA : cA + (size_t)(t + 2) * kstep; const char* b2 = last ? nB : cB + (size_t)(t + 2) * kstep;
            const char* a3 = a2 + kstep; const char* b3 = b2 + kstep;
            G_LDB(B0, 0, 0); G_SCHED; G_LDA(At, 0, 0); G_STAGE(G_SA(1, 1), a1 + hstepA, voffA);
            G_WAIT_L(8); G_BAR; G_WAIT_L(0); G_MMA(0, 0, At, B0); G_BAR; G_SCHED;
            G_LDB(B1, 0, 1); G_STAGE(G_SB(0, 0), b2, voffB);
            G_BAR; G_WAIT_L(0); G_MMA(0, 1, At, B1); G_BAR;
            G_LDA(At, 0, 1); G_STAGE(G_SA(0, 0), a2, voffA);
            G_BAR; G_WAIT_L(0); G_MMA(1, 0, At, B0); G_BAR; G_SCHED;
            G_STAGE(G_SB(0, 1), b2 + hstepB, voffB);
            G_WAIT_V(6); G_BAR; G_MMA(1, 1, At, B1); G_BAR;
            G_LDB(B0, 1, 0); G_SCHED; G_LDA(At, 1, 0); G_STAGE(G_SA(0, 1), a2 + hstepA, voffA);
            G_WAIT_L(8); G_BAR; G_WAIT_L(0); G_MMA(0, 0, At, B0); G_BAR; G_SCHED;
            G_LDB(B1, 1, 1); G_STAGE(G_SB(1, 0), b3, voffB);
            G_BAR; G_WAIT_L(0); G_MMA(0, 1, At, B1); G_BAR;
            G_LDA(At, 1, 1); G_STAGE(G_SA(1, 0), a3, voffA);
            G_BAR; G_WAIT_L(0); G_MMA(1, 0, At, B0); G_BAR; G_SCHED;
            G_STAGE(G_SB(1, 1), b3 + hstepB, voffB);
            G_WAIT_V(6); G_BAR; G_MMA(1, 1, At, B1); G_BAR;
        }
        { const int t2 = TID(), w2 = t2 >> 6, l2 = t2 & 63;
          E(acc, cur, w2 >> 2, w2 & 3, l2 & 15, l2 >> 4); }
        if (!has_next) break;
        if (!E.keep(cur)) {
#pragma unroll
            for (int a = 0; a < 2; ++a)
#pragma unroll
                for (int b = 0; b < 2; ++b)
#pragma unroll
                    for (int m = 0; m < 4; ++m)
#pragma unroll
                        for (int n = 0; n < 2; ++n) acc[a][b][m][n] = (f32x4){0.f, 0.f, 0.f, 0.f};
        }
        cur = nxt; cA = nA; cB = nB; ++ui;
    }
    G_WAIT_V(0);
    if (wr == 0) G_BAR;
    G_BAR;
#undef G_SA
#undef G_SB
#undef G_STAGE
#undef G_LDA
#undef G_LDB
#undef G_MMA
#undef G_WAIT_V
#undef G_WAIT_L
#undef G_BAR
#undef G_SCHED
}


#define XB_TMO      128
#define XB_XCNT(j)  (256  + 64 * (j))
#define XB_XSUB(j)  (1280 + 64 * (j))
#define XB_XGEN(j)  (2304 + 64 * (j))
#define XB_TOP      3328
#define XB_TOPGEN   3392
#define XCD_BAR_WORDS 3456
#define XB_SPIN_CAP (1u << 18)
__device__ __forceinline__ unsigned xb_ld(unsigned* p)              { return __hip_atomic_load(p, __ATOMIC_RELAXED, __HIP_MEMORY_SCOPE_AGENT); }
__device__ __forceinline__ unsigned xb_add(unsigned* p, unsigned v) { return __hip_atomic_fetch_add(p, v, __ATOMIC_RELAXED, __HIP_MEMORY_SCOPE_AGENT); }
__device__ __forceinline__ unsigned xb_xcc_id() { return (unsigned)__builtin_amdgcn_s_getreg((3 << 11) | 20) & 0xFu; }
#define XB_SPIN(cond, bar) do { unsigned _sp = 0; while (cond) { __builtin_amdgcn_s_sleep(1); \
    if ((++_sp & 255u) == 0u) { if (xb_ld(&(bar)[XB_TMO])) break; if (_sp > XB_SPIN_CAP) { atomicAdd(&(bar)[XB_TMO], 1u); break; } } } } while (0)
struct XcdBarrier { unsigned* bar; unsigned x; volatile LAS unsigned* st; };
__device__ __forceinline__ XcdBarrier xcd_barrier_post(unsigned* bar, volatile LAS unsigned* st) {
    XcdBarrier b; b.bar = bar; b.x = xb_xcc_id(); b.st = st;
    if (TID() == 0) (void)xb_add(&bar[XB_XCNT(b.x)], 1u);
    return b;
}
__device__ __forceinline__ void xcd_barrier_complete(unsigned* bar, unsigned x, unsigned& nloc, unsigned& nx) {
    const unsigned G = gridDim.x * gridDim.y * gridDim.z;
    unsigned sum, cnt, mine, sp = 0u;
    for (;;) {
        sum = 0u; cnt = 0u; mine = 0u;
#pragma unroll
        for (unsigned j = 0; j < 16; ++j) { const unsigned c = xb_ld(&bar[XB_XCNT(j)]); sum += c; cnt += (c > 0u) ? 1u : 0u; mine = (j == x) ? c : mine; }
        if (sum == G) break;
        __builtin_amdgcn_s_sleep(1);
        if ((++sp & 255u) == 0u) { if (xb_ld(&bar[XB_TMO])) break; if (sp > XB_SPIN_CAP) { atomicAdd(&bar[XB_TMO], 1u); break; } }
    }
    nloc = mine > 0u ? mine : 1u; nx = cnt > 0u ? cnt : 1u;
}
__device__ __forceinline__ void xcd_barrier(const XcdBarrier& b) {
    asm volatile("s_waitcnt vmcnt(0)" ::: "memory");
    __syncthreads();
    if (TID() == 0) {
        unsigned* bar = b.bar;
        __builtin_amdgcn_s_waitcnt(0);
        unsigned nloc = b.st[0], nx = b.st[1];
        if (nloc == 0u) { xcd_barrier_complete(bar, b.x, nloc, nx); b.st[0] = nloc; b.st[1] = nx; }
        const unsigned old = xb_add(&bar[XB_XSUB(b.x)], 1u);
        const unsigned gen = old / nloc;
        if (old + 1u == (gen + 1u) * nloc) {
            __builtin_amdgcn_fence(__ATOMIC_RELEASE, "agent");
            asm volatile("s_waitcnt vmcnt(0)" ::: "memory");
            const unsigned og = xb_add(&bar[XB_TOP], 1u);
            const unsigned tg = og / nx;
            if (og + 1u == (tg + 1u) * nx) xb_add(&bar[XB_TOPGEN], 1u);
            else XB_SPIN(xb_ld(&bar[XB_TOPGEN]) == tg, bar);
            __builtin_amdgcn_fence(__ATOMIC_ACQUIRE, "agent");
            xb_add(&bar[XB_XGEN(b.x)], 1u);
            asm volatile("s_waitcnt vmcnt(0)" ::: "memory");
        } else {
            XB_SPIN(xb_ld(&bar[XB_XGEN(b.x)]) == gen, bar);
            __builtin_amdgcn_fence(__ATOMIC_ACQUIRE, "agent");
            asm volatile("s_waitcnt vmcnt(0)" ::: "memory");
        }
    }
    __syncthreads();
}

struct TDesc { const float* src; const float* ks; u16* dst; long ldd; int N, coff, rm, tix; };
constexpr int TS_IN = (DM / 256) * (INT / 64), TS_Q = (QL / 256) * (NQ / 64), TS_KV = (KVL / 256) * (NKV / 64), TS_SQ = (DM / 256) * (DM / 64), TS_PLE = (PLE / 256) * (DM / 64);
constexpr int TS_LAYER = TS_IN + TS_Q + TS_KV + 4 * TS_SQ + TS_PLE, TS_TOTAL = DEPTH * TS_LAYER;
__device__ __forceinline__ TDesc tdesc(const Params& p, int g) {
    const int l = g / TS_LAYER; int r = g % TS_LAYER; TDesc d; d.ks = nullptr; d.coff = 0; d.rm = 0;
    if (r < TS_IN) { d.src = p.w_in + (size_t)l * DM * INT; d.N = INT; d.dst = p.Wt_in + (size_t)l * NIN * DM; d.ldd = DM; d.rm = 1; d.ks = p.attn_norm + l * DM; d.tix = r; return d; }
    r -= TS_IN;
    if (r < TS_Q) { d.src = p.w_q_b + (size_t)l * QL * NQ; d.N = NQ; d.dst = p.Wt_q + (size_t)l * NQ * QL; d.ldd = QL; d.rm = 2; d.tix = r; return d; }
    r -= TS_Q;
    if (r < TS_KV) { d.src = p.w_kv_b + (size_t)l * KVL * NKV; d.N = NKV; d.dst = p.Wt_kv + (size_t)l * NKV * KVL; d.ldd = KVL; d.rm = 3; d.tix = r; return d; }
    r -= TS_KV;
    if (r < TS_SQ) { d.src = p.w_o_mla + (size_t)l * DM * DM; d.N = DM; d.dst = p.Wt_o + (size_t)l * DM * 4096; d.ldd = 4096; d.rm = 3; d.tix = r; return d; }
    r -= TS_SQ;
    if (r < TS_SQ) { d.src = p.w_o_lru + (size_t)l * DM * DM; d.N = DM; d.dst = p.Wt_o + (size_t)l * DM * 4096; d.ldd = 4096; d.coff = 2048; d.rm = 3; d.tix = r; return d; }
    r -= TS_SQ;
    if (r < TS_SQ) { d.src = p.w_out + (size_t)l * DM * DM; d.N = DM; d.dst = p.Wt_out + (size_t)l * DM * DM; d.ldd = DM; d.rm = 3; d.tix = r; return d; }
    r -= TS_SQ;
    if (r < TS_SQ) { d.src = p.w_ple_gate + (size_t)l * DM * DM; d.N = DM; d.dst = p.Wt_pg + (size_t)l * DM * DM; d.ldd = DM; d.rm = 3; d.ks = p.ple_norm + l * DM; d.tix = r; return d; }
    r -= TS_SQ;
    d.src = p.w_ple + (size_t)l * PLE * DM; d.N = DM; d.dst = p.Wt_ple + (size_t)l * DM * PLE; d.ldd = PLE; d.rm = 3; d.tix = r; return d;
}
__device__ __forceinline__ int pslot(int r) { const int c = r & 31; return (r & ~31) + 16 * ((c >> 2) & 1) + ((c >> 3) << 2) + (c & 3); }
__device__ __forceinline__ int trowmap(int rm, int n) {
    if (rm == 1) return pslot(n >= 1088 ? n - 1088 : n + ZB);
    if (rm == 2) { const int hh = n / QD, d = n % QD; if (d < NOPE) return pslot(n); const int e = d - NOPE; return pslot(hh * QD + NOPE + ((e & 31) << 1) + (e >> 5)); }
    if (rm == 3) return pslot(n);
    return n;
}
__device__ __forceinline__ void transpose_all(const Params& p, char* lds) {
    u16 (*t)[72] = (u16(*)[72])lds;
    const int tid = TID(), k = tid >> 3, nn = (tid & 7) * 8, G = gridDim.x;
    f32x4 vA[4][2], vB[4][2];
#define TC_LOAD(v_, d_) do { const int tn_ = (d_).N / 64, k0_ = ((d_).tix / tn_) * 256, n0_ = ((d_).tix % tn_) * 64; _Pragma("unroll") for (int j = 0; j < 4; ++j) { \
        const float* p_ = (d_).src + (long)(k0_ + k + 64 * j) * (d_).N + n0_ + nn; v_[j][0] = *(const f32x4*)p_; v_[j][1] = *(const f32x4*)(p_ + 4); \
        if ((d_).ks) { const float g_ = (d_).ks[k0_ + k + 64 * j]; v_[j][0] = v_[j][0] * g_; v_[j][1] = v_[j][1] * g_; } } } while (0)
#define TC_LDSW(v_) do { _Pragma("unroll") for (int j = 0; j < 4; ++j) *(u32x4*)&t[k + 64 * j][nn ^ (((k >> 3) & 7) << 3)] = (u32x4){pk2(v_[j][0][0], v_[j][0][1]), pk2(v_[j][0][2], v_[j][0][3]), pk2(v_[j][1][0], v_[j][1][1]), pk2(v_[j][1][2], v_[j][1][3])}; } while (0)
#define TC_STORE(d_) do { const int tn_ = (d_).N / 64, k0_ = ((d_).tix / tn_) * 256, n0_ = ((d_).tix % tn_) * 64; const int n_ = tid >> 3, kk_ = (tid & 7) * 8; \
        u16* drow_ = (d_).dst + (long)trowmap((d_).rm, n0_ + n_) * (d_).ldd + (d_).coff + k0_ + kk_; \
        _Pragma("unroll") for (int j = 0; j < 4; ++j) { u32x4 o_; _Pragma("unroll") for (int e = 0; e < 4; ++e) o_[e] = (unsigned)t[64 * j + kk_ + 2 * e][n_ ^ kk_] | ((unsigned)t[64 * j + kk_ + 2 * e + 1][n_ ^ kk_] << 16); \
            *(u32x4*)(drow_ + 64 * j) = o_; } } while (0)
    int gA = blockIdx.x, gB = gA + G; TDesc dA, dB, dc;
    if (gA < TS_TOTAL) { dA = tdesc(p, gA); TC_LOAD(vA, dA); }
    if (gB < TS_TOTAL) { dB = tdesc(p, gB); TC_LOAD(vB, dB); }
    while (gA < TS_TOTAL) {
        TC_LDSW(vA); __syncthreads(); dc = dA; gA += 2 * G; if (gA < TS_TOTAL) { dA = tdesc(p, gA); TC_LOAD(vA, dA); } TC_STORE(dc); __syncthreads();
        if (gB >= TS_TOTAL) break;
        TC_LDSW(vB); __syncthreads(); dc = dB; gB += 2 * G; if (gB < TS_TOTAL) { dB = tdesc(p, gB); TC_LOAD(vB, dB); } TC_STORE(dc); __syncthreads();
    }
#undef TC_LOAD
#undef TC_LDSW
#undef TC_STORE
}

__device__ __forceinline__ void lru_fill_t(const Params& p, char* lds) {
    u16 (*t)[136] = (u16(*)[136])lds;
    const int tid = TID();
    for (int unit = blockIdx.x; unit < DEPTH * LRUB * 2; unit += gridDim.x) {
        const int g = unit & 1, blk = (unit >> 1) & 15, l = unit >> 5;
        const float* src = (g ? p.w_ig : p.w_rg) + ((size_t)l * LRUB + blk) * LBD * LBD;
        f32x4 v[8];
#pragma unroll
        for (int j = 0; j < 8; ++j) { const int idx = tid + NTHR * j; v[j] = *(const f32x4*)(src + (idx >> 5) * LBD + (idx & 31) * 4); }
#pragma unroll
        for (int j = 0; j < 8; ++j) { const int idx = tid + NTHR * j; *(u32x2*)&t[idx >> 5][(idx & 31) * 4] = (u32x2){pk2(v[j][0], v[j][1]), pk2(v[j][2], v[j][3])}; }
        __syncthreads();
        { const int cl = tid >> 2, kq = (tid & 3) * 32, o = 2 * cl + g, kbase = 128 * (blk & 1);
          u16* drow = p.Wt_lru + (((size_t)l * LRUB + blk) * 256 + pslot(o)) * 256;
#pragma unroll
          for (int j = 0; j < 4; ++j) { u32x4 w;
#pragma unroll
            for (int e = 0; e < 4; ++e) w[e] = (unsigned)t[kq + 8 * j + 2 * e][cl] | ((unsigned)t[kq + 8 * j + 2 * e + 1][cl] << 16);
            *(u32x4*)(drow + kbase + kq + 8 * j) = w; *(u32x4*)(drow + (128 - kbase) + kq + 8 * j) = (u32x4){0u, 0u, 0u, 0u}; } }
        __syncthreads();
    }
}
__device__ __forceinline__ void phase_prologue(const Params& p, char* lds) {
    const long gtid = (long)blockIdx.x * NTHR + TID(), gsz = (long)gridDim.x * NTHR;
    transpose_all(p, lds);
    for (long i = gtid; i < (long)DEPTH * (NIN - INT) * DM / 8; i += gsz) { const long per = (long)(NIN - INT) * DM / 8; const int l = (int)(i / per); const long r = i % per;
        *(u32x4*)(p.Wt_in + ((size_t)l * NIN + INT) * DM + r * 8) = (u32x4){0u, 0u, 0u, 0u}; }
    lru_fill_t(p, lds);
    for (long i = gtid; i < (long)DEPTH * S * PLE / 8; i += gsz) { const float* s = p.p_in + i * 8; const f32x4 v0 = *(const f32x4*)s, v1 = *(const f32x4*)(s + 4);
        *(u32x4*)(p.pb + i * 8) = (u32x4){pk2(v0[0], v0[1]), pk2(v0[2], v0[3]), pk2(v1[0], v1[1]), pk2(v1[2], v1[3])}; }
    for (long i = gtid; i < (long)DEPTH * DM; i += gsz) p.nsp8[i] = -8.f * log1pf(expf(-p.lam[i]));
    for (long i = gtid; i < (long)S * 32; i += gsz) { const int s = (int)(i >> 5), f = (int)(i & 31);
        const float inv = powf(10000.f, -(float)(2 * f) / 64.f), ang = (float)p.pos[s] * inv;
        p.cs[(long)s * 64 + f] = (float)cos((double)ang); p.cs[(long)s * 64 + 32 + f] = (float)sin((double)ang); }
}

__device__ __forceinline__ void phase_xb_ssq(const float* __restrict__ x, u16* __restrict__ out, float* __restrict__ ssq) {
    const int tid = TID(), lane = tid & 63, gw = blockIdx.x * (NTHR / 64) + (tid >> 6), nw = gridDim.x * (NTHR / 64);
    for (int row = gw; row < S; row += nw) {
        const float* p = x + (long)row * DM; f32x4 v[8]; float s = 0.f;
#pragma unroll
        for (int j = 0; j < 8; ++j) { v[j] = *(const f32x4*)(p + j * 256 + lane * 4); s += v[j][0] * v[j][0] + v[j][1] * v[j][1] + v[j][2] * v[j][2] + v[j][3] * v[j][3]; }
        s = wsum(s, lane);
#pragma unroll
        for (int j = 0; j < 8; ++j) *(u32x2*)(out + (long)row * DM + j * 256 + lane * 4) = (u32x2){pk2(v[j][0], v[j][1]), pk2(v[j][2], v[j][3])};
        if (lane == 0) ssq[row] = s;
    }
}
__device__ __forceinline__ void phase_final_norm(float* __restrict__ x, const float* __restrict__ g) {
    const int tid = TID(), lane = tid & 63, gw = blockIdx.x * (NTHR / 64) + (tid >> 6), nw = gridDim.x * (NTHR / 64);
    for (int row = gw; row < S; row += nw) {
        float* p = x + (long)row * DM; f32x4 v[8]; float s = 0.f;
#pragma unroll
        for (int j = 0; j < 8; ++j) { v[j] = *(const f32x4*)(p + j * 256 + lane * 4); s += v[j][0] * v[j][0] + v[j][1] * v[j][1] + v[j][2] * v[j][2] + v[j][3] * v[j][3]; }
        s = wsum(s, lane); const float rinv = rsqrtf(s * (1.f / DM) + 1e-6f);
#pragma unroll
        for (int j = 0; j < 8; ++j) { const f32x4 gg = *(const f32x4*)(g + j * 256 + lane * 4); *(f32x4*)(p + j * 256 + lane * 4) = v[j] * rinv * gg; }
    }
}
__device__ __forceinline__ void t2_rows(const float* __restrict__ zA, const float* __restrict__ cs,
                                        const float* __restrict__ gq, const float* __restrict__ gkv, u16* __restrict__ qn, u16* __restrict__ kvn, u16* __restrict__ Kf, float* __restrict__ ssqB) {
    const int tid = TID(), lane = tid & 63, gw = blockIdx.x * (NTHR / 64) + (tid >> 6), nw = gridDim.x * (NTHR / 64);
    for (int row = gw; row < S; row += nw) {
        const float* zr = zA + (long)row * ZA;
        f32x4 v[2][2];
#pragma unroll
        for (int part = 0; part < 2; ++part) { v[part][0] = *(const f32x4*)(zr + part * 512 + lane * 4); v[part][1] = *(const f32x4*)(zr + part * 512 + 256 + lane * 4); }
        const int l32 = lane & 31;
        const float x1 = zr[1024 + l32], x2 = zr[1056 + l32], cc = cs[(long)row * 64 + l32], sn = cs[(long)row * 64 + 32 + l32];
        if (lane == 0) ssqB[row] = 0.f;
#pragma unroll
        for (int part = 0; part < 2; ++part) {
            const float* g = part ? gkv : gq; u16* dst = (part ? kvn : qn) + (long)row * 512;
            const f32x4 v0 = v[part][0], v1 = v[part][1];
            float s = v0[0] * v0[0] + v0[1] * v0[1] + v0[2] * v0[2] + v0[3] * v0[3] + v1[0] * v1[0] + v1[1] * v1[1] + v1[2] * v1[2] + v1[3] * v1[3];
            s = wsum(s, lane); const float rinv = rsqrtf(s * (1.f / 512.f) + 1e-6f);
            const f32x4 g0 = *(const f32x4*)(g + lane * 4), g1 = *(const f32x4*)(g + 256 + lane * 4);
            *(u32x2*)(dst + lane * 4) = (u32x2){pk2(v0[0] * rinv * g0[0], v0[1] * rinv * g0[1]), pk2(v0[2] * rinv * g0[2], v0[3] * rinv * g0[3])};
            *(u32x2*)(dst + 256 + lane * 4) = (u32x2){pk2(v1[0] * rinv * g1[0], v1[1] * rinv * g1[1]), pk2(v1[2] * rinv * g1[2], v1[3] * rinv * g1[3])};
        }
        if (lane < 32) { const unsigned w = pk2(x1 * cc - x2 * sn, x2 * cc + x1 * sn);
#pragma unroll
            for (int hh = 0; hh < NH; ++hh) *(unsigned*)(Kf + ((long)hh * S + row) * QD + NOPE + 2 * lane) = w; }
    }
}
__device__ __forceinline__ void t2_conv(const u16* __restrict__ zB, const float* __restrict__ cw, const float* __restrict__ cb, u16* __restrict__ xc) {
    const int tid = TID(), lane = tid & 63, gw = blockIdx.x * (NTHR / 64) + (tid >> 6), nw = gridDim.x * (NTHR / 64);
    for (int unit = gw; unit < (S / 32) * 8; unit += nw) {
        const int row0 = (unit >> 3) * 32, c = (unit & 7) * 256 + lane * 4;
        const f32x4 w0 = *(const f32x4*)(cw + c), w1 = *(const f32x4*)(cw + DM + c), w2 = *(const f32x4*)(cw + 2 * DM + c), w3 = *(const f32x4*)(cw + 3 * DM + c), bias = *(const f32x4*)(cb + c);
        const u16* up = zB + 2048 + c;
        u32x2 h0 = {0u, 0u}, h1 = {0u, 0u}, h2 = {0u, 0u};
        if (row0 > 0) { h0 = *(const u32x2*)(up + (long)(row0 - 3) * ZB); h1 = *(const u32x2*)(up + (long)(row0 - 2) * ZB); h2 = *(const u32x2*)(up + (long)(row0 - 1) * ZB); }
#define UF(w_, i_) ((i_) == 0 ? __uint_as_float((w_)[0] << 16) : (i_) == 1 ? __uint_as_float((w_)[0] & 0xffff0000u) : (i_) == 2 ? __uint_as_float((w_)[1] << 16) : __uint_as_float((w_)[1] & 0xffff0000u))
#pragma unroll 1
        for (int t0 = 0; t0 < 32; t0 += 8) { u32x2 cur[8];
#pragma unroll
            for (int t = 0; t < 8; ++t) cur[t] = *(const u32x2*)(up + (long)(row0 + t0 + t) * ZB);
#pragma unroll
            for (int t = 0; t < 8; ++t) { f32x4 y = bias;
#pragma unroll
                for (int i = 0; i < 4; ++i) y[i] += UF(h0, i) * w0[i] + UF(h1, i) * w1[i] + UF(h2, i) * w2[i] + UF(cur[t], i) * w3[i];
                *(u32x2*)(xc + (long)(row0 + t0 + t) * DM + c) = (u32x2){pk2(y[0], y[1]), pk2(y[2], y[3])};
                h0 = h1; h1 = h2; h2 = cur[t]; } }
#undef UF
    }
}
__device__ __forceinline__ void phase_t2(const Params& p, int l) {
    t2_rows(p.zA, p.cs, p.q_a_norm + l * 512, p.kv_a_norm + l * 512, p.qn, p.kvn, p.Kf, p.ssqB);
    t2_conv(p.zB, p.conv_w + (size_t)l * 4 * DM, p.conv_b + (size_t)l * DM, p.xc);
}
__device__ __forceinline__ void phase_scan1(const Params& p) {
    float* Pc = p.carry; float* Hc = p.carry + 128 * DM;
    for (long i = (long)blockIdx.x * NTHR + TID(); i < 128L * (DM / 2); i += (long)gridDim.x * NTHR) {
        const int c = (int)(i % (DM / 2)) * 2, ch = (int)(i / (DM / 2)); f32x2 P = {1.f, 1.f}, H = {0.f, 0.f};
        const float* pa = p.la + (long)ch * 64 * DM + c; const float* pb = p.lb + (long)ch * 64 * DM + c;
#pragma unroll 1
        for (int t0 = 0; t0 < 64; t0 += 16) { f32x2 a[16], b[16];
#pragma unroll
            for (int t = 0; t < 16; ++t) { a[t] = *(const f32x2*)(pa + (long)(t0 + t) * DM); b[t] = *(const f32x2*)(pb + (long)(t0 + t) * DM); }
#pragma unroll
            for (int t = 0; t < 16; ++t) { H = a[t] * H + b[t]; P = P * a[t]; } }
        *(f32x2*)(Pc + (long)ch * DM + c) = P; *(f32x2*)(Hc + (long)ch * DM + c) = H; }
}
__device__ __forceinline__ void scan3_rows(const float* __restrict__ Pc, const float* __restrict__ Hc, const float* __restrict__ la, const float* __restrict__ lb, const u16* __restrict__ zB,
                                           u16* __restrict__ OH, float* __restrict__ ssqA) {
    for (long i = (long)blockIdx.x * NTHR + TID(); i < 128L * (DM / 2); i += (long)gridDim.x * NTHR) {
        if (i < S) ssqA[i] = 0.f;
        const int c = (int)(i % (DM / 2)) * 2, ch = (int)(i / (DM / 2)); f32x2 H = {0.f, 0.f};
        int k = 0;
#pragma unroll 1
        for (; k + 16 <= ch; k += 16) { f32x2 a[16], b[16];
#pragma unroll
            for (int t = 0; t < 16; ++t) { a[t] = *(const f32x2*)(Pc + (long)(k + t) * DM + c); b[t] = *(const f32x2*)(Hc + (long)(k + t) * DM + c); }
#pragma unroll
            for (int t = 0; t < 16; ++t) H = a[t] * H + b[t]; }
        for (; k < ch; ++k) H = *(const f32x2*)(Pc + (long)k * DM + c) * H + *(const f32x2*)(Hc + (long)k * DM + c);
        const float* pa = la + (long)ch * 64 * DM + c; const float* pb = lb + (long)ch * 64 * DM + c;
        const u16* pg = zB + (long)ch * 64 * ZB + 4096 + c; u16* po = OH + (long)ch * 64 * 4096 + 2048 + c;
#pragma unroll
        for (int t0 = 0; t0 < 64; t0 += 16) { f32x2 a[16], b[16]; unsigned g[16];
#pragma unroll
            for (int t = 0; t < 16; ++t) { a[t] = *(const f32x2*)(pa + (long)(t0 + t) * DM); b[t] = *(const f32x2*)(pb + (long)(t0 + t) * DM); g[t] = *(const unsigned*)(pg + (long)(t0 + t) * ZB); }
#pragma unroll
            for (int t = 0; t < 16; ++t) { H = a[t] * H + b[t];
                *(unsigned*)(po + (long)(t0 + t) * 4096) = pk2(H[0] * __uint_as_float(g[t] << 16), H[1] * __uint_as_float(g[t] & 0xffff0000u)); } } }
}
__device__ __forceinline__ void phase_scan3(const Params& p) { scan3_rows(p.carry, p.carry + 128 * DM, p.la, p.lb, p.zB, p.OH, p.ssqA); }

typedef float f32x16 __attribute__((ext_vector_type(16)));
typedef short s16x4 __attribute__((ext_vector_type(4)));
constexpr int SHM_V = 64 * 128 * 2, SHM_K = 64 * 192 * 2, ATT_WS = 2 * SHM_V + 2 * SHM_K;
#define KSWZ(row, colB) ((row) * 384 + ((colB) ^ (((row) & 7) << 4)))
__device__ __forceinline__ int v_st(int k, int c) { const int kk = (k & ~0xC) | ((k & 4) << 1) | ((k & 8) >> 1); return ((kk >> 3) * 4 + (c >> 5)) * 512 + ((kk & 7) * 32 + (c & 31)) * 2; }
__device__ __forceinline__ int v_rd_base(int lane) { return ((lane & 3) << 3) | (((lane >> 2) & 3) << 6) | (((lane >> 4) & 1) << 5) | (((lane >> 5) & 1) << 8); }
constexpr int v_rd_off(int d0, int ks, int half) { return d0 * 512 + ks * 4096 + half * 2048; }
__device__ __forceinline__ int crow(int r, int hi) { return (r & 3) + 8 * (r >> 2) + 4 * hi; }
__device__ __forceinline__ unsigned cvtpk(float lo, float hi) { unsigned r; asm volatile("v_cvt_pk_bf16_f32 %0, %1, %2" : "=v"(r) : "v"(lo), "v"(hi)); return r; }

__device__ __forceinline__ void partialSM(f32x16& p0, f32x16& p1, float& m_reg, float& mn, float& alpha) {
    float pmax = p0[0];
#pragma unroll
    for (int r = 1; r < 16; ++r) pmax = fmaxf(pmax, p0[r]);
#pragma unroll
    for (int r = 0; r < 16; ++r) pmax = fmaxf(pmax, p1[r]);
    { auto rr = __builtin_amdgcn_permlane32_swap(__float_as_uint(pmax), __float_as_uint(pmax), false, false);
      pmax = fmaxf(__uint_as_float(rr[0]), __uint_as_float(rr[1])); }
    if (__builtin_expect(__all(pmax - m_reg <= 11.5f), 1)) { mn = m_reg; alpha = 1.f; }
    else { mn = fmaxf(m_reg, pmax); alpha = __builtin_amdgcn_exp2f(m_reg - mn); m_reg = mn; }
#pragma unroll
    for (int r = 0; r < 16; ++r) p0[r] = p0[r] - mn;
#pragma unroll
    for (int r = 0; r < 16; ++r) p1[r] = p1[r] - mn;
#pragma unroll
    for (int r = 0; r < 16; ++r) p0[r] = __builtin_amdgcn_exp2f(p0[r]);
}
__device__ __forceinline__ void finishSM(f32x16& p0, f32x16& p1, float alpha, float& l_reg, bf16x8& pa0, bf16x8& pa1, bf16x8& pa2, bf16x8& pa3) {
#pragma unroll
    for (int r = 0; r < 16; ++r) p1[r] = __builtin_amdgcn_exp2f(p1[r]);
    float ps = 0;
#pragma unroll
    for (int r = 0; r < 16; ++r) ps += p0[r];
#pragma unroll
    for (int r = 0; r < 16; ++r) ps += p1[r];
    { auto rr = __builtin_amdgcn_permlane32_swap(__float_as_uint(ps), __float_as_uint(ps), false, false);
      ps = __uint_as_float(rr[0]) + __uint_as_float(rr[1]); }
    l_reg = l_reg * alpha + ps;
#define PK4(P, B_, OUT) do { unsigned a0 = cvtpk(P[B_+0], P[B_+1]), a1 = cvtpk(P[B_+2], P[B_+3]);                          \
        unsigned b0 = cvtpk(P[B_+4], P[B_+5]), b1 = cvtpk(P[B_+6], P[B_+7]);                                             \
        auto r0 = __builtin_amdgcn_permlane32_swap(a0, b0, false, false); auto r1 = __builtin_amdgcn_permlane32_swap(a1, b1, false, false); \
        u32x4 w = {r0[0], r1[0], r0[1], r1[1]}; OUT = *reinterpret_cast<bf16x8*>(&w); } while (0)
    PK4(p0, 0, pa0); PK4(p0, 8, pa1); PK4(p1, 0, pa2); PK4(p1, 8, pa3);
#undef PK4
}
template <int KB>
__device__ __forceinline__ void qkt(f32x16& p0, f32x16& p1, LAS char* K_lds, int r32, int hi, const bf16x8* qr, bool act) {
    if (!act) { const float NEG = -__builtin_inff();
#pragma unroll
        for (int r = 0; r < 16; ++r) { p0[r] = NEG; p1[r] = NEG; } return; }
#pragma unroll
    for (int r = 0; r < 16; ++r) { p0[r] = 0.f; p1[r] = 0.f; }
    LAS char* kb[4];
#pragma unroll
    for (int dd = 0; dd < 4; ++dd) kb[dd] = K_lds + KB * SHM_K + KSWZ(r32, (dd * 16 + hi * 8) * 2);
#pragma unroll
    for (int d0 = 0; d0 < 12; ++d0) { LAS char* a = kb[d0 & 3] + (d0 >> 2) * 128;
        const bf16x8 b0 = *(const LAS bf16x8*)a;
        const bf16x8 b1 = *(const LAS bf16x8*)(a + 32 * 384);
        p0 = __builtin_amdgcn_mfma_f32_32x32x16_bf16(b0, qr[d0], p0, 0, 0, 0);
        p1 = __builtin_amdgcn_mfma_f32_32x32x16_bf16(b1, qr[d0], p1, 0, 0, 0); }
}
template <int VB>
__device__ __forceinline__ void pv_tile(f32x16* o, int vb0, bf16x8 pa0, bf16x8 pa1, bf16x8 pa2, bf16x8 pa3, bool act) {
    if (!act) return;
#define TRRD(dst, off) asm volatile("ds_read_b64_tr_b16 %0, %1 offset:%2" : "=&v"(dst) : "v"(vb0), "i"(off) : "memory")
#define PV_D0(d0) do { s16x4 l0, l1, l2, l3, h0, h1, h2, h3; constexpr int b_ = VB * SHM_V + v_rd_off(d0, 0, 0); \
        TRRD(l0, b_); TRRD(h0, b_ + 2048); TRRD(l1, b_ + 4096); TRRD(h1, b_ + 6144); TRRD(l2, b_ + 8192); TRRD(h2, b_ + 10240); TRRD(l3, b_ + 12288); TRRD(h3, b_ + 14336); \
        asm volatile("s_waitcnt lgkmcnt(0)" ::: "memory"); __builtin_amdgcn_sched_barrier(0); \
        o[d0] = __builtin_amdgcn_mfma_f32_32x32x16_bf16(pa0, (bf16x8){l0[0], l0[1], l0[2], l0[3], h0[0], h0[1], h0[2], h0[3]}, o[d0], 0, 0, 0);   \
        o[d0] = __builtin_amdgcn_mfma_f32_32x32x16_bf16(pa1, (bf16x8){l1[0], l1[1], l1[2], l1[3], h1[0], h1[1], h1[2], h1[3]}, o[d0], 0, 0, 0);   \
        o[d0] = __builtin_amdgcn_mfma_f32_32x32x16_bf16(pa2, (bf16x8){l2[0], l2[1], l2[2], l2[3], h2[0], h2[1], h2[2], h2[3]}, o[d0], 0, 0, 0);   \
        o[d0] = __builtin_amdgcn_mfma_f32_32x32x16_bf16(pa3, (bf16x8){l3[0], l3[1], l3[2], l3[3], h3[0], h3[1], h3[2], h3[3]}, o[d0], 0, 0, 0); } while (0)
    PV_D0(0); PV_D0(1); PV_D0(2); PV_D0(3);
#undef PV_D0
#undef TRRD
}

__device__ __forceinline__ void attn_block(char* lds, const u16* __restrict__ Qb, const u16* __restrict__ Kh, const u16* __restrict__ Vh,
                                           const u16* __restrict__ sg, u16* __restrict__ Ob, int P0) {
    const int tid = TID(), wid = __builtin_amdgcn_readfirstlane(tid >> 6), lane = tid & 63, r32 = lane & 31, hi = lane >> 5;
    const int NT = (P0 >> 6) + 4;
    const int wchunk = (P0 >> 6) + (wid >> 1);
    LAS char* L = (LAS char*)lds; LAS char* V_lds = L; LAS char* K_lds = L + 2 * SHM_V;
    LAS float* wsf = (LAS float*)(L + ATT_WS) + wid * 64; LAS float* li_l = wsf; LAS float* al_l = wsf + 32;
    float m_reg = -1e30f, l_reg = 0.f; f32x16 o[4];
#pragma unroll
    for (int d = 0; d < 4; ++d)
#pragma unroll
        for (int r = 0; r < 16; ++r) o[d][r] = 0.f;
    const int sr = tid >> 4, sc = (tid & 15) * 8, vst0 = v_st(sr, sc), vst1 = v_st(32 + sr, sc);
    const int kc0 = tid, kc1 = tid + 512, kc2 = tid + 1024;
    const int kws0 = KSWZ(kc0 / 24, (kc0 % 24) * 16), kws1 = KSWZ(kc1 / 24, (kc1 % 24) * 16), kws2 = KSWZ(kc2 / 24, (kc2 % 24) * 16);
    const int vb0 = (int)(unsigned)(uintptr_t)V_lds + v_rd_base(lane);
    bf16x8 qr[12];
#pragma unroll
    for (int d0 = 0; d0 < 12; ++d0) qr[d0] = *(const bf16x8*)(Qb + (long)(wid * 32 + r32) * NQ + d0 * 16 + hi * 8);
    bf16x8 st_k0, st_k1, st_k2, st_v0, st_v1;
#define VMW() asm volatile("s_waitcnt vmcnt(0)" ::: "memory")
#define SBAR() __builtin_amdgcn_sched_barrier(0)
#define SLOAD(t) do { const u16* kp_ = Kh + (long)(t) * 64 * QD + tid * 8; st_k0 = *(const bf16x8*)kp_; st_k1 = *(const bf16x8*)(kp_ + 4096); st_k2 = *(const bf16x8*)(kp_ + 8192); \
                      const u16* vp_ = Vh + ((long)(t) * 64 + sr) * VH + sc; st_v0 = *(const bf16x8*)vp_; st_v1 = *(const bf16x8*)(vp_ + 32 * VH); } while (0)
#define SWRITE(bf) do { *(LAS bf16x8*)(K_lds + (bf) * SHM_K + kws0) = st_k0; *(LAS bf16x8*)(K_lds + (bf) * SHM_K + kws1) = st_k1; *(LAS bf16x8*)(K_lds + (bf) * SHM_K + kws2) = st_k2; \
                        *(LAS bf16x8*)(V_lds + (bf) * SHM_V + vst0) = st_v0; *(LAS bf16x8*)(V_lds + (bf) * SHM_V + vst1) = st_v1; } while (0)
#define RESC(a) do { if (__any((a) < 1.f)) { if (hi == 0) al_l[r32] = (a); asm volatile("s_waitcnt lgkmcnt(0)" ::: "memory");              \
                     _Pragma("unroll") for (int d_ = 0; d_ < 4; ++d_) _Pragma("unroll") for (int r = 0; r < 16; ++r) o[d_][r] *= al_l[crow(r, hi)]; } } while (0)
#define ACT(t) ((t) <= wchunk)
    f32x16 pA0, pA1, pB0, pB1; float mnA, mnB, alA, alB; bf16x8 pa0, pa1, pa2, pa3;
    SLOAD(0); VMW(); SWRITE(0); SBAR();
    SLOAD(1);
    __syncthreads();
    SBAR(); qkt<0>(pA0, pA1, K_lds, r32, hi, qr, ACT(0));
    partialSM(pA0, pA1, m_reg, mnA, alA);
    VMW(); SWRITE(1);
    __syncthreads();
#define HALF_STEP(PX0, PX1, mnX, alX, PY0, PY1, alY, t, KB, VB, SB) do {                                                      \
        SBAR(); qkt<KB>(PX0, PX1, K_lds, r32, hi, qr, ACT(t));                                                                \
        finishSM(PY0, PY1, alY, l_reg, pa0, pa1, pa2, pa3); SBAR();                                                           \
        if ((t) + 1 < NT) { SLOAD((t) + 1); SBAR(); }                                                                          \
        pv_tile<VB>(o, vb0, pa0, pa1, pa2, pa3, ACT((t) - 1)); partialSM(PX0, PX1, m_reg, mnX, alX);                          \
        __syncthreads();                                                                                                      \
        if ((t) + 1 < NT) { VMW(); SWRITE(SB); }                                                                               \
        RESC(alX); __syncthreads(); } while (0)
    for (int t = 1; t + 1 < NT; t += 2) {
        HALF_STEP(pB0, pB1, mnB, alB, pA0, pA1, alA, t, 1, 0, 0);
        HALF_STEP(pA0, pA1, mnA, alA, pB0, pB1, alB, t + 1, 0, 1, 1);
    }
    SBAR(); qkt<1>(pB0, pB1, K_lds, r32, hi, qr, ACT(NT - 1)); SBAR();
    finishSM(pA0, pA1, alA, l_reg, pa0, pa1, pa2, pa3); SBAR();
    pv_tile<0>(o, vb0, pa0, pa1, pa2, pa3, ACT(NT - 2));
    partialSM(pB0, pB1, m_reg, mnB, alB); __syncthreads(); RESC(alB);
    finishSM(pB0, pB1, alB, l_reg, pa0, pa1, pa2, pa3); SBAR(); pv_tile<1>(o, vb0, pa0, pa1, pa2, pa3, ACT(NT - 1));
    SBAR();
    if (hi == 0) li_l[r32] = l_reg; asm volatile("s_waitcnt lgkmcnt(0)" ::: "memory");
    float rli[16];
#pragma unroll
    for (int r = 0; r < 16; ++r) rli[r] = __builtin_amdgcn_rcpf(li_l[crow(r, hi)]);
    const int jq = r32 & 3, colb = jq * 32 + (r32 & ~3);
    const bool b0 = (jq & 1) != 0, b1 = (jq & 2) != 0;
    u32x2 gg[16];
#pragma unroll
    for (int r = 0; r < 16; ++r) gg[r] = *(const u32x2*)(sg + (long)(wid * 32 + crow(r, hi)) * ZB + colb);
#define QSWAP1(v_) __int_as_float(__builtin_amdgcn_mov_dpp(__float_as_int(v_), 0xB1, 0xF, 0xF, true))
#define QSWAP2(v_) __int_as_float(__builtin_amdgcn_mov_dpp(__float_as_int(v_), 0x4E, 0xF, 0xF, true))
#pragma unroll
    for (int r = 0; r < 16; ++r) { const int orow = wid * 32 + crow(r, hi);
        float x0 = o[0][r] * rli[r], x1 = o[1][r] * rli[r], x2 = o[2][r] * rli[r], x3 = o[3][r] * rli[r];
        { const float r01 = QSWAP1(b0 ? x0 : x1), r23 = QSWAP1(b0 ? x2 : x3);
          const float n0 = b0 ? r01 : x0, n1 = b0 ? x1 : r01, n2 = b0 ? r23 : x2, n3 = b0 ? x3 : r23; x0 = n0; x1 = n1; x2 = n2; x3 = n3; }
        { const float r02 = QSWAP2(b1 ? x0 : x2), r13 = QSWAP2(b1 ? x1 : x3);
          const float n0 = b1 ? r02 : x0, n2 = b1 ? x2 : r02, n1 = b1 ? r13 : x1, n3 = b1 ? x3 : r13; x0 = n0; x1 = n1; x2 = n2; x3 = n3; }
        const u32x2 g = gg[r];
        *(u32x2*)(Ob + (long)orow * 4096 + colb) = (u32x2){cvtpk(x0 * __uint_as_float(g[0] << 16), x1 * __uint_as_float(g[0] & 0xffff0000u)), cvtpk(x2 * __uint_as_float(g[1] << 16), x3 * __uint_as_float(g[1] & 0xffff0000u))}; }
#undef QSWAP1
#undef QSWAP2
    __syncthreads();
#undef VMW
#undef SBAR
#undef SLOAD
#undef SWRITE
#undef RESC
#undef ACT
#undef HALF_STEP
}
__device__ __forceinline__ void phase_attention(const Params& p, char* lds) {
    for (int it = blockIdx.x; it < 256; it += gridDim.x) {
        const int xcd = it & 7, idx = it >> 3, hh = xcd * 2 + (idx >> 4), x = idx & 15;
        for (int half = 0; half < 2; ++half) { const int P0 = (half ? x : 31 - x) * 256;
            attn_block(lds, p.Q + (long)P0 * NQ + hh * QD, p.Kf + (long)hh * S * QD, p.Vf + (long)hh * S * VH, p.zB + (long)P0 * ZB + hh * VH, p.OH + (long)P0 * 4096 + hh * VH, P0); }
    }
}

#ifndef PROBE_MASK
#define PROBE_MASK 0
#endif
#if PROBE_MASK
#define TICK(cls) do { const unsigned long long now_ = __builtin_amdgcn_s_memrealtime(); if ((PROBE_MASK >> (cls)) & 1) t_acc += now_ - t_last; t_last = now_; } while (0)
#else
#define TICK(cls) do { } while (0)
#endif
__global__ __launch_bounds__(NTHR, 2) void mega(Params p) {
    extern __shared__ __attribute__((aligned(16))) char lds[];
    cg::grid_group grid = cg::this_grid();
    const int G = gridDim.x;
    volatile LAS unsigned* xbst = (volatile LAS unsigned*)((LAS char*)lds + 8 * HTB);
    if (TID() == 0) { xbst[0] = 0u; xbst[1] = 0u; xbst[2] = 0u; xbst[3] = 0u; }
    __syncthreads();
    if (blockIdx.x == 0) for (int i = TID(); i < XCD_BAR_WORDS; i += NTHR) p.bar[i] = 0u;
#if PROBE_MASK
    unsigned long long t_acc = 0, t_last = __builtin_amdgcn_s_memrealtime();
#endif
    phase_prologue(p, lds);
    phase_xb_ssq(p.x_in, p.hb, p.ssqA);
    grid.sync();
    const XcdBarrier xb = xcd_barrier_post(p.bar, xbst);
    TICK(0);
    for (int l = 0; l < DEPTH; ++l) {
        const int c = (int)blockIdx.x + opaque_zero();
        const float* xcur = l ? p.xr : p.x_in;
        { TileSched sc{p.hb, DM, p.Wt_in + (size_t)l * NIN * DM, DM, 32, NIN / 256, G, c}; EpiIn e{p.zB, p.zA, p.ssqA}; gemm_fast(lds, DM, DM, DM, sc, e); }
        xcd_barrier(xb); TICK(2);
        phase_t2(p, l);
        xcd_barrier(xb); TICK(3);
        { TileSched sc{p.qn, QL, p.Wt_q + (size_t)l * NQ * QL, QL, 32, NQ / 256, G, c}; EpiQ e{p.Q, p.cs}; gemm_fast(lds, QL, QL, QL, sc, e); }
        { TileSched sc{p.kvn, KVL, p.Wt_kv + (size_t)l * NKV * KVL, KVL, 32, NKV / 256, G, (c + 128) % G}; EpiKV e{p.Kf, p.Vf}; gemm_fast(lds, KVL, KVL, KVL, sc, e); }
        { LruSched sc{{p.xc, DM, p.Wt_lru + (size_t)l * LRUB * 65536, 256, 32, LRUB, G, c}}; EpiLru e{p.xc, p.b_rg + l * DM, p.b_ig + l * DM, p.nsp8 + l * DM, p.la, p.lb}; gemm_fast(lds, 256, DM, 256, sc, e); }
        xcd_barrier(xb); TICK(4);
        phase_scan1(p);
        phase_attention(p, lds);
        xcd_barrier(xb); TICK(5);
        phase_scan3(p);
        xcd_barrier(xb); TICK(6);
        { MergeSched sc{{p.OH, 4096, p.Wt_o + (size_t)l * DM * 4096, 4096, 32, 8, G, c}}; EpiMerge e{p.zB, p.mg}; gemm_fast(lds, DM, 4096, 4096, sc, e); }
        xcd_barrier(xb); TICK(7);
        { TileSched sc{p.mg, DM, p.Wt_out + (size_t)l * DM * DM, DM, 32, 8, G, c}; EpiOut e{xcur, p.xr, p.hb2, p.ssqB}; gemm_fast(lds, DM, DM, DM, sc, e); }
        { TileSched sc{p.pb + (size_t)l * S * PLE, PLE, p.Wt_ple + (size_t)l * DM * PLE, PLE, 32, 8, G, c}; EpiF32 e{p.pp, DM}; gemm_fast(lds, PLE, PLE, PLE, sc, e); }
        xcd_barrier(xb); TICK(8);
        { TileSched sc{p.hb2, DM, p.Wt_pg + (size_t)l * DM * DM, DM, 32, 8, G, c}; EpiPle e{p.xr, p.pp, p.ssqB, p.hb, p.ssqA}; gemm_fast(lds, DM, DM, DM, sc, e); }
        xcd_barrier(xb); TICK(9);
    }
    phase_final_norm(p.xr, p.final_norm);
#if PROBE_MASK
    __syncthreads();
    if (blockIdx.x == 0) { const float d = sqrtf((float)t_acc * 0.01f * 4.096e-8f);
        for (int j = 0; j < 8; ++j) p.xr[threadIdx.x * 8 + j] += d; }
#endif
}

constexpr size_t LDS_BYTES = 8 * HTB + 16;

extern "C" void kernel_launch(void* const* d_in, const int* in_sizes, int n_in, void* d_out, int out_size, void* d_ws, size_t ws_size, hipStream_t st) {
    Params p{};
    p.x_in = (const float*)d_in[0]; p.p_in = (const float*)d_in[1]; p.pos = (const int*)d_in[2];
    p.attn_norm = (const float*)d_in[3]; p.w_in = (const float*)d_in[4]; p.q_a_norm = (const float*)d_in[5]; p.w_q_b = (const float*)d_in[6];
    p.kv_a_norm = (const float*)d_in[7]; p.w_kv_b = (const float*)d_in[8]; p.conv_w = (const float*)d_in[9]; p.conv_b = (const float*)d_in[10];
    p.w_rg = (const float*)d_in[11]; p.b_rg = (const float*)d_in[12]; p.w_ig = (const float*)d_in[13]; p.b_ig = (const float*)d_in[14]; p.lam = (const float*)d_in[15];
    p.w_o_mla = (const float*)d_in[16]; p.w_o_lru = (const float*)d_in[17]; p.w_out = (const float*)d_in[18]; p.ple_norm = (const float*)d_in[19];
    p.w_ple_gate = (const float*)d_in[20]; p.w_ple = (const float*)d_in[21]; p.final_norm = (const float*)d_in[22];
    p.xr = (float*)d_out;
    char* w = (char*)d_ws; size_t off = 0;
    auto take = [&](size_t bytes) { char* r = w + off; off += (bytes + 255) & ~(size_t)255; return r; };
    p.Wt_in = (u16*)take((size_t)DEPTH * NIN * DM * 2); p.Wt_q = (u16*)take((size_t)DEPTH * NQ * QL * 2); p.Wt_kv = (u16*)take((size_t)DEPTH * NKV * KVL * 2);
    p.Wt_lru = (u16*)take((size_t)DEPTH * LRUB * 65536 * 2); p.Wt_o = (u16*)take((size_t)DEPTH * DM * 4096 * 2); p.Wt_out = (u16*)take((size_t)DEPTH * DM * DM * 2);
    p.Wt_pg = (u16*)take((size_t)DEPTH * DM * DM * 2); p.Wt_ple = (u16*)take((size_t)DEPTH * DM * PLE * 2);
    p.hb = (u16*)take((size_t)S * DM * 2); p.hb2 = (u16*)take((size_t)S * DM * 2); p.ssqA = (float*)take((size_t)S * 4); p.ssqB = (float*)take((size_t)S * 4); p.zB = (u16*)take((size_t)S * ZB * 2); p.zA = (float*)take((size_t)S * ZA * 4);
    p.qn = (u16*)take((size_t)S * QL * 2); p.kvn = (u16*)take((size_t)S * KVL * 2); p.Q = (u16*)take((size_t)S * NQ * 2);
    p.Kf = (u16*)take((size_t)NH * S * QD * 2); p.Vf = (u16*)take((size_t)NH * S * VH * 2); p.xc = (u16*)take((size_t)S * DM * 2);
    p.OH = (u16*)take((size_t)S * 4096 * 2); p.pb = (u16*)take((size_t)DEPTH * S * PLE * 2); p.cs = (float*)take((size_t)S * 64 * 4); p.carry = (float*)take((size_t)3 * 128 * DM * 4); p.nsp8 = (float*)take((size_t)DEPTH * DM * 4); p.bar = (unsigned*)take((size_t)XCD_BAR_WORDS * 4);
    p.la = (float*)take((size_t)S * DM * 4); p.lb = (float*)take((size_t)S * DM * 4); p.pp = (float*)take((size_t)S * DM * 4); p.mg = (u16*)take((size_t)S * DM * 2);
    if (off > ws_size) { fprintf(stderr, "workspace too small: need %zu have %zu\n", off, ws_size); return; }
    (void)hipFuncSetAttribute((const void*)mega, hipFuncAttributeMaxDynamicSharedMemorySize, (int)LDS_BYTES);
    int dev = 0, cus = 0; (void)hipGetDevice(&dev); (void)hipDeviceGetAttribute(&cus, hipDeviceAttributeMultiprocessorCount, dev);
    int per_cu = 0; (void)hipOccupancyMaxActiveBlocksPerMultiprocessor(&per_cu, mega, NTHR, LDS_BYTES);
    if (per_cu < 1 || cus < 1) { fprintf(stderr, "occupancy query failed\n"); return; }
    void* args[] = {&p};
    hipError_t e = hipLaunchCooperativeKernel((const void*)mega, dim3(cus), dim3(NTHR), args, LDS_BYTES, st);
    if (e != hipSuccess) fprintf(stderr, "cooperative launch failed: %s\n", hipGetErrorString(e));
}
```
